# Optimizing an MI355X kernel written in HIP

```python
import math
import numpy as np
import jax
import jax.numpy as jnp
from jax import lax

D_MODEL = 1024
BATCH = 4
SEQ = 4096
DEPTH = 4

GRID_W = 64
CTX_LEN = 256
MIX_HALF = D_MODEL // 2
S5_GROUP = 16
S5_GROUPS = MIX_HALF // S5_GROUP
S5_STATE = 64
NA_HEAD_DIM = 64
NA_HEADS = MIX_HALF // NA_HEAD_DIM
NA_WIN_ROWS = 8
NA_WIN_COLS = 16
GLA_HEADS = 4
GLA_DK = MIX_HALF // (2 * GLA_HEADS)
GLA_DV = MIX_HALF // GLA_HEADS
GLA_QK = GLA_HEADS * GLA_DK
GLA_RANK = 16
GLA_TAU = 16.0
GLA_CHUNK = 64
DIFF_HEADS = 4
DIFF_DV = MIX_HALF // DIFF_HEADS
DIFF_DH = DIFF_DV // 2
DIFF_BLOCK = 128
N_GROUPS = 4
EXP_PER_GROUP = 8
N_EXPERTS = N_GROUPS * EXP_PER_GROUP
TOP_K = 2
D_EXPERT = D_MODEL // 4
ROPE_BASE = 10000.0
EPS = 1e-5
EVEN_SPLITS = (MIX_HALF, MIX_HALF, MIX_HALF, MIX_HALF)
ODD_SPLITS = (GLA_QK, GLA_QK, MIX_HALF, MIX_HALF, 2 * GLA_RANK, MIX_HALF, MIX_HALF, MIX_HALF)
EVEN_IN = sum(EVEN_SPLITS)
ODD_IN = sum(ODD_SPLITS)

kernel_name = 'hybrid_s5_natten_gla_diffattn_hmoe_dit'

F32 = jnp.float32


def _cuts(splits):
    return [int(v) for v in np.cumsum(splits)[:-1]]


def layer_norm(x, g, b):
    x32 = x.astype(F32)
    mu = jnp.mean(x32, -1, keepdims=True)
    var = jnp.mean(jnp.square(x32 - mu), -1, keepdims=True)
    return ((x32 - mu) * lax.rsqrt(var + EPS) * g.astype(F32) + b.astype(F32)).astype(x.dtype)


def rms_norm(x, g):
    x32 = x.astype(F32)
    return x32 * lax.rsqrt(jnp.mean(jnp.square(x32), -1, keepdims=True) + EPS) * g.astype(F32)


def s5_discretize(lam_re, lam_im, log_dt, b_re, b_im):
    lam_re, lam_im = lam_re.astype(F32), lam_im.astype(F32)
    dt = jnp.exp(log_dt.astype(F32))[:, None]
    mag = jnp.exp(lam_re * dt)
    a_re = mag * jnp.cos(lam_im * dt)
    a_im = mag * jnp.sin(lam_im * dt)
    den = lam_re * lam_re + lam_im * lam_im
    f_re = ((a_re - 1.0) * lam_re + a_im * lam_im) / den
    f_im = (a_im * lam_re - (a_re - 1.0) * lam_im) / den
    b_re, b_im = b_re.astype(F32), b_im.astype(F32)
    bb_re = f_re[..., None] * b_re - f_im[..., None] * b_im
    bb_im = f_re[..., None] * b_im + f_im[..., None] * b_re
    return a_re, a_im, bb_re, bb_im


def _complex_linear_combine(e1, e2):
    a1r, a1i, b1r, b1i = e1
    a2r, a2i, b2r, b2i = e2
    return (a1r * a2r - a1i * a2i, a1r * a2i + a1i * a2r,
            a2r * b1r - a2i * b1i + b2r, a2r * b1i + a2i * b1r + b2i)


def s5_scan(u, a_re, a_im, bb_re, bb_im, h0, reverse):
    bu_re = jnp.einsum('btgh,gph->btgp', u, bb_re)
    bu_im = jnp.einsum('btgh,gph->btgp', u, bb_im)
    if h0 is not None:
        idx = -1 if reverse else 0
        h0_re, h0_im = h0
        bu_re = bu_re.at[:, idx].add(a_re * h0_re - a_im * h0_im)
        bu_im = bu_im.at[:, idx].add(a_re * h0_im + a_im * h0_re)
    shape = (1, u.shape[1]) + a_re.shape
    elems = (jnp.broadcast_to(a_re, shape), jnp.broadcast_to(a_im, shape), bu_re, bu_im)
    _, _, h_re, h_im = lax.associative_scan(_complex_linear_combine, elems, reverse=reverse, axis=1)
    return h_re, h_im


def s5_readout(h_re, h_im, c_re, c_im):
    return (jnp.einsum('btgp,ghp->btgh', h_re, c_re.astype(F32))
            - jnp.einsum('btgp,ghp->btgh', h_im, c_im.astype(F32)))


def s5_mixer(u_c, u_l, lam_re, lam_im, log_dt, b_re, b_im, c_re, c_im, d_skip, glu_w, glu_b, need_ctx):
    grp = lambda u: u.astype(F32).reshape(u.shape[0], u.shape[1], S5_GROUPS, S5_GROUP)
    uc, ul = grp(u_c), grp(u_l)
    d = d_skip.astype(F32).reshape(S5_GROUPS, S5_GROUP)
    y_l = d * ul
    y_c = d * uc if need_ctx else None
    for direction in range(2):
        rev = direction == 1
        a_re, a_im, bb_re, bb_im = s5_discretize(lam_re[direction], lam_im[direction], log_dt[direction],
                                                 b_re[direction], b_im[direction])
        hc_re, hc_im = s5_scan(uc, a_re, a_im, bb_re, bb_im, None, rev)
        end = 0 if rev else -1
        hl_re, hl_im = s5_scan(ul, a_re, a_im, bb_re, bb_im, (hc_re[:, end], hc_im[:, end]), rev)
        y_l = y_l + s5_readout(hl_re, hl_im, c_re[direction], c_im[direction])
        if need_ctx:
            y_c = y_c + s5_readout(hc_re, hc_im, c_re[direction], c_im[direction])

    def glu(y):
        z = jax.nn.gelu(y.reshape(y.shape[0], y.shape[1], MIX_HALF))
        val, gate = jnp.split(z @ glu_w.astype(F32) + glu_b.astype(F32), 2, axis=-1)
        return (val * jax.nn.sigmoid(gate)).astype(u_l.dtype)

    return (glu(y_c) if need_ctx else None), glu(y_l)


def natten_mixer(q_c, k_c, v_c, q_l, k_l, v_l, rpb, need_ctx):
    b, t, _ = q_l.shape
    rows = t // GRID_W
    wr = min(NA_WIN_ROWS, rows)
    wc = NA_WIN_COLS
    nk = wr * wc
    scale = NA_HEAD_DIM ** -0.5
    heads = lambda z: z.reshape(z.shape[0], z.shape[1], NA_HEADS, NA_HEAD_DIM).transpose(0, 2, 1, 3)
    kc, vc = heads(k_c), heads(v_c)
    grid = lambda z: heads(z).reshape(b, NA_HEADS, rows, GRID_W, NA_HEAD_DIM)
    qg, kg, vg = grid(q_l * scale), grid(k_l), grid(v_l)
    col_start = np.clip(np.arange(GRID_W) - wc // 2, 0, GRID_W - wc)
    col_idx = col_start[:, None] + np.arange(wc)[None, :]
    dc_idx = col_idx - np.arange(GRID_W)[:, None] + (NA_WIN_COLS - 1)

    def row_block(r):
        rs = jnp.clip(r - wr // 2, 0, rows - wr)
        q_row = lax.dynamic_index_in_dim(qg, r, axis=2, keepdims=False)
        k_rows = lax.dynamic_slice_in_dim(kg, rs, wr, axis=2)
        v_rows = lax.dynamic_slice_in_dim(vg, rs, wr, axis=2)
        k_win = k_rows[:, :, :, col_idx].transpose(0, 1, 3, 2, 4, 5).reshape(b, NA_HEADS, GRID_W, nk, NA_HEAD_DIM)
        v_win = v_rows[:, :, :, col_idx].transpose(0, 1, 3, 2, 4, 5).reshape(b, NA_HEADS, GRID_W, nk, NA_HEAD_DIM)
        dr_idx = rs + jnp.arange(wr) - r + (NA_WIN_ROWS - 1)
        bias = rpb[:, dr_idx[:, None, None], dc_idx[None, :, :]]
        bias = bias.transpose(0, 2, 1, 3).reshape(NA_HEADS, GRID_W, nk).astype(F32)
        s_loc = jnp.einsum('bhwd,bhwkd->bhwk', q_row, k_win).astype(F32) + bias
        s_ctx = jnp.einsum('bhwd,bhcd->bhwc', q_row, kc).astype(F32)
        p = jax.nn.softmax(jnp.concatenate([s_loc, s_ctx], axis=-1), axis=-1).astype(v_l.dtype)
        return (jnp.einsum('bhwk,bhwkd->bhwd', p[..., :nk], v_win)
                + jnp.einsum('bhwc,bhcd->bhwd', p[..., nk:], vc))

    o = lax.map(row_block, jnp.arange(rows))
    y_l = o.transpose(1, 0, 3, 2, 4).reshape(b, t, MIX_HALF)
    y_c = None
    if need_ctx:
        qc = heads(q_c * scale)
        p = jax.nn.softmax(jnp.einsum('bhqd,bhkd->bhqk', qc, kc).astype(F32), axis=-1).astype(v_c.dtype)
        y_c = jnp.einsum('bhqk,bhkd->bhqd', p, vc).transpose(0, 2, 1, 3).reshape(b, q_c.shape[1], MIX_HALF)
    return y_c, y_l


def even_mixer(a_c, a_l, w_in, w_out, lam_re, lam_im, log_dt, b_re, b_im, c_re, c_im, d_skip,
               glu_w, glu_b, rpb, need_ctx):
    u_c, q_c, k_c, v_c = jnp.split(a_c @ w_in, _cuts(EVEN_SPLITS), axis=-1)
    u_l, q_l, k_l, v_l = jnp.split(a_l @ w_in, _cuts(EVEN_SPLITS), axis=-1)
    s_c, s_l = s5_mixer(u_c, u_l, lam_re, lam_im, log_dt, b_re, b_im, c_re, c_im, d_skip, glu_w, glu_b, need_ctx)
    n_c, n_l = natten_mixer(q_c, k_c, v_c, q_l, k_l, v_l, rpb, need_ctx)
    y_l = jnp.concatenate([s_l, n_l], axis=-1) @ w_out
    y_c = jnp.concatenate([s_c, n_c], axis=-1) @ w_out if need_ctx else None
    return y_c, y_l


def gla_chunked(q, k, v, g, s0, need_out):
    b, h, t, dk = q.shape
    dv = v.shape[-1]
    n = t // GLA_CHUNK
    blk = lambda z: z.reshape(b, h, n, GLA_CHUNK, z.shape[-1])
    q, k, v, g = blk(q), blk(k), blk(v), blk(g)
    gc = jnp.cumsum(g, axis=3)
    g_end = gc[:, :, :, -1:, :]
    u = jnp.einsum('bhncd,bhncv->bhndv', k * jnp.exp(g_end - gc), v)
    decay = jnp.exp(g_end[:, :, :, 0, :])
    if s0 is None:
        s0 = jnp.zeros((b, h, dk, dv), q.dtype)

    def step(s, inp):
        dec, un = inp
        return dec[..., None] * s + un, s

    s_fin, s_prev = lax.scan(step, s0, (jnp.moveaxis(decay, 2, 0), jnp.moveaxis(u, 2, 0)))
    if not need_out:
        return None, s_fin
    s_prev = jnp.moveaxis(s_prev, 0, 2)
    q_dec = q * jnp.exp(gc)
    att = jnp.einsum('bhnid,bhnjd->bhnij', q_dec, k * jnp.exp(-gc))
    att = jnp.where(jnp.tril(jnp.ones((GLA_CHUNK, GLA_CHUNK), bool)), att, 0.0)
    o = jnp.einsum('bhnij,bhnjv->bhniv', att, v) + jnp.einsum('bhncd,bhndv->bhncv', q_dec, s_prev)
    return o.reshape(b, h, t, dv), s_fin


def gla_mixer(q_c, k_c, v_c, r_c, z_c, q_l, k_l, v_l, r_l, z_l, gate_w, gate_b, norm_g, need_ctx):
    def heads(z, dh):
        return z.astype(F32).reshape(z.shape[0], z.shape[1], GLA_HEADS, dh).transpose(0, 2, 1, 3)

    def gate(z, d):
        zz = z.astype(F32)[..., d * GLA_RANK:(d + 1) * GLA_RANK]
        gl = jax.nn.log_sigmoid(zz @ gate_w[d].astype(F32) + gate_b[d].astype(F32)) / GLA_TAU
        return heads(gl, GLA_DK)

    scale = GLA_DK ** -0.5
    qc, kc, vc = heads(q_c, GLA_DK) * scale, heads(k_c, GLA_DK), heads(v_c, GLA_DV)
    ql, kl, vl = heads(q_l, GLA_DK) * scale, heads(k_l, GLA_DK), heads(v_l, GLA_DV)
    fl = lambda z: jnp.flip(z, axis=2)
    oc_f, sc_f = gla_chunked(qc, kc, vc, gate(z_c, 0), None, need_ctx)
    ol_f, _ = gla_chunked(ql, kl, vl, gate(z_l, 0), sc_f, True)
    oc_b, sc_b = gla_chunked(fl(qc), fl(kc), fl(vc), fl(gate(z_c, 1)), None, need_ctx)
    ol_b, _ = gla_chunked(fl(ql), fl(kl), fl(vl), fl(gate(z_l, 1)), sc_b, True)

    def out(o, r):
        o = rms_norm(o.transpose(0, 2, 1, 3), norm_g.reshape(GLA_HEADS, GLA_DV))
        return (o.reshape(o.shape[0], o.shape[1], MIX_HALF) * jax.nn.silu(r.astype(F32))).astype(r.dtype)

    y_l = out(ol_f + fl(ol_b), r_l)
    y_c = out(oc_f + fl(oc_b), r_c) if need_ctx else None
    return y_c, y_l


def rope_1d(x, pos):
    n = x.shape[-1] // 2
    inv = ROPE_BASE ** (-jnp.arange(n, dtype=F32) / n)
    ang = pos.astype(F32)[:, None] * inv[None, :]
    cos = jnp.cos(ang)[:, None, None, :]
    sin = jnp.sin(ang)[:, None, None, :]
    x1, x2 = x[..., :n], x[..., n:]
    return jnp.concatenate([x1 * cos - x2 * sin, x1 * sin + x2 * cos], axis=-1)


def axial_rope(x, row_pos, col_pos):
    half = x.shape[-1] // 2
    return jnp.concatenate([rope_1d(x[..., :half], row_pos), rope_1d(x[..., half:], col_pos)],
                           axis=-1).astype(x.dtype)


def diff_mixer(q_c, k_c, v_c, q_l, k_l, v_l, lq1, lk1, lq2, lk2, norm_g, lam_init, row_pos, col_pos, need_ctx):
    b, t, _ = q_l.shape
    qk = lambda z: z.reshape(z.shape[0], z.shape[1], DIFF_HEADS, 2, DIFF_DH)
    to_bh = lambda z: z.transpose(0, 2, 3, 1, 4)
    vh = lambda z: z.reshape(z.shape[0], z.shape[1], DIFF_HEADS, DIFF_DV).transpose(0, 2, 1, 3)
    scale = DIFF_DH ** -0.5
    ql = to_bh(axial_rope(qk(q_l * scale), row_pos, col_pos))
    kl = to_bh(axial_rope(qk(k_l), row_pos, col_pos))
    kc, vc = to_bh(qk(k_c)), vh(v_c)
    k_all = jnp.concatenate([kc, kl], axis=3)
    v_all = jnp.concatenate([vc, vh(v_l)], axis=2)
    lam = (jnp.exp(jnp.sum(lq1.astype(F32) * lk1.astype(F32)))
           - jnp.exp(jnp.sum(lq2.astype(F32) * lk2.astype(F32))) + lam_init)

    def attend(qb, kk, vv):
        p = jax.nn.softmax(jnp.einsum('bhmqd,bhmkd->bhmqk', qb, kk).astype(F32), axis=-1)
        w = p[:, :, 0] - lam * p[:, :, 1]
        return jnp.einsum('bhqk,bhkd->bhqd', w.astype(vv.dtype), vv)

    nb = t // DIFF_BLOCK
    q_blocks = ql.reshape(b, DIFF_HEADS, 2, nb, DIFF_BLOCK, DIFF_DH).transpose(3, 0, 1, 2, 4, 5)
    o = lax.map(lambda qb: attend(qb, k_all, v_all), q_blocks)
    o_l = o.transpose(1, 0, 3, 2, 4).reshape(b, t, DIFF_HEADS, DIFF_DV)

    def post(o):
        o32 = rms_norm(o, norm_g) * (1.0 - lam_init)
        return o32.reshape(o.shape[0], o.shape[1], MIX_HALF).astype(q_l.dtype)

    y_l = post(o_l)
    y_c = post(attend(to_bh(qk(q_c * scale)), kc, vc).transpose(0, 2, 1, 3)) if need_ctx else None
    return y_c, y_l


def odd_mixer(a_c, a_l, w_in, w_out, gate_w, gate_b, gla_g, lq1, lk1, lq2, lk2, diff_g, lam_init,
              row_pos, col_pos, need_ctx):
    gq_c, gk_c, gv_c, gr_c, gz_c, dq_c, dk_c, dv_c = jnp.split(a_c @ w_in, _cuts(ODD_SPLITS), axis=-1)
    gq_l, gk_l, gv_l, gr_l, gz_l, dq_l, dk_l, dv_l = jnp.split(a_l @ w_in, _cuts(ODD_SPLITS), axis=-1)
    g_c, g_l = gla_mixer(gq_c, gk_c, gv_c, gr_c, gz_c, gq_l, gk_l, gv_l, gr_l, gz_l, gate_w, gate_b, gla_g, need_ctx)
    d_c, d_l = diff_mixer(dq_c, dk_c, dv_c, dq_l, dk_l, dv_l, lq1, lk1, lq2, lk2, diff_g, lam_init,
                          row_pos, col_pos, need_ctx)
    y_l = jnp.concatenate([g_l, d_l], axis=-1) @ w_out
    y_c = jnp.concatenate([g_c, d_c], axis=-1) @ w_out if need_ctx else None
    return y_c, y_l


def hier_moe(h, w_grp, b_grp, w_exp, b_exp, w_gate, w_up, w_down):
    lg = (h @ w_grp + b_grp).astype(F32)
    g_sel = jnp.argmax(lg, axis=-1)
    p_grp = jnp.max(jax.nn.softmax(lg, axis=-1), axis=-1, keepdims=True)
    le = (h @ w_exp + b_exp).astype(F32)
    le = le.reshape(le.shape[:-1] + (N_GROUPS, EXP_PER_GROUP))
    le_in = jnp.sum(le * jax.nn.one_hot(g_sel, N_GROUPS, dtype=F32)[..., None], axis=-2)
    top_v, top_i = lax.top_k(le_in, TOP_K)
    w_top = jax.nn.softmax(top_v, axis=-1) * p_grp
    eid = g_sel[..., None] * EXP_PER_GROUP + top_i
    combine = jnp.sum(jax.nn.one_hot(eid, N_EXPERTS, dtype=F32) * w_top[..., None], axis=-2).astype(h.dtype)
    y = jnp.zeros_like(h)
    for gi in range(N_GROUPS):
        e0, e1 = gi * EXP_PER_GROUP, (gi + 1) * EXP_PER_GROUP
        hg = jnp.einsum('btd,edf->btef', h, w_gate[e0:e1])
        hu = jnp.einsum('btd,edf->btef', h, w_up[e0:e1])
        act = jax.nn.silu(hg) * hu * combine[..., e0:e1, None]
        y = y + jnp.einsum('btef,efd->btd', act, w_down[e0:e1])
    return y


def setup_inputs(seed: int = 0) -> dict:
    key = jax.random.key(seed)
    keys = iter(jax.random.split(key, 64))

    def nrm(shape, std):
        return jax.random.normal(next(keys), shape, F32) * std

    D = D_MODEL
    ne, no = (DEPTH + 1) // 2, DEPTH // 2
    beta = (8.0 * DEPTH) ** -0.25
    n_idx = jnp.arange(S5_STATE, dtype=F32)
    return {
        'x': nrm((BATCH, SEQ, D), 1.0),
        'c': nrm((BATCH, D), 1.0),
        'ctx': nrm((BATCH, CTX_LEN, D), 1.0),
        'c_ctx': nrm((D,), 1.0),
        'mod_w': nrm((DEPTH, D, 6 * D), D ** -0.5),
        'mod_b': nrm((DEPTH, 6 * D), 0.01),
        'ln_g': 1.0 + nrm((DEPTH, 2, D), 0.01),
        'ln_b': nrm((DEPTH, 2, D), 0.01),
        'even_w_in': nrm((ne, D, EVEN_IN), D ** -0.5),
        'even_w_out': nrm((ne, D, D), beta * D ** -0.5),
        's5_lam_re': -0.5 + nrm((ne, 2, S5_GROUPS, S5_STATE), 0.01),
        's5_lam_im': math.pi * n_idx + nrm((ne, 2, S5_GROUPS, S5_STATE), 0.01),
        's5_log_dt': jax.random.uniform(next(keys), (ne, 2, S5_GROUPS), F32, math.log(1e-3), math.log(1e-1)),
        's5_b_re': nrm((ne, 2, S5_GROUPS, S5_STATE, S5_GROUP), (2 * S5_GROUP) ** -0.5),
        's5_b_im': nrm((ne, 2, S5_GROUPS, S5_STATE, S5_GROUP), (2 * S5_GROUP) ** -0.5),
        's5_c_re': nrm((ne, 2, S5_GROUPS, S5_GROUP, S5_STATE), S5_STATE ** -0.5),
        's5_c_im': nrm((ne, 2, S5_GROUPS, S5_GROUP, S5_STATE), S5_STATE ** -0.5),
        's5_d': nrm((ne, MIX_HALF), 1.0),
        's5_glu_w': nrm((ne, MIX_HALF, 2 * MIX_HALF), MIX_HALF ** -0.5),
        's5_glu_b': nrm((ne, 2 * MIX_HALF), 0.01),
        'na_rpb': nrm((ne, NA_HEADS, 2 * NA_WIN_ROWS - 1, 2 * NA_WIN_COLS - 1), 0.02),
        'odd_w_in': nrm((no, D, ODD_IN), D ** -0.5),
        'odd_w_out': nrm((no, D, D), beta * D ** -0.5),
        'gla_gate_w': nrm((no, 2, GLA_RANK, GLA_QK), GLA_RANK ** -0.5),
        'gla_gate_b': nrm((no, 2, GLA_QK), 0.01),
        'gla_norm_g': 1.0 + nrm((no, MIX_HALF), 0.01),
        'diff_lq1': nrm((no, DIFF_DH), 0.1),
        'diff_lk1': nrm((no, DIFF_DH), 0.1),
        'diff_lq2': nrm((no, DIFF_DH), 0.1),
        'diff_lk2': nrm((no, DIFF_DH), 0.1),
        'diff_norm_g': 1.0 + nrm((no, DIFF_DV), 0.01),
        'moe_w_grp': nrm((DEPTH, D, N_GROUPS), D ** -0.5),
        'moe_b_grp': nrm((DEPTH, N_GROUPS), 0.01),
        'moe_w_exp': nrm((DEPTH, D, N_EXPERTS), D ** -0.5),
        'moe_b_exp': nrm((DEPTH, N_EXPERTS), 0.01),
        'moe_w_gate': nrm((DEPTH, N_EXPERTS, D, D_EXPERT), D ** -0.5),
        'moe_w_up': nrm((DEPTH, N_EXPERTS, D, D_EXPERT), D ** -0.5),
        'moe_w_down': nrm((DEPTH, N_EXPERTS, D_EXPERT, D), beta * D_EXPERT ** -0.5),
    }


def reference(x, c, ctx, c_ctx, mod_w, mod_b, ln_g, ln_b, even_w_in, even_w_out, s5_lam_re, s5_lam_im,
              s5_log_dt, s5_b_re, s5_b_im, s5_c_re, s5_c_im, s5_d, s5_glu_w, s5_glu_b, na_rpb,
              odd_w_in, odd_w_out, gla_gate_w, gla_gate_b, gla_norm_g, diff_lq1, diff_lk1, diff_lq2,
              diff_lk2, diff_norm_g, moe_w_grp, moe_b_grp, moe_w_exp, moe_b_exp, moe_w_gate, moe_w_up,
              moe_w_down):
    t = jnp.arange(x.shape[1])
    row_pos, col_pos = t // GRID_W, t % GRID_W
    alpha = (2.0 * DEPTH) ** 0.25
    s_lat = jax.nn.silu(c)
    s_ctx = jax.nn.silu(c_ctx)
    h_l, h_c = x, ctx
    for i in range(DEPTH):
        need_ctx = i < DEPTH - 1
        m_l = jnp.split(s_lat @ mod_w[i] + mod_b[i], 6, axis=-1)
        sh1_l, sc1_l, g1_l, sh2_l, sc2_l, g2_l = [m[:, None, :] for m in m_l]
        sh1_c, sc1_c, g1_c, sh2_c, sc2_c, g2_c = jnp.split(s_ctx @ mod_w[i] + mod_b[i], 6, axis=-1)
        a_l = h_l * (1.0 + sc1_l) + sh1_l
        a_c = h_c * (1.0 + sc1_c) + sh1_c
        j = i // 2
        if i % 2 == 0:
            y_c, y_l = even_mixer(a_c, a_l, even_w_in[j], even_w_out[j], s5_lam_re[j], s5_lam_im[j],
                                  s5_log_dt[j], s5_b_re[j], s5_b_im[j], s5_c_re[j], s5_c_im[j], s5_d[j],
                                  s5_glu_w[j], s5_glu_b[j], na_rpb[j], need_ctx)
        else:
            lam_init = 0.8 - 0.6 * math.exp(-0.3 * i)
            y_c, y_l = odd_mixer(a_c, a_l, odd_w_in[j], odd_w_out[j], gla_gate_w[j], gla_gate_b[j],
                                 gla_norm_g[j], diff_lq1[j], diff_lk1[j], diff_lq2[j], diff_lk2[j],
                                 diff_norm_g[j], lam_init, row_pos, col_pos, need_ctx)
        h_l = layer_norm(alpha * h_l + g1_l * y_l, ln_g[i, 0], ln_b[i, 0])
        f_l = hier_moe(h_l * (1.0 + sc2_l) + sh2_l, moe_w_grp[i], moe_b_grp[i], moe_w_exp[i], moe_b_exp[i],
                       moe_w_gate[i], moe_w_up[i], moe_w_down[i])
        h_l = layer_norm(alpha * h_l + g2_l * f_l, ln_g[i, 1], ln_b[i, 1])
        if need_ctx:
            h_c = layer_norm(alpha * h_c + g1_c * y_c, ln_g[i, 0], ln_b[i, 0])
            f_c = hier_moe(h_c * (1.0 + sc2_c) + sh2_c, moe_w_grp[i], moe_b_grp[i], moe_w_exp[i], moe_b_exp[i],
                           moe_w_gate[i], moe_w_up[i], moe_w_down[i])
            h_c = layer_norm(alpha * h_c + g2_c * f_c, ln_g[i, 1], ln_b[i, 1])
    return h_l
```

```cpp
#ifdef CPU_EMU
#include "emu.h"
#else
#include <hip/hip_runtime.h>
#include <cstdio>
#include <cstdint>
#include <cmath>
#endif

#ifndef PROBE_MASK
#define PROBE_MASK 0
#endif
#ifndef CFG_BATCH
#define CFG_BATCH 4
#endif
#ifndef CFG_SEQ
#define CFG_SEQ 4096
#endif
#ifndef CFG_CTX
#define CFG_CTX 256
#endif
#ifndef CFG_DEPTH
#define CFG_DEPTH 4
#endif

typedef unsigned short bf16;
typedef short bf16x8 __attribute__((ext_vector_type(8)));
typedef short bf16x4 __attribute__((ext_vector_type(4)));
typedef float f32x4 __attribute__((ext_vector_type(4)));
typedef float f32x2 __attribute__((ext_vector_type(2)));
typedef float f32x16 __attribute__((ext_vector_type(16)));
typedef unsigned u32x4 __attribute__((ext_vector_type(4)));
typedef unsigned u32x2 __attribute__((ext_vector_type(2)));

constexpr int NB = CFG_BATCH, TS = CFG_SEQ, LC = CFG_CTX, NL = CFG_DEPTH;
constexpr int PT = LC + TS;
constexpr int MR = NB * PT;
constexpr int D = 1024;
constexpr int NE = (NL + 1) / 2, NO = NL / 2;
constexpr int GW = 64;
constexpr int GROWS = TS / GW;
constexpr int NCH = PT / 64, NCC = LC / 64;
constexpr int NTH = 512;
constexpr int EVEN_N = 2048, ODD_N = 3104, ODD_NP = 3328;
constexpr int NEXP = 32;
constexpr float LN_EPS = 1e-5f;
constexpr float ALPHA = 1.681792830507429f;
constexpr float LOG2E = 1.4426950408889634f, QSCALE = 0.125f * LOG2E;
static_assert(MR % 256 == 0 && LC % 128 == 0 && TS % 128 == 0 && GROWS >= 8, "shape");

enum { I_X = 0, I_C, I_CTX, I_CCTX, I_MODW, I_MODB, I_LNG, I_LNB, I_EWIN, I_EWOUT, I_LAMRE, I_LAMIM, I_LOGDT, I_BRE, I_BIM, I_CRE, I_CIM, I_S5D,
       I_GLUW, I_GLUB, I_RPB, I_OWIN, I_OWOUT, I_GGW, I_GGB, I_GNG, I_LQ1, I_LK1, I_LQ2, I_LK2, I_DNG, I_WGRP, I_BGRP, I_WEXP, I_BEXP, I_WGATE, I_WUP, I_WDOWN, N_IN };

constexpr size_t al256(size_t x) { return (x + 255) & ~(size_t)255; }
constexpr size_t WS_CTL = 0;
constexpr size_t CTL_BAR = 0;
constexpr size_t CTL_CNT = 16384;
constexpr size_t CTL_BYTES = 16384 + 4096;
constexpr size_t WS_MODV = al256(WS_CTL + CTL_BYTES);
constexpr size_t WS_S5P = al256(WS_MODV + (size_t)NL * (NB + 1) * 6144 * 4);
constexpr int S5P_STRIDE = 36;
constexpr size_t WS_ROPE = al256(WS_S5P + (size_t)NE * 2 * 32 * 64 * S5P_STRIDE * 4);
constexpr size_t WS_WIN = al256(WS_ROPE + 8192);
constexpr size_t WIN_LSTRIDE = (size_t)ODD_NP * D;
constexpr size_t WS_WOUT = al256(WS_WIN + (size_t)NL * WIN_LSTRIDE * 2);
constexpr size_t WS_GLU = al256(WS_WOUT + (size_t)NL * D * D * 2);
constexpr size_t WS_MGU = al256(WS_GLU + (size_t)NE * 1024 * 512 * 2);
constexpr size_t WS_MDN = al256(WS_MGU + (size_t)NL * NEXP * 512 * 1024 * 2);
constexpr size_t WS_H = al256(WS_MDN + (size_t)NL * NEXP * 1024 * 256 * 2);
constexpr size_t WS_ABF = al256(WS_H + (size_t)MR * D * 4);
constexpr size_t WS_Z = al256(WS_ABF + (size_t)MR * D * 2);
constexpr size_t Z_BYTES = (size_t)MR * 3360 * 2;
constexpr size_t WS_YMIX = al256(WS_Z + Z_BYTES);
constexpr size_t WS_SB = al256(WS_YMIX + (size_t)MR * D * 2);
constexpr size_t MOE_ROWS = (size_t)2 * MR + NEXP * 128;
constexpr size_t SB_GLA = (size_t)NB * 4 * 2 * NCH * 128 * 64 * 4 + (size_t)NB * 4 * 2 * NCH * 64 * 4 + (size_t)NB * 4 * NCH * 2 * 64 * 64 * 4 + 8192;
constexpr size_t SB_S5 = (size_t)2 * NB * 32 * 2 * NCH * 128 * 4 + (size_t)MR * 512 * 2 + 4096;
constexpr size_t SB_F2 = MOE_ROWS * D * 2;
constexpr size_t SB_BYTES = SB_GLA > SB_F2 ? (SB_GLA > SB_S5 ? SB_GLA : SB_S5) : (SB_F2 > SB_S5 ? SB_F2 : SB_S5);
constexpr size_t WS_ACT = al256(WS_SB + SB_BYTES);
constexpr size_t WS_ROUTE = al256(WS_ACT + MOE_ROWS * 256 * 2);
constexpr size_t WS_LTOK = al256(WS_ROUTE + (size_t)MR * 16);
constexpr size_t WS_LW = al256(WS_LTOK + (size_t)NEXP * MR * 4);
constexpr size_t WS_END = al256(WS_LW + (size_t)NEXP * MR * 4);
constexpr size_t ZE_U = 0, ZE_Q = (size_t)MR * 512, ZE_K = (size_t)MR * 1024, ZE_VT = (size_t)MR * 1536;
constexpr size_t ZO_GQ = 0, ZO_GK = (size_t)MR * 256, ZO_GKT = (size_t)MR * 512, ZO_GVT = (size_t)MR * 768, ZO_GR = (size_t)MR * 1280,
                 ZO_GZ = (size_t)MR * 1792, ZO_DQ = (size_t)MR * 1824, ZO_DK = (size_t)MR * 2336, ZO_DVT = (size_t)MR * 2848;
constexpr size_t SBO_S5E = 0;
constexpr size_t SBO_S5H = (size_t)NB * 32 * 2 * NCH * 128 * 4;
constexpr size_t SBO_GS = al256(2 * SBO_S5H);
constexpr size_t SBO_GU = 0;
constexpr size_t SBO_GDEC = al256((size_t)NB * 4 * 2 * NCH * 128 * 64 * 4);
constexpr size_t SBO_GCUM = al256(SBO_GDEC + (size_t)NB * 4 * 2 * NCH * 64 * 4);

#ifdef CPU_EMU
#define DEVFN static inline
#define MEMFN inline
#else
#define DEVFN __device__ __forceinline__
#define MEMFN __device__ __forceinline__
#endif
DEVFN unsigned fbits(float f) { return __builtin_bit_cast(unsigned, f); }
DEVFN float bitsf(unsigned u) { return __builtin_bit_cast(float, u); }
DEVFN bf16 f2bf(float f) { unsigned u = fbits(f); u += 0x7fffu + ((u >> 16) & 1u); return (bf16)(u >> 16); }
DEVFN float bf2f(bf16 h) { return bitsf((unsigned)h << 16); }
DEVFN unsigned pack2(float lo, float hi) {
#ifdef CPU_EMU
    return (unsigned)f2bf(lo) | ((unsigned)f2bf(hi) << 16);
#else
    typedef __bf16 bf16v2_ __attribute__((ext_vector_type(2)));
    return __builtin_bit_cast(unsigned, __builtin_convertvector((f32x2){lo, hi}, bf16v2_));
#endif
}
DEVFN float fexp2(float x) {
#ifdef CPU_EMU
    return exp2f(x);
#else
    return __builtin_amdgcn_exp2f(x);
#endif
}
DEVFN float fexp(float x) { return fexp2(x * 1.4426950408889634f); }
DEVFN float flog2(float x) {
#ifdef CPU_EMU
    return log2f(x);
#else
    return __builtin_amdgcn_logf(x);
#endif
}
DEVFN float sigmoidf_(float x) { return 1.0f / (1.0f + fexp(-x)); }
DEVFN float siluf_(float x) { return x / (1.0f + fexp(-x)); }
DEVFN float geluf_(float x) { const float u = 0.7978845608028654f * (x + 0.044715f * x * x * x); return x / (1.0f + fexp(-2.0f * u)); }

DEVFN float logsigf_(float x) { return fminf(x, 0.f) - 0.6931471805599453f * flog2(1.0f + fexp(-fabsf(x))); }
DEVFN f32x4 mfma16(bf16x8 a, bf16x8 b, f32x4 c) {
#ifdef CPU_EMU
    return emu_mfma16(a, b, c);
#else
    return __builtin_amdgcn_mfma_f32_16x16x32_bf16(a, b, c, 0, 0, 0);
#endif
}
DEVFN f32x16 mfma32(bf16x8 a, bf16x8 b, f32x16 c) {
#ifdef CPU_EMU
    return emu_mfma32(a, b, c);
#else
    return __builtin_amdgcn_mfma_f32_32x32x16_bf16(a, b, c, 0, 0, 0);
#endif
}
DEVFN void sched_fence() {
#ifndef CPU_EMU
    __builtin_amdgcn_sched_barrier(0);
#endif
}
DEVFN bool wave_all(bool c) {
#ifdef CPU_EMU
    int v = c ? 1 : 0; v &= __shfl_xor(v, 32); v &= __shfl_xor(v, 16); v &= __shfl_xor(v, 8); v &= __shfl_xor(v, 4); v &= __shfl_xor(v, 2); v &= __shfl_xor(v, 1); return v != 0;
#else
    return __all(c);
#endif
}
DEVFN float wave_sum(float v) {
#ifdef CPU_EMU
    v += __shfl_xor(v, 32); v += __shfl_xor(v, 16); v += __shfl_xor(v, 8); v += __shfl_xor(v, 4); v += __shfl_xor(v, 2); v += __shfl_xor(v, 1); return v;
#else
#define WS_DPP(x, ctrl) bitsf((unsigned)__builtin_amdgcn_update_dpp(0, (int)fbits(x), ctrl, 0xF, 0xF, true))
    v += WS_DPP(v, 0xB1); v += WS_DPP(v, 0x4E); v += WS_DPP(v, 0x141); v += WS_DPP(v, 0x140);
#undef WS_DPP
    const int iv = (int)fbits(v);
    return bitsf((unsigned)__builtin_amdgcn_readlane(iv, 0)) + bitsf((unsigned)__builtin_amdgcn_readlane(iv, 16)) + bitsf((unsigned)__builtin_amdgcn_readlane(iv, 32)) + bitsf((unsigned)__builtin_amdgcn_readlane(iv, 48));
#endif
}

struct Params { const float* in[N_IN]; float* out; unsigned char* ws; };

constexpr int LDS_BYTES = 128 * 1024;
constexpr int LDS_TOTAL = LDS_BYTES + 16;
#ifdef CPU_EMU
#define DECL_LDS unsigned char* lds = emu::cur_blk->lds
#define GRID_SYNC() emu::grid_barrier()
#else
#define DECL_LDS extern __shared__ __attribute__((aligned(16))) unsigned char lds[]
#define XB_TMO      128
#define XB_XCNT(j)  (256  + 64 * (j))
#define XB_XSUB(j)  (1280 + 64 * (j))
#define XB_XGEN(j)  (2304 + 64 * (j))
#define XB_TOP      3328
#define XB_TOPGEN   3392
#define XCD_BAR_WORDS 3456
#define XB_SPIN_CAP (1u << 18)
#define LAS __attribute__((address_space(3)))

__device__ __forceinline__ unsigned xb_ld(unsigned* p)              { return __hip_atomic_load(p, __ATOMIC_RELAXED, __HIP_MEMORY_SCOPE_AGENT); }
__device__ __forceinline__ unsigned xb_add(unsigned* p, unsigned v) { return __hip_atomic_fetch_add(p, v, __ATOMIC_RELAXED, __HIP_MEMORY_SCOPE_AGENT); }
__device__ __forceinline__ unsigned xb_xcc_id() { return (unsigned)__builtin_amdgcn_s_getreg((3 << 11) | 20) & 0xFu; }
#define XB_SPIN(cond, bar) do { unsigned _sp = 0; while (cond) { __builtin_amdgcn_s_sleep(1); \
    if ((++_sp & 255u) == 0u) { if (xb_ld(&(bar)[XB_TMO])) break; if (_sp > XB_SPIN_CAP) { atomicAdd(&(bar)[XB_TMO], 1u); break; } } } } while (0)

struct XcdBarrier {
    unsigned* bar; unsigned x;
    volatile LAS unsigned* st;
};

__device__ __forceinline__ XcdBarrier xcd_barrier_post(unsigned* bar, volatile LAS unsigned* st) {
    XcdBarrier b; b.bar = bar; b.x = xb_xcc_id(); b.st = st;
    if (threadIdx.x == 0) (void)xb_add(&bar[XB_XCNT(b.x)], 1u);
    return b;
}
__device__ __forceinline__ void xcd_barrier_complete(unsigned* bar, unsigned x, unsigned& nloc, unsigned& nx) {
    const unsigned G = gridDim.x * gridDim.y * gridDim.z;
    unsigned sum, cnt, mine, sp = 0u;
    for (;;) {
        sum = 0u; cnt = 0u; mine = 0u;
#pragma unroll
        for (unsigned j = 0; j < 16; ++j) { const unsigned c = xb_ld(&bar[XB_XCNT(j)]); sum += c; cnt += (c > 0u) ? 1u : 0u; mine = (j == x) ? c : mine; }
        if (sum == G) break;
        __builtin_amdgcn_s_sleep(1);
        if ((++sp & 255u) == 0u) { if (xb_ld(&bar[XB_TMO])) break; if (sp > XB_SPIN_CAP) { atomicAdd(&bar[XB_TMO], 1u); break; } }
    }
    nloc = mine > 0u ? mine : 1u; nx = cnt > 0u ? cnt : 1u;
}

__device__ __forceinline__ void xcd_barrier(const XcdBarrier& b) {
    asm volatile("s_waitcnt vmcnt(0)" ::: "memory");
    __syncthreads();
    if (threadIdx.x == 0) {
        unsigned* bar = b.bar;
        __builtin_amdgcn_s_waitcnt(0);
        unsigned nloc = b.st[0], nx = b.st[1];
        if (nloc == 0u) { xcd_barrier_complete(bar, b.x, nloc, nx); b.st[0] = nloc; b.st[1] = nx; }
        const unsigned old = xb_add(&bar[XB_XSUB(b.x)], 1u);
        const unsigned gen = old / nloc;
        if (old + 1u == (gen + 1u) * nloc) {
            __builtin_amdgcn_fence(__ATOMIC_RELEASE, "agent");
            asm volatile("s_waitcnt vmcnt(0)" ::: "memory");
            const unsigned og = xb_add(&bar[XB_TOP], 1u);
            const unsigned tg = og / nx;
            if (og + 1u == (tg + 1u) * nx) xb_add(&bar[XB_TOPGEN], 1u);
            else XB_SPIN(xb_ld(&bar[XB_TOPGEN]) == tg, bar);
            __builtin_amdgcn_fence(__ATOMIC_ACQUIRE, "agent");
            xb_add(&bar[XB_XGEN(b.x)], 1u);
            asm volatile("s_waitcnt vmcnt(0)" ::: "memory");
        } else {
            XB_SPIN(xb_ld(&bar[XB_XGEN(b.x)]) == gen, bar);
            __builtin_amdgcn_fence(__ATOMIC_ACQUIRE, "agent");
            asm volatile("s_waitcnt vmcnt(0)" ::: "memory");
        }
    }
    __syncthreads();
}

#define GRID_SYNC() xcd_barrier(gbar)
#endif

DEVFN int tidx() { int t = (int)threadIdx.x;
#ifndef CPU_EMU
    asm volatile("" : "+v"(t));
#endif
    return t; }
template <class ColSrc, class DstFn>
DEVFN void conv_group(unsigned char* lds, int nmat, int K, int N, int ld_src, ColSrc colsrc, DstFn dstfn) {
    float* t = (float*)lds;
    const int tid = tidx(), G = gridDim.x, nkt = K / 64, nnt = N / 128, units = nmat * nkt * nnt; float r[16];
    auto load = [&](int u) { const int mat = u / (nkt * nnt), rem = u % (nkt * nnt), k0 = (rem % nkt) * 64, n0 = (rem / nkt) * 128;
#pragma unroll
        for (int it = 0; it < 16; ++it) { const int idx = it * NTH + tid, kl = idx >> 7, nl = idx & 127; const float* sp = colsrc(mat, n0 + nl); r[it] = sp ? sp[(size_t)(k0 + kl) * ld_src] : 0.f; } };
    int u = blockIdx.x; if (u < units) load(u);
    for (; u < units; u += G) {
        __syncthreads();
#pragma unroll
        for (int it = 0; it < 16; ++it) { const int idx = it * NTH + tid, kl = idx >> 7, nl = idx & 127; t[kl * 129 + nl] = r[it]; }
        if (u + G < units) load(u + G);
        __syncthreads();
        const int mat = u / (nkt * nnt), rem = u % (nkt * nnt), k0 = (rem % nkt) * 64, n0 = (rem / nkt) * 128; bf16* dst = dstfn(mat);
#pragma unroll
        for (int it = 0; it < 8; ++it) { const int idx = it * NTH + tid, nl = idx >> 5, kp = idx & 31; *(unsigned*)(dst + (size_t)(n0 + nl) * K + k0 + 2 * kp) = pack2(t[(2 * kp) * 129 + nl], t[(2 * kp + 1) * 129 + nl]); }
    }
}

DEVFN void phase_convert(const Params& p, unsigned char* lds) {
    const int G = gridDim.x, bid = blockIdx.x;
    conv_group(lds, NE, D, EVEN_N, EVEN_N, [&](int j, int n) { return p.in[I_EWIN] + (size_t)j * D * EVEN_N + n; }, [&](int j) { return (bf16*)(p.ws + WS_WIN) + (size_t)(2 * j) * WIN_LSTRIDE; });
    if (NO > 0) conv_group(lds, NO, D, ODD_NP, ODD_N, [&](int j, int n) -> const float* { const float* src = p.in[I_OWIN] + (size_t)j * D * ODD_N; return n < 1536 ? src + n : (n < 3072 ? src + n + 32 : (n < 3104 ? src + 1536 + (n - 3072) : nullptr)); },
                           [&](int j) { return (bf16*)(p.ws + WS_WIN) + (size_t)(2 * j + 1) * WIN_LSTRIDE; });
    conv_group(lds, NL, D, D, D, [&](int l, int n) { return ((l & 1) ? p.in[I_OWOUT] : p.in[I_EWOUT]) + (size_t)(l >> 1) * D * D + n; }, [&](int l) { return (bf16*)(p.ws + WS_WOUT) + (size_t)l * D * D; });
    conv_group(lds, NE, 512, 1024, 1024, [&](int j, int n) { return p.in[I_GLUW] + (size_t)j * 512 * 1024 + ((n & 31) >> 4) * 512 + (n >> 5) * 16 + (n & 15); }, [&](int j) { return (bf16*)(p.ws + WS_GLU) + (size_t)j * 1024 * 512; });
    conv_group(lds, NL * NEXP, D, 512, 256, [&](int e, int n) { return (((n & 31) >> 4) ? p.in[I_WUP] : p.in[I_WGATE]) + (size_t)e * D * 256 + (n >> 5) * 16 + (n & 15); }, [&](int e) { return (bf16*)(p.ws + WS_MGU) + (size_t)e * 512 * 1024; });
    conv_group(lds, NL * NEXP, 256, D, D, [&](int e, int n) { return p.in[I_WDOWN] + (size_t)e * 256 * D + n; }, [&](int e) { return (bf16*)(p.ws + WS_MDN) + (size_t)e * 1024 * 256; });
    {
        float* sv = (float*)lds;
        __syncthreads();
        for (int i = tidx(); i < (NB + 1) * D; i += NTH) { const int r = i / D, k = i % D; const float v = r < NB ? p.in[I_C][r * D + k] : p.in[I_CCTX][k]; sv[i] = siluf_(v); }
        __syncthreads();
        float* modv = (float*)(p.ws + WS_MODV);
        for (int u = bid; u < NL * 96; u += G) { const int l = u / 96, cg = u % 96; const int cl = tidx() & 63, col = cg * 64 + cl, ks = tidx() >> 6;
            const float* w = p.in[I_MODW] + (size_t)l * D * 6144 + col; float acc[NB + 1];
#pragma unroll
            for (int r = 0; r <= NB; ++r) acc[r] = 0.f;
#pragma unroll 8
            for (int k = ks * 128; k < ks * 128 + 128; ++k) { const float wv = w[(size_t)k * 6144];
#pragma unroll
                for (int r = 0; r <= NB; ++r) acc[r] += sv[r * D + k] * wv; }
            float* red = (float*)(lds + 32768);
            __syncthreads();
#pragma unroll
            for (int r = 0; r <= NB; ++r) red[(ks * (NB + 1) + r) * 64 + cl] = acc[r];
            __syncthreads();
            for (int i = tidx(); i < (NB + 1) * 64; i += NTH) { const int r = i >> 6, c = i & 63; const int cc = cg * 64 + c; float sum = p.in[I_MODB][(size_t)l * 6144 + cc];
#pragma unroll
                for (int q = 0; q < 8; ++q) sum += red[(q * (NB + 1) + r) * 64 + c];
                modv[((size_t)l * (NB + 1) + r) * 6144 + cc] = sum; }
            __syncthreads();
        }
    }
    for (int i = bid * NTH + tidx(); i < 1024; i += G * NTH) { const float ang = (float)(i >> 4) * expf(-(float)(i & 15) * (9.210340371976184f / 16.0f)); float sn, cs; sincosf(ang, &sn, &cs); float* rt = (float*)(p.ws + WS_ROPE); rt[i] = cs; rt[1024 + i] = sn; }
    for (int i = bid * NTH + tidx(); i < NE * 2 * 32 * 64; i += G * NTH) {
        const int pidx = i & 63, g = (i >> 6) & 31, jd = i >> 11;
        const float lre = p.in[I_LAMRE][i], lim = p.in[I_LAMIM][i], dt = expf(p.in[I_LOGDT][jd * 32 + g]);
        const float mag = expf(lre * dt), are = mag * cosf(lim * dt), aim = mag * sinf(lim * dt);
        const float magL = expf(lre * dt * 64.f), aLre = magL * cosf(lim * dt * 64.f), aLim = magL * sinf(lim * dt * 64.f);
        const float den = lre * lre + lim * lim;
        const float fre = ((are - 1.0f) * lre + aim * lim) / den, fim = (aim * lre - (are - 1.0f) * lim) / den;
        float* o = (float*)(p.ws + WS_S5P) + (size_t)i * S5P_STRIDE;
        o[0] = are; o[1] = aim; o[2] = aLre; o[3] = aLim;
        const float* bre = p.in[I_BRE] + (size_t)i * 16; const float* bim = p.in[I_BIM] + (size_t)i * 16;
        for (int h = 0; h < 16; ++h) { o[4 + h] = fre * bre[h] - fim * bim[h]; o[20 + h] = fre * bim[h] + fim * bre[h]; }
    }
}

DEVFN void mod_store_row(const Params& p, int layer, int which  , int row, const float (&h)[16], bf16* dstrow) {
    const int b = row / PT, pp = row % PT, mr = pp < LC ? NB : b, lane = tidx() & 63;
    const float* mv = (const float*)(p.ws + WS_MODV) + ((size_t)layer * (NB + 1) + mr) * 6144 + which * 3072;
#pragma unroll
    for (int i = 0; i < 4; ++i) { const int c = i * 256 + lane * 4; const f32x4 sh = *(const f32x4*)(mv + c), sc = *(const f32x4*)(mv + 1024 + c);
        u32x2 w; w.x = pack2(h[i * 4 + 0] * (1.f + sc[0]) + sh[0], h[i * 4 + 1] * (1.f + sc[1]) + sh[1]); w.y = pack2(h[i * 4 + 2] * (1.f + sc[2]) + sh[2], h[i * 4 + 3] * (1.f + sc[3]) + sh[3]);
        *(u32x2*)(dstrow + c) = w; }
}
DEVFN void phase_init_h(const Params& p) {
    const int wave = tidx() >> 6, lane = tidx() & 63; bf16* H = (bf16*)(p.ws + WS_H); bf16* A = (bf16*)(p.ws + WS_ABF);
    auto srcrow = [&](int row) { const int b = row / PT, pp = row % PT; return pp < LC ? p.in[I_CTX] + ((size_t)b * LC + pp) * D : p.in[I_X] + ((size_t)b * TS + (pp - LC)) * D; };
    f32x4 nx[4];
    int row = blockIdx.x * 8 + wave;
    if (row < MR) { const float* src = srcrow(row);
#pragma unroll
        for (int i = 0; i < 4; ++i) nx[i] = *(const f32x4*)(src + i * 256 + lane * 4); }
    for (; row < MR; row += gridDim.x * 8) { float h[16]; f32x4 cv[4];
#pragma unroll
        for (int i = 0; i < 4; ++i) cv[i] = nx[i];
        if (row + (int)gridDim.x * 8 < MR) { const float* src = srcrow(row + gridDim.x * 8);
#pragma unroll
            for (int i = 0; i < 4; ++i) nx[i] = *(const f32x4*)(src + i * 256 + lane * 4); }
#pragma unroll
        for (int i = 0; i < 4; ++i) { const f32x4 v = cv[i]; { u32x2 w; w.x = pack2(v[0], v[1]); w.y = pack2(v[2], v[3]); *(u32x2*)(H + (size_t)row * D + i * 256 + lane * 4) = w; } h[i * 4] = v[0]; h[i * 4 + 1] = v[1]; h[i * 4 + 2] = v[2]; h[i * 4 + 3] = v[3]; }
        mod_store_row(p, 0, 0, row, h, A + (size_t)row * D); }
}

DEVFN int lds_sw(int row, int ch) { return row * 128 + ((ch ^ (row & 7)) << 4); }
DEVFN void dma16(const void* g, unsigned char* l) {
#ifdef CPU_EMU
    memcpy(l + (emu::cur->lin & 63) * 16, g, 16);
#else
    __builtin_amdgcn_global_load_lds((const unsigned*)g, (LAS unsigned*)l, 16, 0, 0);
#endif
}
template <int N> DEVFN void dma_wait_barrier() {
#ifdef CPU_EMU
    __syncthreads();
#else
    asm volatile("s_waitcnt vmcnt(%0) lgkmcnt(0)" :: "n"(N) : "memory"); __builtin_amdgcn_s_barrier(); asm volatile("" ::: "memory");
#endif
}
template <int WM> struct GemmPtrs { const bf16* pa[WM]; const bf16* pb[2]; };
template <int WM, class RowA>
DEVFN void gemm_begin(unsigned char* lds, RowA rowA, const bf16* Bt, int K, int n0, GemmPtrs<WM>& g) {
    constexpr int NA = WM, ABYTES = WM * 8192, BUF = ABYTES + 16384;
    const int tid = tidx(), wave = tid >> 6;
#ifdef CPU_EMU
    const int wvu = wave;
#else
    const int wvu = __builtin_amdgcn_readfirstlane(wave);
#endif
#pragma unroll
    for (int i = 0; i < NA; ++i) { const int idx = i * NTH + tid, row = idx >> 3, ch = (idx & 7) ^ (row & 7); g.pa[i] = rowA(row) + ch * 8; }
#pragma unroll
    for (int i = 0; i < 2; ++i) { const int idx = i * NTH + tid, row = idx >> 3, ch = (idx & 7) ^ (row & 7); g.pb[i] = Bt + (size_t)(n0 + row) * K + ch * 8; }
#pragma unroll
    for (int t = 0; t < 2; ++t) {
#pragma unroll
        for (int i = 0; i < NA; ++i) dma16(g.pa[i] + t * 64, lds + t * BUF + (i * NTH + wvu * 64) * 16);
#pragma unroll
        for (int i = 0; i < 2; ++i) dma16(g.pb[i] + t * 64, lds + t * BUF + ABYTES + (i * NTH + wvu * 64) * 16); }
}
template <int WM, bool SWAP, class Hook, class Epi>
DEVFN void gemm_run(unsigned char* lds, const GemmPtrs<WM>& g, int K, Hook hook, Epi epi) {
    constexpr int WN = 8 / WM, NG = WM / 2, NA = WM, ABYTES = WM * 8192, BUF = ABYTES + 16384;
    static_assert(3 * BUF <= LDS_BYTES, "GEMM LDS");
    const int tid = tidx(), lane = tid & 63, wave = tid >> 6, wr = wave / WN, wc = wave % WN, fr = lane & 15, fg = lane >> 4;
#ifdef CPU_EMU
    const int wvu = wave;
#else
    const int wvu = __builtin_amdgcn_readfirstlane(wave);
#endif
    f32x4 acc[4][2 * NG];
#pragma unroll
    for (int m = 0; m < 4; ++m)
#pragma unroll
        for (int n = 0; n < 2 * NG; ++n) acc[m][n] = (f32x4){0.f, 0.f, 0.f, 0.f};
    const int nk = K / 64;
#define GM_DMA(kt, buf) do { _Pragma("unroll") for (int i = 0; i < NA; ++i) dma16(g.pa[i] + (kt) * 64, lds + (buf) + (i * NTH + wvu * 64) * 16); \
        _Pragma("unroll") for (int i = 0; i < 2; ++i) dma16(g.pb[i] + (kt) * 64, lds + (buf) + ABYTES + (i * NTH + wvu * 64) * 16); } while (0)
#define GM_COMPUTE(cur) do { _Pragma("unroll") for (int ks = 0; ks < 2; ++ks) { bf16x8 a[4], b[2 * NG]; \
        _Pragma("unroll") for (int m = 0; m < 4; ++m) a[m] = *(const bf16x8*)(lds + (cur) + lds_sw(wr * 64 + m * 16 + fr, ks * 4 + fg)); \
        _Pragma("unroll") for (int n = 0; n < 2 * NG; ++n) b[n] = *(const bf16x8*)(lds + (cur) + ABYTES + lds_sw(wc * 32 * NG + n * 16 + fr, ks * 4 + fg)); \
        _Pragma("unroll") for (int m = 0; m < 4; ++m) _Pragma("unroll") for (int n = 0; n < 2 * NG; ++n) acc[m][n] = SWAP ? mfma16(b[n], a[m], acc[m][n]) : mfma16(a[m], b[n], acc[m][n]); } } while (0)
    dma_wait_barrier<NA + 2>();
    int cur = 0, nxt2 = 2 * BUF;
    for (int kt = 0; kt < nk; ++kt) {
        if (kt + 2 < nk) GM_DMA(kt + 2, nxt2);
        GM_COMPUTE(cur);
        if (kt + 2 < nk) dma_wait_barrier<NA + 2>(); else dma_wait_barrier<0>();
        nxt2 = cur; cur = cur + BUF >= 3 * BUF ? 0 : cur + BUF;
    }
#undef GM_DMA
#undef GM_COMPUTE
    hook();
#pragma unroll
    for (int m = 0; m < 4; ++m)
#pragma unroll
        for (int g2 = 0; g2 < NG; ++g2) { if (SWAP) epi(wr * 64 + m * 16 + fr, wc * 32 * NG + g2 * 32 + 4 * fg, acc[m][2 * g2], acc[m][2 * g2 + 1]); else epi(wr * 64 + m * 16 + 4 * fg, wc * 32 * NG + g2 * 32, acc[m][2 * g2], acc[m][2 * g2 + 1]); }
}

namespace pg8 {
constexpr int BM = 256, BK = 64, HALF = 128, HTB = HALF * BK * 2  , STAGE_BYTES = 8 * HTB, NXCD = 8, WGM = 8;
DEVFN int lds_byte(int r, int c) { const int st = (r >> 4) * 2 + (c >> 5), rr = r & 15, cc = c & 31, ob = rr * 64 + cc * 2; return st * 1024 + (ob ^ (((ob >> 9) & 1) << 5)); }
DEVFN void stage_rc(int b, int& R, int& C) { const int st = b / 1024, sb = b % 1024, swz = sb ^ (((sb >> 9) & 1) << 5); R = (st >> 1) * 16 + swz / 64; C = (st & 1) * 32 + (swz % 64) / 2; }
struct Unit { int pm, pn; };
struct Gemm { const bf16* A; const bf16* Bt; int M, N, K; };
struct StaticOrder {
    int nM, nN, nwg, G, c;
    MEMFN void init(int M, int N, int G_, int c_) { nM = M / BM; nN = N / BM; nwg = nM * nN; G = G_; c = c_; }
    MEMFN bool next(int i, Unit& u) const {
        const long L = (long)i * G + c; if (L >= nwg) return false;
        int wgid = (int)L; { const int q = nwg / NXCD, r = nwg % NXCD, xcd = wgid % NXCD, off = wgid / NXCD; wgid = (xcd < r ? xcd * (q + 1) : r * (q + 1) + (xcd - r) * q) + off; }
        const int nig = WGM * nN, gid = wgid / nig, fm = gid * WGM, gsz = (nM - fm) < WGM ? (nM - fm) : WGM;
        u.pm = fm + ((wgid % nig) % gsz); u.pn = (wgid % nig) / gsz; return true;
    }
};
#ifdef CPU_EMU
#define PG8_WAIT_V(n) do {} while (0)
#define PG8_WAIT_L(n) do {} while (0)
#define PG8_BAR __syncthreads()
#define PG8_SCHED do {} while (0)
#define PG8_PRIO(x) do {} while (0)
#else
#define PG8_WAIT_V(n) asm volatile("s_waitcnt vmcnt(" #n ")" ::: "memory")
#define PG8_WAIT_L(n) asm volatile("s_waitcnt lgkmcnt(" #n ")" ::: "memory")
#define PG8_BAR __builtin_amdgcn_s_barrier()
#define PG8_SCHED __builtin_amdgcn_sched_barrier(0)
#define PG8_PRIO(x) __builtin_amdgcn_s_setprio(x)
#endif
template <class Epi, class Sched>
DEVFN void gemm_phase(unsigned char* lds, const Gemm g, const Sched& S, const Epi& E) {
    const int tid = tidx();
#ifdef CPU_EMU
    const int wid = tid >> 6;
#else
    const int wid = __builtin_amdgcn_readfirstlane(tid >> 6);
#endif
    const int lane = tid & 63, wr = wid >> 2, wc = wid & 3, fr = lane & 15, fq = lane >> 4;
    const int K = g.K, nt = K / BK;
    unsigned voffA[2], voffB[2];
#pragma unroll
    for (int i = 0; i < 2; ++i) { int R, C; stage_rc(tid * 16 + i * 8192, R, C); voffA[i] = (unsigned)(R * K + C) * 2u; voffB[i] = voffA[i]; }
    const size_t kstep = (size_t)(BK * 2);
    const size_t hstep = (size_t)HALF * K * 2;
    const size_t tstep = 2 * hstep;
    const unsigned ldsw = (unsigned)wid * 1024u;
    const int aoff = lds_byte(wr * 64 + fr, fq * 8), boff = lds_byte(wc * 32 + fr, fq * 8);
#define PG8_SA(b, h) (((b) * 2 + (h)) * HTB)
#define PG8_SB(b, h) ((4 + (b) * 2 + (h)) * HTB)
#define PG8_STAGE(bufoff, gbase, voff) do { _Pragma("unroll") for (int _i = 0; _i < 2; ++_i) dma16((const char*)(gbase) + (voff)[_i], lds + (bufoff) + ldsw + _i * 8192); } while (0)
#define PG8_LDA(dst, b, h) do { _Pragma("unroll") for (int m = 0; m < 4; ++m) _Pragma("unroll") for (int k = 0; k < 2; ++k) dst[m][k] = *(const bf16x8*)(lds + PG8_SA(b, h) + aoff + m * 2048 + k * 1024); } while (0)
#define PG8_LDB(dst, b, h) do { _Pragma("unroll") for (int n = 0; n < 2; ++n) _Pragma("unroll") for (int k = 0; k < 2; ++k) dst[n][k] = *(const bf16x8*)(lds + PG8_SB(b, h) + boff + n * 2048 + k * 1024); } while (0)
#define PG8_MMA(ai, bj, At, Bt) do { PG8_PRIO(1); _Pragma("unroll") for (int m = 0; m < 4; ++m) _Pragma("unroll") for (int n = 0; n < 2; ++n) _Pragma("unroll") for (int k = 0; k < 2; ++k) \
        acc[ai][bj][m][n] = mfma16(Bt[n][k], At[m][k], acc[ai][bj][m][n]); PG8_PRIO(0); } while (0)
    Unit cur, nxt; int ui = 0;
    __syncthreads();
    if (!S.next(0, cur)) return;
    f32x4 acc[2][2][4][2];
#pragma unroll
    for (int a = 0; a < 2; ++a)
#pragma unroll
        for (int b = 0; b < 2; ++b)
#pragma unroll
            for (int m = 0; m < 4; ++m)
#pragma unroll
                for (int n = 0; n < 2; ++n) acc[a][b][m][n] = (f32x4){0.f, 0.f, 0.f, 0.f};
    bf16x8 At[4][2], B0[2][2], B1[2][2];
    const char* cA = (const char*)g.A + (size_t)cur.pm * tstep; const char* cB = (const char*)g.Bt + (size_t)cur.pn * tstep;
    PG8_STAGE(PG8_SB(0, 0), cB, voffB); PG8_STAGE(PG8_SA(0, 0), cA, voffA); PG8_STAGE(PG8_SB(0, 1), cB + hstep, voffB); PG8_STAGE(PG8_SA(0, 1), cA + hstep, voffA);
    if (wr == 1) PG8_BAR;
    PG8_WAIT_V(4); PG8_BAR;
    PG8_STAGE(PG8_SB(1, 0), cB + kstep, voffB); PG8_STAGE(PG8_SA(1, 0), cA + kstep, voffA); PG8_STAGE(PG8_SB(1, 1), cB + hstep + kstep, voffB);
    PG8_WAIT_V(6); PG8_BAR;
    for (;;) {
        const bool has_next = S.next(ui + 1, nxt);
        const char* nA = has_next ? (const char*)g.A + (size_t)nxt.pm * tstep : cA; const char* nB = has_next ? (const char*)g.Bt + (size_t)nxt.pn * tstep : cB;
        for (int t = 0; t < nt; t += 2) {
            const bool last = (t == nt - 2);
            const char* a1 = cA + (size_t)(t + 1) * kstep;
            const char* a2 = last ? nA : cA + (size_t)(t + 2) * kstep; const char* b2 = last ? nB : cB + (size_t)(t + 2) * kstep;
            const char* a3 = a2 + kstep; const char* b3 = b2 + kstep;
            PG8_LDB(B0, 0, 0); PG8_SCHED; PG8_LDA(At, 0, 0); PG8_STAGE(PG8_SA(1, 1), a1 + hstep, voffA);
            PG8_WAIT_L(8); PG8_BAR; PG8_WAIT_L(0); PG8_MMA(0, 0, At, B0); PG8_BAR; PG8_SCHED;
            PG8_LDB(B1, 0, 1); PG8_STAGE(PG8_SB(0, 0), b2, voffB);
            PG8_BAR; PG8_WAIT_L(0); PG8_MMA(0, 1, At, B1); PG8_BAR;
            PG8_LDA(At, 0, 1); PG8_STAGE(PG8_SA(0, 0), a2, voffA);
            PG8_BAR; PG8_WAIT_L(0); PG8_MMA(1, 0, At, B0); PG8_BAR; PG8_SCHED;
            PG8_STAGE(PG8_SB(0, 1), b2 + hstep, voffB);
            PG8_WAIT_V(6); PG8_BAR; PG8_MMA(1, 1, At, B1); PG8_BAR;
            PG8_LDB(B0, 1, 0); PG8_SCHED; PG8_LDA(At, 1, 0); PG8_STAGE(PG8_SA(0, 1), a2 + hstep, voffA);
            PG8_WAIT_L(8); PG8_BAR; PG8_WAIT_L(0); PG8_MMA(0, 0, At, B0); PG8_BAR; PG8_SCHED;
            PG8_LDB(B1, 1, 1); PG8_STAGE(PG8_SB(1, 0), b3, voffB);
            PG8_BAR; PG8_WAIT_L(0); PG8_MMA(0, 1, At, B1); PG8_BAR;
            PG8_LDA(At, 1, 1); PG8_STAGE(PG8_SA(1, 0), a3, voffA);
            PG8_BAR; PG8_WAIT_L(0); PG8_MMA(1, 0, At, B0); PG8_BAR; PG8_SCHED;
            PG8_STAGE(PG8_SB(1, 1), b3 + hstep, voffB);
            PG8_WAIT_V(6); PG8_BAR; PG8_MMA(1, 1, At, B1); PG8_BAR;
        }
        E(acc, cur, wr, wc, fr, fq);
        if (!has_next) break;
#pragma unroll
        for (int a = 0; a < 2; ++a)
#pragma unroll
            for (int b = 0; b < 2; ++b)
#pragma unroll
                for (int m = 0; m < 4; ++m)
#pragma unroll
                    for (int n = 0; n < 2; ++n) acc[a][b][m][n] = (f32x4){0.f, 0.f, 0.f, 0.f};
        cur = nxt; cA = nA; cB = nB; ++ui;
    }
    PG8_WAIT_V(0);
    if (wr == 0) PG8_BAR;
    PG8_BAR;
#undef PG8_SA
#undef PG8_SB
#undef PG8_STAGE
#undef PG8_LDA
#undef PG8_LDB
#undef PG8_MMA
}
template <class F> struct EpiFn { F f;
    MEMFN void operator()(const f32x4 (&acc)[2][2][4][2], const Unit& u, int wr, int wc, int fr, int fq) const {
#pragma unroll
        for (int ai = 0; ai < 2; ++ai)
#pragma unroll
            for (int m = 0; m < 4; ++m)
#pragma unroll
                for (int bj = 0; bj < 2; ++bj) f(u.pm * BM + ai * HALF + wr * 64 + m * 16 + fr, u.pn * BM + bj * HALF + wc * 32 + 4 * fq, acc[ai][bj][m][0], acc[ai][bj][m][1]); }
};
struct LatentOrder {
    int nN, nwg, G, c;
    MEMFN void init(int N, int G_, int c_) { nN = N / BM; nwg = (TS / BM) * NB * nN; G = G_; c = c_; }
    MEMFN bool next(int i, Unit& u) const { const long L = (long)i * G + c; if (L >= nwg) return false; const int lp = (int)(L / nN); u.pn = (int)(L % nN); u.pm = (lp / (TS / BM)) * (PT / BM) + LC / BM + lp % (TS / BM); return true; }
};
template <class F> DEVFN void run_latent(unsigned char* lds, const bf16* A, const bf16* Bt, int M, int N, int K, F f) {
    Gemm g{A, Bt, M, N, K}; LatentOrder S; S.init(N, (int)gridDim.x, (int)blockIdx.x); EpiFn<F> E{f}; gemm_phase(lds, g, S, E);
}
template <class F> DEVFN void run(unsigned char* lds, const bf16* A, const bf16* Bt, int M, int N, int K, F f) {
    Gemm g{A, Bt, M, N, K}; StaticOrder S; S.init(M, N, (int)gridDim.x, (int)blockIdx.x); EpiFn<F> E{f}; gemm_phase(lds, g, S, E);
}
}

DEVFN int vperm(int pp) { return (pp & ~12) | ((pp & 4) << 1) | ((pp & 8) >> 1); }
DEVFN f32x4 load4b(const bf16* src) { const u32x2 w = *(const u32x2*)src; return (f32x4){bitsf(w.x << 16), bitsf(w.x & 0xffff0000u), bitsf(w.y << 16), bitsf(w.y & 0xffff0000u)}; }
DEVFN void store4s(bf16* dst, const f32x4& v, float sc) { u32x2 w; w.x = pack2(v[0] * sc, v[1] * sc); w.y = pack2(v[2] * sc, v[3] * sc); *(u32x2*)dst = w; }
DEVFN void store4_t(bf16* dst, const f32x4& v) { u32x2 w; w.x = pack2(v[0], v[1]); w.y = pack2(v[2], v[3]); *(u32x2*)dst = w; }

constexpr int GW_INE = 2, GW_INO = 2, GW_OUT = 2, GW_GLU = 2;
constexpr bool SPLIT_CTX = (LC % 256 == 0) && (PT % 256 == 0);
template <class RB, class F> DEVFN void gemm_small_rows(unsigned char* lds, const bf16* A, int lda, const bf16* Bt, int nnt, int K, int nrt, RB rowbase, F f) {
    const int NU = nrt * nnt; GemmPtrs<2> gp, gq;
    auto begin = [&](int u, GemmPtrs<2>& g) { const int m0 = rowbase(u / nnt), n0 = (u % nnt) * 128; gemm_begin<2>(lds, [&](int r) { return A + (size_t)(m0 + r) * lda; }, Bt, K, n0, g); };
    __syncthreads();
    if ((int)blockIdx.x < NU) begin(blockIdx.x, gp);
    for (int u = blockIdx.x; u < NU; u += gridDim.x, gp = gq) { const int m0 = rowbase(u / nnt), n0 = (u % nnt) * 128;
        gemm_run<2, true>(lds, gp, K, [&]() { if (u + (int)gridDim.x < NU) begin(u + gridDim.x, gq); }, [&](int rl, int cl, const f32x4& a0, const f32x4& a1) { f(m0 + rl, n0 + cl, a0, a1); }); }
}
template <class F> DEVFN void gemm_ctx_rows(unsigned char* lds, const bf16* A, int lda, const bf16* Bt, int N, int K, F f) {
    constexpr int RT = LC / 128; gemm_small_rows(lds, A, lda, Bt, N / 128, K, NB * RT, [&](int rt) { return (rt / RT) * PT + (rt % RT) * 128; }, f);
}
template <class F> DEVFN void dense_gemm(unsigned char* lds, const bf16* A, const bf16* Bt, int N, int K, bool ctx_needed, F f) {
    if constexpr (SPLIT_CTX) { pg8::run_latent(lds, A, Bt, MR, N, K, f); if (ctx_needed) gemm_ctx_rows(lds, A, K, Bt, N, K, f); }
    else pg8::run(lds, A, Bt, MR, N, K, f);
}
DEVFN void scatter4_t(bf16* base, size_t rowstride, const f32x4& v) {
#pragma unroll
    for (int e = 0; e < 4; ++e) base[(size_t)e * rowstride] = f2bf(v[e]);
}
DEVFN void phase_inproj_even(const Params& p, unsigned char* lds, int l) {
    const bf16* A = (const bf16*)(p.ws + WS_ABF); const bf16* Bt = (const bf16*)(p.ws + WS_WIN) + (size_t)l * WIN_LSTRIDE; bf16* Z = (bf16*)(p.ws + WS_Z);
    dense_gemm(lds, A, Bt, EVEN_N, D, true, [&](int row, int col, const f32x4& a0, const f32x4& a1) {
        const int region = col >> 9, cc = col & 511;
        if (region == 3) { const int b = row / PT, pp = row % PT;
            bf16* vb = Z + ZE_VT + ((size_t)(b * 8 + (cc >> 6)) * 64 + (cc & 63)) * PT + vperm(pp); scatter4_t(vb, PT, a0); scatter4_t(vb + (size_t)16 * PT, PT, a1); }
        else { bf16* dst = Z + (region == 0 ? ZE_U : region == 1 ? ZE_Q : ZE_K) + (size_t)row * 512 + cc; const float sc = region == 1 ? QSCALE : 1.0f; store4s(dst, a0, sc); store4s(dst + 16, a1, sc); } });
}

DEVFN void phase_inproj_odd(const Params& p, unsigned char* lds, int l) {
    const bf16* A = (const bf16*)(p.ws + WS_ABF); const bf16* Bt = (const bf16*)(p.ws + WS_WIN) + (size_t)l * WIN_LSTRIDE; bf16* Z = (bf16*)(p.ws + WS_Z);
    const int fg = (tidx() & 63) >> 4;
    const float* rtab = (const float*)(p.ws + WS_ROPE);
    auto epi = [&](int row, int cb, const f32x4& a0, const f32x4& a1) {
        const int b = row / PT, pp = row % PT;
        if (cb < 256) { store4s(Z + ZO_GQ + (size_t)row * 256 + cb, a0, 0.125f); store4s(Z + ZO_GQ + (size_t)row * 256 + cb + 16, a1, 0.125f); }
        else if (cb < 512) { const int c = cb - 256;
            store4s(Z + ZO_GK + (size_t)row * 256 + c, a0, 1.0f); store4s(Z + ZO_GK + (size_t)row * 256 + c + 16, a1, 1.0f);
            bf16* kb = Z + ZO_GKT + ((size_t)(b * 4 + (c >> 6)) * 64 + (c & 63)) * PT + pp; scatter4_t(kb, PT, a0); scatter4_t(kb + (size_t)16 * PT, PT, a1); }
        else if (cb < 1024) { const int c = cb - 512; bf16* vb = Z + ZO_GVT + ((size_t)(b * 4 + (c >> 7)) * 128 + (c & 127)) * PT + pp; scatter4_t(vb, PT, a0); scatter4_t(vb + (size_t)16 * PT, PT, a1); }
        else if (cb < 1536) { store4s(Z + ZO_GR + (size_t)row * 512 + cb - 1024, a0, 1.0f); store4s(Z + ZO_GR + (size_t)row * 512 + cb - 1024 + 16, a1, 1.0f); }
        else if (cb < 2560) {
            const bool isq = cb < 2048; const int c0 = cb - (isq ? 1536 : 2048); const int blk = (c0 >> 5) & 1; bf16* dst = Z + (isq ? ZO_DQ : ZO_DK) + (size_t)row * 512 + c0; const float sc = isq ? QSCALE : 1.0f;
            f32x4 x1 = a0 * sc, x2 = a1 * sc;
            if (pp >= LC) { const int t = pp - LC; const int pos = blk == 0 ? (t >> 6) : (t & 63); const f32x4 cs = *(const f32x4*)(rtab + pos * 16 + 4 * fg), sn = *(const f32x4*)(rtab + 1024 + pos * 16 + 4 * fg);
                const f32x4 o1 = x1 * cs - x2 * sn, o2 = x1 * sn + x2 * cs; x1 = o1; x2 = o2; }
            store4s(dst, x1, 1.0f); store4s(dst + 16, x2, 1.0f); }
        else if (cb < 3072) { const int c = cb - 2560; bf16* vb = Z + ZO_DVT + ((size_t)(b * 4 + (c >> 7)) * 128 + (c & 127)) * PT + vperm(pp); scatter4_t(vb, PT, a0); scatter4_t(vb + (size_t)16 * PT, PT, a1); }
        else if (cb < 3072 + 16) { store4s(Z + ZO_GZ + (size_t)row * 32 + (cb - 3072), a0, 1.0f); store4s(Z + ZO_GZ + (size_t)row * 32 + (cb - 3072) + 16, a1, 1.0f); } };
    if constexpr (SPLIT_CTX) {
        dense_gemm(lds, A, Bt, 3072, D, true, epi);
        gemm_small_rows(lds, A, D, Bt + (size_t)3072 * D, 1, D, MR / 128, [&](int rt) { return rt * 128; },
                        [&](int row, int col, const f32x4& a0, const f32x4& a1) { epi(row, 3072 + col, a0, a1); });
    } else pg8::run(lds, A, Bt, MR, ODD_NP, D, epi);
}

DEVFN void phase_glu(const Params& p, unsigned char* lds, int j) {
    const bf16* A = (const bf16*)(p.ws + WS_SB + SBO_GS); const bf16* Bt = (const bf16*)(p.ws + WS_GLU) + (size_t)j * 1024 * 512; bf16* Y = (bf16*)(p.ws + WS_YMIX);
    const float* gb = p.in[I_GLUB] + (size_t)j * 1024;
    dense_gemm(lds, A, Bt, 1024, 512, true, [&](int row, int col, const f32x4& a0, const f32x4& a1) {
        const int jj = (col >> 5) * 16 + (col & 15); const f32x4 bv = *(const f32x4*)(gb + jj), bg = *(const f32x4*)(gb + 512 + jj); f32x4 o;
#pragma unroll
        for (int r = 0; r < 4; ++r) o[r] = (a0[r] + bv[r]) * sigmoidf_(a1[r] + bg[r]);
        store4s(Y + (size_t)row * D + jj, o, 1.0f); });
}

constexpr int OPS = 4;
constexpr size_t OP_PSTRIDE = (size_t)NB * LC * D;
static_assert(!SPLIT_CTX || OPS * OP_PSTRIDE * 4 <= (size_t)2 * MR * D * 2, "split-K partials must fit the MoE output region");
DEVFN void outproj_ctx_splitk(unsigned char* lds, const bf16* A, const bf16* Bt, float* P) {
    constexpr int RT = LC / 128, NNT = D / 128, NU = NB * RT * NNT * OPS, KS = D / OPS;
    GemmPtrs<2> gp, gq;
    auto begin = [&](int u, GemmPtrs<2>& g) { const int s = u % OPS, t = u / OPS, rt = t / NNT, n0 = (t % NNT) * 128, m0 = (rt / RT) * PT + (rt % RT) * 128;
        gemm_begin<2>(lds, [&](int r) { return A + (size_t)(m0 + r) * D + s * KS; }, Bt + s * KS, D, n0, g); };
    __syncthreads();
    if ((int)blockIdx.x < NU) begin(blockIdx.x, gp);
    for (int u = blockIdx.x; u < NU; u += gridDim.x, gp = gq) { const int s = u % OPS, t = u / OPS, rt = t / NNT, n0 = (t % NNT) * 128, c0 = (rt / RT) * LC + (rt % RT) * 128;
        gemm_run<2, true>(lds, gp, KS, [&]() { if (u + (int)gridDim.x < NU) begin(u + gridDim.x, gq); }, [&](int rl, int cl, const f32x4& a0, const f32x4& a1) {
            float* dst = P + (size_t)s * OP_PSTRIDE + (size_t)(c0 + rl) * D + n0 + cl; *(f32x4*)dst = a0; *(f32x4*)(dst + 16) = a1; }); }
}
DEVFN void phase_outproj(const Params& p, unsigned char* lds, int l) {
    const bf16* A = (const bf16*)(p.ws + WS_YMIX); const bf16* Bt = (const bf16*)(p.ws + WS_WOUT) + (size_t)l * D * D; bf16* C = (bf16*)(p.ws + WS_Z);
    auto epi = [&](int row, int col, const f32x4& a0, const f32x4& a1) { bf16* dst = C + (size_t)row * D + col; store4s(dst, a0, 1.0f); store4s(dst + 16, a1, 1.0f); };
    if constexpr (SPLIT_CTX) { pg8::run_latent(lds, A, Bt, MR, D, D, epi); outproj_ctx_splitk(lds, A, Bt, (float*)(p.ws + WS_SB)); }
    else dense_gemm(lds, A, Bt, D, D, true, epi);
}

struct MoeMap { int e, mt, cnt, off; };
DEVFN bool moe_find(const unsigned* cnt, int tile, MoeMap& mm) {
    int acc = 0;
    for (int e = 0; e < NEXP; ++e) { const int c = (int)cnt[e], nt = (c + 127) >> 7; if (tile < acc + nt) { mm.e = e; mm.mt = tile - acc; mm.cnt = c; mm.off = acc * 128; return true; } acc += nt; }
    return false;
}
DEVFN int moe_off(const unsigned* cnt, int e) { int acc = 0; for (int i = 0; i < e; ++i) acc += ((int)cnt[i] + 127) >> 7; return acc * 128; }
constexpr int MOE_TAB = 3 * 32768;
DEVFN const unsigned* moe_table(unsigned char* lds, const unsigned* cnt) {
    unsigned* tab = (unsigned*)(lds + MOE_TAB);
    __syncthreads();
    if (tidx() < NEXP) tab[tidx()] = cnt[tidx()];
    __syncthreads();
    return tab;
}

DEVFN void phase_moe_up(const Params& p, unsigned char* lds, int l) {
    const bf16* A = (const bf16*)(p.ws + WS_ABF); bf16* ACT = (bf16*)(p.ws + WS_ACT); const unsigned* cnt = (const unsigned*)(p.ws + WS_CTL + CTL_CNT) + l * NEXP;
    const int* ltok = (const int*)(p.ws + WS_LTOK); const float* lw = (const float*)(p.ws + WS_LW); const unsigned* tab = moe_table(lds, cnt);
    GemmPtrs<2> gp, gq; MoeMap mm, mn;
    auto begin = [&](const MoeMap& m, int nt, GemmPtrs<2>& g) { const bf16* Bt = (const bf16*)(p.ws + WS_MGU) + (size_t)(l * NEXP + m.e) * 512 * 1024; const int* lt = ltok + (size_t)m.e * MR;
        gemm_begin<2>(lds, [&](int r) { const int slot = m.mt * 128 + r; const int tok = lt[slot < m.cnt ? slot : 0]; return A + (size_t)tok * D; }, Bt, D, nt * 128, g); };
    int u = (gridDim.x & 7) == 0 ? (int)(blockIdx.x & 7) * (int)(gridDim.x >> 3) + (int)(blockIdx.x >> 3) : (int)blockIdx.x;
    bool ok = moe_find(tab, u >> 2, mm);
    if (ok) begin(mm, u & 3, gp);
    while (ok) { const int un = u + gridDim.x; const bool okn = moe_find(tab, un >> 2, mn); const int n0 = (u & 3) * 128;
        gemm_run<2, true>(lds, gp, D, [&]() { if (okn) begin(mn, un & 3, gq); }, [&](int rl, int cl, const f32x4& a0, const f32x4& a1) {
            const int jj = ((n0 + cl) >> 5) * 16 + (cl & 15), slot = mm.mt * 128 + rl;
            if (slot < mm.cnt) { const float w = lw[(size_t)mm.e * MR + slot]; f32x4 o;
#pragma unroll
                for (int r = 0; r < 4; ++r) o[r] = siluf_(a0[r]) * a1[r] * w;
                store4s(ACT + (size_t)(mm.off + slot) * 256 + jj, o, 1.0f); } });
        gp = gq; mm = mn; ok = okn; u = un; }
}
DEVFN void phase_moe_down(const Params& p, unsigned char* lds, int l) {
    const bf16* ACT = (const bf16*)(p.ws + WS_ACT); bf16* F2 = (bf16*)(p.ws + WS_SB); const unsigned* cnt = (const unsigned*)(p.ws + WS_CTL + CTL_CNT) + l * NEXP;
    const unsigned* tab = moe_table(lds, cnt);
    GemmPtrs<2> gp, gq; MoeMap mm, mn;
    auto begin = [&](const MoeMap& m, int nt, GemmPtrs<2>& g) { const bf16* Bt = (const bf16*)(p.ws + WS_MDN) + (size_t)(l * NEXP + m.e) * 1024 * 256; const size_t r0 = (size_t)m.off + m.mt * 128;
        gemm_begin<2>(lds, [&](int r) { return ACT + (r0 + r) * 256; }, Bt, 256, nt * 128, g); };
    int u = (gridDim.x & 7) == 0 ? (int)(blockIdx.x & 7) * (int)(gridDim.x >> 3) + (int)(blockIdx.x >> 3) : (int)blockIdx.x;
    bool ok = moe_find(tab, u >> 3, mm);
    if (ok) begin(mm, u & 7, gp);
    while (ok) { const int un = u + gridDim.x; const bool okn = moe_find(tab, un >> 3, mn); const int n0 = (u & 7) * 128; const size_t r0 = (size_t)mm.off + mm.mt * 128;
        gemm_run<2, true>(lds, gp, 256, [&]() { if (okn) begin(mn, un & 7, gq); }, [&](int rl, int cl, const f32x4& a0, const f32x4& a1) {
            bf16* dst = F2 + (r0 + rl) * D + n0 + cl; store4s(dst, a0, 1.0f); store4s(dst + 16, a1, 1.0f); });
        gp = gq; mm = mn; ok = okn; u = un; }
}

DEVFN void ln_row(float (&v)[16], const float* g, const float* bta, int lane) {
    float s = 0.f;
#pragma unroll
    for (int i = 0; i < 16; ++i) s += v[i];
    const float mu = wave_sum(s) * (1.0f / 1024.0f); float q = 0.f;
#pragma unroll
    for (int i = 0; i < 16; ++i) { const float d = v[i] - mu; q += d * d; }
    const float rstd = 1.0f / sqrtf(wave_sum(q) * (1.0f / 1024.0f) + LN_EPS);
#pragma unroll
    for (int i = 0; i < 4; ++i) { const f32x4 gg = *(const f32x4*)(g + i * 256 + lane * 4), bb = *(const f32x4*)(bta + i * 256 + lane * 4);
#pragma unroll
        for (int e = 0; e < 4; ++e) v[i * 4 + e] = (v[i * 4 + e] - mu) * rstd * gg[e] + bb[e]; }
}

DEVFN void ln_row_r(float (&v)[16], const float (&g)[16], const float (&bta)[16]) {
    float s = 0.f;
#pragma unroll
    for (int i = 0; i < 16; ++i) s += v[i];
    const float mu = wave_sum(s) * (1.0f / 1024.0f); float q = 0.f;
#pragma unroll
    for (int i = 0; i < 16; ++i) { const float d = v[i] - mu; q += d * d; }
    const float rstd = 1.0f / sqrtf(wave_sum(q) * (1.0f / 1024.0f) + LN_EPS);
#pragma unroll
    for (int i = 0; i < 16; ++i) v[i] = (v[i] - mu) * rstd * g[i] + bta[i];
}
DEVFN void ln_load_gb(const float* g, const float* bta, int lane, float (&gr)[16], float (&br)[16]) {
#pragma unroll
    for (int i = 0; i < 4; ++i) { const f32x4 gg = *(const f32x4*)(g + i * 256 + lane * 4), bb = *(const f32x4*)(bta + i * 256 + lane * 4);
#pragma unroll
        for (int e = 0; e < 4; ++e) { gr[i * 4 + e] = gg[e]; br[i * 4 + e] = bb[e]; } }
}

DEVFN void phase_ln1_route(const Params& p, unsigned char* lds, int l) {
    const int wave = tidx() >> 6, lane = tidx() & 63; bf16* H = (bf16*)(p.ws + WS_H); const bf16* C = (const bf16*)(p.ws + WS_Z); bf16* A = (bf16*)(p.ws + WS_ABF);
    unsigned* cnt = (unsigned*)(p.ws + WS_CTL + CTL_CNT) + l * NEXP; int* route = (int*)(p.ws + WS_ROUTE); int* ltok = (int*)(p.ws + WS_LTOK); float* lw = (float*)(p.ws + WS_LW);
    const float* wg = p.in[I_WGRP] + (size_t)l * D * 4; const float* we = p.in[I_WEXP] + (size_t)l * D * 32;
    float* hrow = (float*)lds;
    float* part = (float*)(lds + 32768);
    const int ke = wave * 128 + (lane >> 5) * 64, kg = wave * 128 + (lane >> 2) * 8;
    f32x2 wreg[32], wgr[4];
#pragma unroll
    for (int i = 0; i < 32; ++i) wreg[i] = (f32x2){we[(size_t)(ke + 2 * i) * 32 + (lane & 31)], we[(size_t)(ke + 2 * i + 1) * 32 + (lane & 31)]};
#pragma unroll
    for (int i = 0; i < 4; ++i) wgr[i] = (f32x2){wg[(size_t)(kg + 2 * i) * 4 + (lane & 3)], wg[(size_t)(kg + 2 * i + 1) * 4 + (lane & 3)]};
    const float bias = lane < 32 ? p.in[I_BEXP][l * 32 + lane] : (lane < 36 ? p.in[I_BGRP][l * 4 + lane - 32] : 0.f);
    unsigned* lcnt = (unsigned*)(lds + 49152); unsigned* lbase = lcnt + 32; int* rt = (int*)(lds + 49152 + 256);
    constexpr int RT_MAX = 1024;
    __syncthreads();
    if (tidx() < 32) lcnt[tidx()] = 0u;
    __syncthreads();
    float lng[16], lnb[16]; ln_load_gb(p.in[I_LNG] + (size_t)(l * 2) * D, p.in[I_LNB] + (size_t)(l * 2) * D, lane, lng, lnb);
    int nrec = 0; u32x2 hn[4], yn[4];
    if (blockIdx.x * 8 < MR) {
#pragma unroll
        for (int i = 0; i < 4; ++i) { const size_t o = (size_t)(blockIdx.x * 8 + wave) * D + i * 256 + lane * 4; hn[i] = *(const u32x2*)(H + o); yn[i] = *(const u32x2*)(C + o); } }
    for (int r0 = blockIdx.x * 8; r0 < MR; r0 += gridDim.x * 8, ++nrec) { const int row = r0 + wave; const int b = row / PT, pp = row % PT, mr = pp < LC ? NB : b;
        const float* mv = (const float*)(p.ws + WS_MODV) + ((size_t)l * (NB + 1) + mr) * 6144; float v[16];
        const bool ctxp = SPLIT_CTX && pp < LC; const float* pb = (const float*)(p.ws + WS_SB) + (size_t)(b * LC + (ctxp ? pp : 0)) * D;
#pragma unroll
        for (int i = 0; i < 4; ++i) { const int c = i * 256 + lane * 4; const f32x4 g1 = *(const f32x4*)(mv + 2048 + c);
            const f32x4 h = (f32x4){bitsf(hn[i].x << 16), bitsf(hn[i].x & 0xffff0000u), bitsf(hn[i].y << 16), bitsf(hn[i].y & 0xffff0000u)};
            f32x4 y = (f32x4){bitsf(yn[i].x << 16), bitsf(yn[i].x & 0xffff0000u), bitsf(yn[i].y << 16), bitsf(yn[i].y & 0xffff0000u)};
            if (ctxp) y = (*(const f32x4*)(pb + c) + *(const f32x4*)(pb + OP_PSTRIDE + c)) + (*(const f32x4*)(pb + 2 * OP_PSTRIDE + c) + *(const f32x4*)(pb + 3 * OP_PSTRIDE + c));
#pragma unroll
            for (int e = 0; e < 4; ++e) v[i * 4 + e] = ALPHA * h[e] + g1[e] * y[e]; }
        if (r0 + gridDim.x * 8 < MR) {
#pragma unroll
            for (int i = 0; i < 4; ++i) { const size_t o = (size_t)(row + gridDim.x * 8) * D + i * 256 + lane * 4; hn[i] = *(const u32x2*)(H + o); yn[i] = *(const u32x2*)(C + o); } }
        f32x4 shv[4], scv[4];
#pragma unroll
        for (int i = 0; i < 4; ++i) { const int c = i * 256 + lane * 4; shv[i] = *(const f32x4*)(mv + 3072 + c); scv[i] = *(const f32x4*)(mv + 4096 + c); }
        ln_row_r(v, lng, lnb);
        __syncthreads();
#pragma unroll
        for (int i = 0; i < 4; ++i) { const int c = i * 256 + lane * 4; { u32x2 hw; hw.x = pack2(v[i * 4], v[i * 4 + 1]); hw.y = pack2(v[i * 4 + 2], v[i * 4 + 3]); *(u32x2*)(H + (size_t)row * D + c) = hw; }
            const f32x4 sh = shv[i], sc = scv[i]; f32x4 h2;
#pragma unroll
            for (int e = 0; e < 4; ++e) h2[e] = v[i * 4 + e] * (1.f + sc[e]) + sh[e];
            *(f32x4*)(hrow + wave * 1024 + c) = h2;
            u32x2 w; w.x = pack2(h2[0], h2[1]); w.y = pack2(h2[2], h2[3]); *(u32x2*)(A + (size_t)row * D + c) = w; }
        __syncthreads();
#pragma unroll
        for (int r = 0; r < 8; ++r) { f32x2 ae2 = {0.f, 0.f}, ae3 = {0.f, 0.f}, ag2 = {0.f, 0.f};
#pragma unroll
            for (int i = 0; i < 64; i += 4) { const f32x4 hv = *(const f32x4*)(hrow + r * 1024 + ke + i);
                ae2 = __builtin_elementwise_fma((f32x2){hv[0], hv[1]}, wreg[i >> 1], ae2); ae3 = __builtin_elementwise_fma((f32x2){hv[2], hv[3]}, wreg[(i >> 1) + 1], ae3); }
#pragma unroll
            for (int i = 0; i < 8; i += 4) { const f32x4 hv = *(const f32x4*)(hrow + r * 1024 + kg + i);
                ag2 = __builtin_elementwise_fma((f32x2){hv[0], hv[1]}, wgr[i >> 1], ag2); ag2 = __builtin_elementwise_fma((f32x2){hv[2], hv[3]}, wgr[(i >> 1) + 1], ag2); }
            float ae = (ae2[0] + ae3[0]) + (ae2[1] + ae3[1]), ag = ag2[0] + ag2[1];
            ae += __shfl_xor(ae, 32);
            ag += __shfl_xor(ag, 4); ag += __shfl_xor(ag, 8); ag += __shfl_xor(ag, 16); ag += __shfl_xor(ag, 32);
            if (lane < 32) part[(wave * 8 + r) * 64 + lane] = ae; else if (lane < 36) part[(wave * 8 + r) * 64 + lane] = ag;
        }
        __syncthreads();
        float logit = bias;
#pragma unroll
        for (int w8 = 0; w8 < 8; ++w8) logit += part[(w8 * 8 + wave) * 64 + lane];
        float lg[4];
#pragma unroll
        for (int o = 0; o < 4; ++o) lg[o] = __shfl(logit, 32 + o);
        int gs = 0; float gm = lg[0];
#pragma unroll
        for (int o = 1; o < 4; ++o) if (lg[o] > gm) { gm = lg[o]; gs = o; }
        float den = 0.f;
#pragma unroll
        for (int o = 0; o < 4; ++o) den += fexp(lg[o] - gm);
        const float pg = 1.0f / den;
        float li[8];
#pragma unroll
        for (int e = 0; e < 8; ++e) li[e] = __shfl(logit, gs * 8 + e);
        int i0 = 0; float v0 = li[0];
#pragma unroll
        for (int e = 1; e < 8; ++e) if (li[e] > v0) { v0 = li[e]; i0 = e; }
        int i1 = -1; float v1 = -3.0e38f;
#pragma unroll
        for (int e = 0; e < 8; ++e) if (e != i0 && li[e] > v1) { v1 = li[e]; i1 = e; }
        if (i1 < 0) i1 = (i0 + 1) & 7;
        const float w0 = 1.0f / (1.0f + fexp(v1 - v0)), w1 = 1.0f - w0;
        if (lane == 0) { const int e0 = gs * 8 + i0, e1 = gs * 8 + i1; const int rec = nrec * 8 + wave;
            if (rec < RT_MAX) { int* q = rt + rec * 6; q[0] = e0; q[1] = e1; q[2] = (int)fbits(w0 * pg); q[3] = (int)fbits(w1 * pg); q[4] = (int)atomicAdd(&lcnt[e0], 1u); q[5] = (int)atomicAdd(&lcnt[e1], 1u); } }
    }
    __syncthreads();
    if (tidx() < 32) lbase[tidx()] = atomicAdd(&cnt[tidx()], lcnt[tidx()]);
    __syncthreads();
    for (int rec = tidx(); rec < nrec * 8 && rec < RT_MAX; rec += NTH) { const int row = (blockIdx.x + (rec >> 3) * gridDim.x) * 8 + (rec & 7); const int* q = rt + rec * 6;
        const int e0 = q[0], e1 = q[1], s0 = (int)lbase[e0] + q[4], s1 = (int)lbase[e1] + q[5];
        ltok[(size_t)e0 * MR + s0] = row; lw[(size_t)e0 * MR + s0] = bitsf((unsigned)q[2]); ltok[(size_t)e1 * MR + s1] = row; lw[(size_t)e1 * MR + s1] = bitsf((unsigned)q[3]);
        route[row * 4 + 0] = e0; route[row * 4 + 1] = e1; route[row * 4 + 2] = s0; route[row * 4 + 3] = s1; }
}

DEVFN void phase_ln2(const Params& p, unsigned char* lds, int l) {
    const int wave = tidx() >> 6, lane = tidx() & 63; bf16* H = (bf16*)(p.ws + WS_H); const bf16* F2 = (const bf16*)(p.ws + WS_SB); bf16* A = (bf16*)(p.ws + WS_ABF);
    const unsigned* cnt = (const unsigned*)(p.ws + WS_CTL + CTL_CNT) + l * NEXP; const int* route = (const int*)(p.ws + WS_ROUTE);
    int* offs = (int*)lds;
    __syncthreads();
    if (tidx() < NEXP) offs[tidx()] = moe_off(cnt, tidx());
    __syncthreads();
    float lng[16], lnb[16]; ln_load_gb(p.in[I_LNG] + (size_t)(l * 2 + 1) * D, p.in[I_LNB] + (size_t)(l * 2 + 1) * D, lane, lng, lnb);
    for (int rw = (blockIdx.x * 8 + wave) * 2; rw < MR; rw += gridDim.x * 16) {
        float v[2][16]; size_t r0[2], r1[2];
#pragma unroll
        for (int q = 0; q < 2; ++q) { const int row = rw + q; const int e0 = route[row * 4], e1 = route[row * 4 + 1]; r0[q] = (size_t)offs[e0] + route[row * 4 + 2]; r1[q] = (size_t)offs[e1] + route[row * 4 + 3]; }
#pragma unroll
        for (int q = 0; q < 2; ++q) { const int row = rw + q; const int b = row / PT, pp = row % PT, mr = pp < LC ? NB : b; const float* mv = (const float*)(p.ws + WS_MODV) + ((size_t)l * (NB + 1) + mr) * 6144;
#pragma unroll
            for (int i = 0; i < 4; ++i) { const int c = i * 256 + lane * 4; const f32x4 h = load4b(H + (size_t)row * D + c), g2 = *(const f32x4*)(mv + 5120 + c);
                const u32x2 fa = *(const u32x2*)(F2 + r0[q] * D + c), fb = *(const u32x2*)(F2 + r1[q] * D + c);
                const float f0 = bitsf(fa.x << 16) + bitsf(fb.x << 16), f1 = bitsf(fa.x & 0xffff0000u) + bitsf(fb.x & 0xffff0000u), f2 = bitsf(fa.y << 16) + bitsf(fb.y << 16), f3 = bitsf(fa.y & 0xffff0000u) + bitsf(fb.y & 0xffff0000u);
                v[q][i * 4] = ALPHA * h[0] + g2[0] * f0; v[q][i * 4 + 1] = ALPHA * h[1] + g2[1] * f1; v[q][i * 4 + 2] = ALPHA * h[2] + g2[2] * f2; v[q][i * 4 + 3] = ALPHA * h[3] + g2[3] * f3; } }
#pragma unroll
        for (int q = 0; q < 2; ++q) { const int row = rw + q; const int b = row / PT, pp = row % PT;
            ln_row_r(v[q], lng, lnb);
#pragma unroll
            for (int i = 0; i < 4; ++i) { const int c = i * 256 + lane * 4; const f32x4 o = (f32x4){v[q][i * 4], v[q][i * 4 + 1], v[q][i * 4 + 2], v[q][i * 4 + 3]};
                if (l + 1 < NL) { u32x2 hw; hw.x = pack2(o[0], o[1]); hw.y = pack2(o[2], o[3]); *(u32x2*)(H + (size_t)row * D + c) = hw; }
                else if (pp >= LC) *(f32x4*)(p.out + ((size_t)b * TS + (pp - LC)) * D + c) = o; }
            if (l + 1 < NL) mod_store_row(p, l + 1, 0, row, v[q], A + (size_t)row * D); }
    }
}

DEVFN void wave_sync() {
#ifdef CPU_EMU
    (void)__shfl(0, 0);
#else
    __builtin_amdgcn_fence(__ATOMIC_RELEASE, "wavefront"); asm volatile("s_waitcnt lgkmcnt(0)" ::: "memory"); __builtin_amdgcn_wave_barrier(); __builtin_amdgcn_fence(__ATOMIC_ACQUIRE, "wavefront");
#endif
}
DEVFN bf16x8 cvt8(const f32x4 lo, const f32x4 hi, float sg) { u32x4 w; w[0] = pack2(lo[0] * sg, lo[1] * sg); w[1] = pack2(lo[2] * sg, lo[3] * sg); w[2] = pack2(hi[0] * sg, hi[1] * sg); w[3] = pack2(hi[2] * sg, hi[3] * sg); return __builtin_bit_cast(bf16x8, w); }
constexpr int S5_WAVE_LDS = 16 * 132 * 4;
DEVFN void s5_chunk(const Params& p, float* buf, int j, int b, int g, int c, int lane, const bool READOUT, int dlo = 0, int dhi = 2, float* xch = nullptr) {
    const int fr = lane & 15, fg = lane >> 4; const bf16* U = (const bf16*)(p.ws + WS_Z) + ZE_U + ((size_t)b * PT + c * 64) * 512 + g * 16;
    f32x4 y[4], y2[4];
#pragma unroll
    for (int sb = 0; sb < 4; ++sb) { y[sb] = (f32x4){0.f, 0.f, 0.f, 0.f}; y2[sb] = (f32x4){0.f, 0.f, 0.f, 0.f}; }
#pragma unroll 1
    for (int d = dlo; d < dhi; ++d) { const size_t pbase = (size_t)((j * 2 + d) * 32 + g) * 64; const float* prm = (const float*)(p.ws + WS_S5P);
        bf16x8 bbf[8];
#pragma unroll
        for (int n = 0; n < 8; ++n) { const int pp = (n & 3) * 16 + fr; const float* src = prm + (pbase + pp) * S5P_STRIDE + (n < 4 ? 4 : 20) + (fg & 1) * 8;
            f32x4 lo = *(const f32x4*)src, hi = *(const f32x4*)(src + 4); if (fg >= 2) { lo = (f32x4){0.f, 0.f, 0.f, 0.f}; hi = lo; } bbf[n] = cvt8(lo, hi, 1.0f); }
        bf16x8 cf[4];
        if (READOUT) {
#pragma unroll
            for (int ks = 0; ks < 4; ++ks) { const float* src = (ks < 2 ? p.in[I_CRE] : p.in[I_CIM]) + (((size_t)(j * 2 + d) * 32 + g) * 16 + fr) * 64 + (ks & 1) * 32 + fg * 8;
                cf[ks] = cvt8(*(const f32x4*)src, *(const f32x4*)(src + 4), ks < 2 ? 1.0f : -1.0f); } }
        const float are = prm[(pbase + lane) * S5P_STRIDE], aim = prm[(pbase + lane) * S5P_STRIDE + 1];
        float hr = 0.f, hi = 0.f;
        if (READOUT) { const f32x2 h0 = *(const f32x2*)((const float*)(p.ws + WS_SB + SBO_S5H) + ((size_t)((b * 32 + g) * 2 + d) * NCH + c) * 128 + lane * 2); hr = h0[0]; hi = h0[1]; }
#pragma unroll
        for (int sbi = 0; sbi < 4; ++sbi) { const int sb = d ? 3 - sbi : sbi;
            u32x4 uv = (u32x4){0u, 0u, 0u, 0u}; if (fg < 2) uv = *(const u32x4*)(U + (size_t)(sb * 16 + fr) * 512 + fg * 8); const bf16x8 ua = __builtin_bit_cast(bf16x8, uv);
            f32x4 yy = (f32x4){0.f, 0.f, 0.f, 0.f};
            wave_sync();
#pragma unroll
            for (int n = 0; n < 8; ++n) { const f32x4 t4 = mfma16(ua, bbf[n], (f32x4){0.f, 0.f, 0.f, 0.f});
#pragma unroll
                for (int r = 0; r < 4; ++r) buf[(fg * 4 + r) * 132 + n * 16 + fr] = t4[r]; }
            wave_sync();
            for (int t0 = 0; t0 < 16; ++t0) { const int tt = d ? 15 - t0 : t0; const float ur = buf[tt * 132 + lane], ui = buf[tt * 132 + 64 + lane];
                const float nr = are * hr - aim * hi + ur, ni = are * hi + aim * hr + ui; hr = nr; hi = ni;
                buf[tt * 132 + lane] = hr; buf[tt * 132 + 64 + lane] = hi; }
            if (READOUT) { wave_sync();
#pragma unroll
                for (int ks = 0; ks < 4; ++ks) { const float* hp = buf + fr * 132 + ks * 32 + fg * 8; yy = mfma16(cf[ks], cvt8(*(const f32x4*)hp, *(const f32x4*)(hp + 4), 1.0f), yy); }
                if (d == 0) y[sbi] += yy; else y2[sbi] += yy; }
        }
        if (!READOUT) *(f32x2*)((float*)(p.ws + WS_SB + SBO_S5E) + ((size_t)((b * 32 + g) * 2 + d) * NCH + c) * 128 + lane * 2) = (f32x2){hr, hi};
    }
    if (READOUT && xch) {
        if (dlo == 1) {
#pragma unroll
            for (int sb = 0; sb < 4; ++sb) *(f32x4*)(xch + (sb * 64 + lane) * 4) = y2[sb];
            __syncthreads(); return; }
        __syncthreads();
#pragma unroll
        for (int sb = 0; sb < 4; ++sb) y2[sb] = *(const f32x4*)(xch + (sb * 64 + lane) * 4); }
    if (READOUT) { bf16* GS = (bf16*)(p.ws + WS_SB + SBO_GS); const f32x4 dsk = *(const f32x4*)(p.in[I_S5D] + (size_t)j * 512 + g * 16 + fg * 4);
#pragma unroll
        for (int sb = 0; sb < 4; ++sb) { const int t = sb * 16 + fr; const u32x2 uu = *(const u32x2*)(U + (size_t)t * 512 + fg * 4); f32x4 o; y[sb] += y2[3 - sb];
            o[0] = geluf_(y[sb][0] + dsk[0] * bitsf(uu.x << 16)); o[1] = geluf_(y[sb][1] + dsk[1] * bitsf(uu.x & 0xffff0000u));
            o[2] = geluf_(y[sb][2] + dsk[2] * bitsf(uu.y << 16)); o[3] = geluf_(y[sb][3] + dsk[3] * bitsf(uu.y & 0xffff0000u));
            store4_t(GS + ((size_t)b * PT + c * 64 + t) * 512 + g * 16 + fg * 4, o); } }
}
DEVFN void phase_s5a(const Params& p, unsigned char* lds, int j) {
    const int wave = tidx() >> 6, lane = tidx() & 63; float* buf = (float*)(lds + wave * S5_WAVE_LDS);
    const int NIT = NB * 32 * NCH, GW = gridDim.x * 8, full = (NIT / GW) * GW, wid = blockIdx.x * 8 + wave;
    for (int it = wid; it < full; it += GW) { const int c = it % NCH, g = (it / NCH) % 32, b = it / (NCH * 32); s5_chunk(p, buf, j, b, g, c, lane, false); }
    for (int pi = wid; pi < 2 * (NIT - full); pi += GW) { const int it = full + (pi >> 1), d = pi & 1; const int c = it % NCH, g = (it / NCH) % 32, b = it / (NCH * 32); s5_chunk(p, buf, j, b, g, c, lane, false, d, d + 1); }
}
constexpr int S5B_BS = 17;
DEVFN int chunk_order(int d, int k);
DEVFN void phase_s5b(const Params& p, int j) {
    const float* E = (const float*)(p.ws + WS_SB + SBO_S5E); float* Hin = (float*)(p.ws + WS_SB + SBO_S5H);
    constexpr int NBT = (NCH + S5B_BS - 1) / S5B_BS;
    int vb = blockIdx.x, vstep = gridDim.x;
    if (gridDim.x == 256 && NB * 32 * 2 * 64 == 32 * NTH) { const int m = blockIdx.x & 15; if (m != 0 && m != 15) return; vb = (blockIdx.x >> 4) * 2 + (m == 15 ? 1 : 0); vstep = 32; }
    for (int i = vb * NTH + tidx(); i < NB * 32 * 2 * 64; i += vstep * NTH) { const int pi = i & 63, d = (i >> 6) & 1, g = (i >> 7) & 31, b = i >> 12;
        const float* pr = (const float*)(p.ws + WS_S5P) + ((size_t)((j * 2 + d) * 32 + g) * 64 + pi) * S5P_STRIDE; const float aLr = pr[2], aLi = pr[3];
        const size_t base = (size_t)((b * 32 + g) * 2 + d) * NCH; float hr = 0.f, hi = 0.f;
        f32x2 en[S5B_BS];
#pragma unroll
        for (int x = 0; x < S5B_BS; ++x) { const int k = x < NCH ? x : NCH - 1; const int c = chunk_order(d, k); en[x] = *(const f32x2*)(E + (base + c) * 128 + pi * 2); }
#pragma unroll 1
        for (int kb = 0; kb < NBT; ++kb) { f32x2 e[S5B_BS];
#pragma unroll
            for (int x = 0; x < S5B_BS; ++x) e[x] = en[x];
            if (kb + 1 < NBT) {
#pragma unroll
                for (int x = 0; x < S5B_BS; ++x) { const int k = (kb + 1) * S5B_BS + x < NCH ? (kb + 1) * S5B_BS + x : NCH - 1; const int c = chunk_order(d, k); en[x] = *(const f32x2*)(E + (base + c) * 128 + pi * 2); } }
#pragma unroll
            for (int x = 0; x < S5B_BS; ++x) { const int k = kb * S5B_BS + x; if (k < NCH) { const int c = chunk_order(d, k);
                *(f32x2*)(Hin + (base + c) * 128 + pi * 2) = (f32x2){hr, hi};
                const float nr = aLr * hr - aLi * hi + e[x][0], ni = aLr * hi + aLi * hr + e[x][1]; hr = nr; hi = ni; } } }
    }
}
DEVFN void phase_s5c(const Params& p, unsigned char* lds, int j) {
    const int wave = tidx() >> 6, lane = tidx() & 63; float* buf = (float*)(lds + wave * S5_WAVE_LDS);
    const int NIT = NB * 32 * NCH, GW = gridDim.x * 8, full = (NIT / GW) * GW, rem = NIT - full;
    for (int it = blockIdx.x * 8 + wave; it < full; it += GW) { const int c = it % NCH, g = (it / NCH) % 32, b = it / (NCH * 32); s5_chunk(p, buf, j, b, g, c, lane, true); }
    float* xch = (float*)(lds + 8 * S5_WAVE_LDS) + (wave & 3) * 1024;
    for (int base = blockIdx.x * 4; base < rem; base += gridDim.x * 4) { const int ri = base + (wave & 3), d = wave >> 2;
        if (ri < rem) { const int it = full + ri; const int c = it % NCH, g = (it / NCH) % 32, b = it / (NCH * 32); s5_chunk(p, buf, j, b, g, c, lane, true, d, d + 1, xch); }
        else __syncthreads();
        __syncthreads(); }
}

template <int NDV> struct AttnState { float m, l; f32x16 o[NDV]; };
template <int NDV> DEVFN void attn_init(AttnState<NDV>& st) { st.m = -INFINITY; st.l = 0.f;
#pragma unroll
    for (int i = 0; i < NDV; ++i)
#pragma unroll
        for (int r = 0; r < 16; ++r) st.o[i][r] = 0.f; }
DEVFN float attn_softmax(float& m, float& l, f32x16 s, bf16x8 (&pb)[2]) {
    float mx = fmaxf(fmaxf(fmaxf(s[0], s[1]), fmaxf(s[2], s[3])), fmaxf(fmaxf(s[4], s[5]), fmaxf(s[6], s[7])));
    mx = fmaxf(mx, fmaxf(fmaxf(fmaxf(s[8], s[9]), fmaxf(s[10], s[11])), fmaxf(fmaxf(s[12], s[13]), fmaxf(s[14], s[15]))));
    mx = fmaxf(mx, __shfl_xor(mx, 32));
    const float mn = fmaxf(m, mx), ms = mn == -INFINITY ? 0.f : mn, corr = fexp2(m - ms);
    m = mn; float ps = 0.f;
#pragma unroll
    for (int r = 0; r < 16; ++r) { s[r] = fexp2(s[r] - ms); ps += s[r]; }
    ps += __shfl_xor(ps, 32);
    l = l * corr + ps;
#pragma unroll
    for (int ks = 0; ks < 2; ++ks) { u32x4 w;
#pragma unroll
        for (int jj = 0; jj < 4; ++jj) w[jj] = pack2(s[8 * ks + 2 * jj], s[8 * ks + 2 * jj + 1]);
        pb[ks] = __builtin_bit_cast(bf16x8, w); }
    return corr;
}
DEVFN bf16x8 cat4(const bf16x4 a, const bf16x4 b) { bf16x8 o;
#pragma unroll
    for (int jj = 0; jj < 4; ++jj) { o[jj] = a[jj]; o[4 + jj] = b[jj]; }
    return o; }
template <int NDV, class VLoad>
DEVFN void attn_update(AttnState<NDV>& st, f32x16 s, VLoad vload) {
    bf16x8 pb[2]; const float corr = attn_softmax(st.m, st.l, s, pb);
    if (!wave_all(corr == 1.0f)) {
#pragma unroll
        for (int i = 0; i < NDV; ++i)
#pragma unroll
            for (int r = 0; r < 16; ++r) st.o[i][r] *= corr; }
#pragma unroll
    for (int ks = 0; ks < 2; ++ks)
#pragma unroll
        for (int mt = 0; mt < NDV; ++mt) st.o[mt] = mfma32(vload(mt, ks), pb[ks], st.o[mt]);
}

DEVFN float attn_softmax2(float& m, float& l, f32x16 s0, f32x16 s1, bf16x8 (&pb0)[2], bf16x8 (&pb1)[2]) {
    float mx = fmaxf(s0[0], s1[0]);
#pragma unroll
    for (int r = 1; r < 16; ++r) mx = fmaxf(mx, fmaxf(s0[r], s1[r]));
    mx = fmaxf(mx, __shfl_xor(mx, 32));
    const float mn = fmaxf(m, mx), ms = mn == -INFINITY ? 0.f : mn, corr = fexp2(m - ms);
    m = mn; float ps = 0.f;
#pragma unroll
    for (int r = 0; r < 16; ++r) { s0[r] = fexp2(s0[r] - ms); s1[r] = fexp2(s1[r] - ms); ps += s0[r] + s1[r]; }
    ps += __shfl_xor(ps, 32);
    l = l * corr + ps;
#pragma unroll
    for (int ks = 0; ks < 2; ++ks) { u32x4 w0, w1;
#pragma unroll
        for (int jj = 0; jj < 4; ++jj) { w0[jj] = pack2(s0[8 * ks + 2 * jj], s0[8 * ks + 2 * jj + 1]); w1[jj] = pack2(s1[8 * ks + 2 * jj], s1[8 * ks + 2 * jj + 1]); }
        pb0[ks] = __builtin_bit_cast(bf16x8, w0); pb1[ks] = __builtin_bit_cast(bf16x8, w1); }
    return corr;
}
template <int NDV, class VLoad>
DEVFN void attn_update2(AttnState<NDV>& st, f32x16 s0, f32x16 s1, VLoad vload) {
    bf16x8 pb0[2], pb1[2]; const float corr = attn_softmax2(st.m, st.l, s0, s1, pb0, pb1);
    if (!wave_all(corr == 1.0f)) {
#pragma unroll
        for (int i = 0; i < NDV; ++i)
#pragma unroll
            for (int r = 0; r < 16; ++r) st.o[i][r] *= corr; }
#pragma unroll
    for (int ks = 0; ks < 2; ++ks)
#pragma unroll
        for (int mt = 0; mt < NDV; ++mt) { st.o[mt] = mfma32(vload(0, mt, ks), pb0[ks], st.o[mt]); st.o[mt] = mfma32(vload(1, mt, ks), pb1[ks], st.o[mt]); }
}

constexpr int NAT_STAGE = 16384, NAT_RING = 4, NAT_RPB = NAT_RING * NAT_STAGE;
DEVFN void phase_natten(const Params& p, unsigned char* lds, int j) {
    const int tid = tidx(), wave = tid >> 6, lane = tid & 63, ql = lane & 31, hh = lane >> 5;
#ifdef CPU_EMU
    const int wvu = wave;
#else
    const int wvu = __builtin_amdgcn_readfirstlane(wave);
#endif
    const bf16* Z = (const bf16*)(p.ws + WS_Z); const bf16* Q = Z + ZE_Q; const bf16* K = Z + ZE_K; const bf16* VT = Z + ZE_VT; bf16* Y = (bf16*)(p.ws + WS_YMIX);
    float* rpbs = (float*)(lds + NAT_RPB);
    constexpr int NRG = GROWS / 4, NLAT = NB * 8 * NRG, NCQ = (LC + 255) / 256, NCTX = NB * 8 * NCQ, NCT = LC / 64;
    const bool remap = gridDim.x == 256 && NLAT == 512 && NCTX == 32 && NRG == 16;
    for (int uu = blockIdx.x; uu < NLAT + (remap ? (int)gridDim.x : NCTX); uu += gridDim.x) { int u = uu;
        if (remap && uu >= NLAT) { const int m = blockIdx.x & 15; if (m != 0 && m != 15) break; u = NLAT + (blockIdx.x >> 4) * 2 + (m == 15 ? 1 : 0); }
        const bool lat = u < NLAT;
        int b, hd, r = 0, rs = 0, klo = 0, nloc = 0, qp; bool qvalid = true;
        if (lat) { const int rg = u % NRG; hd = (u / NRG) & 7; b = u / (NRG * 8); r = rg * 4 + (wave >> 1); rs = r - 4 < 0 ? 0 : (r - 4 > GROWS - 8 ? GROWS - 8 : r - 4);
            const int ra = rg * 4, rb = rg * 4 + 3; klo = ra - 4 < 0 ? 0 : (ra - 4 > GROWS - 8 ? GROWS - 8 : ra - 4); const int khi = (rb - 4 < 0 ? 0 : (rb - 4 > GROWS - 8 ? GROWS - 8 : rb - 4)) + 7; nloc = khi - klo + 1;
            qp = LC + r * 64 + (wave & 1) * 32 + ql; }
        else { const int v = u - NLAT; const int qt = v % NCQ; hd = (v / NCQ) & 7; b = v / (NCQ * 8); qp = qt * 256 + wave * 32 + ql; qvalid = qp < LC; if (!qvalid) qp = 0; }
        const size_t qrow = (size_t)b * PT + qp; const int ntile = nloc + NCT;
        __syncthreads();
        if (lat) for (int i = tid; i < 15 * 31; i += NTH) rpbs[i] = LOG2E * p.in[I_RPB][(size_t)(j * 8 + hd) * 15 * 31 + i];
        bf16x8 qf[4];
#pragma unroll
        for (int ks = 0; ks < 4; ++ks) qf[ks] = *(const bf16x8*)(Q + qrow * 512 + hd * 64 + ks * 16 + hh * 8);
        const int drow = tid >> 3, dch = (tid & 7) ^ (drow & 7);
        const bf16* ksrc = K + ((size_t)b * PT + drow) * 512 + hd * 64 + dch * 8; const bf16* vsrc = VT + ((size_t)(b * 8 + hd) * 64 + drow) * PT + dch * 8;
        auto tile_tok = [&](int t) { return t < nloc ? LC + (klo + t) * 64 : (t - nloc) * 64; };
#define NAT_DMA(t) do { const int tok_ = tile_tok(t); unsigned char* st_ = lds + ((t) & (NAT_RING - 1)) * NAT_STAGE + (wvu * 64) * 16; dma16(ksrc + (size_t)tok_ * 512, st_); dma16(vsrc + tok_, st_ + 8192); } while (0)
        AttnState<2> st; attn_init(st);
        const int cq = (wave & 1) * 32 + ql, cstart = cq - 8 < 0 ? 0 : (cq - 8 > 48 ? 48 : cq - 8);
        for (int t = 0; t < 3 && t < ntile; ++t) NAT_DMA(t);
        if (ntile >= 3) dma_wait_barrier<4>(); else if (ntile == 2) dma_wait_barrier<2>(); else dma_wait_barrier<0>();
        for (int t = 0; t < ntile; ++t) {
            if (t + 3 < ntile) NAT_DMA(t + 3);
            const bool loc = t < nloc; const int krow = klo + t; const bool active = !loc || (krow >= rs && krow <= rs + 7);
            if (active) { const unsigned char* sb = lds + (t & (NAT_RING - 1)) * NAT_STAGE;
#pragma unroll
                for (int s2 = 0; s2 < 2; ++s2) { f32x16 s;
#pragma unroll
                    for (int i = 0; i < 16; ++i) s[i] = 0.f;
#pragma unroll
                    for (int ks = 0; ks < 4; ++ks) s = mfma32(*(const bf16x8*)(sb + lds_sw(s2 * 32 + ql, ks * 2 + hh)), qf[ks], s);
                    if (loc) {
#pragma unroll
                        for (int i = 0; i < 16; ++i) { const int ck = s2 * 32 + (i & 3) + 8 * (i >> 2) + 4 * hh; const bool ok = ck >= cstart && ck < cstart + 16; const int dc = ok ? ck - cq + 15 : 0;
                            s[i] = ok ? s[i] + rpbs[(krow - r + 7) * 31 + dc] : -INFINITY; } }
                    attn_update<2>(st, s, [&](int mt, int ks) { return *(const bf16x8*)(sb + 8192 + lds_sw(mt * 32 + ql, s2 * 4 + ks * 2 + hh)); }); } }
            const int inflight = (t + 3 < ntile ? t + 3 : ntile - 1) - (t + 1);
            if (inflight >= 2) dma_wait_barrier<4>(); else if (inflight == 1) dma_wait_barrier<2>(); else dma_wait_barrier<0>();
        }
#undef NAT_DMA
        const float il = 1.0f / st.l;
        if (qvalid) {
#pragma unroll
            for (int mt = 0; mt < 2; ++mt)
#pragma unroll
                for (int q4 = 0; q4 < 4; ++q4) { const int dv = mt * 32 + 8 * q4 + 4 * hh; f32x4 o;
#pragma unroll
                    for (int k = 0; k < 4; ++k) o[k] = st.o[mt][q4 * 4 + k] * il;
                    store4_t(Y + qrow * D + 512 + hd * 64 + dv, o); } }
    }
}

DEVFN int chunk_order(int d, int k) { return d == 0 ? k : (k < NCC ? NCC - 1 - k : NCH - 1 - (k - NCC)); }
constexpr int GLR = 144;
constexpr int GL_CUM = 0, GL_ZZ = 32768, GL_PART = 32768 + 8192, GL_KT = 45056, GL_VT = GL_KT + 64 * GLR, GL_K = GL_VT + 128 * GLR, GL_Q = GL_K + 64 * GLR, GL_S = GL_Q + 64 * GLR, GL_SSQ = GL_S + 256 * GLR;
static_assert(GL_SSQ + 512 <= LDS_BYTES, "GLA LDS");
DEVFN bf16x8 scale8(const u32x4 raw, const float (&f)[8]) { u32x4 w;
#pragma unroll
    for (int i = 0; i < 4; ++i) w[i] = pack2(bitsf(raw[i] << 16) * f[2 * i], bitsf(raw[i] & 0xffff0000u) * f[2 * i + 1]);
    return __builtin_bit_cast(bf16x8, w); }
DEVFN void gl_stage(unsigned char* dst, const bf16* src, size_t ld, int rows, int tid) {
    for (int i = tid; i < rows * 8; i += NTH) { const int r = i >> 3, ch = i & 7; *(u32x4*)(dst + r * GLR + ch * 16) = *(const u32x4*)(src + (size_t)r * ld + ch * 8); }
}

DEVFN void phase_gla_a(const Params& p, unsigned char* lds, int j) {
    const int tid = tidx(), lane = tid & 63, wave = tid >> 6, fr = lane & 15, fg = lane >> 4; float* cum = (float*)(lds + GL_CUM); float* zz = (float*)(lds + GL_ZZ); float* part = (float*)(lds + GL_PART);
    const bf16* Z = (const bf16*)(p.ws + WS_Z); float* GU = (float*)(p.ws + WS_SB + SBO_GU); float* GDEC = (float*)(p.ws + WS_SB + SBO_GDEC); float* GCUM = (float*)(p.ws + WS_SB + SBO_GCUM);
    u32x2 pz; u32x4 pk, pv0, pv1; float pw[16], pgb;
#define GLA_A_FETCH(itx) { const int c_ = (itx) % NCH, hd_ = ((itx) / NCH) & 3, b_ = (itx) / (NCH * 4); \
        pz = *(const u32x2*)(Z + ZO_GZ + ((size_t)b_ * PT + c_ * 64) * 32 + tid * 4); \
        pk = *(const u32x4*)(Z + ZO_GKT + (size_t)(b_ * 4 + hd_) * 64 * PT + c_ * 64 + (size_t)(tid >> 3) * PT + (tid & 7) * 8); \
        const bf16* vs_ = Z + ZO_GVT + (size_t)(b_ * 4 + hd_) * 128 * PT + c_ * 64; \
        pv0 = *(const u32x4*)(vs_ + (size_t)(tid >> 3) * PT + (tid & 7) * 8); pv1 = *(const u32x4*)(vs_ + (size_t)(64 + (tid >> 3)) * PT + (tid & 7) * 8); \
        { const int d_ = tid >> 8, dk_ = (tid >> 2) & 63; const float* gw_ = p.in[I_GGW] + ((size_t)(j * 2 + d_) * 16) * 256 + hd_ * 64 + dk_; pgb = p.in[I_GGB][(size_t)(j * 2 + d_) * 256 + hd_ * 64 + dk_]; \
          _Pragma("unroll") for (int r = 0; r < 16; ++r) pw[r] = gw_[(size_t)r * 256]; } }
    if (blockIdx.x < NB * 4 * NCH) GLA_A_FETCH(blockIdx.x)
    for (int it = blockIdx.x; it < NB * 4 * NCH; it += gridDim.x) { const int c = it % NCH, hd = (it / NCH) & 3, b = it / (NCH * 4);
        __syncthreads();
        { f32x4 zf = (f32x4){bitsf(pz.x << 16), bitsf(pz.x & 0xffff0000u), bitsf(pz.y << 16), bitsf(pz.y & 0xffff0000u)}; *(f32x4*)(zz + tid * 4) = zf;
          *(u32x4*)(lds + GL_KT + (tid >> 3) * GLR + (tid & 7) * 16) = pk;
          *(u32x4*)(lds + GL_VT + (tid >> 3) * GLR + (tid & 7) * 16) = pv0; *(u32x4*)(lds + GL_VT + (64 + (tid >> 3)) * GLR + (tid & 7) * 16) = pv1; }
        float w[16]; const float gb = pgb;
#pragma unroll
        for (int r = 0; r < 16; ++r) w[r] = pw[r];
        if (it + (int)gridDim.x < NB * 4 * NCH) GLA_A_FETCH(it + gridDim.x)
        __syncthreads();
        { const int d = tid >> 8, dk = (tid >> 2) & 63, tg = tid & 3; float gl[16];
#pragma unroll
            for (int t = 0; t < 16; ++t) { float x = gb;
#pragma unroll
                for (int r = 0; r < 16; ++r) x += zz[(tg * 16 + t) * 32 + d * 16 + r] * w[r];
                gl[t] = logsigf_(x) * (1.0f / 16.0f); }
            if (d == 0) {
#pragma unroll
                for (int t = 1; t < 16; ++t) gl[t] += gl[t - 1];
                part[(d * 64 + dk) * 4 + tg] = gl[15];
            } else {
#pragma unroll
                for (int t = 14; t >= 0; --t) gl[t] += gl[t + 1];
                part[(d * 64 + dk) * 4 + tg] = gl[0]; }
            __syncthreads();
            float pre = 0.f;
#pragma unroll
            for (int q = 0; q < 4; ++q) { const bool inc = d == 0 ? q < tg : q > tg; pre += inc ? part[(d * 64 + dk) * 4 + q] : 0.f; }
            float* gc = GCUM + ((size_t)((b * 4 + hd) * NCH + c) * 2 + d) * 4096;
#pragma unroll
            for (int t = 0; t < 16; ++t) { const float v = gl[t] + pre; cum[(d * 64 + tg * 16 + t) * 64 + dk] = v; gc[(tg * 16 + t) * 64 + dk] = v; } }
        __syncthreads();
        bf16x8 va[2];
#pragma unroll
        for (int ks = 0; ks < 2; ++ks) va[ks] = *(const bf16x8*)(lds + GL_VT + (wave * 16 + fr) * GLR + (ks * 32 + fg * 8) * 2);
#pragma unroll
        for (int d = 0; d < 2; ++d) { const int tend = d ? 0 : 63;
#pragma unroll
            for (int n = 0; n < 4; ++n) { const int dk = n * 16 + fr; const float cend = cum[(d * 64 + tend) * 64 + dk]; f32x4 acc = (f32x4){0.f, 0.f, 0.f, 0.f};
#pragma unroll
                for (int ks = 0; ks < 2; ++ks) { const u32x4 raw = *(const u32x4*)(lds + GL_KT + dk * GLR + (ks * 32 + fg * 8) * 2); float f[8];
#pragma unroll
                    for (int e = 0; e < 8; ++e) f[e] = fexp(cend - cum[(d * 64 + ks * 32 + fg * 8 + e) * 64 + dk]);
                    acc = mfma16(va[ks], scale8(raw, f), acc); }
                float* dst = GU + ((size_t)(((b * 4 + hd) * 2 + d) * NCH + c) * 128 + wave * 16 + fg * 4) * 64 + dk;
#pragma unroll
                for (int r = 0; r < 4; ++r) dst[r * 64] = acc[r]; } }
        if (tid < 128) { const int d = tid >> 6, dk = tid & 63; GDEC[(size_t)(((b * 4 + hd) * 2 + d) * NCH + c) * 64 + dk] = fexp(cum[(d * 64 + (d ? 0 : 63)) * 64 + dk]); }
    }
#undef GLA_A_FETCH
}
constexpr int GLB_BS = 17;
DEVFN void phase_gla_b(const Params& p) {
    const float* GU = (const float*)(p.ws + WS_SB + SBO_GU); const float* GDEC = (const float*)(p.ws + WS_SB + SBO_GDEC); bf16* GSB = (bf16*)(p.ws + WS_H + (size_t)MR * D * 2);
    constexpr int NBT = (NCH + GLB_BS - 1) / GLB_BS, TOT = NB * 4 * 2 * 8192;
    const int GT = gridDim.x * NTH;
    for (int i = blockIdx.x * NTH + tidx(); i < TOT; i += 2 * GT) { int e[2], seq[2], dk[2], d[2]; bool ok[2]; float s[2] = {0.f, 0.f};
#pragma unroll
        for (int q = 0; q < 2; ++q) { const int iq = i + q * GT; ok[q] = iq < TOT; const int ic = ok[q] ? iq : i; e[q] = ic & 8191; seq[q] = ic >> 13; dk[q] = e[q] & 63; d[q] = seq[q] & 1; }
        float un[2][GLB_BS], dn[2][GLB_BS];
#pragma unroll
        for (int q = 0; q < 2; ++q)
#pragma unroll
            for (int x = 0; x < GLB_BS; ++x) { const int k = x < NCH ? x : NCH - 1; const int c = chunk_order(d[q], k); un[q][x] = GU[((size_t)seq[q] * NCH + c) * 8192 + e[q]]; dn[q][x] = GDEC[((size_t)seq[q] * NCH + c) * 64 + dk[q]]; }
#pragma unroll 1
        for (int kb = 0; kb < NBT; ++kb) { float u[2][GLB_BS], dc[2][GLB_BS];
#pragma unroll
            for (int q = 0; q < 2; ++q)
#pragma unroll
                for (int x = 0; x < GLB_BS; ++x) { u[q][x] = un[q][x]; dc[q][x] = dn[q][x]; }
            if (kb + 1 < NBT) {
#pragma unroll
                for (int q = 0; q < 2; ++q)
#pragma unroll
                    for (int x = 0; x < GLB_BS; ++x) { const int k = (kb + 1) * GLB_BS + x < NCH ? (kb + 1) * GLB_BS + x : NCH - 1; const int c = chunk_order(d[q], k); un[q][x] = GU[((size_t)seq[q] * NCH + c) * 8192 + e[q]]; dn[q][x] = GDEC[((size_t)seq[q] * NCH + c) * 64 + dk[q]]; } }
#pragma unroll
            for (int x = 0; x < GLB_BS; ++x) { const int k = kb * GLB_BS + x; if (k < NCH) {
#pragma unroll
                for (int q = 0; q < 2; ++q) { const int c = chunk_order(d[q], k); if (ok[q]) GSB[((size_t)seq[q] * NCH + c) * 8192 + e[q]] = f2bf(s[q]); s[q] = dc[q][x] * s[q] + u[q][x]; } } } }
    }
}
DEVFN void phase_gla_c(const Params& p, unsigned char* lds, int j) {
    const int tid = tidx(), lane = tid & 63, wave = tid >> 6, fr = lane & 15, fg = lane >> 4, itl = wave & 3, half = wave >> 2;
    float* cum = (float*)(lds + GL_CUM); float* ssq = (float*)(lds + GL_SSQ);
    const bf16* Z = (const bf16*)(p.ws + WS_Z); const bf16* GSB = (const bf16*)(p.ws + WS_H + (size_t)MR * D * 2); const float* GCUM = (const float*)(p.ws + WS_SB + SBO_GCUM); bf16* Y = (bf16*)(p.ws + WS_YMIX);
    f32x4 pc[4]; u32x4 pkq[2], pvt[2];
#define GLA_C_FETCH(itx) { const int c_ = (itx) % NCH, hd_ = ((itx) / NCH) & 3, b_ = (itx) / (NCH * 4); const size_t row0_ = (size_t)b_ * PT + c_ * 64; \
        const float* gc_ = GCUM + (size_t)((b_ * 4 + hd_) * NCH + c_) * 8192; \
        _Pragma("unroll") for (int x = 0; x < 4; ++x) pc[x] = *(const f32x4*)(gc_ + (x * NTH + tid) * 4); \
        pkq[0] = *(const u32x4*)(Z + ZO_GK + (row0_ + (tid >> 3)) * 256 + hd_ * 64 + (tid & 7) * 8); pkq[1] = *(const u32x4*)(Z + ZO_GQ + (row0_ + (tid >> 3)) * 256 + hd_ * 64 + (tid & 7) * 8); \
        const bf16* vs_ = Z + ZO_GVT + (size_t)(b_ * 4 + hd_) * 128 * PT + c_ * 64; \
        pvt[0] = *(const u32x4*)(vs_ + (size_t)(tid >> 3) * PT + (tid & 7) * 8); pvt[1] = *(const u32x4*)(vs_ + (size_t)(64 + (tid >> 3)) * PT + (tid & 7) * 8); }
    if (blockIdx.x < NB * 4 * NCH) GLA_C_FETCH(blockIdx.x)
    for (int it = blockIdx.x; it < NB * 4 * NCH; it += gridDim.x) { const int c = it % NCH, hd = (it / NCH) & 3, b = it / (NCH * 4);
        const size_t row0 = (size_t)b * PT + c * 64;
        __syncthreads();
#pragma unroll
        for (int x = 0; x < 4; ++x) *(f32x4*)(cum + (x * NTH + tid) * 4) = pc[x];
        *(u32x4*)(lds + GL_K + (tid >> 3) * GLR + (tid & 7) * 16) = pkq[0]; *(u32x4*)(lds + GL_Q + (tid >> 3) * GLR + (tid & 7) * 16) = pkq[1];
        *(u32x4*)(lds + GL_VT + (tid >> 3) * GLR + (tid & 7) * 16) = pvt[0]; *(u32x4*)(lds + GL_VT + (64 + (tid >> 3)) * GLR + (tid & 7) * 16) = pvt[1];
        for (int i = tid; i < 2 * 128 * 8; i += NTH) { const int d = i >> 10, r = (i >> 3) & 127, ch = i & 7;
            *(u32x4*)(lds + GL_S + (d * 128 + r) * GLR + ch * 16) = *(const u32x4*)(GSB + ((size_t)(((b * 4 + hd) * 2 + d) * NCH + c) * 128 + r) * 64 + ch * 8); }
        if (it + (int)gridDim.x < NB * 4 * NCH) GLA_C_FETCH(it + gridDim.x)
        __syncthreads();
        const int ti = itl * 16 + fr;
        f32x4 o[4];
#pragma unroll
        for (int mt = 0; mt < 4; ++mt) o[mt] = (f32x4){0.f, 0.f, 0.f, 0.f};
#pragma unroll 1
        for (int d = 0; d < 2; ++d) {
            bf16x8 qd[2];
#pragma unroll
            for (int ks = 0; ks < 2; ++ks) { const u32x4 raw = *(const u32x4*)(lds + GL_Q + ti * GLR + (ks * 32 + fg * 8) * 2); float f[8];
#pragma unroll
                for (int e = 0; e < 8; ++e) f[e] = fexp(cum[(d * 64 + ti) * 64 + ks * 32 + fg * 8 + e]);
                qd[ks] = scale8(raw, f); }
            f32x4 att[4];
#pragma unroll
            for (int jt = 0; jt < 4; ++jt) { const int tj = jt * 16 + fr; f32x4 a = (f32x4){0.f, 0.f, 0.f, 0.f};
#pragma unroll
                for (int ks = 0; ks < 2; ++ks) { const u32x4 raw = *(const u32x4*)(lds + GL_K + tj * GLR + (ks * 32 + fg * 8) * 2); float f[8];
#pragma unroll
                    for (int e = 0; e < 8; ++e) f[e] = fexp(-cum[(d * 64 + tj) * 64 + ks * 32 + fg * 8 + e]);
                    a = mfma16(scale8(raw, f), qd[ks], a); }
#pragma unroll
                for (int r = 0; r < 4; ++r) { const int jrow = jt * 16 + fg * 4 + r; const bool keep = d ? (jrow >= ti) : (jrow <= ti); a[r] = keep ? a[r] : 0.f; }
                att[jt] = a; }
#pragma unroll
            for (int s2 = 0; s2 < 2; ++s2) { bf16x8 pb;
#pragma unroll
                for (int e = 0; e < 0; ++e) {}
                { u32x4 w; w[0] = pack2(att[2 * s2][0], att[2 * s2][1]); w[1] = pack2(att[2 * s2][2], att[2 * s2][3]); w[2] = pack2(att[2 * s2 + 1][0], att[2 * s2 + 1][1]); w[3] = pack2(att[2 * s2 + 1][2], att[2 * s2 + 1][3]); pb = __builtin_bit_cast(bf16x8, w); }
#pragma unroll
                for (int mt = 0; mt < 4; ++mt) { const unsigned char* vp = lds + GL_VT + (half * 64 + mt * 16 + fr) * GLR + (s2 * 32 + fg * 4) * 2;
                    o[mt] = mfma16(cat4(*(const bf16x4*)vp, *(const bf16x4*)(vp + 32)), pb, o[mt]); } }
#pragma unroll
            for (int ks = 0; ks < 2; ++ks)
#pragma unroll
                for (int mt = 0; mt < 4; ++mt) o[mt] = mfma16(*(const bf16x8*)(lds + GL_S + (d * 128 + half * 64 + mt * 16 + fr) * GLR + (ks * 32 + fg * 8) * 2), qd[ks], o[mt]);
        }
        float ss = 0.f;
#pragma unroll
        for (int mt = 0; mt < 4; ++mt)
#pragma unroll
            for (int r = 0; r < 4; ++r) ss += o[mt][r] * o[mt][r];
        ss += __shfl_xor(ss, 16); ss += __shfl_xor(ss, 32);
        if (fg == 0) ssq[half * 64 + ti] = ss;
        __syncthreads();
        const float rstd = 1.0f / sqrtf((ssq[ti] + ssq[64 + ti]) * (1.0f / 128.0f) + LN_EPS);
#pragma unroll
        for (int mt = 0; mt < 4; ++mt) { const int dv = hd * 128 + half * 64 + mt * 16 + fg * 4; const f32x4 ng = *(const f32x4*)(p.in[I_GNG] + (size_t)j * 512 + dv);
            const u32x2 rr = *(const u32x2*)(Z + ZO_GR + (row0 + ti) * 512 + dv); f32x4 y;
            y[0] = o[mt][0] * rstd * ng[0] * siluf_(bitsf(rr.x << 16)); y[1] = o[mt][1] * rstd * ng[1] * siluf_(bitsf(rr.x & 0xffff0000u));
            y[2] = o[mt][2] * rstd * ng[2] * siluf_(bitsf(rr.y << 16)); y[3] = o[mt][3] * rstd * ng[3] * siluf_(bitsf(rr.y & 0xffff0000u));
            store4_t(Y + (row0 + ti) * D + dv, y); }
    }
#undef GLA_C_FETCH
}

constexpr int DK_ROW = 272, DV_ROW = 144, DF_VOFF = 64 * DK_ROW, DF_BUF = DF_VOFF + 128 * DV_ROW, DF_Q = 2 * DF_BUF;
DEVFN int dk_off(int key, int ch) { return key * DK_ROW + ch * 16; }
DEVFN int dv_off(int dv, int ch) { return dv * DV_ROW + ch * 16; }
DEVFN void phase_diff(const Params& p, unsigned char* lds, int l, int part) {
    const int j = l >> 1, tid = tidx(), lane = tid & 63, wave = tid >> 6, ql = lane & 31, hh = lane >> 5, qg = wave >> 1, m = wave & 1;
    const bf16* Z = (const bf16*)(p.ws + WS_Z); bf16* Y = (bf16*)(p.ws + WS_YMIX);
    constexpr int NQT = TS / 128, NQC = (LC + 127) / 128, NU = NB * 4 * (NQT + NQC);
    constexpr int NUL = NB * 4 * NQT;
    const int G_ = gridDim.x, vb_ = (G_ & 7) == 0 ? (int)(blockIdx.x & 7) * (G_ >> 3) + (int)(blockIdx.x >> 3) : (int)blockIdx.x;
    const int u0 = part == 0 ? vb_ : NUL + ((int)blockIdx.x + G_ - (64 % G_)) % G_, uend = part == 0 ? NUL : NU;
    if (u0 >= uend) return;
    const float laminit = 0.8f - 0.6f * expf(-0.3f * (float)l);
    const float d1 = wave_sum(p.in[I_LQ1][j * 64 + lane] * p.in[I_LK1][j * 64 + lane]), d2 = wave_sum(p.in[I_LQ2][j * 64 + lane] * p.in[I_LK2][j * 64 + lane]);
    const float lam = expf(d1) - expf(d2) + laminit;
    for (int u = u0; u < uend; u += gridDim.x) { const bool isctx = u >= NUL; const int v = isctx ? u - NUL : u, per = isctx ? NQC : NQT;
        const int qt = isctx ? NQT + v % per : v % per, hd = (v / per) & 3, b = v / (per * 4);
        const int q0 = isctx ? (qt - NQT) * 128 : LC + qt * 128, nkt = (isctx ? LC : PT) / 64; const int qp = q0 + qg * 32 + ql; const size_t qrow = (size_t)b * PT + qp;
        const bool qvalid = !isctx || qp < LC;
        bf16x8 qf[4];
#pragma unroll
        for (int ks = 0; ks < 4; ++ks) qf[ks] = *(const bf16x8*)(Z + ZO_DQ + qrow * 512 + hd * 128 + m * 64 + ks * 16 + hh * 8);
        AttnState<4> st; attn_init(st);
        const bf16* ksrc[2]; const bf16* vsrc[2]; int klo[2], vlo[2];
#pragma unroll
        for (int i = 0; i < 2; ++i) { const int idx = i * NTH + tid; const int key = idx >> 4, kch = idx & 15, dv = idx >> 3, vch = idx & 7;
            ksrc[i] = Z + ZO_DK + ((size_t)b * PT + key) * 512 + hd * 128 + kch * 8; klo[i] = dk_off(key, kch);
            vsrc[i] = Z + ZO_DVT + ((size_t)(b * 4 + hd) * 128 + dv) * PT + vch * 8; vlo[i] = DF_VOFF + dv_off(dv, vch); }
        u32x4 rk0[2], rv0[2], rk1[2], rv1[2];
#define DF_LOAD(RK, RV, t) do { _Pragma("unroll") for (int i = 0; i < 2; ++i) { RK[i] = *(const u32x4*)(ksrc[i] + (size_t)(t) * 64 * 512); RV[i] = *(const u32x4*)(vsrc[i] + (t) * 64); } } while (0)
#define DF_STORE(RK, RV, buf) do { _Pragma("unroll") for (int i = 0; i < 2; ++i) { *(u32x4*)(lds + (buf) + klo[i]) = RK[i]; *(u32x4*)(lds + (buf) + vlo[i]) = RV[i]; } } while (0)
#define DF_COMPUTE(cur) do { f32x16 sA, sB; _Pragma("unroll") for (int i = 0; i < 16; ++i) { sA[i] = 0.f; sB[i] = 0.f; } \
            _Pragma("unroll") for (int ks = 0; ks < 4; ++ks) { sA = mfma32(*(const bf16x8*)(lds + (cur) + dk_off(ql, m * 8 + ks * 2 + hh)), qf[ks], sA); sB = mfma32(*(const bf16x8*)(lds + (cur) + dk_off(32 + ql, m * 8 + ks * 2 + hh)), qf[ks], sB); } \
            const unsigned char* vb = lds + (cur) + DF_VOFF + 16 * hh; \
            attn_update2<4>(st, sA, sB, [&](int st2, int mt, int ks) { return *(const bf16x8*)(vb + dv_off(mt * 32 + ql, st2 * 4 + ks * 2)); }); } while (0)
        __syncthreads();
        DF_LOAD(rk0, rv0, 0); DF_LOAD(rk1, rv1, 1);
        DF_STORE(rk0, rv0, 0);
        __syncthreads();
        for (int t = 0; t < nkt; t += 2) {
            if (t + 2 < nkt) DF_LOAD(rk0, rv0, t + 2);
            DF_COMPUTE(0);
            DF_STORE(rk1, rv1, DF_BUF);
            __syncthreads();
            if (t + 3 < nkt) DF_LOAD(rk1, rv1, t + 3);
            DF_COMPUTE(DF_BUF);
            if (t + 2 < nkt) DF_STORE(rk0, rv0, 0);
            __syncthreads();
        }
#undef DF_LOAD
#undef DF_STORE
#undef DF_COMPUTE
        float* xch = (float*)lds + (size_t)qg * 4096 + lane;
        if (m == 1) { const float f = lam / st.l;
#pragma unroll
            for (int mt = 0; mt < 4; ++mt)
#pragma unroll
                for (int r = 0; r < 16; ++r) xch[(mt * 16 + r) * 64] = st.o[mt][r] * f; }
        __syncthreads();
        if (m == 0) { const float i0 = 1.0f / st.l; float ss = 0.f;
#pragma unroll
            for (int mt = 0; mt < 4; ++mt)
#pragma unroll
                for (int r = 0; r < 16; ++r) { const float o = st.o[mt][r] * i0 - xch[(mt * 16 + r) * 64]; st.o[mt][r] = o; ss += o * o; }
            ss += __shfl_xor(ss, 32);
            const float rstd = (1.0f - laminit) / sqrtf(ss * (1.0f / 128.0f) + LN_EPS);
            if (qvalid) {
#pragma unroll
                for (int mt = 0; mt < 4; ++mt)
#pragma unroll
                    for (int q4 = 0; q4 < 4; ++q4) { const int dv = mt * 32 + 8 * q4 + 4 * hh; const f32x4 ng = *(const f32x4*)(p.in[I_DNG] + (size_t)j * 128 + dv); f32x4 o;
#pragma unroll
                        for (int k = 0; k < 4; ++k) o[k] = st.o[mt][q4 * 4 + k] * rstd * ng[k];
                        store4_t(Y + qrow * D + 512 + hd * 128 + dv, o); } }
        }
    }
}

enum { PH_CONVERT = 0, PH_INIT, PH_INPROJ_E, PH_S5A, PH_S5B_NAT, PH_S5C, PH_GLU, PH_INPROJ_O, PH_GLA_A, PH_GLAB_DIFF, PH_GLA_C, PH_GLA_B, PH_DIFF, PH_OUTPROJ, PH_LN1, PH_MOE_UP, PH_MOE_DOWN, PH_LN2, PH_COUNT };

#ifdef CPU_EMU
#define PHASEFN static
#else
#define PHASEFN __device__ __forceinline__
#endif
template <int PH> PHASEFN void run_phase(const Params& p, unsigned char* lds, int l) {
    if constexpr (PH == PH_CONVERT) phase_convert(p, lds);
    else if constexpr (PH == PH_INIT) phase_init_h(p);
    else if constexpr (PH == PH_INPROJ_E) phase_inproj_even(p, lds, l);
    else if constexpr (PH == PH_S5A) phase_s5a(p, lds, l >> 1);
    else if constexpr (PH == PH_S5B_NAT) { phase_s5b(p, l >> 1); phase_natten(p, lds, l >> 1); }
    else if constexpr (PH == PH_S5C) phase_s5c(p, lds, l >> 1);
    else if constexpr (PH == PH_GLU) phase_glu(p, lds, l >> 1);
    else if constexpr (PH == PH_INPROJ_O) phase_inproj_odd(p, lds, l);
    else if constexpr (PH == PH_GLA_A) { phase_gla_a(p, lds, l >> 1); phase_diff(p, lds, l, 1); }
    else if constexpr (PH == PH_GLAB_DIFF) { phase_gla_b(p); phase_diff(p, lds, l, 0); }
    else if constexpr (PH == PH_GLA_C) phase_gla_c(p, lds, l >> 1);
    else if constexpr (PH == PH_GLA_B) phase_gla_b(p);
    else if constexpr (PH == PH_DIFF) phase_diff(p, lds, l, 0);
    else if constexpr (PH == PH_OUTPROJ) phase_outproj(p, lds, l);
    else if constexpr (PH == PH_LN1) phase_ln1_route(p, lds, l);
    else if constexpr (PH == PH_MOE_UP) phase_moe_up(p, lds, l);
    else if constexpr (PH == PH_MOE_DOWN) phase_moe_down(p, lds, l);
    else if constexpr (PH == PH_LN2) phase_ln2(p, lds, l);
}

template <int PH> __global__ void __launch_bounds__(NTH, 2) k_phase(Params p, int l) { DECL_LDS; run_phase<PH>(p, lds, l); }

#ifdef CPU_EMU
static int g_grid = 8; static int g_stop_layer = 1000, g_stop_phase = 1000;
template <int PH> static bool launch_phase(const Params& p, int l, hipStream_t) {
    if (l > g_stop_layer || (l == g_stop_layer && PH > g_stop_phase)) return false;
    fprintf(stderr, "[emu] layer %d phase %d\n", l, PH);
    emu::launch([=] { k_phase<PH>(p, l); }, dim3(g_grid), dim3(NTH), LDS_BYTES); return true;
}
static void hipMemsetAsync(void* d, int v, size_t n, hipStream_t) { memset(d, v, n); }
#else
static int g_grid = 0;
template <int PH> static bool launch_phase(const Params& p, int l, hipStream_t s) {
    static bool attr = false;
    if (!attr) { (void)hipFuncSetAttribute((const void*)k_phase<PH>, hipFuncAttributeMaxDynamicSharedMemorySize, LDS_BYTES); attr = true; }
    hipLaunchKernelGGL(k_phase<PH>, dim3(g_grid), dim3(NTH), LDS_BYTES, s, p, l); return true;
}
#endif


__global__ void __launch_bounds__(NTH, 2) k_mega(Params p_arg) {
    DECL_LDS;
#ifdef CPU_EMU
    const Params& p = p_arg;
#else
    const Params& p = *(const Params*)(uintptr_t)__builtin_amdgcn_kernarg_segment_ptr();
#endif
#ifndef CPU_EMU
    if (threadIdx.x == 0) *(uint4*)(lds + LDS_BYTES) = make_uint4(0u, 0u, 0u, 0u);
    __syncthreads();
    XcdBarrier gbar = xcd_barrier_post((unsigned*)(p.ws + WS_CTL + CTL_BAR), (volatile LAS unsigned*)(lds + LDS_BYTES));
#endif
    run_phase<PH_CONVERT>(p, lds, -1); GRID_SYNC();
    if (PROBE_MASK & 2048) { run_phase<PH_CONVERT>(p, lds, -1); GRID_SYNC(); }
    run_phase<PH_INIT>(p, lds, -1); GRID_SYNC();
#define RP(ph, l, bit) do { run_phase<ph>(p, lds, l); GRID_SYNC(); if (PROBE_MASK & (bit)) { run_phase<ph>(p, lds, l); GRID_SYNC(); } } while (0)
#define MK_EVEN(l) do { RP(PH_INPROJ_E, l, 1); RP(PH_S5A, l, 2); RP(PH_S5B_NAT, l, 4); RP(PH_S5C, l, 8); RP(PH_GLU, l, 16); } while (0)
#define MK_ODD(l) do { RP(PH_INPROJ_O, l, 1); RP(PH_GLA_A, l, 32); run_phase<PH_GLA_B>(p, lds, l); RP(PH_DIFF, l, 64); RP(PH_GLA_C, l, 128); } while (0)
#define MK_TAIL(l) do { RP(PH_OUTPROJ, l, 256); run_phase<PH_LN1>(p, lds, l); GRID_SYNC(); RP(PH_MOE_UP, l, 512); RP(PH_MOE_DOWN, l, 1024); run_phase<PH_LN2>(p, lds, l); if ((l) + 1 < NL) GRID_SYNC(); } while (0)
    MK_EVEN(0); MK_TAIL(0);
    if (NL > 1) { MK_ODD(1); MK_TAIL(1); }
    if (NL > 2) { MK_EVEN(2); MK_TAIL(2); }
    if (NL > 3) { MK_ODD(3); MK_TAIL(3); }
}
#ifdef CPU_EMU
static void launch_mega(const Params& p, hipStream_t) { emu::launch([=] { k_mega(p); }, dim3(g_grid), dim3(NTH), LDS_TOTAL); }
#else
static void launch_mega(const Params& p, hipStream_t s) {
    static bool attr = false;
    if (!attr) { (void)hipFuncSetAttribute((const void*)k_mega, hipFuncAttributeMaxDynamicSharedMemorySize, LDS_TOTAL); attr = true; }
    hipLaunchKernelGGL(k_mega, dim3(g_grid), dim3(NTH), LDS_TOTAL, s, p);
}
#endif

extern "C" void kernel_launch(void* const* d_in, const int* in_sizes, int n_in, void* d_out, int out_size, void* d_ws, size_t ws_size, hipStream_t stream) {
#ifndef CPU_EMU
    if (g_grid == 0) { int dev = 0, cus = 0; (void)hipGetDevice(&dev); (void)hipDeviceGetAttribute(&cus, hipDeviceAttributeMultiprocessorCount, dev); g_grid = cus > 0 ? cus : 256; }
#endif
    if (n_in != N_IN || ws_size < WS_END) { fprintf(stderr, "kernel_launch: unexpected inputs (n_in %d) or workspace (%zu < %zu)\n", n_in, ws_size, (size_t)WS_END); return; }
    Params p{};
    for (int i = 0; i < N_IN; ++i) p.in[i] = (const float*)d_in[i];
    p.out = (float*)d_out; p.ws = (unsigned char*)d_ws;
    (void)hipMemsetAsync((char*)d_ws + WS_CTL, 0, CTL_BYTES, stream);
#if defined(MK_MULTI)
    launch_phase<PH_CONVERT>(p, -1, stream);
    launch_phase<PH_INIT>(p, -1, stream);
    for (int l = 0; l < NL; ++l) {
        if ((l & 1) == 0) { launch_phase<PH_INPROJ_E>(p, l, stream); launch_phase<PH_S5A>(p, l, stream); launch_phase<PH_S5B_NAT>(p, l, stream); launch_phase<PH_S5C>(p, l, stream); launch_phase<PH_GLU>(p, l, stream); }
        else { launch_phase<PH_INPROJ_O>(p, l, stream); launch_phase<PH_GLA_A>(p, l, stream); launch_phase<PH_GLAB_DIFF>(p, l, stream); launch_phase<PH_GLA_C>(p, l, stream); }
        launch_phase<PH_OUTPROJ>(p, l, stream); launch_phase<PH_LN1>(p, l, stream); launch_phase<PH_MOE_UP>(p, l, stream); launch_phase<PH_MOE_DOWN>(p, l, stream); launch_phase<PH_LN2>(p, l, stream);
    }
#else
    launch_mega(p, stream);
#endif
}

#ifdef CPU_EMU_MAIN
#include <string>
#include <fstream>
#include <sys/mman.h>
static void* guard_alloc(size_t n) { const size_t pg = 4096, tot = ((n + pg - 1) / pg + 2) * pg; char* b = (char*)mmap(nullptr, tot, PROT_READ | PROT_WRITE, MAP_PRIVATE | MAP_ANONYMOUS, -1, 0); mprotect(b, pg, PROT_NONE); mprotect(b + tot - pg, pg, PROT_NONE); return b + tot - pg - ((n + 255) & ~(size_t)255); }
static std::vector<float> load_npy(const std::string& fn, bool& ok) {
    std::ifstream f(fn, std::ios::binary); std::vector<float> v; ok = false; if (!f) return v;
    char hdr[10]; f.read(hdr, 10); int hl = (unsigned char)hdr[8] | ((unsigned char)hdr[9] << 8); std::string h(hl, ' '); f.read(&h[0], hl);
    f.seekg(0, std::ios::end); size_t n = ((size_t)f.tellg() - 10 - hl) / 4; f.seekg(10 + hl); v.resize(n); f.read((char*)v.data(), n * 4); ok = true; return v;
}
template <class G> static void check(const char* name, const std::vector<float>& ref, size_t rows, size_t cols, size_t ref_ld, size_t ref_c0, G get) {
    double num = 0, den = 0, mx = 0; size_t wr = 0, wc = 0;
    for (size_t r = 0; r < rows; ++r) for (size_t c = 0; c < cols; ++c) { const double a = get(r, c), b = ref[r * ref_ld + ref_c0 + c], e = a - b; num += e * e; den += b * b; if (fabs(e) > mx) { mx = fabs(e); wr = r; wc = c; } }
    printf("CHECK %-14s rvr=%.3e  maxabs=%.4f at (%zu,%zu) refrms=%.4f\n", name, num / (den + 1e-30), mx, wr, wc, sqrt(den / (rows * cols)));
}
int main(int argc, char** argv) {
    std::string dir = argv[1]; if (argc > 2) g_stop_layer = atoi(argv[2]); if (argc > 3) g_stop_phase = atoi(argv[3]); if (const char* e = getenv("EMU_GRID")) g_grid = atoi(e);
    std::vector<int> sizes; { std::ifstream f(dir + "/sizes.txt"); int s; while (f >> s) sizes.push_back(s); }
    if ((int)sizes.size() != N_IN) { printf("bad sizes\n"); return 1; }
    std::vector<void*> din(N_IN); { std::ifstream f(dir + "/inputs.bin", std::ios::binary); for (int i = 0; i < N_IN; ++i) { din[i] = guard_alloc((size_t)sizes[i] * 4); f.read((char*)din[i], (size_t)sizes[i] * 4); } }
    printf("WS_END = %.1f MB\n", WS_END / 1048576.0);
    unsigned char* ws = (unsigned char*)guard_alloc(WS_END); memset(ws, 0x7F, WS_END);
    std::vector<float> out((size_t)NB * TS * D, NAN);
    kernel_launch(din.data(), sizes.data(), N_IN, out.data(), (int)out.size(), ws, WS_END, nullptr);
    const int L = g_stop_layer < NL ? g_stop_layer : NL - 1; const int PHS = g_stop_layer < NL ? g_stop_phase : 1000; bool ok; char nm[64];
    const bf16* Z = (const bf16*)(ws + WS_Z); const bf16* Y = (const bf16*)(ws + WS_YMIX); const bf16* H = (const bf16*)(ws + WS_H);
    auto ref = [&](const char* what) { snprintf(nm, 64, "/L%d_%s.npy", L, what); return load_npy(dir + nm, ok); };
    if (PHS >= PH_INPROJ_E || PHS >= PH_INPROJ_O) {
        auto a = ref("a"); if (ok && PHS < PH_LN1) check("abf", a, MR, D, D, 0, [&](size_t r, size_t c) { return bf2f(((const bf16*)(ws + WS_ABF))[r * D + c]); });
        auto z = ref("z");
        if (ok && (L & 1) == 0 && PHS < PH_OUTPROJ) {
            check("z.u", z, MR, 512, 2048, 0, [&](size_t r, size_t c) { return bf2f(Z[ZE_U + r * 512 + c]); });
            check("z.q", z, MR, 512, 2048, 512, [&](size_t r, size_t c) { return bf2f(Z[ZE_Q + r * 512 + c]) / QSCALE; });
            check("z.k", z, MR, 512, 2048, 1024, [&](size_t r, size_t c) { return bf2f(Z[ZE_K + r * 512 + c]); });
            check("z.v", z, MR, 512, 2048, 1536, [&](size_t r, size_t c) { size_t b = r / PT, pp = r % PT; return bf2f(Z[ZE_VT + ((b * 8 + c / 64) * 64 + c % 64) * PT + vperm((int)pp)]); });
        }
        if (ok && (L & 1) == 1 && PHS < PH_OUTPROJ) {
            check("z.gq", z, MR, 256, ODD_N, 0, [&](size_t r, size_t c) { return bf2f(Z[ZO_GQ + r * 256 + c]) * 8.f; });
            check("z.gk", z, MR, 256, ODD_N, 256, [&](size_t r, size_t c) { return bf2f(Z[ZO_GK + r * 256 + c]); });
            check("z.gkt", z, MR, 256, ODD_N, 256, [&](size_t r, size_t c) { size_t b = r / PT, pp = r % PT; return bf2f(Z[ZO_GKT + ((b * 4 + c / 64) * 64 + c % 64) * PT + pp]); });
            check("z.gvt", z, MR, 512, ODD_N, 512, [&](size_t r, size_t c) { size_t b = r / PT, pp = r % PT; return bf2f(Z[ZO_GVT + ((b * 4 + c / 128) * 128 + c % 128) * PT + pp]); });
            check("z.gr", z, MR, 512, ODD_N, 1024, [&](size_t r, size_t c) { return bf2f(Z[ZO_GR + r * 512 + c]); });
            check("z.gz", z, MR, 32, ODD_N, 1536, [&](size_t r, size_t c) { return bf2f(Z[ZO_GZ + r * 32 + c]); });
            check("z.dvt", z, MR, 512, ODD_N, 2592, [&](size_t r, size_t c) { size_t b = r / PT, pp = r % PT; return bf2f(Z[ZO_DVT + ((b * 4 + c / 128) * 128 + c % 128) * PT + vperm((int)pp)]); });
            check("z.dq(ctx rows)", z, LC, 512, ODD_N, 1568, [&](size_t r, size_t c) { return bf2f(Z[ZO_DQ + r * 512 + c]) / QSCALE; });
            check("z.dk(ctx rows)", z, LC, 512, ODD_N, 2080, [&](size_t r, size_t c) { return bf2f(Z[ZO_DK + r * 512 + c]); });
        }
    }
    if ((L & 1) == 0 && PHS >= PH_S5C && PHS < PH_MOE_DOWN) { auto s = ref("s5pre"); for (auto& x : s) x = geluf_(x); if (ok) check("gelu(s5pre)", s, MR, 512, 512, 0, [&](size_t r, size_t c) { return bf2f(((const bf16*)(ws + WS_SB + SBO_GS))[r * 512 + c]); }); }
    if (PHS >= PH_GLU && PHS >= PH_GLA_C) { auto m = ref("mix"); if (ok) { check("mix[0:512]", m, MR, 512, D, 0, [&](size_t r, size_t c) { return bf2f(Y[r * D + c]); }); check("mix[512:]", m, MR, 512, D, 512, [&](size_t r, size_t c) { return bf2f(Y[r * D + 512 + c]); }); } }
    else if (PHS >= PH_S5B_NAT) { auto m = ref("mix"); if (ok) { check("mix[0:512]", m, MR, 512, D, 0, [&](size_t r, size_t c) { return bf2f(Y[r * D + c]); }); check("mix[512:]", m, MR, 512, D, 512, [&](size_t r, size_t c) { return bf2f(Y[r * D + 512 + c]); }); } }
    if (PHS >= PH_OUTPROJ && PHS < PH_LN2) { auto y = ref("y"); if (ok && PHS < PH_MOE_UP) check("y", y, MR, D, D, 0, [&](size_t r, size_t c) { return bf2f(((const bf16*)(ws + WS_Z))[r * D + c]); }); }
    if (PHS >= PH_LN1 && PHS < PH_LN2) { auto h = ref("h1"); if (ok) check("h1", h, MR, D, D, 0, [&](size_t r, size_t c) { return bf2f(H[r * D + c]); });
        std::vector<int> eid; { snprintf(nm, 64, "/L%d_eid.npy", L); auto e = load_npy(dir + nm, ok); if (ok) { const int* ep = (const int*)e.data(); const int* rt = (const int*)(ws + WS_ROUTE); int bad = 0; for (int r = 0; r < MR; ++r) if (rt[r * 4] != ep[r * 2] || rt[r * 4 + 1] != ep[r * 2 + 1]) ++bad; printf("CHECK routing mismatches: %d / %d\n", bad, MR); } } }
    if (PHS >= PH_MOE_DOWN && PHS < PH_LN2) { auto f = ref("f"); if (ok) { const unsigned* cnt = (const unsigned*)(ws + WS_CTL + CTL_CNT) + L * NEXP; const int* rt = (const int*)(ws + WS_ROUTE); const bf16* F2 = (const bf16*)(ws + WS_SB);
        check("moe f", f, MR, D, D, 0, [&](size_t r, size_t c) { size_t r0 = (size_t)moe_off(cnt, rt[r * 4]) + rt[r * 4 + 2], r1 = (size_t)moe_off(cnt, rt[r * 4 + 1]) + rt[r * 4 + 3]; return bf2f(F2[r0 * D + c]) + bf2f(F2[r1 * D + c]); }); } }
    if (PHS >= PH_LN2 && L + 1 < NL) { auto h = ref("h2"); if (ok) check("h2", h, MR, D, D, 0, [&](size_t r, size_t c) { return bf2f(H[r * D + c]); }); }
    if (g_stop_layer >= NL) { auto o = load_npy(dir + "/ref_out.npy", ok); if (ok) { std::vector<float> of(o.size() / 2); const double* od = (const double*)o.data(); for (size_t i = 0; i < of.size(); ++i) of[i] = (float)od[i];
        check("FINAL out", of, (size_t)NB * TS, D, D, 0, [&](size_t r, size_t c) { return out[r * D + c]; }); } }
    return 0;
}
#endif
```

```cpp
#ifdef CPU_EMU
#include "emu.h"
#else
#include <hip/hip_runtime.h>
#include <cstdio>
#include <cstdint>
#include <cmath>
#endif

#ifndef PROBE_MASK
#define PROBE_MASK 0
#endif
#ifndef CFG_BATCH
#define CFG_BATCH 4
#endif
#ifndef CFG_SEQ
#define CFG_SEQ 4096
#endif
#ifndef CFG_CTX
#define CFG_CTX 256
#endif
#ifndef CFG_DEPTH
#define CFG_DEPTH 4
#endif

typedef unsigned short bf16;
typedef short bf16x8 __attribute__((ext_vector_type(8)));
typedef short bf16x4 __attribute__((ext_vector_type(4)));
typedef float f32x4 __attribute__((ext_vector_type(4)));
typedef float f32x2 __attribute__((ext_vector_type(2)));
typedef float f32x16 __attribute__((ext_vector_type(16)));
typedef unsigned u32x4 __attribute__((ext_vector_type(4)));
typedef unsigned u32x2 __attribute__((ext_vector_type(2)));

constexpr int NB = CFG_BATCH, TS = CFG_SEQ, LC = CFG_CTX, NL = CFG_DEPTH;
constexpr int PT = LC + TS;
constexpr int MR = NB * PT;
constexpr int D = 1024;
constexpr int NE = (NL + 1) / 2, NO = NL / 2;
constexpr int GW = 64;
constexpr int GROWS = TS / GW;
constexpr int NCH = PT / 64, NCC = LC / 64;
constexpr int NTH = 512;
constexpr int EVEN_N = 2048, ODD_N = 3104, ODD_NP = 3328;
constexpr int NEXP = 32;
constexpr float LN_EPS = 1e-5f;
constexpr float ALPHA = 1.681792830507429f;
constexpr float LOG2E = 1.4426950408889634f, QSCALE = 0.125f * LOG2E;
static_assert(MR % 256 == 0 && LC % 128 == 0 && TS % 128 == 0 && GROWS >= 8, "shape");

enum { I_X = 0, I_C, I_CTX, I_CCTX, I_MODW, I_MODB, I_LNG, I_LNB, I_EWIN, I_EWOUT, I_LAMRE, I_LAMIM, I_LOGDT, I_BRE, I_BIM, I_CRE, I_CIM, I_S5D,
       I_GLUW, I_GLUB, I_RPB, I_OWIN, I_OWOUT, I_GGW, I_GGB, I_GNG, I_LQ1, I_LK1, I_LQ2, I_LK2, I_DNG, I_WGRP, I_BGRP, I_WEXP, I_BEXP, I_WGATE, I_WUP, I_WDOWN, N_IN };

constexpr size_t al256(size_t x) { return (x + 255) & ~(size_t)255; }
constexpr size_t WS_CTL = 0;
constexpr size_t CTL_BAR = 0;
constexpr size_t CTL_CNT = 16384;
constexpr size_t CTL_BYTES = 16384 + 4096;
constexpr size_t WS_MODV = al256(WS_CTL + CTL_BYTES);
constexpr size_t WS_S5P = al256(WS_MODV + (size_t)NL * (NB + 1) * 6144 * 4);
constexpr int S5P_STRIDE = 36;
constexpr size_t WS_ROPE = al256(WS_S5P + (size_t)NE * 2 * 32 * 64 * S5P_STRIDE * 4);
constexpr size_t WS_WIN = al256(WS_ROPE + 8192);
constexpr size_t WIN_LSTRIDE = (size_t)ODD_NP * D;
constexpr size_t WS_WOUT = al256(WS_WIN + (size_t)NL * WIN_LSTRIDE * 2);
constexpr size_t WS_GLU = al256(WS_WOUT + (size_t)NL * D * D * 2);
constexpr size_t WS_MGU = al256(WS_GLU + (size_t)NE * 1024 * 512 * 2);
constexpr size_t WS_MDN = al256(WS_MGU + (size_t)NL * NEXP * 512 * 1024 * 2);
constexpr size_t WS_H = al256(WS_MDN + (size_t)NL * NEXP * 1024 * 256 * 2);
constexpr size_t WS_ABF = al256(WS_H + (size_t)MR * D * 4);
constexpr size_t WS_Z = al256(WS_ABF + (size_t)MR * D * 2);
constexpr size_t Z_BYTES = (size_t)MR * 3360 * 2;
constexpr size_t WS_YMIX = al256(WS_Z + Z_BYTES);
constexpr size_t WS_SB = al256(WS_YMIX + (size_t)MR * D * 2);
constexpr size_t MOE_ROWS = (size_t)2 * MR + NEXP * 128;
constexpr size_t SB_GLA = (size_t)NB * 4 * 2 * NCH * 128 * 64 * 4 + (size_t)NB * 4 * 2 * NCH * 64 * 4 + (size_t)NB * 4 * NCH * 2 * 64 * 64 * 4 + 8192;
constexpr size_t SB_S5 = (size_t)2 * NB * 32 * 2 * NCH * 128 * 4 + (size_t)MR * 512 * 2 + 4096;
constexpr size_t SB_F2 = MOE_ROWS * D * 2;
constexpr size_t SB_BYTES = SB_GLA > SB_F2 ? (SB_GLA > SB_S5 ? SB_GLA : SB_S5) : (SB_F2 > SB_S5 ? SB_F2 : SB_S5);
constexpr size_t WS_ACT = al256(WS_SB + SB_BYTES);
constexpr size_t WS_ROUTE = al256(WS_ACT + MOE_ROWS * 256 * 2);
constexpr size_t WS_LTOK = al256(WS_ROUTE + (size_t)MR * 16);
constexpr size_t WS_LW = al256(WS_LTOK + (size_t)NEXP * MR * 4);
constexpr size_t WS_END = al256(WS_LW + (size_t)NEXP * MR * 4);
constexpr size_t ZE_U = 0, ZE_Q = (size_t)MR * 512, ZE_K = (size_t)MR * 1024, ZE_VT = (size_t)MR * 1536;
constexpr size_t ZO_GQ = 0, ZO_GK = (size_t)MR * 256, ZO_GKT = (size_t)MR * 512, ZO_GVT = (size_t)MR * 768, ZO_GR = (size_t)MR * 1280,
                 ZO_GZ = (size_t)MR * 1792, ZO_DQ = (size_t)MR * 1824, ZO_DK = (size_t)MR * 2336, ZO_DVT = (size_t)MR * 2848;
constexpr size_t SBO_S5E = 0;
constexpr size_t SBO_S5H = (size_t)NB * 32 * 2 * NCH * 128 * 4;
constexpr size_t SBO_GS = al256(2 * SBO_S5H);
constexpr size_t SBO_GU = 0;
constexpr size_t SBO_GDEC = al256((size_t)NB * 4 * 2 * NCH * 128 * 64 * 4);
constexpr size_t SBO_GCUM = al256(SBO_GDEC + (size_t)NB * 4 * 2 * NCH * 64 * 4);

#ifdef CPU_EMU
#define DEVFN static inline
#define MEMFN inline
#else
#define DEVFN __device__ __forceinline__
#define MEMFN __device__ __forceinline__
#endif
DEVFN unsigned fbits(float f) { return __builtin_bit_cast(unsigned, f); }
DEVFN float bitsf(unsigned u) { return __builtin_bit_cast(float, u); }
DEVFN bf16 f2bf(float f) { unsigned u = fbits(f); u += 0x7fffu + ((u >> 16) & 1u); return (bf16)(u >> 16); }
DEVFN float bf2f(bf16 h) { return bitsf((unsigned)h << 16); }
DEVFN unsigned pack2(float lo, float hi) {
#ifdef CPU_EMU
    return (unsigned)f2bf(lo) | ((unsigned)f2bf(hi) << 16);
#else
    typedef __bf16 bf16v2_ __attribute__((ext_vector_type(2)));
    return __builtin_bit_cast(unsigned, __builtin_convertvector((f32x2){lo, hi}, bf16v2_));
#endif
}
DEVFN float fexp2(float x) {
#ifdef CPU_EMU
    return exp2f(x);
#else
    return __builtin_amdgcn_exp2f(x);
#endif
}
DEVFN float fexp(float x) { return fexp2(x * 1.4426950408889634f); }
DEVFN float flog2(float x) {
#ifdef CPU_EMU
    return log2f(x);
#else
    return __builtin_amdgcn_logf(x);
#endif
}
DEVFN float sigmoidf_(float x) { return 1.0f / (1.0f + fexp(-x)); }
DEVFN float siluf_(float x) { return x / (1.0f + fexp(-x)); }
DEVFN float geluf_(float x) { const float u = 0.7978845608028654f * (x + 0.044715f * x * x * x); return x / (1.0f + fexp(-2.0f * u)); }

DEVFN float logsigf_(float x) { return fminf(x, 0.f) - 0.6931471805599453f * flog2(1.0f + fexp(-fabsf(x))); }
DEVFN f32x4 mfma16(bf16x8 a, bf16x8 b, f32x4 c) {
#ifdef CPU_EMU
    return emu_mfma16(a, b, c);
#else
    return __builtin_amdgcn_mfma_f32_16x16x32_bf16(a, b, c, 0, 0, 0);
#endif
}
DEVFN f32x16 mfma32(bf16x8 a, bf16x8 b, f32x16 c) {
#ifdef CPU_EMU
    return emu_mfma32(a, b, c);
#else
    return __builtin_amdgcn_mfma_f32_32x32x16_bf16(a, b, c, 0, 0, 0);
#endif
}
DEVFN void sched_fence() {
#ifndef CPU_EMU
    __builtin_amdgcn_sched_barrier(0);
#endif
}
DEVFN bool wave_all(bool c) {
#ifdef CPU_EMU
    int v = c ? 1 : 0; v &= __shfl_xor(v, 32); v &= __shfl_xor(v, 16); v &= __shfl_xor(v, 8); v &= __shfl_xor(v, 4); v &= __shfl_xor(v, 2); v &= __shfl_xor(v, 1); return v != 0;
#else
    return __all(c);
#endif
}
DEVFN float wave_sum(float v) {
#ifdef CPU_EMU
    v += __shfl_xor(v, 32); v += __shfl_xor(v, 16); v += __shfl_xor(v, 8); v += __shfl_xor(v, 4); v += __shfl_xor(v, 2); v += __shfl_xor(v, 1); return v;
#else
#define WS_DPP(x, ctrl) bitsf((unsigned)__builtin_amdgcn_update_dpp(0, (int)fbits(x), ctrl, 0xF, 0xF, true))
    v += WS_DPP(v, 0xB1); v += WS_DPP(v, 0x4E); v += WS_DPP(v, 0x141); v += WS_DPP(v, 0x140);
#undef WS_DPP
    const int iv = (int)fbits(v);
    return bitsf((unsigned)__builtin_amdgcn_readlane(iv, 0)) + bitsf((unsigned)__builtin_amdgcn_readlane(iv, 16)) + bitsf((unsigned)__builtin_amdgcn_readlane(iv, 32)) + bitsf((unsigned)__builtin_amdgcn_readlane(iv, 48));
#endif
}

struct Params { const float* in[N_IN]; float* out; unsigned char* ws; };

constexpr int LDS_BYTES = 128 * 1024;
constexpr int LDS_TOTAL = LDS_BYTES + 16;
#ifdef CPU_EMU
#define DECL_LDS unsigned char* lds = emu::cur_blk->lds
#define GRID_SYNC() emu::grid_barrier()
#else
#define DECL_LDS extern __shared__ __attribute__((aligned(16))) unsigned char lds[]
#define XB_TMO      128
#define XB_XCNT(j)  (256  + 64 * (j))
#define XB_XSUB(j)  (1280 + 64 * (j))
#define XB_XGEN(j)  (2304 + 64 * (j))
#define XB_TOP      3328
#define XB_TOPGEN   3392
#define XCD_BAR_WORDS 3456
#define XB_SPIN_CAP (1u << 18)
#define LAS __attribute__((address_space(3)))

__device__ __forceinline__ unsigned xb_ld(unsigned* p)              { return __hip_atomic_load(p, __ATOMIC_RELAXED, __HIP_MEMORY_SCOPE_AGENT); }
__device__ __forceinline__ unsigned xb_add(unsigned* p, unsigned v) { return __hip_atomic_fetch_add(p, v, __ATOMIC_RELAXED, __HIP_MEMORY_SCOPE_AGENT); }
__device__ __forceinline__ unsigned xb_xcc_id() { return (unsigned)__builtin_amdgcn_s_getreg((3 << 11) | 20) & 0xFu; }
#define XB_SPIN(cond, bar) do { unsigned _sp = 0; while (cond) { __builtin_amdgcn_s_sleep(1); \
    if ((++_sp & 255u) == 0u) { if (xb_ld(&(bar)[XB_TMO])) break; if (_sp > XB_SPIN_CAP) { atomicAdd(&(bar)[XB_TMO], 1u); break; } } } } while (0)

struct XcdBarrier {
    unsigned* bar; unsigned x;
    volatile LAS unsigned* st;
};

__device__ __forceinline__ XcdBarrier xcd_barrier_post(unsigned* bar, volatile LAS unsigned* st) {
    XcdBarrier b; b.bar = bar; b.x = xb_xcc_id(); b.st = st;
    if (threadIdx.x == 0) (void)xb_add(&bar[XB_XCNT(b.x)], 1u);
    return b;
}
__device__ __forceinline__ void xcd_barrier_complete(unsigned* bar, unsigned x, unsigned& nloc, unsigned& nx) {
    const unsigned G = gridDim.x * gridDim.y * gridDim.z;
    unsigned sum, cnt, mine, sp = 0u;
    for (;;) {
        sum = 0u; cnt = 0u; mine = 0u;
#pragma unroll
        for (unsigned j = 0; j < 16; ++j) { const unsigned c = xb_ld(&bar[XB_XCNT(j)]); sum += c; cnt += (c > 0u) ? 1u : 0u; mine = (j == x) ? c : mine; }
        if (sum == G) break;
        __builtin_amdgcn_s_sleep(1);
        if ((++sp & 255u) == 0u) { if (xb_ld(&bar[XB_TMO])) break; if (sp > XB_SPIN_CAP) { atomicAdd(&bar[XB_TMO], 1u); break; } }
    }
    nloc = mine > 0u ? mine : 1u; nx = cnt > 0u ? cnt : 1u;
}

__device__ __forceinline__ void xcd_barrier(const XcdBarrier& b) {
    asm volatile("s_waitcnt vmcnt(0)" ::: "memory");
    __syncthreads();
    if (threadIdx.x == 0) {
        unsigned* bar = b.bar;
        __builtin_amdgcn_s_waitcnt(0);
        unsigned nloc = b.st[0], nx = b.st[1];
        if (nloc == 0u) { xcd_barrier_complete(bar, b.x, nloc, nx); b.st[0] = nloc; b.st[1] = nx; }
        const unsigned old = xb_add(&bar[XB_XSUB(b.x)], 1u);
        const unsigned gen = old / nloc;
        if (old + 1u == (gen + 1u) * nloc) {
            __builtin_amdgcn_fence(__ATOMIC_RELEASE, "agent");
            asm volatile("s_waitcnt vmcnt(0)" ::: "memory");
            const unsigned og = xb_add(&bar[XB_TOP], 1u);
            const unsigned tg = og / nx;
            if (og + 1u == (tg + 1u) * nx) xb_add(&bar[XB_TOPGEN], 1u);
            else XB_SPIN(xb_ld(&bar[XB_TOPGEN]) == tg, bar);
            __builtin_amdgcn_fence(__ATOMIC_ACQUIRE, "agent");
            xb_add(&bar[XB_XGEN(b.x)], 1u);
            asm volatile("s_waitcnt vmcnt(0)" ::: "memory");
        } else {
            XB_SPIN(xb_ld(&bar[XB_XGEN(b.x)]) == gen, bar);
            __builtin_amdgcn_fence(__ATOMIC_ACQUIRE, "agent");
            asm volatile("s_waitcnt vmcnt(0)" ::: "memory");
        }
    }
    __syncthreads();
}

#define GRID_SYNC() xcd_barrier(gbar)
#endif

DEVFN int tidx() { int t = (int)threadIdx.x;
#ifndef CPU_EMU
    asm volatile("" : "+v"(t));
#endif
    return t; }
template <class ColSrc, class DstFn>
DEVFN void conv_group(unsigned char* lds, int nmat, int K, int N, int ld_src, ColSrc colsrc, DstFn dstfn) {
    float* t = (float*)lds;
    const int tid = tidx(), G = gridDim.x, nkt = K / 64, nnt = N / 128, units = nmat * nkt * nnt; float r[16];
    auto load = [&](int u) { const int mat = u / (nkt * nnt), rem = u % (nkt * nnt), k0 = (rem % nkt) * 64, n0 = (rem / nkt) * 128;
#pragma unroll
        for (int it = 0; it < 16; ++it) { const int idx = it * NTH + tid, kl = idx >> 7, nl = idx & 127; const float* sp = colsrc(mat, n0 + nl); r[it] = sp ? sp[(size_t)(k0 + kl) * ld_src] : 0.f; } };
    int u = blockIdx.x; if (u < units) load(u);
    for (; u < units; u += G) {
        __syncthreads();
#pragma unroll
        for (int it = 0; it < 16; ++it) { const int idx = it * NTH + tid, kl = idx >> 7, nl = idx & 127; t[kl * 129 + nl] = r[it]; }
        if (u + G < units) load(u + G);
        __syncthreads();
        const int mat = u / (nkt * nnt), rem = u % (nkt * nnt), k0 = (rem % nkt) * 64, n0 = (rem / nkt) * 128; bf16* dst = dstfn(mat);
#pragma unroll
        for (int it = 0; it < 8; ++it) { const int idx = it * NTH + tid, nl = idx >> 5, kp = idx & 31; *(unsigned*)(dst + (size_t)(n0 + nl) * K + k0 + 2 * kp) = pack2(t[(2 * kp) * 129 + nl], t[(2 * kp + 1) * 129 + nl]); }
    }
}

DEVFN void phase_convert(const Params& p, unsigned char* lds) {
    const int G = gridDim.x, bid = blockIdx.x;
    conv_group(lds, NE, D, EVEN_N, EVEN_N, [&](int j, int n) { return p.in[I_EWIN] + (size_t)j * D * EVEN_N + n; }, [&](int j) { return (bf16*)(p.ws + WS_WIN) + (size_t)(2 * j) * WIN_LSTRIDE; });
    if (NO > 0) conv_group(lds, NO, D, ODD_NP, ODD_N, [&](int j, int n) -> const float* { const float* src = p.in[I_OWIN] + (size_t)j * D * ODD_N; return n < 1536 ? src + n : (n < 3072 ? src + n + 32 : (n < 3104 ? src + 1536 + (n - 3072) : nullptr)); },
                           [&](int j) { return (bf16*)(p.ws + WS_WIN) + (size_t)(2 * j + 1) * WIN_LSTRIDE; });
    conv_group(lds, NL, D, D, D, [&](int l, int n) { return ((l & 1) ? p.in[I_OWOUT] : p.in[I_EWOUT]) + (size_t)(l >> 1) * D * D + n; }, [&](int l) { return (bf16*)(p.ws + WS_WOUT) + (size_t)l * D * D; });
    conv_group(lds, NE, 512, 1024, 1024, [&](int j, int n) { return p.in[I_GLUW] + (size_t)j * 512 * 1024 + ((n & 31) >> 4) * 512 + (n >> 5) * 16 + (n & 15); }, [&](int j) { return (bf16*)(p.ws + WS_GLU) + (size_t)j * 1024 * 512; });
    conv_group(lds, NL * NEXP, D, 512, 256, [&](int e, int n) { return (((n & 31) >> 4) ? p.in[I_WUP] : p.in[I_WGATE]) + (size_t)e * D * 256 + (n >> 5) * 16 + (n & 15); }, [&](int e) { return (bf16*)(p.ws + WS_MGU) + (size_t)e * 512 * 1024; });
    conv_group(lds, NL * NEXP, 256, D, D, [&](int e, int n) { return p.in[I_WDOWN] + (size_t)e * 256 * D + n; }, [&](int e) { return (bf16*)(p.ws + WS_MDN) + (size_t)e * 1024 * 256; });
    {
        float* sv = (float*)lds;
        __syncthreads();
        for (int i = tidx(); i < (NB + 1) * D; i += NTH) { const int r = i / D, k = i % D; const float v = r < NB ? p.in[I_C][r * D + k] : p.in[I_CCTX][k]; sv[i] = siluf_(v); }
        __syncthreads();
        float* modv = (float*)(p.ws + WS_MODV);
        for (int u = bid; u < NL * 96; u += G) { const int l = u / 96, cg = u % 96; const int cl = tidx() & 63, col = cg * 64 + cl, ks = tidx() >> 6;
            const float* w = p.in[I_MODW] + (size_t)l * D * 6144 + col; float acc[NB + 1];
#pragma unroll
            for (int r = 0; r <= NB; ++r) acc[r] = 0.f;
#pragma unroll 8
            for (int k = ks * 128; k < ks * 128 + 128; ++k) { const float wv = w[(size_t)k * 6144];
#pragma unroll
                for (int r = 0; r <= NB; ++r) acc[r] += sv[r * D + k] * wv; }
            float* red = (float*)(lds + 32768);
            __syncthreads();
#pragma unroll
            for (int r = 0; r <= NB; ++r) red[(ks * (NB + 1) + r) * 64 + cl] = acc[r];
            __syncthreads();
            for (int i = tidx(); i < (NB + 1) * 64; i += NTH) { const int r = i >> 6, c = i & 63; const int cc = cg * 64 + c; float sum = p.in[I_MODB][(size_t)l * 6144 + cc];
#pragma unroll
                for (int q = 0; q < 8; ++q) sum += red[(q * (NB + 1) + r) * 64 + c];
                modv[((size_t)l * (NB + 1) + r) * 6144 + cc] = sum; }
            __syncthreads();
        }
    }
    for (int i = bid * NTH + tidx(); i < 1024; i += G * NTH) { const float ang = (float)(i >> 4) * expf(-(float)(i & 15) * (9.210340371976184f / 16.0f)); float sn, cs; sincosf(ang, &sn, &cs); float* rt = (float*)(p.ws + WS_ROPE); rt[i] = cs; rt[1024 + i] = sn; }
    for (int i = bid * NTH + tidx(); i < NE * 2 * 32 * 64; i += G * NTH) {
        const int pidx = i & 63, g = (i >> 6) & 31, jd = i >> 11;
        const float lre = p.in[I_LAMRE][i], lim = p.in[I_LAMIM][i], dt = expf(p.in[I_LOGDT][jd * 32 + g]);
        const float mag = expf(lre * dt), are = mag * cosf(lim * dt), aim = mag * sinf(lim * dt);
        const float magL = expf(lre * dt * 64.f), aLre = magL * cosf(lim * dt * 64.f), aLim = magL * sinf(lim * dt * 64.f);
        const float den = lre * lre + lim * lim;
        const float fre = ((are - 1.0f) * lre + aim * lim) / den, fim = (aim * lre - (are - 1.0f) * lim) / den;
        float* o = (float*)(p.ws + WS_S5P) + (size_t)i * S5P_STRIDE;
        o[0] = are; o[1] = aim; o[2] = aLre; o[3] = aLim;
        const float* bre = p.in[I_BRE] + (size_t)i * 16; const float* bim = p.in[I_BIM] + (size_t)i * 16;
        for (int h = 0; h < 16; ++h) { o[4 + h] = fre * bre[h] - fim * bim[h]; o[20 + h] = fre * bim[h] + fim * bre[h]; }
    }
}

DEVFN void mod_store_row(const Params& p, int layer, int which  , int row, const float (&h)[16], bf16* dstrow) {
    const int b = row / PT, pp = row % PT, mr = pp < LC ? NB : b, lane = tidx() & 63;
    const float* mv = (const float*)(p.ws + WS_MODV) + ((size_t)layer * (NB + 1) + mr) * 6144 + which * 3072;
#pragma unroll
    for (int i = 0; i < 4; ++i) { const int c = i * 256 + lane * 4; const f32x4 sh = *(const f32x4*)(mv + c), sc = *(const f32x4*)(mv + 1024 + c);
        u32x2 w; w.x = pack2(h[i * 4 + 0] * (1.f + sc[0]) + sh[0], h[i * 4 + 1] * (1.f + sc[1]) + sh[1]); w.y = pack2(h[i * 4 + 2] * (1.f + sc[2]) + sh[2], h[i * 4 + 3] * (1.f + sc[3]) + sh[3]);
        *(u32x2*)(dstrow + c) = w; }
}
DEVFN void phase_init_h(const Params& p) {
    const int wave = tidx() >> 6, lane = tidx() & 63; bf16* H = (bf16*)(p.ws + WS_H); bf16* A = (bf16*)(p.ws + WS_ABF);
    auto srcrow = [&](int row) { const int b = row / PT, pp = row % PT; return pp < LC ? p.in[I_CTX] + ((size_t)b * LC + pp) * D : p.in[I_X] + ((size_t)b * TS + (pp - LC)) * D; };
    f32x4 nx[4];
    int row = blockIdx.x * 8 + wave;
    if (row < MR) { const float* src = srcrow(row);
#pragma unroll
        for (int i = 0; i < 4; ++i) nx[i] = *(const f32x4*)(src + i * 256 + lane * 4); }
    for (; row < MR; row += gridDim.x * 8) { float h[16]; f32x4 cv[4];
#pragma unroll
        for (int i = 0; i < 4; ++i) cv[i] = nx[i];
        if (row + (int)gridDim.x * 8 < MR) { const float* src = srcrow(row + gridDim.x * 8);
#pragma unroll
            for (int i = 0; i < 4; ++i) nx[i] = *(const f32x4*)(src + i * 256 + lane * 4); }
#pragma unroll
        for (int i = 0; i < 4; ++i) { const f32x4 v = cv[i]; { u32x2 w; w.x = pack2(v[0], v[1]); w.y = pack2(v[2], v[3]); *(u32x2*)(H + (size_t)row * D + i * 256 + lane * 4) = w; } h[i * 4] = v[0]; h[i * 4 + 1] = v[1]; h[i * 4 + 2] = v[2]; h[i * 4 + 3] = v[3]; }
        mod_store_row(p, 0, 0, row, h, A + (size_t)row * D); }
}

DEVFN int lds_sw(int row, int ch) { return row * 128 + ((ch ^ (row & 7)) << 4); }
DEVFN void dma16(const void* g, unsigned char* l) {
#ifdef CPU_EMU
    memcpy(l + (emu::cur->lin & 63) * 16, g, 16);
#else
    __builtin_amdgcn_global_load_lds((const unsigned*)g, (LAS unsigned*)l, 16, 0, 0);
#endif
}
template <int N> DEVFN void dma_wait_barrier() {
#ifdef CPU_EMU
    __syncthreads();
#else
    asm volatile("s_waitcnt vmcnt(%0) lgkmcnt(0)" :: "n"(N) : "memory"); __builtin_amdgcn_s_barrier(); asm volatile("" ::: "memory");
#endif
}
template <int WM> struct GemmPtrs { const bf16* pa[WM]; const bf16* pb[2]; };
template <int WM, class RowA>
DEVFN void gemm_begin(unsigned char* lds, RowA rowA, const bf16* Bt, int K, int n0, GemmPtrs<WM>& g) {
    constexpr int NA = WM, ABYTES = WM * 8192, BUF = ABYTES + 16384;
    const int tid = tidx(), wave = tid >> 6;
#ifdef CPU_EMU
    const int wvu = wave;
#else
    const int wvu = __builtin_amdgcn_readfirstlane(wave);
#endif
#pragma unroll
    for (int i = 0; i < NA; ++i) { const int idx = i * NTH + tid, row = idx >> 3, ch = (idx & 7) ^ (row & 7); g.pa[i] = rowA(row) + ch * 8; }
#pragma unroll
    for (int i = 0; i < 2; ++i) { const int idx = i * NTH + tid, row = idx >> 3, ch = (idx & 7) ^ (row & 7); g.pb[i] = Bt + (size_t)(n0 + row) * K + ch * 8; }
#pragma unroll
    for (int t = 0; t < 2; ++t) {
#pragma unroll
        for (int i = 0; i < NA; ++i) dma16(g.pa[i] + t * 64, lds + t * BUF + (i * NTH + wvu * 64) * 16);
#pragma unroll
        for (int i = 0; i < 2; ++i) dma16(g.pb[i] + t * 64, lds + t * BUF + ABYTES + (i * NTH + wvu * 64) * 16); }
}
template <int WM, bool SWAP, class Hook, class Epi>
DEVFN void gemm_run(unsigned char* lds, const GemmPtrs<WM>& g, int K, Hook hook, Epi epi) {
    constexpr int WN = 8 / WM, NG = WM / 2, NA = WM, ABYTES = WM * 8192, BUF = ABYTES + 16384;
    static_assert(3 * BUF <= LDS_BYTES, "GEMM LDS");
    const int tid = tidx(), lane = tid & 63, wave = tid >> 6, wr = wave / WN, wc = wave % WN, fr = lane & 15, fg = lane >> 4;
#ifdef CPU_EMU
    const int wvu = wave;
#else
    const int wvu = __builtin_amdgcn_readfirstlane(wave);
#endif
    f32x4 acc[4][2 * NG];
#pragma unroll
    for (int m = 0; m < 4; ++m)
#pragma unroll
        for (int n = 0; n < 2 * NG; ++n) acc[m][n] = (f32x4){0.f, 0.f, 0.f, 0.f};
    const int nk = K / 64;
#define GM_DMA(kt, buf) do { _Pragma("unroll") for (int i = 0; i < NA; ++i) dma16(g.pa[i] + (kt) * 64, lds + (buf) + (i * NTH + wvu * 64) * 16); \
        _Pragma("unroll") for (int i = 0; i < 2; ++i) dma16(g.pb[i] + (kt) * 64, lds + (buf) + ABYTES + (i * NTH + wvu * 64) * 16); } while (0)
#define GM_COMPUTE(cur) do { _Pragma("unroll") for (int ks = 0; ks < 2; ++ks) { bf16x8 a[4], b[2 * NG]; \
        _Pragma("unroll") for (int m = 0; m < 4; ++m) a[m] = *(const bf16x8*)(lds + (cur) + lds_sw(wr * 64 + m * 16 + fr, ks * 4 + fg)); \
        _Pragma("unroll") for (int n = 0; n < 2 * NG; ++n) b[n] = *(const bf16x8*)(lds + (cur) + ABYTES + lds_sw(wc * 32 * NG + n * 16 + fr, ks * 4 + fg)); \
        _Pragma("unroll") for (int m = 0; m < 4; ++m) _Pragma("unroll") for (int n = 0; n < 2 * NG; ++n) acc[m][n] = SWAP ? mfma16(b[n], a[m], acc[m][n]) : mfma16(a[m], b[n], acc[m][n]); } } while (0)
    dma_wait_barrier<NA + 2>();
    int cur = 0, nxt2 = 2 * BUF;
    for (int kt = 0; kt < nk; ++kt) {
        if (kt + 2 < nk) GM_DMA(kt + 2, nxt2);
        GM_COMPUTE(cur);
        if (kt + 2 < nk) dma_wait_barrier<NA + 2>(); else dma_wait_barrier<0>();
        nxt2 = cur; cur = cur + BUF >= 3 * BUF ? 0 : cur + BUF;
    }
#undef GM_DMA
#undef GM_COMPUTE
    hook();
#pragma unroll
    for (int m = 0; m < 4; ++m)
#pragma unroll
        for (int g2 = 0; g2 < NG; ++g2) { if (SWAP) epi(wr * 64 + m * 16 + fr, wc * 32 * NG + g2 * 32 + 4 * fg, acc[m][2 * g2], acc[m][2 * g2 + 1]); else epi(wr * 64 + m * 16 + 4 * fg, wc * 32 * NG + g2 * 32, acc[m][2 * g2], acc[m][2 * g2 + 1]); }
}

namespace pg8 {
constexpr int BM = 256, BK = 64, HALF = 128, HTB = HALF * BK * 2  , STAGE_BYTES = 8 * HTB, NXCD = 8, WGM = 8;
DEVFN int lds_byte(int r, int c) { const int st = (r >> 4) * 2 + (c >> 5), rr = r & 15, cc = c & 31, ob = rr * 64 + cc * 2; return st * 1024 + (ob ^ (((ob >> 9) & 1) << 5)); }
DEVFN void stage_rc(int b, int& R, int& C) { const int st = b / 1024, sb = b % 1024, swz = sb ^ (((sb >> 9) & 1) << 5); R = (st >> 1) * 16 + swz / 64; C = (st & 1) * 32 + (swz % 64) / 2; }
struct Unit { int pm, pn; };
struct Gemm { const bf16* A; const bf16* Bt; int M, N, K; };
struct StaticOrder {
    int nM, nN, nwg, G, c;
    MEMFN void init(int M, int N, int G_, int c_) { nM = M / BM; nN = N / BM; nwg = nM * nN; G = G_; c = c_; }
    MEMFN bool next(int i, Unit& u) const {
        const long L = (long)i * G + c; if (L >= nwg) return false;
        int wgid = (int)L; { const int q = nwg / NXCD, r = nwg % NXCD, xcd = wgid % NXCD, off = wgid / NXCD; wgid = (xcd < r ? xcd * (q + 1) : r * (q + 1) + (xcd - r) * q) + off; }
        const int nig = WGM * nN, gid = wgid / nig, fm = gid * WGM, gsz = (nM - fm) < WGM ? (nM - fm) : WGM;
        u.pm = fm + ((wgid % nig) % gsz); u.pn = (wgid % nig) / gsz; return true;
    }
};
#ifdef CPU_EMU
#define PG8_WAIT_V(n) do {} while (0)
#define PG8_WAIT_L(n) do {} while (0)
#define PG8_BAR __syncthreads()
#define PG8_SCHED do {} while (0)
#define PG8_PRIO(x) do {} while (0)
#else
#define PG8_WAIT_V(n) asm volatile("s_waitcnt vmcnt(" #n ")" ::: "memory")
#define PG8_WAIT_L(n) asm volatile("s_waitcnt lgkmcnt(" #n ")" ::: "memory")
#define PG8_BAR __builtin_amdgcn_s_barrier()
#define PG8_SCHED __builtin_amdgcn_sched_barrier(0)
#define PG8_PRIO(x) __builtin_amdgcn_s_setprio(x)
#endif
template <class Epi, class Sched>
DEVFN void gemm_phase(unsigned char* lds, const Gemm g, const Sched& S, const Epi& E) {
    const int tid = tidx();
#ifdef CPU_EMU
    const int wid = tid >> 6;
#else
    const int wid = __builtin_amdgcn_readfirstlane(tid >> 6);
#endif
    const int lane = tid & 63, wr = wid >> 2, wc = wid & 3, fr = lane & 15, fq = lane >> 4;
    const int K = g.K, nt = K / BK;
    unsigned voffA[2], voffB[2];
#pragma unroll
    for (int i = 0; i < 2; ++i) { int R, C; stage_rc(tid * 16 + i * 8192, R, C); voffA[i] = (unsigned)(R * K + C) * 2u; voffB[i] = voffA[i]; }
    const size_t kstep = (size_t)(BK * 2);
    const size_t hstep = (size_t)HALF * K * 2;
    const size_t tstep = 2 * hstep;
    const unsigned ldsw = (unsigned)wid * 1024u;
    const int aoff = lds_byte(wr * 64 + fr, fq * 8), boff = lds_byte(wc * 32 + fr, fq * 8);
#define PG8_SA(b, h) (((b) * 2 + (h)) * HTB)
#define PG8_SB(b, h) ((4 + (b) * 2 + (h)) * HTB)
#define PG8_STAGE(bufoff, gbase, voff) do { _Pragma("unroll") for (int _i = 0; _i < 2; ++_i) dma16((const char*)(gbase) + (voff)[_i], lds + (bufoff) + ldsw + _i * 8192); } while (0)
#define PG8_LDA(dst, b, h) do { _Pragma("unroll") for (int m = 0; m < 4; ++m) _Pragma("unroll") for (int k = 0; k < 2; ++k) dst[m][k] = *(const bf16x8*)(lds + PG8_SA(b, h) + aoff + m * 2048 + k * 1024); } while (0)
#define PG8_LDB(dst, b, h) do { _Pragma("unroll") for (int n = 0; n < 2; ++n) _Pragma("unroll") for (int k = 0; k < 2; ++k) dst[n][k] = *(const bf16x8*)(lds + PG8_SB(b, h) + boff + n * 2048 + k * 1024); } while (0)
#define PG8_MMA(ai, bj, At, Bt) do { PG8_PRIO(1); _Pragma("unroll") for (int m = 0; m < 4; ++m) _Pragma("unroll") for (int n = 0; n < 2; ++n) _Pragma("unroll") for (int k = 0; k < 2; ++k) \
        acc[ai][bj][m][n] = mfma16(Bt[n][k], At[m][k], acc[ai][bj][m][n]); PG8_PRIO(0); } while (0)
    Unit cur, nxt; int ui = 0;
    __syncthreads();
    if (!S.next(0, cur)) return;
    f32x4 acc[2][2][4][2];
#pragma unroll
    for (int a = 0; a < 2; ++a)
#pragma unroll
        for (int b = 0; b < 2; ++b)
#pragma unroll
            for (int m = 0; m < 4; ++m)
#pragma unroll
                for (int n = 0; n < 2; ++n) acc[a][b][m][n] = (f32x4){0.f, 0.f, 0.f, 0.f};
    bf16x8 At[4][2], B0[2][2], B1[2][2];
    const char* cA = (const char*)g.A + (size_t)cur.pm * tstep; const char* cB = (const char*)g.Bt + (size_t)cur.pn * tstep;
    PG8_STAGE(PG8_SB(0, 0), cB, voffB); PG8_STAGE(PG8_SA(0, 0), cA, voffA); PG8_STAGE(PG8_SB(0, 1), cB + hstep, voffB); PG8_STAGE(PG8_SA(0, 1), cA + hstep, voffA);
    if (wr == 1) PG8_BAR;
    PG8_WAIT_V(4); PG8_BAR;
    PG8_STAGE(PG8_SB(1, 0), cB + kstep, voffB); PG8_STAGE(PG8_SA(1, 0), cA + kstep, voffA); PG8_STAGE(PG8_SB(1, 1), cB + hstep + kstep, voffB);
    PG8_WAIT_V(6); PG8_BAR;
    for (;;) {
        const bool has_next = S.next(ui + 1, nxt);
        const char* nA = has_next ? (const char*)g.A + (size_t)nxt.pm * tstep : cA; const char* nB = has_next ? (const char*)g.Bt + (size_t)nxt.pn * tstep : cB;
        for (int t = 0; t < nt; t += 2) {
            const bool last = (t == nt - 2);
            const char* a1 = cA + (size_t)(t + 1) * kstep;
            const char* a2 = last ? nA : cA + (size_t)(t + 2) * kstep; const char* b2 = last ? nB : cB + (size_t)(t + 2) * kstep;
            const char* a3 = a2 + kstep; const char* b3 = b2 + kstep;
            PG8_LDB(B0, 0, 0); PG8_SCHED; PG8_LDA(At, 0, 0); PG8_STAGE(PG8_SA(1, 1), a1 + hstep, voffA);
            PG8_WAIT_L(8); PG8_BAR; PG8_WAIT_L(0); PG8_MMA(0, 0, At, B0); PG8_BAR; PG8_SCHED;
            PG8_LDB(B1, 0, 1); PG8_STAGE(PG8_SB(0, 0), b2, voffB);
            PG8_BAR; PG8_WAIT_L(0); PG8_MMA(0, 1, At, B1); PG8_BAR;
            PG8_LDA(At, 0, 1); PG8_STAGE(PG8_SA(0, 0), a2, voffA);
            PG8_BAR; PG8_WAIT_L(0); PG8_MMA(1, 0, At, B0); PG8_BAR; PG8_SCHED;
            PG8_STAGE(PG8_SB(0, 1), b2 + hstep, voffB);
            PG8_WAIT_V(6); PG8_BAR; PG8_MMA(1, 1, At, B1); PG8_BAR;
            PG8_LDB(B0, 1, 0); PG8_SCHED; PG8_LDA(At, 1, 0); PG8_STAGE(PG8_SA(0, 1), a2 + hstep, voffA);
            PG8_WAIT_L(8); PG8_BAR; PG8_WAIT_L(0); PG8_MMA(0, 0, At, B0); PG8_BAR; PG8_SCHED;
            PG8_LDB(B1, 1, 1); PG8_STAGE(PG8_SB(1, 0), b3, voffB);
            PG8_BAR; PG8_WAIT_L(0); PG8_MMA(0, 1, At, B1); PG8_BAR;
            PG8_LDA(At, 1, 1); PG8_STAGE(PG8_SA(1, 0), a3, voffA);
            PG8_BAR; PG8_WAIT_L(0); PG8_MMA(1, 0, At, B0); PG8_BAR; PG8_SCHED;
            PG8_STAGE(PG8_SB(1, 1), b3 + hstep, voffB);
            PG8_WAIT_V(6); PG8_BAR; PG8_MMA(1, 1, At, B1); PG8_BAR;
        }
        E(acc, cur, wr, wc, fr, fq);
        if (!has_next) break;
#pragma unroll
        for (int a = 0; a < 2; ++a)
#pragma unroll
            for (int b = 0; b < 2; ++b)
#pragma unroll
                for (int m = 0; m < 4; ++m)
#pragma unroll
                    for (int n = 0; n < 2; ++n) acc[a][b][m][n] = (f32x4){0.f, 0.f, 0.f, 0.f};
        cur = nxt; cA = nA; cB = nB; ++ui;
    }
    PG8_WAIT_V(0);
    if (wr == 0) PG8_BAR;
    PG8_BAR;
#undef PG8_SA
#undef PG8_SB
#undef PG8_STAGE
#undef PG8_LDA
#undef PG8_LDB
#undef PG8_MMA
}
template <class F> struct EpiFn { F f;
    MEMFN void operator()(const f32x4 (&acc)[2][2][4][2], const Unit& u, int wr, int wc, int fr, int fq) const {
#pragma unroll
        for (int ai = 0; ai < 2; ++ai)
#pragma unroll
            for (int m = 0; m < 4; ++m)
#pragma unroll
                for (int bj = 0; bj < 2; ++bj) f(u.pm * BM + ai * HALF + wr * 64 + m * 16 + fr, u.pn * BM + bj * HALF + wc * 32 + 4 * fq, acc[ai][bj][m][0], acc[ai][bj][m][1]); }
};
struct LatentOrder {
    int nN, nwg, G, c;
    MEMFN void init(int N, int G_, int c_) { nN = N / BM; nwg = (TS / BM) * NB * nN; G = G_; c = c_; }
    MEMFN bool next(int i, Unit& u) const { const long L = (long)i * G + c; if (L >= nwg) return false; const int lp = (int)(L / nN); u.pn = (int)(L % nN); u.pm = (lp / (TS / BM)) * (PT / BM) + LC / BM + lp % (TS / BM); return true; }
};
template <class F> DEVFN void run_latent(unsigned char* lds, const bf16* A, const bf16* Bt, int M, int N, int K, F f) {
    Gemm g{A, Bt, M, N, K}; LatentOrder S; S.init(N, (int)gridDim.x, (int)blockIdx.x); EpiFn<F> E{f}; gemm_phase(lds, g, S, E);
}
template <class F> DEVFN void run(unsigned char* lds, const bf16* A, const bf16* Bt, int M, int N, int K, F f) {
    Gemm g{A, Bt, M, N, K}; StaticOrder S; S.init(M, N, (int)gridDim.x, (int)blockIdx.x); EpiFn<F> E{f}; gemm_phase(lds, g, S, E);
}
}

DEVFN int vperm(int pp) { return (pp & ~12) | ((pp & 4) << 1) | ((pp & 8) >> 1); }
DEVFN f32x4 load4b(const bf16* src) { const u32x2 w = *(const u32x2*)src; return (f32x4){bitsf(w.x << 16), bitsf(w.x & 0xffff0000u), bitsf(w.y << 16), bitsf(w.y & 0xffff0000u)}; }
DEVFN void store4s(bf16* dst, const f32x4& v, float sc) { u32x2 w; w.x = pack2(v[0] * sc, v[1] * sc); w.y = pack2(v[2] * sc, v[3] * sc); *(u32x2*)dst = w; }
DEVFN void store4_t(bf16* dst, const f32x4& v) { u32x2 w; w.x = pack2(v[0], v[1]); w.y = pack2(v[2], v[3]); *(u32x2*)dst = w; }

constexpr int GW_INE = 2, GW_INO = 2, GW_OUT = 2, GW_GLU = 2;
constexpr bool SPLIT_CTX = (LC % 256 == 0) && (PT % 256 == 0);
template <class RB, class F> DEVFN void gemm_small_rows(unsigned char* lds, const bf16* A, int lda, const bf16* Bt, int nnt, int K, int nrt, RB rowbase, F f) {
    const int NU = nrt * nnt; GemmPtrs<2> gp, gq;
    auto begin = [&](int u, GemmPtrs<2>& g) { const int m0 = rowbase(u / nnt), n0 = (u % nnt) * 128; gemm_begin<2>(lds, [&](int r) { return A + (size_t)(m0 + r) * lda; }, Bt, K, n0, g); };
    __syncthreads();
    if ((int)blockIdx.x < NU) begin(blockIdx.x, gp);
    for (int u = blockIdx.x; u < NU; u += gridDim.x, gp = gq) { const int m0 = rowbase(u / nnt), n0 = (u % nnt) * 128;
        gemm_run<2, true>(lds, gp, K, [&]() { if (u + (int)gridDim.x < NU) begin(u + gridDim.x, gq); }, [&](int rl, int cl, const f32x4& a0, const f32x4& a1) { f(m0 + rl, n0 + cl, a0, a1); }); }
}
template <class F> DEVFN void gemm_ctx_rows(unsigned char* lds, const bf16* A, int lda, const bf16* Bt, int N, int K, F f) {
    constexpr int RT = LC / 128; gemm_small_rows(lds, A, lda, Bt, N / 128, K, NB * RT, [&](int rt) { return (rt / RT) * PT + (rt % RT) * 128; }, f);
}
template <class F> DEVFN void dense_gemm(unsigned char* lds, const bf16* A, const bf16* Bt, int N, int K, bool ctx_needed, F f) {
    if constexpr (SPLIT_CTX) { pg8::run_latent(lds, A, Bt, MR, N, K, f); if (ctx_needed) gemm_ctx_rows(lds, A, K, Bt, N, K, f); }
    else pg8::run(lds, A, Bt, MR, N, K, f);
}
DEVFN void scatter4_t(bf16* base, size_t rowstride, const f32x4& v) {
#pragma unroll
    for (int e = 0; e < 4; ++e) base[(size_t)e * rowstride] = f2bf(v[e]);
}
DEVFN void phase_inproj_even(const Params& p, unsigned char* lds, int l) {
    const bf16* A = (const bf16*)(p.ws + WS_ABF); const bf16* Bt = (const bf16*)(p.ws + WS_WIN) + (size_t)l * WIN_LSTRIDE; bf16* Z = (bf16*)(p.ws + WS_Z);
    dense_gemm(lds, A, Bt, EVEN_N, D, true, [&](int row, int col, const f32x4& a0, const f32x4& a1) {
        const int region = col >> 9, cc = col & 511;
        if (region == 3) { const int b = row / PT, pp = row % PT;
            bf16* vb = Z + ZE_VT + ((size_t)(b * 8 + (cc >> 6)) * 64 + (cc & 63)) * PT + vperm(pp); scatter4_t(vb, PT, a0); scatter4_t(vb + (size_t)16 * PT, PT, a1); }
        else { bf16* dst = Z + (region == 0 ? ZE_U : region == 1 ? ZE_Q : ZE_K) + (size_t)row * 512 + cc; const float sc = region == 1 ? QSCALE : 1.0f; store4s(dst, a0, sc); store4s(dst + 16, a1, sc); } });
}

DEVFN void phase_inproj_odd(const Params& p, unsigned char* lds, int l) {
    const bf16* A = (const bf16*)(p.ws + WS_ABF); const bf16* Bt = (const bf16*)(p.ws + WS_WIN) + (size_t)l * WIN_LSTRIDE; bf16* Z = (bf16*)(p.ws + WS_Z);
    const int fg = (tidx() & 63) >> 4;
    const float* rtab = (const float*)(p.ws + WS_ROPE);
    auto epi = [&](int row, int cb, const f32x4& a0, const f32x4& a1) {
        const int b = row / PT, pp = row % PT;
        if (cb < 256) { store4s(Z + ZO_GQ + (size_t)row * 256 + cb, a0, 0.125f); store4s(Z + ZO_GQ + (size_t)row * 256 + cb + 16, a1, 0.125f); }
        else if (cb < 512) { const int c = cb - 256;
            store4s(Z + ZO_GK + (size_t)row * 256 + c, a0, 1.0f); store4s(Z + ZO_GK + (size_t)row * 256 + c + 16, a1, 1.0f);
            bf16* kb = Z + ZO_GKT + ((size_t)(b * 4 + (c >> 6)) * 64 + (c & 63)) * PT + pp; scatter4_t(kb, PT, a0); scatter4_t(kb + (size_t)16 * PT, PT, a1); }
        else if (cb < 1024) { const int c = cb - 512; bf16* vb = Z + ZO_GVT + ((size_t)(b * 4 + (c >> 7)) * 128 + (c & 127)) * PT + pp; scatter4_t(vb, PT, a0); scatter4_t(vb + (size_t)16 * PT, PT, a1); }
        else if (cb < 1536) { store4s(Z + ZO_GR + (size_t)row * 512 + cb - 1024, a0, 1.0f); store4s(Z + ZO_GR + (size_t)row * 512 + cb - 1024 + 16, a1, 1.0f); }
        else if (cb < 2560) {
            const bool isq = cb < 2048; const int c0 = cb - (isq ? 1536 : 2048); const int blk = (c0 >> 5) & 1; bf16* dst = Z + (isq ? ZO_DQ : ZO_DK) + (size_t)row * 512 + c0; const float sc = isq ? QSCALE : 1.0f;
            f32x4 x1 = a0 * sc, x2 = a1 * sc;
            if (pp >= LC) { const int t = pp - LC; const int pos = blk == 0 ? (t >> 6) : (t & 63); const f32x4 cs = *(const f32x4*)(rtab + pos * 16 + 4 * fg), sn = *(const f32x4*)(rtab + 1024 + pos * 16 + 4 * fg);
                const f32x4 o1 = x1 * cs - x2 * sn, o2 = x1 * sn + x2 * cs; x1 = o1; x2 = o2; }
            store4s(dst, x1, 1.0f); store4s(dst + 16, x2, 1.0f); }
        else if (cb < 3072) { const int c = cb - 2560; bf16* vb = Z + ZO_DVT + ((size_t)(b * 4 + (c >> 7)) * 128 + (c & 127)) * PT + vperm(pp); scatter4_t(vb, PT, a0); scatter4_t(vb + (size_t)16 * PT, PT, a1); }
        else if (cb < 3072 + 16) { store4s(Z + ZO_GZ + (size_t)row * 32 + (cb - 3072), a0, 1.0f); store4s(Z + ZO_GZ + (size_t)row * 32 + (cb - 3072) + 16, a1, 1.0f); } };
    if constexpr (SPLIT_CTX) {
        dense_gemm(lds, A, Bt, 3072, D, true, epi);
        gemm_small_rows(lds, A, D, Bt + (size_t)3072 * D, 1, D, MR / 128, [&](int rt) { return rt * 128; },
                        [&](int row, int col, const f32x4& a0, const f32x4& a1) { epi(row, 3072 + col, a0, a1); });
    } else pg8::run(lds, A, Bt, MR, ODD_NP, D, epi);
}

DEVFN void phase_glu(const Params& p, unsigned char* lds, int j) {
    const bf16* A = (const bf16*)(p.ws + WS_SB + SBO_GS); const bf16* Bt = (const bf16*)(p.ws + WS_GLU) + (size_t)j * 1024 * 512; bf16* Y = (bf16*)(p.ws + WS_YMIX);
    const float* gb = p.in[I_GLUB] + (size_t)j * 1024;
    dense_gemm(lds, A, Bt, 1024, 512, true, [&](int row, int col, const f32x4& a0, const f32x4& a1) {
        const int jj = (col >> 5) * 16 + (col & 15); const f32x4 bv = *(const f32x4*)(gb + jj), bg = *(const f32x4*)(gb + 512 + jj); f32x4 o;
#pragma unroll
        for (int r = 0; r < 4; ++r) o[r] = (a0[r] + bv[r]) * sigmoidf_(a1[r] + bg[r]);
        store4s(Y + (size_t)row * D + jj, o, 1.0f); });
}

constexpr int OPS = 4;
constexpr size_t OP_PSTRIDE = (size_t)NB * LC * D;
static_assert(!SPLIT_CTX || OPS * OP_PSTRIDE * 4 <= (size_t)2 * MR * D * 2, "split-K partials must fit the MoE output region");
DEVFN void outproj_ctx_splitk(unsigned char* lds, const bf16* A, const bf16* Bt, float* P) {
    constexpr int RT = LC / 128, NNT = D / 128, NU = NB * RT * NNT * OPS, KS = D / OPS;
    GemmPtrs<2> gp, gq;
    auto begin = [&](int u, GemmPtrs<2>& g) { const int s = u % OPS, t = u / OPS, rt = t / NNT, n0 = (t % NNT) * 128, m0 = (rt / RT) * PT + (rt % RT) * 128;
        gemm_begin<2>(lds, [&](int r) { return A + (size_t)(m0 + r) * D + s * KS; }, Bt + s * KS, D, n0, g); };
    __syncthreads();
    if ((int)blockIdx.x < NU) begin(blockIdx.x, gp);
    for (int u = blockIdx.x; u < NU; u += gridDim.x, gp = gq) { const int s = u % OPS, t = u / OPS, rt = t / NNT, n0 = (t % NNT) * 128, c0 = (rt / RT) * LC + (rt % RT) * 128;
        gemm_run<2, true>(lds, gp, KS, [&]() { if (u + (int)gridDim.x < NU) begin(u + gridDim.x, gq); }, [&](int rl, int cl, const f32x4& a0, const f32x4& a1) {
            float* dst = P + (size_t)s * OP_PSTRIDE + (size_t)(c0 + rl) * D + n0 + cl; *(f32x4*)dst = a0; *(f32x4*)(dst + 16) = a1; }); }
}
DEVFN void phase_outproj(const Params& p, unsigned char* lds, int l) {
    const bf16* A = (const bf16*)(p.ws + WS_YMIX); const bf16* Bt = (const bf16*)(p.ws + WS_WOUT) + (size_t)l * D * D; bf16* C = (bf16*)(p.ws + WS_Z);
    auto epi = [&](int row, int col, const f32x4& a0, const f32x4& a1) { bf16* dst = C + (size_t)row * D + col; store4s(dst, a0, 1.0f); store4s(dst + 16, a1, 1.0f); };
    if constexpr (SPLIT_CTX) { pg8::run_latent(lds, A, Bt, MR, D, D, epi); outproj_ctx_splitk(lds, A, Bt, (float*)(p.ws + WS_SB)); }
    else dense_gemm(lds, A, Bt, D, D, true, epi);
}

struct MoeMap { int e, mt, cnt, off; };
DEVFN bool moe_find(const unsigned* cnt, int tile, MoeMap& mm) {
    int acc = 0;
    for (int e = 0; e < NEXP; ++e) { const int c = (int)cnt[e], nt = (c + 127) >> 7; if (tile < acc + nt) { mm.e = e; mm.mt = tile - acc; mm.cnt = c; mm.off = acc * 128; return true; } acc += nt; }
    return false;
}
DEVFN int moe_off(const unsigned* cnt, int e) { int acc = 0; for (int i = 0; i < e; ++i) acc += ((int)cnt[i] + 127) >> 7; return acc * 128; }
constexpr int MOE_TAB = 3 * 32768;
DEVFN const unsigned* moe_table(unsigned char* lds, const unsigned* cnt) {
    unsigned* tab = (unsigned*)(lds + MOE_TAB);
    __syncthreads();
    if (tidx() < NEXP) tab[tidx()] = cnt[tidx()];
    __syncthreads();
    return tab;
}

DEVFN void phase_moe_up(const Params& p, unsigned char* lds, int l) {
    const bf16* A = (const bf16*)(p.ws + WS_ABF); bf16* ACT = (bf16*)(p.ws + WS_ACT); const unsigned* cnt = (const unsigned*)(p.ws + WS_CTL + CTL_CNT) + l * NEXP;
    const int* ltok = (const int*)(p.ws + WS_LTOK); const float* lw = (const float*)(p.ws + WS_LW); const unsigned* tab = moe_table(lds, cnt);
    GemmPtrs<2> gp, gq; MoeMap mm, mn;
    auto begin = [&](const MoeMap& m, int nt, GemmPtrs<2>& g) { const bf16* Bt = (const bf16*)(p.ws + WS_MGU) + (size_t)(l * NEXP + m.e) * 512 * 1024; const int* lt = ltok + (size_t)m.e * MR;
        gemm_begin<2>(lds, [&](int r) { const int slot = m.mt * 128 + r; const int tok = lt[slot < m.cnt ? slot : 0]; return A + (size_t)tok * D; }, Bt, D, nt * 128, g); };
    int u = blockIdx.x; bool ok = moe_find(tab, u >> 2, mm);
    if (ok) begin(mm, u & 3, gp);
    while (ok) { const int un = u + gridDim.x; const bool okn = moe_find(tab, un >> 2, mn); const int n0 = (u & 3) * 128;
        gemm_run<2, true>(lds, gp, D, [&]() { if (okn) begin(mn, un & 3, gq); }, [&](int rl, int cl, const f32x4& a0, const f32x4& a1) {
            const int jj = ((n0 + cl) >> 5) * 16 + (cl & 15), slot = mm.mt * 128 + rl;
            if (slot < mm.cnt) { const float w = lw[(size_t)mm.e * MR + slot]; f32x4 o;
#pragma unroll
                for (int r = 0; r < 4; ++r) o[r] = siluf_(a0[r]) * a1[r] * w;
                store4s(ACT + (size_t)(mm.off + slot) * 256 + jj, o, 1.0f); } });
        gp = gq; mm = mn; ok = okn; u = un; }
}
DEVFN void phase_moe_down(const Params& p, unsigned char* lds, int l) {
    const bf16* ACT = (const bf16*)(p.ws + WS_ACT); bf16* F2 = (bf16*)(p.ws + WS_SB); const unsigned* cnt = (const unsigned*)(p.ws + WS_CTL + CTL_CNT) + l * NEXP;
    const unsigned* tab = moe_table(lds, cnt);
    GemmPtrs<2> gp, gq; MoeMap mm, mn;
    auto begin = [&](const MoeMap& m, int nt, GemmPtrs<2>& g) { const bf16* Bt = (const bf16*)(p.ws + WS_MDN) + (size_t)(l * NEXP + m.e) * 1024 * 256; const size_t r0 = (size_t)m.off + m.mt * 128;
        gemm_begin<2>(lds, [&](int r) { return ACT + (r0 + r) * 256; }, Bt, 256, nt * 128, g); };
    int u = blockIdx.x; bool ok = moe_find(tab, u >> 3, mm);
    if (ok) begin(mm, u & 7, gp);
    while (ok) { const int un = u + gridDim.x; const bool okn = moe_find(tab, un >> 3, mn); const int n0 = (u & 7) * 128; const size_t r0 = (size_t)mm.off + mm.mt * 128;
        gemm_run<2, true>(lds, gp, 256, [&]() { if (okn) begin(mn, un & 7, gq); }, [&](int rl, int cl, const f32x4& a0, const f32x4& a1) {
            bf16* dst = F2 + (r0 + rl) * D + n0 + cl; store4s(dst, a0, 1.0f); store4s(dst + 16, a1, 1.0f); });
        gp = gq; mm = mn; ok = okn; u = un; }
}

DEVFN void ln_row(float (&v)[16], const float* g, const float* bta, int lane) {
    float s = 0.f;
#pragma unroll
    for (int i = 0; i < 16; ++i) s += v[i];
    const float mu = wave_sum(s) * (1.0f / 1024.0f); float q = 0.f;
#pragma unroll
    for (int i = 0; i < 16; ++i) { const float d = v[i] - mu; q += d * d; }
    const float rstd = 1.0f / sqrtf(wave_sum(q) * (1.0f / 1024.0f) + LN_EPS);
#pragma unroll
    for (int i = 0; i < 4; ++i) { const f32x4 gg = *(const f32x4*)(g + i * 256 + lane * 4), bb = *(const f32x4*)(bta + i * 256 + lane * 4);
#pragma unroll
        for (int e = 0; e < 4; ++e) v[i * 4 + e] = (v[i * 4 + e] - mu) * rstd * gg[e] + bb[e]; }
}

DEVFN void ln_row_r(float (&v)[16], const float (&g)[16], const float (&bta)[16]) {
    float s = 0.f;
#pragma unroll
    for (int i = 0; i < 16; ++i) s += v[i];
    const float mu = wave_sum(s) * (1.0f / 1024.0f); float q = 0.f;
#pragma unroll
    for (int i = 0; i < 16; ++i) { const float d = v[i] - mu; q += d * d; }
    const float rstd = 1.0f / sqrtf(wave_sum(q) * (1.0f / 1024.0f) + LN_EPS);
#pragma unroll
    for (int i = 0; i < 16; ++i) v[i] = (v[i] - mu) * rstd * g[i] + bta[i];
}
DEVFN void ln_load_gb(const float* g, const float* bta, int lane, float (&gr)[16], float (&br)[16]) {
#pragma unroll
    for (int i = 0; i < 4; ++i) { const f32x4 gg = *(const f32x4*)(g + i * 256 + lane * 4), bb = *(const f32x4*)(bta + i * 256 + lane * 4);
#pragma unroll
        for (int e = 0; e < 4; ++e) { gr[i * 4 + e] = gg[e]; br[i * 4 + e] = bb[e]; } }
}

DEVFN void phase_ln1_route(const Params& p, unsigned char* lds, int l) {
    const int wave = tidx() >> 6, lane = tidx() & 63; bf16* H = (bf16*)(p.ws + WS_H); const bf16* C = (const bf16*)(p.ws + WS_Z); bf16* A = (bf16*)(p.ws + WS_ABF);
    unsigned* cnt = (unsigned*)(p.ws + WS_CTL + CTL_CNT) + l * NEXP; int* route = (int*)(p.ws + WS_ROUTE); int* ltok = (int*)(p.ws + WS_LTOK); float* lw = (float*)(p.ws + WS_LW);
    const float* wg = p.in[I_WGRP] + (size_t)l * D * 4; const float* we = p.in[I_WEXP] + (size_t)l * D * 32;
    float* hrow = (float*)lds;
    float* part = (float*)(lds + 32768);
    const int ke = wave * 128 + (lane >> 5) * 64, kg = wave * 128 + (lane >> 2) * 8;
    f32x2 wreg[32], wgr[4];
#pragma unroll
    for (int i = 0; i < 32; ++i) wreg[i] = (f32x2){we[(size_t)(ke + 2 * i) * 32 + (lane & 31)], we[(size_t)(ke + 2 * i + 1) * 32 + (lane & 31)]};
#pragma unroll
    for (int i = 0; i < 4; ++i) wgr[i] = (f32x2){wg[(size_t)(kg + 2 * i) * 4 + (lane & 3)], wg[(size_t)(kg + 2 * i + 1) * 4 + (lane & 3)]};
    const float bias = lane < 32 ? p.in[I_BEXP][l * 32 + lane] : (lane < 36 ? p.in[I_BGRP][l * 4 + lane - 32] : 0.f);
    unsigned* lcnt = (unsigned*)(lds + 49152); unsigned* lbase = lcnt + 32; int* rt = (int*)(lds + 49152 + 256);
    constexpr int RT_MAX = 1024;
    __syncthreads();
    if (tidx() < 32) lcnt[tidx()] = 0u;
    __syncthreads();
    float lng[16], lnb[16]; ln_load_gb(p.in[I_LNG] + (size_t)(l * 2) * D, p.in[I_LNB] + (size_t)(l * 2) * D, lane, lng, lnb);
    int nrec = 0; u32x2 hn[4], yn[4];
    if (blockIdx.x * 8 < MR) {
#pragma unroll
        for (int i = 0; i < 4; ++i) { const size_t o = (size_t)(blockIdx.x * 8 + wave) * D + i * 256 + lane * 4; hn[i] = *(const u32x2*)(H + o); yn[i] = *(const u32x2*)(C + o); } }
    for (int r0 = blockIdx.x * 8; r0 < MR; r0 += gridDim.x * 8, ++nrec) { const int row = r0 + wave; const int b = row / PT, pp = row % PT, mr = pp < LC ? NB : b;
        const float* mv = (const float*)(p.ws + WS_MODV) + ((size_t)l * (NB + 1) + mr) * 6144; float v[16];
        const bool ctxp = SPLIT_CTX && pp < LC; const float* pb = (const float*)(p.ws + WS_SB) + (size_t)(b * LC + (ctxp ? pp : 0)) * D;
#pragma unroll
        for (int i = 0; i < 4; ++i) { const int c = i * 256 + lane * 4; const f32x4 g1 = *(const f32x4*)(mv + 2048 + c);
            const f32x4 h = (f32x4){bitsf(hn[i].x << 16), bitsf(hn[i].x & 0xffff0000u), bitsf(hn[i].y << 16), bitsf(hn[i].y & 0xffff0000u)};
            f32x4 y = (f32x4){bitsf(yn[i].x << 16), bitsf(yn[i].x & 0xffff0000u), bitsf(yn[i].y << 16), bitsf(yn[i].y & 0xffff0000u)};
            if (ctxp) y = (*(const f32x4*)(pb + c) + *(const f32x4*)(pb + OP_PSTRIDE + c)) + (*(const f32x4*)(pb + 2 * OP_PSTRIDE + c) + *(const f32x4*)(pb + 3 * OP_PSTRIDE + c));
#pragma unroll
            for (int e = 0; e < 4; ++e) v[i * 4 + e] = ALPHA * h[e] + g1[e] * y[e]; }
        if (r0 + gridDim.x * 8 < MR) {
#pragma unroll
            for (int i = 0; i < 4; ++i) { const size_t o = (size_t)(row + gridDim.x * 8) * D + i * 256 + lane * 4; hn[i] = *(const u32x2*)(H + o); yn[i] = *(const u32x2*)(C + o); } }
        f32x4 shv[4], scv[4];
#pragma unroll
        for (int i = 0; i < 4; ++i) { const int c = i * 256 + lane * 4; shv[i] = *(const f32x4*)(mv + 3072 + c); scv[i] = *(const f32x4*)(mv + 4096 + c); }
        ln_row_r(v, lng, lnb);
        __syncthreads();
#pragma unroll
        for (int i = 0; i < 4; ++i) { const int c = i * 256 + lane * 4; { u32x2 hw; hw.x = pack2(v[i * 4], v[i * 4 + 1]); hw.y = pack2(v[i * 4 + 2], v[i * 4 + 3]); __builtin_nontemporal_store(hw, (u32x2*)(H + (size_t)row * D + c)); }
            const f32x4 sh = shv[i], sc = scv[i]; f32x4 h2;
#pragma unroll
            for (int e = 0; e < 4; ++e) h2[e] = v[i * 4 + e] * (1.f + sc[e]) + sh[e];
            *(f32x4*)(hrow + wave * 1024 + c) = h2;
            u32x2 w; w.x = pack2(h2[0], h2[1]); w.y = pack2(h2[2], h2[3]); *(u32x2*)(A + (size_t)row * D + c) = w; }
        __syncthreads();
#pragma unroll
        for (int r = 0; r < 8; ++r) { f32x2 ae2 = {0.f, 0.f}, ae3 = {0.f, 0.f}, ag2 = {0.f, 0.f};
#pragma unroll
            for (int i = 0; i < 64; i += 4) { const f32x4 hv = *(const f32x4*)(hrow + r * 1024 + ke + i);
                ae2 = __builtin_elementwise_fma((f32x2){hv[0], hv[1]}, wreg[i >> 1], ae2); ae3 = __builtin_elementwise_fma((f32x2){hv[2], hv[3]}, wreg[(i >> 1) + 1], ae3); }
#pragma unroll
            for (int i = 0; i < 8; i += 4) { const f32x4 hv = *(const f32x4*)(hrow + r * 1024 + kg + i);
                ag2 = __builtin_elementwise_fma((f32x2){hv[0], hv[1]}, wgr[i >> 1], ag2); ag2 = __builtin_elementwise_fma((f32x2){hv[2], hv[3]}, wgr[(i >> 1) + 1], ag2); }
            float ae = (ae2[0] + ae3[0]) + (ae2[1] + ae3[1]), ag = ag2[0] + ag2[1];
            ae += __shfl_xor(ae, 32);
            ag += __shfl_xor(ag, 4); ag += __shfl_xor(ag, 8); ag += __shfl_xor(ag, 16); ag += __shfl_xor(ag, 32);
            if (lane < 32) part[(wave * 8 + r) * 64 + lane] = ae; else if (lane < 36) part[(wave * 8 + r) * 64 + lane] = ag;
        }
        __syncthreads();
        float logit = bias;
#pragma unroll
        for (int w8 = 0; w8 < 8; ++w8) logit += part[(w8 * 8 + wave) * 64 + lane];
        float lg[4];
#pragma unroll
        for (int o = 0; o < 4; ++o) lg[o] = __shfl(logit, 32 + o);
        int gs = 0; float gm = lg[0];
#pragma unroll
        for (int o = 1; o < 4; ++o) if (lg[o] > gm) { gm = lg[o]; gs = o; }
        float den = 0.f;
#pragma unroll
        for (int o = 0; o < 4; ++o) den += fexp(lg[o] - gm);
        const float pg = 1.0f / den;
        float li[8];
#pragma unroll
        for (int e = 0; e < 8; ++e) li[e] = __shfl(logit, gs * 8 + e);
        int i0 = 0; float v0 = li[0];
#pragma unroll
        for (int e = 1; e < 8; ++e) if (li[e] > v0) { v0 = li[e]; i0 = e; }
        int i1 = -1; float v1 = -3.0e38f;
#pragma unroll
        for (int e = 0; e < 8; ++e) if (e != i0 && li[e] > v1) { v1 = li[e]; i1 = e; }
        if (i1 < 0) i1 = (i0 + 1) & 7;
        const float w0 = 1.0f / (1.0f + fexp(v1 - v0)), w1 = 1.0f - w0;
        if (lane == 0) { const int e0 = gs * 8 + i0, e1 = gs * 8 + i1; const int rec = nrec * 8 + wave;
            if (rec < RT_MAX) { int* q = rt + rec * 6; q[0] = e0; q[1] = e1; q[2] = (int)fbits(w0 * pg); q[3] = (int)fbits(w1 * pg); q[4] = (int)atomicAdd(&lcnt[e0], 1u); q[5] = (int)atomicAdd(&lcnt[e1], 1u); } }
    }
    __syncthreads();
    if (tidx() < 32) lbase[tidx()] = atomicAdd(&cnt[tidx()], lcnt[tidx()]);
    __syncthreads();
    for (int rec = tidx(); rec < nrec * 8 && rec < RT_MAX; rec += NTH) { const int row = (blockIdx.x + (rec >> 3) * gridDim.x) * 8 + (rec & 7); const int* q = rt + rec * 6;
        const int e0 = q[0], e1 = q[1], s0 = (int)lbase[e0] + q[4], s1 = (int)lbase[e1] + q[5];
        ltok[(size_t)e0 * MR + s0] = row; lw[(size_t)e0 * MR + s0] = bitsf((unsigned)q[2]); ltok[(size_t)e1 * MR + s1] = row; lw[(size_t)e1 * MR + s1] = bitsf((unsigned)q[3]);
        route[row * 4 + 0] = e0; route[row * 4 + 1] = e1; route[row * 4 + 2] = s0; route[row * 4 + 3] = s1; }
}

DEVFN void phase_ln2(const Params& p, unsigned char* lds, int l) {
    const int wave = tidx() >> 6, lane = tidx() & 63; bf16* H = (bf16*)(p.ws + WS_H); const bf16* F2 = (const bf16*)(p.ws + WS_SB); bf16* A = (bf16*)(p.ws + WS_ABF);
    const unsigned* cnt = (const unsigned*)(p.ws + WS_CTL + CTL_CNT) + l * NEXP; const int* route = (const int*)(p.ws + WS_ROUTE);
    int* offs = (int*)lds;
    __syncthreads();
    if (tidx() < NEXP) offs[tidx()] = moe_off(cnt, tidx());
    __syncthreads();
    float lng[16], lnb[16]; ln_load_gb(p.in[I_LNG] + (size_t)(l * 2 + 1) * D, p.in[I_LNB] + (size_t)(l * 2 + 1) * D, lane, lng, lnb);
    for (int rw = (blockIdx.x * 8 + wave) * 2; rw < MR; rw += gridDim.x * 16) {
        float v[2][16]; size_t r0[2], r1[2];
#pragma unroll
        for (int q = 0; q < 2; ++q) { const int row = rw + q; const int e0 = route[row * 4], e1 = route[row * 4 + 1]; r0[q] = (size_t)offs[e0] + route[row * 4 + 2]; r1[q] = (size_t)offs[e1] + route[row * 4 + 3]; }
#pragma unroll
        for (int q = 0; q < 2; ++q) { const int row = rw + q; const int b = row / PT, pp = row % PT, mr = pp < LC ? NB : b; const float* mv = (const float*)(p.ws + WS_MODV) + ((size_t)l * (NB + 1) + mr) * 6144;
#pragma unroll
            for (int i = 0; i < 4; ++i) { const int c = i * 256 + lane * 4; const f32x4 h = load4b(H + (size_t)row * D + c), g2 = *(const f32x4*)(mv + 5120 + c);
                const u32x2 fa = *(const u32x2*)(F2 + r0[q] * D + c), fb = *(const u32x2*)(F2 + r1[q] * D + c);
                const float f0 = bitsf(fa.x << 16) + bitsf(fb.x << 16), f1 = bitsf(fa.x & 0xffff0000u) + bitsf(fb.x & 0xffff0000u), f2 = bitsf(fa.y << 16) + bitsf(fb.y << 16), f3 = bitsf(fa.y & 0xffff0000u) + bitsf(fb.y & 0xffff0000u);
                v[q][i * 4] = ALPHA * h[0] + g2[0] * f0; v[q][i * 4 + 1] = ALPHA * h[1] + g2[1] * f1; v[q][i * 4 + 2] = ALPHA * h[2] + g2[2] * f2; v[q][i * 4 + 3] = ALPHA * h[3] + g2[3] * f3; } }
#pragma unroll
        for (int q = 0; q < 2; ++q) { const int row = rw + q; const int b = row / PT, pp = row % PT;
            ln_row_r(v[q], lng, lnb);
#pragma unroll
            for (int i = 0; i < 4; ++i) { const int c = i * 256 + lane * 4; const f32x4 o = (f32x4){v[q][i * 4], v[q][i * 4 + 1], v[q][i * 4 + 2], v[q][i * 4 + 3]};
                if (l + 1 < NL) { u32x2 hw; hw.x = pack2(o[0], o[1]); hw.y = pack2(o[2], o[3]); __builtin_nontemporal_store(hw, (u32x2*)(H + (size_t)row * D + c)); }
                else if (pp >= LC) __builtin_nontemporal_store(o, (f32x4*)(p.out + ((size_t)b * TS + (pp - LC)) * D + c)); }
            if (l + 1 < NL) mod_store_row(p, l + 1, 0, row, v[q], A + (size_t)row * D); }
    }
}

DEVFN void wave_sync() {
#ifdef CPU_EMU
    (void)__shfl(0, 0);
#else
    __builtin_amdgcn_fence(__ATOMIC_RELEASE, "wavefront"); asm volatile("s_waitcnt lgkmcnt(0)" ::: "memory"); __builtin_amdgcn_wave_barrier(); __builtin_amdgcn_fence(__ATOMIC_ACQUIRE, "wavefront");
#endif
}
DEVFN bf16x8 cvt8(const f32x4 lo, const f32x4 hi, float sg) { u32x4 w; w[0] = pack2(lo[0] * sg, lo[1] * sg); w[1] = pack2(lo[2] * sg, lo[3] * sg); w[2] = pack2(hi[0] * sg, hi[1] * sg); w[3] = pack2(hi[2] * sg, hi[3] * sg); return __builtin_bit_cast(bf16x8, w); }
constexpr int S5_WAVE_LDS = 16 * 132 * 4;
DEVFN void s5_chunk(const Params& p, float* buf, int j, int b, int g, int c, int lane, const bool READOUT, int dlo = 0, int dhi = 2, float* xch = nullptr) {
    const int fr = lane & 15, fg = lane >> 4; const bf16* U = (const bf16*)(p.ws + WS_Z) + ZE_U + ((size_t)b * PT + c * 64) * 512 + g * 16;
    f32x4 y[4], y2[4];
#pragma unroll
    for (int sb = 0; sb < 4; ++sb) { y[sb] = (f32x4){0.f, 0.f, 0.f, 0.f}; y2[sb] = (f32x4){0.f, 0.f, 0.f, 0.f}; }
#pragma unroll 1
    for (int d = dlo; d < dhi; ++d) { const size_t pbase = (size_t)((j * 2 + d) * 32 + g) * 64; const float* prm = (const float*)(p.ws + WS_S5P);
        bf16x8 bbf[8];
#pragma unroll
        for (int n = 0; n < 8; ++n) { const int pp = (n & 3) * 16 + fr; const float* src = prm + (pbase + pp) * S5P_STRIDE + (n < 4 ? 4 : 20) + (fg & 1) * 8;
            f32x4 lo = *(const f32x4*)src, hi = *(const f32x4*)(src + 4); if (fg >= 2) { lo = (f32x4){0.f, 0.f, 0.f, 0.f}; hi = lo; } bbf[n] = cvt8(lo, hi, 1.0f); }
        bf16x8 cf[4];
        if (READOUT) {
#pragma unroll
            for (int ks = 0; ks < 4; ++ks) { const float* src = (ks < 2 ? p.in[I_CRE] : p.in[I_CIM]) + (((size_t)(j * 2 + d) * 32 + g) * 16 + fr) * 64 + (ks & 1) * 32 + fg * 8;
                cf[ks] = cvt8(*(const f32x4*)src, *(const f32x4*)(src + 4), ks < 2 ? 1.0f : -1.0f); } }
        const float are = prm[(pbase + lane) * S5P_STRIDE], aim = prm[(pbase + lane) * S5P_STRIDE + 1];
        float hr = 0.f, hi = 0.f;
        if (READOUT) { const f32x2 h0 = *(const f32x2*)((const float*)(p.ws + WS_SB + SBO_S5H) + ((size_t)((b * 32 + g) * 2 + d) * NCH + c) * 128 + lane * 2); hr = h0[0]; hi = h0[1]; }
#pragma unroll
        for (int sbi = 0; sbi < 4; ++sbi) { const int sb = d ? 3 - sbi : sbi;
            u32x4 uv = (u32x4){0u, 0u, 0u, 0u}; if (fg < 2) uv = *(const u32x4*)(U + (size_t)(sb * 16 + fr) * 512 + fg * 8); const bf16x8 ua = __builtin_bit_cast(bf16x8, uv);
            f32x4 yy = (f32x4){0.f, 0.f, 0.f, 0.f};
            wave_sync();
#pragma unroll
            for (int n = 0; n < 8; ++n) { const f32x4 t4 = mfma16(ua, bbf[n], (f32x4){0.f, 0.f, 0.f, 0.f});
#pragma unroll
                for (int r = 0; r < 4; ++r) buf[(fg * 4 + r) * 132 + n * 16 + fr] = t4[r]; }
            wave_sync();
            for (int t0 = 0; t0 < 16; ++t0) { const int tt = d ? 15 - t0 : t0; const float ur = buf[tt * 132 + lane], ui = buf[tt * 132 + 64 + lane];
                const float nr = are * hr - aim * hi + ur, ni = are * hi + aim * hr + ui; hr = nr; hi = ni;
                buf[tt * 132 + lane] = hr; buf[tt * 132 + 64 + lane] = hi; }
            if (READOUT) { wave_sync();
#pragma unroll
                for (int ks = 0; ks < 4; ++ks) { const float* hp = buf + fr * 132 + ks * 32 + fg * 8; yy = mfma16(cf[ks], cvt8(*(const f32x4*)hp, *(const f32x4*)(hp + 4), 1.0f), yy); }
                if (d == 0) y[sbi] += yy; else y2[sbi] += yy; }
        }
        if (!READOUT) *(f32x2*)((float*)(p.ws + WS_SB + SBO_S5E) + ((size_t)((b * 32 + g) * 2 + d) * NCH + c) * 128 + lane * 2) = (f32x2){hr, hi};
    }
    if (READOUT && xch) {
        if (dlo == 1) {
#pragma unroll
            for (int sb = 0; sb < 4; ++sb) *(f32x4*)(xch + (sb * 64 + lane) * 4) = y2[sb];
            __syncthreads(); return; }
        __syncthreads();
#pragma unroll
        for (int sb = 0; sb < 4; ++sb) y2[sb] = *(const f32x4*)(xch + (sb * 64 + lane) * 4); }
    if (READOUT) { bf16* GS = (bf16*)(p.ws + WS_SB + SBO_GS); const f32x4 dsk = *(const f32x4*)(p.in[I_S5D] + (size_t)j * 512 + g * 16 + fg * 4);
#pragma unroll
        for (int sb = 0; sb < 4; ++sb) { const int t = sb * 16 + fr; const u32x2 uu = *(const u32x2*)(U + (size_t)t * 512 + fg * 4); f32x4 o; y[sb] += y2[3 - sb];
            o[0] = geluf_(y[sb][0] + dsk[0] * bitsf(uu.x << 16)); o[1] = geluf_(y[sb][1] + dsk[1] * bitsf(uu.x & 0xffff0000u));
            o[2] = geluf_(y[sb][2] + dsk[2] * bitsf(uu.y << 16)); o[3] = geluf_(y[sb][3] + dsk[3] * bitsf(uu.y & 0xffff0000u));
            store4_t(GS + ((size_t)b * PT + c * 64 + t) * 512 + g * 16 + fg * 4, o); } }
}
DEVFN void phase_s5a(const Params& p, unsigned char* lds, int j) {
    const int wave = tidx() >> 6, lane = tidx() & 63; float* buf = (float*)(lds + wave * S5_WAVE_LDS);
    const int NIT = NB * 32 * NCH, GW = gridDim.x * 8, full = (NIT / GW) * GW, wid = blockIdx.x * 8 + wave;
    for (int it = wid; it < full; it += GW) { const int c = it % NCH, g = (it / NCH) % 32, b = it / (NCH * 32); s5_chunk(p, buf, j, b, g, c, lane, false); }
    for (int pi = wid; pi < 2 * (NIT - full); pi += GW) { const int it = full + (pi >> 1), d = pi & 1; const int c = it % NCH, g = (it / NCH) % 32, b = it / (NCH * 32); s5_chunk(p, buf, j, b, g, c, lane, false, d, d + 1); }
}
constexpr int S5B_BS = 17;
DEVFN int chunk_order(int d, int k);
DEVFN void phase_s5b(const Params& p, int j) {
    const float* E = (const float*)(p.ws + WS_SB + SBO_S5E); float* Hin = (float*)(p.ws + WS_SB + SBO_S5H);
    constexpr int NBT = (NCH + S5B_BS - 1) / S5B_BS;
    int vb = blockIdx.x, vstep = gridDim.x;
    if (gridDim.x == 256 && NB * 32 * 2 * 64 == 32 * NTH) { const int m = blockIdx.x & 15; if (m != 0 && m != 15) return; vb = (blockIdx.x >> 4) * 2 + (m == 15 ? 1 : 0); vstep = 32; }
    for (int i = vb * NTH + tidx(); i < NB * 32 * 2 * 64; i += vstep * NTH) { const int pi = i & 63, d = (i >> 6) & 1, g = (i >> 7) & 31, b = i >> 12;
        const float* pr = (const float*)(p.ws + WS_S5P) + ((size_t)((j * 2 + d) * 32 + g) * 64 + pi) * S5P_STRIDE; const float aLr = pr[2], aLi = pr[3];
        const size_t base = (size_t)((b * 32 + g) * 2 + d) * NCH; float hr = 0.f, hi = 0.f;
        f32x2 en[S5B_BS];
#pragma unroll
        for (int x = 0; x < S5B_BS; ++x) { const int k = x < NCH ? x : NCH - 1; const int c = chunk_order(d, k); en[x] = *(const f32x2*)(E + (base + c) * 128 + pi * 2); }
#pragma unroll 1
        for (int kb = 0; kb < NBT; ++kb) { f32x2 e[S5B_BS];
#pragma unroll
            for (int x = 0; x < S5B_BS; ++x) e[x] = en[x];
            if (kb + 1 < NBT) {
#pragma unroll
                for (int x = 0; x < S5B_BS; ++x) { const int k = (kb + 1) * S5B_BS + x < NCH ? (kb + 1) * S5B_BS + x : NCH - 1; const int c = chunk_order(d, k); en[x] = *(const f32x2*)(E + (base + c) * 128 + pi * 2); } }
#pragma unroll
            for (int x = 0; x < S5B_BS; ++x) { const int k = kb * S5B_BS + x; if (k < NCH) { const int c = chunk_order(d, k);
                *(f32x2*)(Hin + (base + c) * 128 + pi * 2) = (f32x2){hr, hi};
                const float nr = aLr * hr - aLi * hi + e[x][0], ni = aLr * hi + aLi * hr + e[x][1]; hr = nr; hi = ni; } } }
    }
}
DEVFN void phase_s5c(const Params& p, unsigned char* lds, int j) {
    const int wave = tidx() >> 6, lane = tidx() & 63; float* buf = (float*)(lds + wave * S5_WAVE_LDS);
    const int NIT = NB * 32 * NCH, GW = gridDim.x * 8, full = (NIT / GW) * GW, rem = NIT - full;
    for (int it = blockIdx.x * 8 + wave; it < full; it += GW) { const int c = it % NCH, g = (it / NCH) % 32, b = it / (NCH * 32); s5_chunk(p, buf, j, b, g, c, lane, true); }
    float* xch = (float*)(lds + 8 * S5_WAVE_LDS) + (wave & 3) * 1024;
    for (int base = blockIdx.x * 4; base < rem; base += gridDim.x * 4) { const int ri = base + (wave & 3), d = wave >> 2;
        if (ri < rem) { const int it = full + ri; const int c = it % NCH, g = (it / NCH) % 32, b = it / (NCH * 32); s5_chunk(p, buf, j, b, g, c, lane, true, d, d + 1, xch); }
        else __syncthreads();
        __syncthreads(); }
}

template <int NDV> struct AttnState { float m, l; f32x16 o[NDV]; };
template <int NDV> DEVFN void attn_init(AttnState<NDV>& st) { st.m = -INFINITY; st.l = 0.f;
#pragma unroll
    for (int i = 0; i < NDV; ++i)
#pragma unroll
        for (int r = 0; r < 16; ++r) st.o[i][r] = 0.f; }
DEVFN float attn_softmax(float& m, float& l, f32x16 s, bf16x8 (&pb)[2]) {
    float mx = fmaxf(fmaxf(fmaxf(s[0], s[1]), fmaxf(s[2], s[3])), fmaxf(fmaxf(s[4], s[5]), fmaxf(s[6], s[7])));
    mx = fmaxf(mx, fmaxf(fmaxf(fmaxf(s[8], s[9]), fmaxf(s[10], s[11])), fmaxf(fmaxf(s[12], s[13]), fmaxf(s[14], s[15]))));
    mx = fmaxf(mx, __shfl_xor(mx, 32));
    const float mn = fmaxf(m, mx), ms = mn == -INFINITY ? 0.f : mn, corr = fexp2(m - ms);
    m = mn; float ps = 0.f;
#pragma unroll
    for (int r = 0; r < 16; ++r) { s[r] = fexp2(s[r] - ms); ps += s[r]; }
    ps += __shfl_xor(ps, 32);
    l = l * corr + ps;
#pragma unroll
    for (int ks = 0; ks < 2; ++ks) { u32x4 w;
#pragma unroll
        for (int jj = 0; jj < 4; ++jj) w[jj] = pack2(s[8 * ks + 2 * jj], s[8 * ks + 2 * jj + 1]);
        pb[ks] = __builtin_bit_cast(bf16x8, w); }
    return corr;
}
DEVFN bf16x8 cat4(const bf16x4 a, const bf16x4 b) { bf16x8 o;
#pragma unroll
    for (int jj = 0; jj < 4; ++jj) { o[jj] = a[jj]; o[4 + jj] = b[jj]; }
    return o; }
template <int NDV, class VLoad>
DEVFN void attn_update(AttnState<NDV>& st, f32x16 s, VLoad vload) {
    bf16x8 pb[2]; const float corr = attn_softmax(st.m, st.l, s, pb);
    if (!wave_all(corr == 1.0f)) {
#pragma unroll
        for (int i = 0; i < NDV; ++i)
#pragma unroll
            for (int r = 0; r < 16; ++r) st.o[i][r] *= corr; }
#pragma unroll
    for (int ks = 0; ks < 2; ++ks)
#pragma unroll
        for (int mt = 0; mt < NDV; ++mt) st.o[mt] = mfma32(vload(mt, ks), pb[ks], st.o[mt]);
}

DEVFN float attn_softmax2(float& m, float& l, f32x16 s0, f32x16 s1, bf16x8 (&pb0)[2], bf16x8 (&pb1)[2]) {
    float mx = fmaxf(s0[0], s1[0]);
#pragma unroll
    for (int r = 1; r < 16; ++r) mx = fmaxf(mx, fmaxf(s0[r], s1[r]));
    mx = fmaxf(mx, __shfl_xor(mx, 32));
    const float mn = fmaxf(m, mx), ms = mn == -INFINITY ? 0.f : mn, corr = fexp2(m - ms);
    m = mn; float ps = 0.f;
#pragma unroll
    for (int r = 0; r < 16; ++r) { s0[r] = fexp2(s0[r] - ms); s1[r] = fexp2(s1[r] - ms); ps += s0[r] + s1[r]; }
    ps += __shfl_xor(ps, 32);
    l = l * corr + ps;
#pragma unroll
    for (int ks = 0; ks < 2; ++ks) { u32x4 w0, w1;
#pragma unroll
        for (int jj = 0; jj < 4; ++jj) { w0[jj] = pack2(s0[8 * ks + 2 * jj], s0[8 * ks + 2 * jj + 1]); w1[jj] = pack2(s1[8 * ks + 2 * jj], s1[8 * ks + 2 * jj + 1]); }
        pb0[ks] = __builtin_bit_cast(bf16x8, w0); pb1[ks] = __builtin_bit_cast(bf16x8, w1); }
    return corr;
}
template <int NDV, class VLoad>
DEVFN void attn_update2(AttnState<NDV>& st, f32x16 s0, f32x16 s1, VLoad vload) {
    bf16x8 pb0[2], pb1[2]; const float corr = attn_softmax2(st.m, st.l, s0, s1, pb0, pb1);
    if (!wave_all(corr == 1.0f)) {
#pragma unroll
        for (int i = 0; i < NDV; ++i)
#pragma unroll
            for (int r = 0; r < 16; ++r) st.o[i][r] *= corr; }
#pragma unroll
    for (int ks = 0; ks < 2; ++ks)
#pragma unroll
        for (int mt = 0; mt < NDV; ++mt) { st.o[mt] = mfma32(vload(0, mt, ks), pb0[ks], st.o[mt]); st.o[mt] = mfma32(vload(1, mt, ks), pb1[ks], st.o[mt]); }
}

constexpr int NAT_STAGE = 16384, NAT_RING = 4, NAT_RPB = NAT_RING * NAT_STAGE;
DEVFN void phase_natten(const Params& p, unsigned char* lds, int j) {
    const int tid = tidx(), wave = tid >> 6, lane = tid & 63, ql = lane & 31, hh = lane >> 5;
#ifdef CPU_EMU
    const int wvu = wave;
#else
    const int wvu = __builtin_amdgcn_readfirstlane(wave);
#endif
    const bf16* Z = (const bf16*)(p.ws + WS_Z); const bf16* Q = Z + ZE_Q; const bf16* K = Z + ZE_K; const bf16* VT = Z + ZE_VT; bf16* Y = (bf16*)(p.ws + WS_YMIX);
    float* rpbs = (float*)(lds + NAT_RPB);
    constexpr int NRG = GROWS / 4, NLAT = NB * 8 * NRG, NCQ = (LC + 255) / 256, NCTX = NB * 8 * NCQ, NCT = LC / 64;
    const bool remap = gridDim.x == 256 && NLAT == 512 && NCTX == 32 && NRG == 16;
    for (int uu = blockIdx.x; uu < NLAT + (remap ? (int)gridDim.x : NCTX); uu += gridDim.x) { int u = uu;
        if (remap && uu >= NLAT) { const int m = blockIdx.x & 15; if (m != 0 && m != 15) break; u = NLAT + (blockIdx.x >> 4) * 2 + (m == 15 ? 1 : 0); }
        const bool lat = u < NLAT;
        int b, hd, r = 0, rs = 0, klo = 0, nloc = 0, qp; bool qvalid = true;
        if (lat) { const int rg = u % NRG; hd = (u / NRG) & 7; b = u / (NRG * 8); r = rg * 4 + (wave >> 1); rs = r - 4 < 0 ? 0 : (r - 4 > GROWS - 8 ? GROWS - 8 : r - 4);
            const int ra = rg * 4, rb = rg * 4 + 3; klo = ra - 4 < 0 ? 0 : (ra - 4 > GROWS - 8 ? GROWS - 8 : ra - 4); const int khi = (rb - 4 < 0 ? 0 : (rb - 4 > GROWS - 8 ? GROWS - 8 : rb - 4)) + 7; nloc = khi - klo + 1;
            qp = LC + r * 64 + (wave & 1) * 32 + ql; }
        else { const int v = u - NLAT; const int qt = v % NCQ; hd = (v / NCQ) & 7; b = v / (NCQ * 8); qp = qt * 256 + wave * 32 + ql; qvalid = qp < LC; if (!qvalid) qp = 0; }
        const size_t qrow = (size_t)b * PT + qp; const int ntile = nloc + NCT;
        __syncthreads();
        if (lat) for (int i = tid; i < 15 * 31; i += NTH) rpbs[i] = LOG2E * p.in[I_RPB][(size_t)(j * 8 + hd) * 15 * 31 + i];
        bf16x8 qf[4];
#pragma unroll
        for (int ks = 0; ks < 4; ++ks) qf[ks] = *(const bf16x8*)(Q + qrow * 512 + hd * 64 + ks * 16 + hh * 8);
        const int drow = tid >> 3, dch = (tid & 7) ^ (drow & 7);
        const bf16* ksrc = K + ((size_t)b * PT + drow) * 512 + hd * 64 + dch * 8; const bf16* vsrc = VT + ((size_t)(b * 8 + hd) * 64 + drow) * PT + dch * 8;
        auto tile_tok = [&](int t) { return t < nloc ? LC + (klo + t) * 64 : (t - nloc) * 64; };
#define NAT_DMA(t) do { const int tok_ = tile_tok(t); unsigned char* st_ = lds + ((t) & (NAT_RING - 1)) * NAT_STAGE + (wvu * 64) * 16; dma16(ksrc + (size_t)tok_ * 512, st_); dma16(vsrc + tok_, st_ + 8192); } while (0)
        AttnState<2> st; attn_init(st);
        const int cq = (wave & 1) * 32 + ql, cstart = cq - 8 < 0 ? 0 : (cq - 8 > 48 ? 48 : cq - 8);
        for (int t = 0; t < 3 && t < ntile; ++t) NAT_DMA(t);
        if (ntile >= 3) dma_wait_barrier<4>(); else if (ntile == 2) dma_wait_barrier<2>(); else dma_wait_barrier<0>();
        for (int t = 0; t < ntile; ++t) {
            if (t + 3 < ntile) NAT_DMA(t + 3);
            const bool loc = t < nloc; const int krow = klo + t; const bool active = !loc || (krow >= rs && krow <= rs + 7);
            if (active) { const unsigned char* sb = lds + (t & (NAT_RING - 1)) * NAT_STAGE;
#pragma unroll
                for (int s2 = 0; s2 < 2; ++s2) { f32x16 s;
#pragma unroll
                    for (int i = 0; i < 16; ++i) s[i] = 0.f;
#pragma unroll
                    for (int ks = 0; ks < 4; ++ks) s = mfma32(*(const bf16x8*)(sb + lds_sw(s2 * 32 + ql, ks * 2 + hh)), qf[ks], s);
                    if (loc) {
#pragma unroll
                        for (int i = 0; i < 16; ++i) { const int ck = s2 * 32 + (i & 3) + 8 * (i >> 2) + 4 * hh; const bool ok = ck >= cstart && ck < cstart + 16; const int dc = ok ? ck - cq + 15 : 0;
                            s[i] = ok ? s[i] + rpbs[(krow - r + 7) * 31 + dc] : -INFINITY; } }
                    attn_update<2>(st, s, [&](int mt, int ks) { return *(const bf16x8*)(sb + 8192 + lds_sw(mt * 32 + ql, s2 * 4 + ks * 2 + hh)); }); } }
            const int inflight = (t + 3 < ntile ? t + 3 : ntile - 1) - (t + 1);
            if (inflight >= 2) dma_wait_barrier<4>(); else if (inflight == 1) dma_wait_barrier<2>(); else dma_wait_barrier<0>();
        }
#undef NAT_DMA
        const float il = 1.0f / st.l;
        if (qvalid) {
#pragma unroll
            for (int mt = 0; mt < 2; ++mt)
#pragma unroll
                for (int q4 = 0; q4 < 4; ++q4) { const int dv = mt * 32 + 8 * q4 + 4 * hh; f32x4 o;
#pragma unroll
                    for (int k = 0; k < 4; ++k) o[k] = st.o[mt][q4 * 4 + k] * il;
                    store4_t(Y + qrow * D + 512 + hd * 64 + dv, o); } }
    }
}

DEVFN int chunk_order(int d, int k) { return d == 0 ? k : (k < NCC ? NCC - 1 - k : NCH - 1 - (k - NCC)); }
constexpr int GLR = 144;
constexpr int GL_CUM = 0, GL_ZZ = 32768, GL_PART = 32768 + 8192, GL_KT = 45056, GL_VT = GL_KT + 64 * GLR, GL_K = GL_VT + 128 * GLR, GL_Q = GL_K + 64 * GLR, GL_S = GL_Q + 64 * GLR, GL_SSQ = GL_S + 256 * GLR;
static_assert(GL_SSQ + 512 <= LDS_BYTES, "GLA LDS");
DEVFN bf16x8 scale8(const u32x4 raw, const float (&f)[8]) { u32x4 w;
#pragma unroll
    for (int i = 0; i < 4; ++i) w[i] = pack2(bitsf(raw[i] << 16) * f[2 * i], bitsf(raw[i] & 0xffff0000u) * f[2 * i + 1]);
    return __builtin_bit_cast(bf16x8, w); }
DEVFN void gl_stage(unsigned char* dst, const bf16* src, size_t ld, int rows, int tid) {
    for (int i = tid; i < rows * 8; i += NTH) { const int r = i >> 3, ch = i & 7; *(u32x4*)(dst + r * GLR + ch * 16) = *(const u32x4*)(src + (size_t)r * ld + ch * 8); }
}

DEVFN void phase_gla_a(const Params& p, unsigned char* lds, int j) {
    const int tid = tidx(), lane = tid & 63, wave = tid >> 6, fr = lane & 15, fg = lane >> 4; float* cum = (float*)(lds + GL_CUM); float* zz = (float*)(lds + GL_ZZ); float* part = (float*)(lds + GL_PART);
    const bf16* Z = (const bf16*)(p.ws + WS_Z); float* GU = (float*)(p.ws + WS_SB + SBO_GU); float* GDEC = (float*)(p.ws + WS_SB + SBO_GDEC); float* GCUM = (float*)(p.ws + WS_SB + SBO_GCUM);
    u32x2 pz; u32x4 pk, pv0, pv1; float pw[16], pgb;
#define GLA_A_FETCH(itx) { const int c_ = (itx) % NCH, hd_ = ((itx) / NCH) & 3, b_ = (itx) / (NCH * 4); \
        pz = *(const u32x2*)(Z + ZO_GZ + ((size_t)b_ * PT + c_ * 64) * 32 + tid * 4); \
        pk = *(const u32x4*)(Z + ZO_GKT + (size_t)(b_ * 4 + hd_) * 64 * PT + c_ * 64 + (size_t)(tid >> 3) * PT + (tid & 7) * 8); \
        const bf16* vs_ = Z + ZO_GVT + (size_t)(b_ * 4 + hd_) * 128 * PT + c_ * 64; \
        pv0 = *(const u32x4*)(vs_ + (size_t)(tid >> 3) * PT + (tid & 7) * 8); pv1 = *(const u32x4*)(vs_ + (size_t)(64 + (tid >> 3)) * PT + (tid & 7) * 8); \
        { const int d_ = tid >> 8, dk_ = (tid >> 2) & 63; const float* gw_ = p.in[I_GGW] + ((size_t)(j * 2 + d_) * 16) * 256 + hd_ * 64 + dk_; pgb = p.in[I_GGB][(size_t)(j * 2 + d_) * 256 + hd_ * 64 + dk_]; \
          _Pragma("unroll") for (int r = 0; r < 16; ++r) pw[r] = gw_[(size_t)r * 256]; } }
    if (blockIdx.x < NB * 4 * NCH) GLA_A_FETCH(blockIdx.x)
    for (int it = blockIdx.x; it < NB * 4 * NCH; it += gridDim.x) { const int c = it % NCH, hd = (it / NCH) & 3, b = it / (NCH * 4);
        __syncthreads();
        { f32x4 zf = (f32x4){bitsf(pz.x << 16), bitsf(pz.x & 0xffff0000u), bitsf(pz.y << 16), bitsf(pz.y & 0xffff0000u)}; *(f32x4*)(zz + tid * 4) = zf;
          *(u32x4*)(lds + GL_KT + (tid >> 3) * GLR + (tid & 7) * 16) = pk;
          *(u32x4*)(lds + GL_VT + (tid >> 3) * GLR + (tid & 7) * 16) = pv0; *(u32x4*)(lds + GL_VT + (64 + (tid >> 3)) * GLR + (tid & 7) * 16) = pv1; }
        float w[16]; const float gb = pgb;
#pragma unroll
        for (int r = 0; r < 16; ++r) w[r] = pw[r];
        if (it + (int)gridDim.x < NB * 4 * NCH) GLA_A_FETCH(it + gridDim.x)
        __syncthreads();
        { const int d = tid >> 8, dk = (tid >> 2) & 63, tg = tid & 3; float gl[16];
#pragma unroll
            for (int t = 0; t < 16; ++t) { float x = gb;
#pragma unroll
                for (int r = 0; r < 16; ++r) x += zz[(tg * 16 + t) * 32 + d * 16 + r] * w[r];
                gl[t] = logsigf_(x) * (1.0f / 16.0f); }
            if (d == 0) {
#pragma unroll
                for (int t = 1; t < 16; ++t) gl[t] += gl[t - 1];
                part[(d * 64 + dk) * 4 + tg] = gl[15];
            } else {
#pragma unroll
                for (int t = 14; t >= 0; --t) gl[t] += gl[t + 1];
                part[(d * 64 + dk) * 4 + tg] = gl[0]; }
            __syncthreads();
            float pre = 0.f;
#pragma unroll
            for (int q = 0; q < 4; ++q) { const bool inc = d == 0 ? q < tg : q > tg; pre += inc ? part[(d * 64 + dk) * 4 + q] : 0.f; }
            float* gc = GCUM + ((size_t)((b * 4 + hd) * NCH + c) * 2 + d) * 4096;
#pragma unroll
            for (int t = 0; t < 16; ++t) { const float v = gl[t] + pre; cum[(d * 64 + tg * 16 + t) * 64 + dk] = v; gc[(tg * 16 + t) * 64 + dk] = v; } }
        __syncthreads();
        bf16x8 va[2];
#pragma unroll
        for (int ks = 0; ks < 2; ++ks) va[ks] = *(const bf16x8*)(lds + GL_VT + (wave * 16 + fr) * GLR + (ks * 32 + fg * 8) * 2);
#pragma unroll
        for (int d = 0; d < 2; ++d) { const int tend = d ? 0 : 63;
#pragma unroll
            for (int n = 0; n < 4; ++n) { const int dk = n * 16 + fr; const float cend = cum[(d * 64 + tend) * 64 + dk]; f32x4 acc = (f32x4){0.f, 0.f, 0.f, 0.f};
#pragma unroll
                for (int ks = 0; ks < 2; ++ks) { const u32x4 raw = *(const u32x4*)(lds + GL_KT + dk * GLR + (ks * 32 + fg * 8) * 2); float f[8];
#pragma unroll
                    for (int e = 0; e < 8; ++e) f[e] = fexp(cend - cum[(d * 64 + ks * 32 + fg * 8 + e) * 64 + dk]);
                    acc = mfma16(va[ks], scale8(raw, f), acc); }
                float* dst = GU + ((size_t)(((b * 4 + hd) * 2 + d) * NCH + c) * 128 + wave * 16 + fg * 4) * 64 + dk;
#pragma unroll
                for (int r = 0; r < 4; ++r) dst[r * 64] = acc[r]; } }
        if (tid < 128) { const int d = tid >> 6, dk = tid & 63; GDEC[(size_t)(((b * 4 + hd) * 2 + d) * NCH + c) * 64 + dk] = fexp(cum[(d * 64 + (d ? 0 : 63)) * 64 + dk]); }
    }
#undef GLA_A_FETCH
}
constexpr int GLB_BS = 17;
DEVFN void phase_gla_b(const Params& p) {
    const float* GU = (const float*)(p.ws + WS_SB + SBO_GU); const float* GDEC = (const float*)(p.ws + WS_SB + SBO_GDEC); bf16* GSB = (bf16*)(p.ws + WS_H + (size_t)MR * D * 2);
    constexpr int NBT = (NCH + GLB_BS - 1) / GLB_BS, TOT = NB * 4 * 2 * 8192;
    const int GT = gridDim.x * NTH;
    for (int i = blockIdx.x * NTH + tidx(); i < TOT; i += 2 * GT) { int e[2], seq[2], dk[2], d[2]; bool ok[2]; float s[2] = {0.f, 0.f};
#pragma unroll
        for (int q = 0; q < 2; ++q) { const int iq = i + q * GT; ok[q] = iq < TOT; const int ic = ok[q] ? iq : i; e[q] = ic & 8191; seq[q] = ic >> 13; dk[q] = e[q] & 63; d[q] = seq[q] & 1; }
        float un[2][GLB_BS], dn[2][GLB_BS];
#pragma unroll
        for (int q = 0; q < 2; ++q)
#pragma unroll
            for (int x = 0; x < GLB_BS; ++x) { const int k = x < NCH ? x : NCH - 1; const int c = chunk_order(d[q], k); un[q][x] = GU[((size_t)seq[q] * NCH + c) * 8192 + e[q]]; dn[q][x] = GDEC[((size_t)seq[q] * NCH + c) * 64 + dk[q]]; }
#pragma unroll 1
        for (int kb = 0; kb < NBT; ++kb) { float u[2][GLB_BS], dc[2][GLB_BS];
#pragma unroll
            for (int q = 0; q < 2; ++q)
#pragma unroll
                for (int x = 0; x < GLB_BS; ++x) { u[q][x] = un[q][x]; dc[q][x] = dn[q][x]; }
            if (kb + 1 < NBT) {
#pragma unroll
                for (int q = 0; q < 2; ++q)
#pragma unroll
                    for (int x = 0; x < GLB_BS; ++x) { const int k = (kb + 1) * GLB_BS + x < NCH ? (kb + 1) * GLB_BS + x : NCH - 1; const int c = chunk_order(d[q], k); un[q][x] = GU[((size_t)seq[q] * NCH + c) * 8192 + e[q]]; dn[q][x] = GDEC[((size_t)seq[q] * NCH + c) * 64 + dk[q]]; } }
#pragma unroll
            for (int x = 0; x < GLB_BS; ++x) { const int k = kb * GLB_BS + x; if (k < NCH) {
#pragma unroll
                for (int q = 0; q < 2; ++q) { const int c = chunk_order(d[q], k); if (ok[q]) GSB[((size_t)seq[q] * NCH + c) * 8192 + e[q]] = f2bf(s[q]); s[q] = dc[q][x] * s[q] + u[q][x]; } } } }
    }
}
DEVFN void phase_gla_c(const Params& p, unsigned char* lds, int j) {
    const int tid = tidx(), lane = tid & 63, wave = tid >> 6, fr = lane & 15, fg = lane >> 4, itl = wave & 3, half = wave >> 2;
    float* cum = (float*)(lds + GL_CUM); float* ssq = (float*)(lds + GL_SSQ);
    const bf16* Z = (const bf16*)(p.ws + WS_Z); const bf16* GSB = (const bf16*)(p.ws + WS_H + (size_t)MR * D * 2); const float* GCUM = (const float*)(p.ws + WS_SB + SBO_GCUM); bf16* Y = (bf16*)(p.ws + WS_YMIX);
    f32x4 pc[4]; u32x4 pkq[2], pvt[2];
#define GLA_C_FETCH(itx) { const int c_ = (itx) % NCH, hd_ = ((itx) / NCH) & 3, b_ = (itx) / (NCH * 4); const size_t row0_ = (size_t)b_ * PT + c_ * 64; \
        const float* gc_ = GCUM + (size_t)((b_ * 4 + hd_) * NCH + c_) * 8192; \
        _Pragma("unroll") for (int x = 0; x < 4; ++x) pc[x] = *(const f32x4*)(gc_ + (x * NTH + tid) * 4); \
        pkq[0] = *(const u32x4*)(Z + ZO_GK + (row0_ + (tid >> 3)) * 256 + hd_ * 64 + (tid & 7) * 8); pkq[1] = *(const u32x4*)(Z + ZO_GQ + (row0_ + (tid >> 3)) * 256 + hd_ * 64 + (tid & 7) * 8); \
        const bf16* vs_ = Z + ZO_GVT + (size_t)(b_ * 4 + hd_) * 128 * PT + c_ * 64; \
        pvt[0] = *(const u32x4*)(vs_ + (size_t)(tid >> 3) * PT + (tid & 7) * 8); pvt[1] = *(const u32x4*)(vs_ + (size_t)(64 + (tid >> 3)) * PT + (tid & 7) * 8); }
    if (blockIdx.x < NB * 4 * NCH) GLA_C_FETCH(blockIdx.x)
    for (int it = blockIdx.x; it < NB * 4 * NCH; it += gridDim.x) { const int c = it % NCH, hd = (it / NCH) & 3, b = it / (NCH * 4);
        const size_t row0 = (size_t)b * PT + c * 64;
        __syncthreads();
#pragma unroll
        for (int x = 0; x < 4; ++x) *(f32x4*)(cum + (x * NTH + tid) * 4) = pc[x];
        *(u32x4*)(lds + GL_K + (tid >> 3) * GLR + (tid & 7) * 16) = pkq[0]; *(u32x4*)(lds + GL_Q + (tid >> 3) * GLR + (tid & 7) * 16) = pkq[1];
        *(u32x4*)(lds + GL_VT + (tid >> 3) * GLR + (tid & 7) * 16) = pvt[0]; *(u32x4*)(lds + GL_VT + (64 + (tid >> 3)) * GLR + (tid & 7) * 16) = pvt[1];
        for (int i = tid; i < 2 * 128 * 8; i += NTH) { const int d = i >> 10, r = (i >> 3) & 127, ch = i & 7;
            *(u32x4*)(lds + GL_S + (d * 128 + r) * GLR + ch * 16) = *(const u32x4*)(GSB + ((size_t)(((b * 4 + hd) * 2 + d) * NCH + c) * 128 + r) * 64 + ch * 8); }
        if (it + (int)gridDim.x < NB * 4 * NCH) GLA_C_FETCH(it + gridDim.x)
        __syncthreads();
        const int ti = itl * 16 + fr;
        f32x4 o[4];
#pragma unroll
        for (int mt = 0; mt < 4; ++mt) o[mt] = (f32x4){0.f, 0.f, 0.f, 0.f};
#pragma unroll 1
        for (int d = 0; d < 2; ++d) {
            bf16x8 qd[2];
#pragma unroll
            for (int ks = 0; ks < 2; ++ks) { const u32x4 raw = *(const u32x4*)(lds + GL_Q + ti * GLR + (ks * 32 + fg * 8) * 2); float f[8];
#pragma unroll
                for (int e = 0; e < 8; ++e) f[e] = fexp(cum[(d * 64 + ti) * 64 + ks * 32 + fg * 8 + e]);
                qd[ks] = scale8(raw, f); }
            f32x4 att[4];
#pragma unroll
            for (int jt = 0; jt < 4; ++jt) { const int tj = jt * 16 + fr; f32x4 a = (f32x4){0.f, 0.f, 0.f, 0.f};
#pragma unroll
                for (int ks = 0; ks < 2; ++ks) { const u32x4 raw = *(const u32x4*)(lds + GL_K + tj * GLR + (ks * 32 + fg * 8) * 2); float f[8];
#pragma unroll
                    for (int e = 0; e < 8; ++e) f[e] = fexp(-cum[(d * 64 + tj) * 64 + ks * 32 + fg * 8 + e]);
                    a = mfma16(scale8(raw, f), qd[ks], a); }
#pragma unroll
                for (int r = 0; r < 4; ++r) { const int jrow = jt * 16 + fg * 4 + r; const bool keep = d ? (jrow >= ti) : (jrow <= ti); a[r] = keep ? a[r] : 0.f; }
                att[jt] = a; }
#pragma unroll
            for (int s2 = 0; s2 < 2; ++s2) { bf16x8 pb;
#pragma unroll
                for (int e = 0; e < 0; ++e) {}
                { u32x4 w; w[0] = pack2(att[2 * s2][0], att[2 * s2][1]); w[1] = pack2(att[2 * s2][2], att[2 * s2][3]); w[2] = pack2(att[2 * s2 + 1][0], att[2 * s2 + 1][1]); w[3] = pack2(att[2 * s2 + 1][2], att[2 * s2 + 1][3]); pb = __builtin_bit_cast(bf16x8, w); }
#pragma unroll
                for (int mt = 0; mt < 4; ++mt) { const unsigned char* vp = lds + GL_VT + (half * 64 + mt * 16 + fr) * GLR + (s2 * 32 + fg * 4) * 2;
                    o[mt] = mfma16(cat4(*(const bf16x4*)vp, *(const bf16x4*)(vp + 32)), pb, o[mt]); } }
#pragma unroll
            for (int ks = 0; ks < 2; ++ks)
#pragma unroll
                for (int mt = 0; mt < 4; ++mt) o[mt] = mfma16(*(const bf16x8*)(lds + GL_S + (d * 128 + half * 64 + mt * 16 + fr) * GLR + (ks * 32 + fg * 8) * 2), qd[ks], o[mt]);
        }
        float ss = 0.f;
#pragma unroll
        for (int mt = 0; mt < 4; ++mt)
#pragma unroll
            for (int r = 0; r < 4; ++r) ss += o[mt][r] * o[mt][r];
        ss += __shfl_xor(ss, 16); ss += __shfl_xor(ss, 32);
        if (fg == 0) ssq[half * 64 + ti] = ss;
        __syncthreads();
        const float rstd = 1.0f / sqrtf((ssq[ti] + ssq[64 + ti]) * (1.0f / 128.0f) + LN_EPS);
#pragma unroll
        for (int mt = 0; mt < 4; ++mt) { const int dv = hd * 128 + half * 64 + mt * 16 + fg * 4; const f32x4 ng = *(const f32x4*)(p.in[I_GNG] + (size_t)j * 512 + dv);
            const u32x2 rr = *(const u32x2*)(Z + ZO_GR + (row0 + ti) * 512 + dv); f32x4 y;
            y[0] = o[mt][0] * rstd * ng[0] * siluf_(bitsf(rr.x << 16)); y[1] = o[mt][1] * rstd * ng[1] * siluf_(bitsf(rr.x & 0xffff0000u));
            y[2] = o[mt][2] * rstd * ng[2] * siluf_(bitsf(rr.y << 16)); y[3] = o[mt][3] * rstd * ng[3] * siluf_(bitsf(rr.y & 0xffff0000u));
            store4_t(Y + (row0 + ti) * D + dv, y); }
    }
#undef GLA_C_FETCH
}

constexpr int DK_ROW = 272, DV_ROW = 144, DF_VOFF = 64 * DK_ROW, DF_BUF = DF_VOFF + 128 * DV_ROW, DF_Q = 2 * DF_BUF;
DEVFN int dk_off(int key, int ch) { return key * DK_ROW + ch * 16; }
DEVFN int dv_off(int dv, int ch) { return dv * DV_ROW + ch * 16; }
DEVFN void phase_diff(const Params& p, unsigned char* lds, int l, int part) {
    const int j = l >> 1, tid = tidx(), lane = tid & 63, wave = tid >> 6, ql = lane & 31, hh = lane >> 5, qg = wave >> 1, m = wave & 1;
    const bf16* Z = (const bf16*)(p.ws + WS_Z); bf16* Y = (bf16*)(p.ws + WS_YMIX);
    constexpr int NQT = TS / 128, NQC = (LC + 127) / 128, NU = NB * 4 * (NQT + NQC);
    constexpr int NUL = NB * 4 * NQT;
    const int G_ = gridDim.x, u0 = part == 0 ? (int)blockIdx.x : NUL + ((int)blockIdx.x + G_ - (64 % G_)) % G_, uend = part == 0 ? NUL : NU;
    if (u0 >= uend) return;
    const float laminit = 0.8f - 0.6f * expf(-0.3f * (float)l);
    const float d1 = wave_sum(p.in[I_LQ1][j * 64 + lane] * p.in[I_LK1][j * 64 + lane]), d2 = wave_sum(p.in[I_LQ2][j * 64 + lane] * p.in[I_LK2][j * 64 + lane]);
    const float lam = expf(d1) - expf(d2) + laminit;
    for (int u = u0; u < uend; u += gridDim.x) { const bool isctx = u >= NUL; const int v = isctx ? u - NUL : u, per = isctx ? NQC : NQT;
        const int qt = isctx ? NQT + v % per : v % per, hd = (v / per) & 3, b = v / (per * 4);
        const int q0 = isctx ? (qt - NQT) * 128 : LC + qt * 128, nkt = (isctx ? LC : PT) / 64; const int qp = q0 + qg * 32 + ql; const size_t qrow = (size_t)b * PT + qp;
        const bool qvalid = !isctx || qp < LC;
        bf16x8 qf[4];
#pragma unroll
        for (int ks = 0; ks < 4; ++ks) qf[ks] = *(const bf16x8*)(Z + ZO_DQ + qrow * 512 + hd * 128 + m * 64 + ks * 16 + hh * 8);
        AttnState<4> st; attn_init(st);
        const bf16* ksrc[2]; const bf16* vsrc[2]; int klo[2], vlo[2];
#pragma unroll
        for (int i = 0; i < 2; ++i) { const int idx = i * NTH + tid; const int key = idx >> 4, kch = idx & 15, dv = idx >> 3, vch = idx & 7;
            ksrc[i] = Z + ZO_DK + ((size_t)b * PT + key) * 512 + hd * 128 + kch * 8; klo[i] = dk_off(key, kch);
            vsrc[i] = Z + ZO_DVT + ((size_t)(b * 4 + hd) * 128 + dv) * PT + vch * 8; vlo[i] = DF_VOFF + dv_off(dv, vch); }
        u32x4 rk0[2], rv0[2], rk1[2], rv1[2];
#define DF_LOAD(RK, RV, t) do { _Pragma("unroll") for (int i = 0; i < 2; ++i) { RK[i] = *(const u32x4*)(ksrc[i] + (size_t)(t) * 64 * 512); RV[i] = *(const u32x4*)(vsrc[i] + (t) * 64); } } while (0)
#define DF_STORE(RK, RV, buf) do { _Pragma("unroll") for (int i = 0; i < 2; ++i) { *(u32x4*)(lds + (buf) + klo[i]) = RK[i]; *(u32x4*)(lds + (buf) + vlo[i]) = RV[i]; } } while (0)
#define DF_COMPUTE(cur) do { f32x16 sA, sB; _Pragma("unroll") for (int i = 0; i < 16; ++i) { sA[i] = 0.f; sB[i] = 0.f; } \
            _Pragma("unroll") for (int ks = 0; ks < 4; ++ks) { sA = mfma32(*(const bf16x8*)(lds + (cur) + dk_off(ql, m * 8 + ks * 2 + hh)), qf[ks], sA); sB = mfma32(*(const bf16x8*)(lds + (cur) + dk_off(32 + ql, m * 8 + ks * 2 + hh)), qf[ks], sB); } \
            const unsigned char* vb = lds + (cur) + DF_VOFF + 16 * hh; \
            attn_update2<4>(st, sA, sB, [&](int st2, int mt, int ks) { return *(const bf16x8*)(vb + dv_off(mt * 32 + ql, st2 * 4 + ks * 2)); }); } while (0)
        __syncthreads();
        DF_LOAD(rk0, rv0, 0); DF_LOAD(rk1, rv1, 1);
        DF_STORE(rk0, rv0, 0);
        __syncthreads();
        for (int t = 0; t < nkt; t += 2) {
            if (t + 2 < nkt) DF_LOAD(rk0, rv0, t + 2);
            DF_COMPUTE(0);
            DF_STORE(rk1, rv1, DF_BUF);
            __syncthreads();
            if (t + 3 < nkt) DF_LOAD(rk1, rv1, t + 3);
            DF_COMPUTE(DF_BUF);
            if (t + 2 < nkt) DF_STORE(rk0, rv0, 0);
            __syncthreads();
        }
#undef DF_LOAD
#undef DF_STORE
#undef DF_COMPUTE
        float* xch = (float*)lds + (size_t)qg * 4096 + lane;
        if (m == 1) { const float f = lam / st.l;
#pragma unroll
            for (int mt = 0; mt < 4; ++mt)
#pragma unroll
                for (int r = 0; r < 16; ++r) xch[(mt * 16 + r) * 64] = st.o[mt][r] * f; }
        __syncthreads();
        if (m == 0) { const float i0 = 1.0f / st.l; float ss = 0.f;
#pragma unroll
            for (int mt = 0; mt < 4; ++mt)
#pragma unroll
                for (int r = 0; r < 16; ++r) { const float o = st.o[mt][r] * i0 - xch[(mt * 16 + r) * 64]; st.o[mt][r] = o; ss += o * o; }
            ss += __shfl_xor(ss, 32);
            const float rstd = (1.0f - laminit) / sqrtf(ss * (1.0f / 128.0f) + LN_EPS);
            if (qvalid) {
#pragma unroll
                for (int mt = 0; mt < 4; ++mt)
#pragma unroll
                    for (int q4 = 0; q4 < 4; ++q4) { const int dv = mt * 32 + 8 * q4 + 4 * hh; const f32x4 ng = *(const f32x4*)(p.in[I_DNG] + (size_t)j * 128 + dv); f32x4 o;
#pragma unroll
                        for (int k = 0; k < 4; ++k) o[k] = st.o[mt][q4 * 4 + k] * rstd * ng[k];
                        store4_t(Y + qrow * D + 512 + hd * 128 + dv, o); } }
        }
    }
}

enum { PH_CONVERT = 0, PH_INIT, PH_INPROJ_E, PH_S5A, PH_S5B_NAT, PH_S5C, PH_GLU, PH_INPROJ_O, PH_GLA_A, PH_GLAB_DIFF, PH_GLA_C, PH_GLA_B, PH_DIFF, PH_OUTPROJ, PH_LN1, PH_MOE_UP, PH_MOE_DOWN, PH_LN2, PH_COUNT };

#ifdef CPU_EMU
#define PHASEFN static
#else
#define PHASEFN __device__ __forceinline__
#endif
template <int PH> PHASEFN void run_phase(const Params& p, unsigned char* lds, int l) {
    if constexpr (PH == PH_CONVERT) phase_convert(p, lds);
    else if constexpr (PH == PH_INIT) phase_init_h(p);
    else if constexpr (PH == PH_INPROJ_E) phase_inproj_even(p, lds, l);
    else if constexpr (PH == PH_S5A) phase_s5a(p, lds, l >> 1);
    else if constexpr (PH == PH_S5B_NAT) { phase_s5b(p, l >> 1); phase_natten(p, lds, l >> 1); }
    else if constexpr (PH == PH_S5C) phase_s5c(p, lds, l >> 1);
    else if constexpr (PH == PH_GLU) phase_glu(p, lds, l >> 1);
    else if constexpr (PH == PH_INPROJ_O) phase_inproj_odd(p, lds, l);
    else if constexpr (PH == PH_GLA_A) { phase_gla_a(p, lds, l >> 1); phase_diff(p, lds, l, 1); }
    else if constexpr (PH == PH_GLAB_DIFF) { phase_gla_b(p); phase_diff(p, lds, l, 0); }
    else if constexpr (PH == PH_GLA_C) phase_gla_c(p, lds, l >> 1);
    else if constexpr (PH == PH_GLA_B) phase_gla_b(p);
    else if constexpr (PH == PH_DIFF) phase_diff(p, lds, l, 0);
    else if constexpr (PH == PH_OUTPROJ) phase_outproj(p, lds, l);
    else if constexpr (PH == PH_LN1) phase_ln1_route(p, lds, l);
    else if constexpr (PH == PH_MOE_UP) phase_moe_up(p, lds, l);
    else if constexpr (PH == PH_MOE_DOWN) phase_moe_down(p, lds, l);
    else if constexpr (PH == PH_LN2) phase_ln2(p, lds, l);
}

template <int PH> __global__ void __launch_bounds__(NTH, 2) k_phase(Params p, int l) { DECL_LDS; run_phase<PH>(p, lds, l); }

#ifdef CPU_EMU
static int g_grid = 8; static int g_stop_layer = 1000, g_stop_phase = 1000;
template <int PH> static bool launch_phase(const Params& p, int l, hipStream_t) {
    if (l > g_stop_layer || (l == g_stop_layer && PH > g_stop_phase)) return false;
    fprintf(stderr, "[emu] layer %d phase %d\n", l, PH);
    emu::launch([=] { k_phase<PH>(p, l); }, dim3(g_grid), dim3(NTH), LDS_BYTES); return true;
}
static void hipMemsetAsync(void* d, int v, size_t n, hipStream_t) { memset(d, v, n); }
#else
static int g_grid = 0;
template <int PH> static bool launch_phase(const Params& p, int l, hipStream_t s) {
    static bool attr = false;
    if (!attr) { (void)hipFuncSetAttribute((const void*)k_phase<PH>, hipFuncAttributeMaxDynamicSharedMemorySize, LDS_BYTES); attr = true; }
    hipLaunchKernelGGL(k_phase<PH>, dim3(g_grid), dim3(NTH), LDS_BYTES, s, p, l); return true;
}
#endif


__global__ void __launch_bounds__(NTH, 2) k_mega(Params p_arg) {
    DECL_LDS;
#ifdef CPU_EMU
    const Params& p = p_arg;
#else
    const Params& p = *(const Params*)(uintptr_t)__builtin_amdgcn_kernarg_segment_ptr();
#endif
#ifndef CPU_EMU
    if (threadIdx.x == 0) *(uint4*)(lds + LDS_BYTES) = make_uint4(0u, 0u, 0u, 0u);
    __syncthreads();
    XcdBarrier gbar = xcd_barrier_post((unsigned*)(p.ws + WS_CTL + CTL_BAR), (volatile LAS unsigned*)(lds + LDS_BYTES));
#endif
    run_phase<PH_CONVERT>(p, lds, -1); GRID_SYNC();
    if (PROBE_MASK & 2048) { run_phase<PH_CONVERT>(p, lds, -1); GRID_SYNC(); }
    run_phase<PH_INIT>(p, lds, -1); GRID_SYNC();
#define RP(ph, l, bit) do { run_phase<ph>(p, lds, l); GRID_SYNC(); if (PROBE_MASK & (bit)) { run_phase<ph>(p, lds, l); GRID_SYNC(); } } while (0)
#define MK_EVEN(l) do { RP(PH_INPROJ_E, l, 1); RP(PH_S5A, l, 2); RP(PH_S5B_NAT, l, 4); RP(PH_S5C, l, 8); RP(PH_GLU, l, 16); } while (0)
#define MK_ODD(l) do { RP(PH_INPROJ_O, l, 1); RP(PH_GLA_A, l, 32); run_phase<PH_GLA_B>(p, lds, l); RP(PH_DIFF, l, 64); RP(PH_GLA_C, l, 128); } while (0)
#define MK_TAIL(l) do { RP(PH_OUTPROJ, l, 256); run_phase<PH_LN1>(p, lds, l); GRID_SYNC(); RP(PH_MOE_UP, l, 512); RP(PH_MOE_DOWN, l, 1024); run_phase<PH_LN2>(p, lds, l); if ((l) + 1 < NL) GRID_SYNC(); } while (0)
    MK_EVEN(0); MK_TAIL(0);
    if (NL > 1) { MK_ODD(1); MK_TAIL(1); }
    if (NL > 2) { MK_EVEN(2); MK_TAIL(2); }
    if (NL > 3) { MK_ODD(3); MK_TAIL(3); }
}
#ifdef CPU_EMU
static void launch_mega(const Params& p, hipStream_t) { emu::launch([=] { k_mega(p); }, dim3(g_grid), dim3(NTH), LDS_TOTAL); }
#else
static void launch_mega(const Params& p, hipStream_t s) {
    static bool attr = false;
    if (!attr) { (void)hipFuncSetAttribute((const void*)k_mega, hipFuncAttributeMaxDynamicSharedMemorySize, LDS_TOTAL); attr = true; }
    hipLaunchKernelGGL(k_mega, dim3(g_grid), dim3(NTH), LDS_TOTAL, s, p);
}
#endif

extern "C" void kernel_launch(void* const* d_in, const int* in_sizes, int n_in, void* d_out, int out_size, void* d_ws, size_t ws_size, hipStream_t stream) {
#ifndef CPU_EMU
    if (g_grid == 0) { int dev = 0, cus = 0; (void)hipGetDevice(&dev); (void)hipDeviceGetAttribute(&cus, hipDeviceAttributeMultiprocessorCount, dev); g_grid = cus > 0 ? cus : 256; }
#endif
    if (n_in != N_IN || ws_size < WS_END) { fprintf(stderr, "kernel_launch: unexpected inputs (n_in %d) or workspace (%zu < %zu)\n", n_in, ws_size, (size_t)WS_END); return; }
    Params p{};
    for (int i = 0; i < N_IN; ++i) p.in[i] = (const float*)d_in[i];
    p.out = (float*)d_out; p.ws = (unsigned char*)d_ws;
    (void)hipMemsetAsync((char*)d_ws + WS_CTL, 0, CTL_BYTES, stream);
#if defined(MK_MULTI)
    launch_phase<PH_CONVERT>(p, -1, stream);
    launch_phase<PH_INIT>(p, -1, stream);
    for (int l = 0; l < NL; ++l) {
        if ((l & 1) == 0) { launch_phase<PH_INPROJ_E>(p, l, stream); launch_phase<PH_S5A>(p, l, stream); launch_phase<PH_S5B_NAT>(p, l, stream); launch_phase<PH_S5C>(p, l, stream); launch_phase<PH_GLU>(p, l, stream); }
        else { launch_phase<PH_INPROJ_O>(p, l, stream); launch_phase<PH_GLA_A>(p, l, stream); launch_phase<PH_GLAB_DIFF>(p, l, stream); launch_phase<PH_GLA_C>(p, l, stream); }
        launch_phase<PH_OUTPROJ>(p, l, stream); launch_phase<PH_LN1>(p, l, stream); launch_phase<PH_MOE_UP>(p, l, stream); launch_phase<PH_MOE_DOWN>(p, l, stream); launch_phase<PH_LN2>(p, l, stream);
    }
#else
    launch_mega(p, stream);
#endif
}

#ifdef CPU_EMU_MAIN
#include <string>
#include <fstream>
#include <sys/mman.h>
static void* guard_alloc(size_t n) { const size_t pg = 4096, tot = ((n + pg - 1) / pg + 2) * pg; char* b = (char*)mmap(nullptr, tot, PROT_READ | PROT_WRITE, MAP_PRIVATE | MAP_ANONYMOUS, -1, 0); mprotect(b, pg, PROT_NONE); mprotect(b + tot - pg, pg, PROT_NONE); return b + tot - pg - ((n + 255) & ~(size_t)255); }
static std::vector<float> load_npy(const std::string& fn, bool& ok) {
    std::ifstream f(fn, std::ios::binary); std::vector<float> v; ok = false; if (!f) return v;
    char hdr[10]; f.read(hdr, 10); int hl = (unsigned char)hdr[8] | ((unsigned char)hdr[9] << 8); std::string h(hl, ' '); f.read(&h[0], hl);
    f.seekg(0, std::ios::end); size_t n = ((size_t)f.tellg() - 10 - hl) / 4; f.seekg(10 + hl); v.resize(n); f.read((char*)v.data(), n * 4); ok = true; return v;
}
template <class G> static void check(const char* name, const std::vector<float>& ref, size_t rows, size_t cols, size_t ref_ld, size_t ref_c0, G get) {
    double num = 0, den = 0, mx = 0; size_t wr = 0, wc = 0;
    for (size_t r = 0; r < rows; ++r) for (size_t c = 0; c < cols; ++c) { const double a = get(r, c), b = ref[r * ref_ld + ref_c0 + c], e = a - b; num += e * e; den += b * b; if (fabs(e) > mx) { mx = fabs(e); wr = r; wc = c; } }
    printf("CHECK %-14s rvr=%.3e  maxabs=%.4f at (%zu,%zu) refrms=%.4f\n", name, num / (den + 1e-30), mx, wr, wc, sqrt(den / (rows * cols)));
}
int main(int argc, char** argv) {
    std::string dir = argv[1]; if (argc > 2) g_stop_layer = atoi(argv[2]); if (argc > 3) g_stop_phase = atoi(argv[3]); if (const char* e = getenv("EMU_GRID")) g_grid = atoi(e);
    std::vector<int> sizes; { std::ifstream f(dir + "/sizes.txt"); int s; while (f >> s) sizes.push_back(s); }
    if ((int)sizes.size() != N_IN) { printf("bad sizes\n"); return 1; }
    std::vector<void*> din(N_IN); { std::ifstream f(dir + "/inputs.bin", std::ios::binary); for (int i = 0; i < N_IN; ++i) { din[i] = guard_alloc((size_t)sizes[i] * 4); f.read((char*)din[i], (size_t)sizes[i] * 4); } }
    printf("WS_END = %.1f MB\n", WS_END / 1048576.0);
    unsigned char* ws = (unsigned char*)guard_alloc(WS_END); memset(ws, 0x7F, WS_END);
    std::vector<float> out((size_t)NB * TS * D, NAN);
    kernel_launch(din.data(), sizes.data(), N_IN, out.data(), (int)out.size(), ws, WS_END, nullptr);
    const int L = g_stop_layer < NL ? g_stop_layer : NL - 1; const int PHS = g_stop_layer < NL ? g_stop_phase : 1000; bool ok; char nm[64];
    const bf16* Z = (const bf16*)(ws + WS_Z); const bf16* Y = (const bf16*)(ws + WS_YMIX); const bf16* H = (const bf16*)(ws + WS_H);
    auto ref = [&](const char* what) { snprintf(nm, 64, "/L%d_%s.npy", L, what); return load_npy(dir + nm, ok); };
    if (PHS >= PH_INPROJ_E || PHS >= PH_INPROJ_O) {
        auto a = ref("a"); if (ok && PHS < PH_LN1) check("abf", a, MR, D, D, 0, [&](size_t r, size_t c) { return bf2f(((const bf16*)(ws + WS_ABF))[r * D + c]); });
        auto z = ref("z");
        if (ok && (L & 1) == 0 && PHS < PH_OUTPROJ) {
            check("z.u", z, MR, 512, 2048, 0, [&](size_t r, size_t c) { return bf2f(Z[ZE_U + r * 512 + c]); });
            check("z.q", z, MR, 512, 2048, 512, [&](size_t r, size_t c) { return bf2f(Z[ZE_Q + r * 512 + c]) / QSCALE; });
            check("z.k", z, MR, 512, 2048, 1024, [&](size_t r, size_t c) { return bf2f(Z[ZE_K + r * 512 + c]); });
            check("z.v", z, MR, 512, 2048, 1536, [&](size_t r, size_t c) { size_t b = r / PT, pp = r % PT; return bf2f(Z[ZE_VT + ((b * 8 + c / 64) * 64 + c % 64) * PT + vperm((int)pp)]); });
        }
        if (ok && (L & 1) == 1 && PHS < PH_OUTPROJ) {
            check("z.gq", z, MR, 256, ODD_N, 0, [&](size_t r, size_t c) { return bf2f(Z[ZO_GQ + r * 256 + c]) * 8.f; });
            check("z.gk", z, MR, 256, ODD_N, 256, [&](size_t r, size_t c) { return bf2f(Z[ZO_GK + r * 256 + c]); });
            check("z.gkt", z, MR, 256, ODD_N, 256, [&](size_t r, size_t c) { size_t b = r / PT, pp = r % PT; return bf2f(Z[ZO_GKT + ((b * 4 + c / 64) * 64 + c % 64) * PT + pp]); });
            check("z.gvt", z, MR, 512, ODD_N, 512, [&](size_t r, size_t c) { size_t b = r / PT, pp = r % PT; return bf2f(Z[ZO_GVT + ((b * 4 + c / 128) * 128 + c % 128) * PT + pp]); });
            check("z.gr", z, MR, 512, ODD_N, 1024, [&](size_t r, size_t c) { return bf2f(Z[ZO_GR + r * 512 + c]); });
            check("z.gz", z, MR, 32, ODD_N, 1536, [&](size_t r, size_t c) { return bf2f(Z[ZO_GZ + r * 32 + c]); });
            check("z.dvt", z, MR, 512, ODD_N, 2592, [&](size_t r, size_t c) { size_t b = r / PT, pp = r % PT; return bf2f(Z[ZO_DVT + ((b * 4 + c / 128) * 128 + c % 128) * PT + vperm((int)pp)]); });
            check("z.dq(ctx rows)", z, LC, 512, ODD_N, 1568, [&](size_t r, size_t c) { return bf2f(Z[ZO_DQ + r * 512 + c]) / QSCALE; });
            check("z.dk(ctx rows)", z, LC, 512, ODD_N, 2080, [&](size_t r, size_t c) { return bf2f(Z[ZO_DK + r * 512 + c]); });
        }
    }
    if ((L & 1) == 0 && PHS >= PH_S5C && PHS < PH_MOE_DOWN) { auto s = ref("s5pre"); for (auto& x : s) x = geluf_(x); if (ok) check("gelu(s5pre)", s, MR, 512, 512, 0, [&](size_t r, size_t c) { return bf2f(((const bf16*)(ws + WS_SB + SBO_GS))[r * 512 + c]); }); }
    if (PHS >= PH_GLU && PHS >= PH_GLA_C) { auto m = ref("mix"); if (ok) { check("mix[0:512]", m, MR, 512, D, 0, [&](size_t r, size_t c) { return bf2f(Y[r * D + c]); }); check("mix[512:]", m, MR, 512, D, 512, [&](size_t r, size_t c) { return bf2f(Y[r * D + 512 + c]); }); } }
    else if (PHS >= PH_S5B_NAT) { auto m = ref("mix"); if (ok) { check("mix[0:512]", m, MR, 512, D, 0, [&](size_t r, size_t c) { return bf2f(Y[r * D + c]); }); check("mix[512:]", m, MR, 512, D, 512, [&](size_t r, size_t c) { return bf2f(Y[r * D + 512 + c]); }); } }
    if (PHS >= PH_OUTPROJ && PHS < PH_LN2) { auto y = ref("y"); if (ok && PHS < PH_MOE_UP) check("y", y, MR, D, D, 0, [&](size_t r, size_t c) { return bf2f(((const bf16*)(ws + WS_Z))[r * D + c]); }); }
    if (PHS >= PH_LN1 && PHS < PH_LN2) { auto h = ref("h1"); if (ok) check("h1", h, MR, D, D, 0, [&](size_t r, size_t c) { return bf2f(H[r * D + c]); });
        std::vector<int> eid; { snprintf(nm, 64, "/L%d_eid.npy", L); auto e = load_npy(dir + nm, ok); if (ok) { const int* ep = (const int*)e.data(); const int* rt = (const int*)(ws + WS_ROUTE); int bad = 0; for (int r = 0; r < MR; ++r) if (rt[r * 4] != ep[r * 2] || rt[r * 4 + 1] != ep[r * 2 + 1]) ++bad; printf("CHECK routing mismatches: %d / %d\n", bad, MR); } } }
    if (PHS >= PH_MOE_DOWN && PHS < PH_LN2) { auto f = ref("f"); if (ok) { const unsigned* cnt = (const unsigned*)(ws + WS_CTL + CTL_CNT) + L * NEXP; const int* rt = (const int*)(ws + WS_ROUTE); const bf16* F2 = (const bf16*)(ws + WS_SB);
        check("moe f", f, MR, D, D, 0, [&](size_t r, size_t c) { size_t r0 = (size_t)moe_off(cnt, rt[r * 4]) + rt[r * 4 + 2], r1 = (size_t)moe_off(cnt, rt[r * 4 + 1]) + rt[r * 4 + 3]; return bf2f(F2[r0 * D + c]) + bf2f(F2[r1 * D + c]); }); } }
    if (PHS >= PH_LN2 && L + 1 < NL) { auto h = ref("h2"); if (ok) check("h2", h, MR, D, D, 0, [&](size_t r, size_t c) { return bf2f(H[r * D + c]); }); }
    if (g_stop_layer >= NL) { auto o = load_npy(dir + "/ref_out.npy", ok); if (ok) { std::vector<float> of(o.size() / 2); const double* od = (const double*)o.data(); for (size_t i = 0; i < of.size(); ++i) of[i] = (float)od[i];
        check("FINAL out", of, (size_t)NB * TS, D, D, 0, [&](size_t r, size_t c) { return out[r * D + c]; }); } }
    return 0;
}
#endif
```

```cpp
#ifdef CPU_EMU
#include "emu.h"
#else
#include <hip/hip_runtime.h>
#include <cstdio>
#include <cstdint>
#include <cmath>
#endif

#ifndef PROBE_MASK
#define PROBE_MASK 0
#endif
#ifndef CFG_BATCH
#define CFG_BATCH 4
#endif
#ifndef CFG_SEQ
#define CFG_SEQ 4096
#endif
#ifndef CFG_CTX
#define CFG_CTX 256
#endif
#ifndef CFG_DEPTH
#define CFG_DEPTH 4
#endif

typedef unsigned short bf16;
typedef short bf16x8 __attribute__((ext_vector_type(8)));
typedef short bf16x4 __attribute__((ext_vector_type(4)));
typedef float f32x4 __attribute__((ext_vector_type(4)));
typedef float f32x2 __attribute__((ext_vector_type(2)));
typedef float f32x16 __attribute__((ext_vector_type(16)));
typedef unsigned u32x4 __attribute__((ext_vector_type(4)));
typedef unsigned u32x2 __attribute__((ext_vector_type(2)));

constexpr int NB = CFG_BATCH, TS = CFG_SEQ, LC = CFG_CTX, NL = CFG_DEPTH;
constexpr int PT = LC + TS;
constexpr int MR = NB * PT;
constexpr int D = 1024;
constexpr int NE = (NL + 1) / 2, NO = NL / 2;
constexpr int GW = 64;
constexpr int GROWS = TS / GW;
constexpr int NCH = PT / 64, NCC = LC / 64;
constexpr int NTH = 512;
constexpr int EVEN_N = 2048, ODD_N = 3104, ODD_NP = 3328;
constexpr int NEXP = 32;
constexpr float LN_EPS = 1e-5f;
constexpr float ALPHA = 1.681792830507429f;
constexpr float LOG2E = 1.4426950408889634f, QSCALE = 0.125f * LOG2E;
static_assert(MR % 256 == 0 && LC % 128 == 0 && TS % 128 == 0 && GROWS >= 8, "shape");

enum { I_X = 0, I_C, I_CTX, I_CCTX, I_MODW, I_MODB, I_LNG, I_LNB, I_EWIN, I_EWOUT, I_LAMRE, I_LAMIM, I_LOGDT, I_BRE, I_BIM, I_CRE, I_CIM, I_S5D,
       I_GLUW, I_GLUB, I_RPB, I_OWIN, I_OWOUT, I_GGW, I_GGB, I_GNG, I_LQ1, I_LK1, I_LQ2, I_LK2, I_DNG, I_WGRP, I_BGRP, I_WEXP, I_BEXP, I_WGATE, I_WUP, I_WDOWN, N_IN };

constexpr size_t al256(size_t x) { return (x + 255) & ~(size_t)255; }
constexpr size_t WS_CTL = 0;
constexpr size_t CTL_BAR = 0;
constexpr size_t CTL_CNT = 16384;
constexpr size_t CTL_BYTES = 16384 + 4096;
constexpr size_t WS_MODV = al256(WS_CTL + CTL_BYTES);
constexpr size_t WS_S5P = al256(WS_MODV + (size_t)NL * (NB + 1) * 6144 * 4);
constexpr int S5P_STRIDE = 36;
constexpr size_t WS_ROPE = al256(WS_S5P + (size_t)NE * 2 * 32 * 64 * S5P_STRIDE * 4);
constexpr size_t WS_WIN = al256(WS_ROPE + 8192);
constexpr size_t WIN_LSTRIDE = (size_t)ODD_NP * D;
constexpr size_t WS_WOUT = al256(WS_WIN + (size_t)NL * WIN_LSTRIDE * 2);
constexpr size_t WS_GLU = al256(WS_WOUT + (size_t)NL * D * D * 2);
constexpr size_t WS_MGU = al256(WS_GLU + (size_t)NE * 1024 * 512 * 2);
constexpr size_t WS_MDN = al256(WS_MGU + (size_t)NL * NEXP * 512 * 1024 * 2);
constexpr size_t WS_H = al256(WS_MDN + (size_t)NL * NEXP * 1024 * 256 * 2);
constexpr size_t WS_ABF = al256(WS_H + (size_t)MR * D * 4);
constexpr size_t WS_Z = al256(WS_ABF + (size_t)MR * D * 2);
constexpr size_t Z_BYTES = (size_t)MR * 3360 * 2;
constexpr size_t WS_YMIX = al256(WS_Z + Z_BYTES);
constexpr size_t WS_SB = al256(WS_YMIX + (size_t)MR * D * 2);
constexpr size_t MOE_ROWS = (size_t)2 * MR + NEXP * 128;
constexpr size_t SB_GLA = (size_t)NB * 4 * 2 * NCH * 128 * 64 * 4 + (size_t)NB * 4 * 2 * NCH * 64 * 4 + (size_t)NB * 4 * NCH * 2 * 64 * 64 * 4 + 8192;
constexpr size_t SB_S5 = (size_t)2 * NB * 32 * 2 * NCH * 128 * 4 + (size_t)MR * 512 * 2 + 4096;
constexpr size_t SB_F2 = MOE_ROWS * D * 2;
constexpr size_t SB_BYTES = SB_GLA > SB_F2 ? (SB_GLA > SB_S5 ? SB_GLA : SB_S5) : (SB_F2 > SB_S5 ? SB_F2 : SB_S5);
constexpr size_t WS_ACT = al256(WS_SB + SB_BYTES);
constexpr size_t WS_ROUTE = al256(WS_ACT + MOE_ROWS * 256 * 2);
constexpr size_t WS_LTOK = al256(WS_ROUTE + (size_t)MR * 16);
constexpr size_t WS_LW = al256(WS_LTOK + (size_t)NEXP * MR * 4);
constexpr size_t WS_END = al256(WS_LW + (size_t)NEXP * MR * 4);
constexpr size_t ZE_U = 0, ZE_Q = (size_t)MR * 512, ZE_K = (size_t)MR * 1024, ZE_VT = (size_t)MR * 1536;
constexpr size_t ZO_GQ = 0, ZO_GK = (size_t)MR * 256, ZO_GKT = (size_t)MR * 512, ZO_GVT = (size_t)MR * 768, ZO_GR = (size_t)MR * 1280,
                 ZO_GZ = (size_t)MR * 1792, ZO_DQ = (size_t)MR * 1824, ZO_DK = (size_t)MR * 2336, ZO_DVT = (size_t)MR * 2848;
constexpr size_t SBO_S5E = 0;
constexpr size_t SBO_S5H = (size_t)NB * 32 * 2 * NCH * 128 * 4;
constexpr size_t SBO_GS = al256(2 * SBO_S5H);
constexpr size_t SBO_GU = 0;
constexpr size_t SBO_GDEC = al256((size_t)NB * 4 * 2 * NCH * 128 * 64 * 4);
constexpr size_t SBO_GCUM = al256(SBO_GDEC + (size_t)NB * 4 * 2 * NCH * 64 * 4);

#ifdef CPU_EMU
#define DEVFN static inline
#define MEMFN inline
#else
#define DEVFN __device__ __forceinline__
#define MEMFN __device__ __forceinline__
#endif
DEVFN unsigned fbits(float f) { return __builtin_bit_cast(unsigned, f); }
DEVFN float bitsf(unsigned u) { return __builtin_bit_cast(float, u); }
DEVFN bf16 f2bf(float f) { unsigned u = fbits(f); u += 0x7fffu + ((u >> 16) & 1u); return (bf16)(u >> 16); }
DEVFN float bf2f(bf16 h) { return bitsf((unsigned)h << 16); }
DEVFN unsigned pack2(float lo, float hi) {
#ifdef CPU_EMU
    return (unsigned)f2bf(lo) | ((unsigned)f2bf(hi) << 16);
#else
    typedef __bf16 bf16v2_ __attribute__((ext_vector_type(2)));
    return __builtin_bit_cast(unsigned, __builtin_convertvector((f32x2){lo, hi}, bf16v2_));
#endif
}
DEVFN float fexp2(float x) {
#ifdef CPU_EMU
    return exp2f(x);
#else
    return __builtin_amdgcn_exp2f(x);
#endif
}
DEVFN float fexp(float x) { return fexp2(x * 1.4426950408889634f); }
DEVFN float flog2(float x) {
#ifdef CPU_EMU
    return log2f(x);
#else
    return __builtin_amdgcn_logf(x);
#endif
}
DEVFN float sigmoidf_(float x) { return 1.0f / (1.0f + fexp(-x)); }
DEVFN float siluf_(float x) { return x / (1.0f + fexp(-x)); }
DEVFN float geluf_(float x) { const float u = 0.7978845608028654f * (x + 0.044715f * x * x * x); return x / (1.0f + fexp(-2.0f * u)); }

DEVFN float logsigf_(float x) { return fminf(x, 0.f) - 0.6931471805599453f * flog2(1.0f + fexp(-fabsf(x))); }
DEVFN f32x4 mfma16(bf16x8 a, bf16x8 b, f32x4 c) {
#ifdef CPU_EMU
    return emu_mfma16(a, b, c);
#else
    return __builtin_amdgcn_mfma_f32_16x16x32_bf16(a, b, c, 0, 0, 0);
#endif
}
DEVFN f32x16 mfma32(bf16x8 a, bf16x8 b, f32x16 c) {
#ifdef CPU_EMU
    return emu_mfma32(a, b, c);
#else
    return __builtin_amdgcn_mfma_f32_32x32x16_bf16(a, b, c, 0, 0, 0);
#endif
}
DEVFN void sched_fence() {
#ifndef CPU_EMU
    __builtin_amdgcn_sched_barrier(0);
#endif
}
DEVFN bool wave_all(bool c) {
#ifdef CPU_EMU
    int v = c ? 1 : 0; v &= __shfl_xor(v, 32); v &= __shfl_xor(v, 16); v &= __shfl_xor(v, 8); v &= __shfl_xor(v, 4); v &= __shfl_xor(v, 2); v &= __shfl_xor(v, 1); return v != 0;
#else
    return __all(c);
#endif
}
DEVFN float wave_sum(float v) {
#ifdef CPU_EMU
    v += __shfl_xor(v, 32); v += __shfl_xor(v, 16); v += __shfl_xor(v, 8); v += __shfl_xor(v, 4); v += __shfl_xor(v, 2); v += __shfl_xor(v, 1); return v;
#else
#define WS_DPP(x, ctrl) bitsf((unsigned)__builtin_amdgcn_update_dpp(0, (int)fbits(x), ctrl, 0xF, 0xF, true))
    v += WS_DPP(v, 0xB1); v += WS_DPP(v, 0x4E); v += WS_DPP(v, 0x141); v += WS_DPP(v, 0x140);
#undef WS_DPP
    const int iv = (int)fbits(v);
    return bitsf((unsigned)__builtin_amdgcn_readlane(iv, 0)) + bitsf((unsigned)__builtin_amdgcn_readlane(iv, 16)) + bitsf((unsigned)__builtin_amdgcn_readlane(iv, 32)) + bitsf((unsigned)__builtin_amdgcn_readlane(iv, 48));
#endif
}

struct Params { const float* in[N_IN]; float* out; unsigned char* ws; };

constexpr int LDS_BYTES = 128 * 1024;
constexpr int LDS_TOTAL = LDS_BYTES + 16;
#ifdef CPU_EMU
#define DECL_LDS unsigned char* lds = emu::cur_blk->lds
#define GRID_SYNC() emu::grid_barrier()
#else
#define DECL_LDS extern __shared__ __attribute__((aligned(16))) unsigned char lds[]
#define XB_TMO      128
#define XB_XCNT(j)  (256  + 64 * (j))
#define XB_XSUB(j)  (1280 + 64 * (j))
#define XB_XGEN(j)  (2304 + 64 * (j))
#define XB_TOP      3328
#define XB_TOPGEN   3392
#define XCD_BAR_WORDS 3456
#define XB_SPIN_CAP (1u << 18)
#define LAS __attribute__((address_space(3)))

__device__ __forceinline__ unsigned xb_ld(unsigned* p)              { return __hip_atomic_load(p, __ATOMIC_RELAXED, __HIP_MEMORY_SCOPE_AGENT); }
__device__ __forceinline__ unsigned xb_add(unsigned* p, unsigned v) { return __hip_atomic_fetch_add(p, v, __ATOMIC_RELAXED, __HIP_MEMORY_SCOPE_AGENT); }
__device__ __forceinline__ unsigned xb_xcc_id() { return (unsigned)__builtin_amdgcn_s_getreg((3 << 11) | 20) & 0xFu; }
#define XB_SPIN(cond, bar) do { unsigned _sp = 0; while (cond) { __builtin_amdgcn_s_sleep(1); \
    if ((++_sp & 255u) == 0u) { if (xb_ld(&(bar)[XB_TMO])) break; if (_sp > XB_SPIN_CAP) { atomicAdd(&(bar)[XB_TMO], 1u); break; } } } } while (0)

struct XcdBarrier {
    unsigned* bar; unsigned x;
    volatile LAS unsigned* st;
};

__device__ __forceinline__ XcdBarrier xcd_barrier_post(unsigned* bar, volatile LAS unsigned* st) {
    XcdBarrier b; b.bar = bar; b.x = xb_xcc_id(); b.st = st;
    if (threadIdx.x == 0) (void)xb_add(&bar[XB_XCNT(b.x)], 1u);
    return b;
}
__device__ __forceinline__ void xcd_barrier_complete(unsigned* bar, unsigned x, unsigned& nloc, unsigned& nx) {
    const unsigned G = gridDim.x * gridDim.y * gridDim.z;
    unsigned sum, cnt, mine, sp = 0u;
    for (;;) {
        sum = 0u; cnt = 0u; mine = 0u;
#pragma unroll
        for (unsigned j = 0; j < 16; ++j) { const unsigned c = xb_ld(&bar[XB_XCNT(j)]); sum += c; cnt += (c > 0u) ? 1u : 0u; mine = (j == x) ? c : mine; }
        if (sum == G) break;
        __builtin_amdgcn_s_sleep(1);
        if ((++sp & 255u) == 0u) { if (xb_ld(&bar[XB_TMO])) break; if (sp > XB_SPIN_CAP) { atomicAdd(&bar[XB_TMO], 1u); break; } }
    }
    nloc = mine > 0u ? mine : 1u; nx = cnt > 0u ? cnt : 1u;
}

__device__ __forceinline__ void xcd_barrier(const XcdBarrier& b) {
    asm volatile("s_waitcnt vmcnt(0)" ::: "memory");
    __syncthreads();
    if (threadIdx.x == 0) {
        unsigned* bar = b.bar;
        __builtin_amdgcn_s_waitcnt(0);
        unsigned nloc = b.st[0], nx = b.st[1];
        if (nloc == 0u) { xcd_barrier_complete(bar, b.x, nloc, nx); b.st[0] = nloc; b.st[1] = nx; }
        const unsigned old = xb_add(&bar[XB_XSUB(b.x)], 1u);
        const unsigned gen = old / nloc;
        if (old + 1u == (gen + 1u) * nloc) {
            __builtin_amdgcn_fence(__ATOMIC_RELEASE, "agent");
            asm volatile("s_waitcnt vmcnt(0)" ::: "memory");
            const unsigned og = xb_add(&bar[XB_TOP], 1u);
            const unsigned tg = og / nx;
            if (og + 1u == (tg + 1u) * nx) xb_add(&bar[XB_TOPGEN], 1u);
            else XB_SPIN(xb_ld(&bar[XB_TOPGEN]) == tg, bar);
            __builtin_amdgcn_fence(__ATOMIC_ACQUIRE, "agent");
            xb_add(&bar[XB_XGEN(b.x)], 1u);
            asm volatile("s_waitcnt vmcnt(0)" ::: "memory");
        } else {
            XB_SPIN(xb_ld(&bar[XB_XGEN(b.x)]) == gen, bar);
            __builtin_amdgcn_fence(__ATOMIC_ACQUIRE, "agent");
            asm volatile("s_waitcnt vmcnt(0)" ::: "memory");
        }
    }
    __syncthreads();
}

#define GRID_SYNC() xcd_barrier(gbar)
#endif

DEVFN int tidx() { int t = (int)threadIdx.x;
#ifndef CPU_EMU
    asm volatile("" : "+v"(t));
#endif
    return t; }
template <class ColSrc, class DstFn>
DEVFN void conv_group(unsigned char* lds, int nmat, int K, int N, int ld_src, ColSrc colsrc, DstFn dstfn) {
    float* t = (float*)lds;
    const int tid = tidx(), G = gridDim.x, nkt = K / 64, nnt = N / 128, units = nmat * nkt * nnt; float r[16];
    auto load = [&](int u) { const int mat = u / (nkt * nnt), rem = u % (nkt * nnt), k0 = (rem % nkt) * 64, n0 = (rem / nkt) * 128;
#pragma unroll
        for (int it = 0; it < 16; ++it) { const int idx = it * NTH + tid, kl = idx >> 7, nl = idx & 127; const float* sp = colsrc(mat, n0 + nl); r[it] = sp ? __builtin_nontemporal_load(sp + (size_t)(k0 + kl) * ld_src) : 0.f; } };
    int u = blockIdx.x; if (u < units) load(u);
    for (; u < units; u += G) {
        __syncthreads();
#pragma unroll
        for (int it = 0; it < 16; ++it) { const int idx = it * NTH + tid, kl = idx >> 7, nl = idx & 127; t[kl * 129 + nl] = r[it]; }
        if (u + G < units) load(u + G);
        __syncthreads();
        const int mat = u / (nkt * nnt), rem = u % (nkt * nnt), k0 = (rem % nkt) * 64, n0 = (rem / nkt) * 128; bf16* dst = dstfn(mat);
#pragma unroll
        for (int it = 0; it < 8; ++it) { const int idx = it * NTH + tid, nl = idx >> 5, kp = idx & 31; __builtin_nontemporal_store(pack2(t[(2 * kp) * 129 + nl], t[(2 * kp + 1) * 129 + nl]), (unsigned*)(dst + (size_t)(n0 + nl) * K + k0 + 2 * kp)); }
    }
}

DEVFN void phase_convert(const Params& p, unsigned char* lds) {
    const int G = gridDim.x, bid = blockIdx.x;
    conv_group(lds, NE, D, EVEN_N, EVEN_N, [&](int j, int n) { return p.in[I_EWIN] + (size_t)j * D * EVEN_N + n; }, [&](int j) { return (bf16*)(p.ws + WS_WIN) + (size_t)(2 * j) * WIN_LSTRIDE; });
    if (NO > 0) conv_group(lds, NO, D, ODD_NP, ODD_N, [&](int j, int n) -> const float* { const float* src = p.in[I_OWIN] + (size_t)j * D * ODD_N; return n < 1536 ? src + n : (n < 3072 ? src + n + 32 : (n < 3104 ? src + 1536 + (n - 3072) : nullptr)); },
                           [&](int j) { return (bf16*)(p.ws + WS_WIN) + (size_t)(2 * j + 1) * WIN_LSTRIDE; });
    conv_group(lds, NL, D, D, D, [&](int l, int n) { return ((l & 1) ? p.in[I_OWOUT] : p.in[I_EWOUT]) + (size_t)(l >> 1) * D * D + n; }, [&](int l) { return (bf16*)(p.ws + WS_WOUT) + (size_t)l * D * D; });
    conv_group(lds, NE, 512, 1024, 1024, [&](int j, int n) { return p.in[I_GLUW] + (size_t)j * 512 * 1024 + ((n & 31) >> 4) * 512 + (n >> 5) * 16 + (n & 15); }, [&](int j) { return (bf16*)(p.ws + WS_GLU) + (size_t)j * 1024 * 512; });
    conv_group(lds, NL * NEXP, D, 512, 256, [&](int e, int n) { return (((n & 31) >> 4) ? p.in[I_WUP] : p.in[I_WGATE]) + (size_t)e * D * 256 + (n >> 5) * 16 + (n & 15); }, [&](int e) { return (bf16*)(p.ws + WS_MGU) + (size_t)e * 512 * 1024; });
    conv_group(lds, NL * NEXP, 256, D, D, [&](int e, int n) { return p.in[I_WDOWN] + (size_t)e * 256 * D + n; }, [&](int e) { return (bf16*)(p.ws + WS_MDN) + (size_t)e * 1024 * 256; });
    {
        float* sv = (float*)lds;
        __syncthreads();
        for (int i = tidx(); i < (NB + 1) * D; i += NTH) { const int r = i / D, k = i % D; const float v = r < NB ? p.in[I_C][r * D + k] : p.in[I_CCTX][k]; sv[i] = siluf_(v); }
        __syncthreads();
        float* modv = (float*)(p.ws + WS_MODV);
        for (int u = bid; u < NL * 96; u += G) { const int l = u / 96, cg = u % 96; const int cl = tidx() & 63, col = cg * 64 + cl, ks = tidx() >> 6;
            const float* w = p.in[I_MODW] + (size_t)l * D * 6144 + col; float acc[NB + 1];
#pragma unroll
            for (int r = 0; r <= NB; ++r) acc[r] = 0.f;
#pragma unroll 8
            for (int k = ks * 128; k < ks * 128 + 128; ++k) { const float wv = w[(size_t)k * 6144];
#pragma unroll
                for (int r = 0; r <= NB; ++r) acc[r] += sv[r * D + k] * wv; }
            float* red = (float*)(lds + 32768);
            __syncthreads();
#pragma unroll
            for (int r = 0; r <= NB; ++r) red[(ks * (NB + 1) + r) * 64 + cl] = acc[r];
            __syncthreads();
            for (int i = tidx(); i < (NB + 1) * 64; i += NTH) { const int r = i >> 6, c = i & 63; const int cc = cg * 64 + c; float sum = p.in[I_MODB][(size_t)l * 6144 + cc];
#pragma unroll
                for (int q = 0; q < 8; ++q) sum += red[(q * (NB + 1) + r) * 64 + c];
                modv[((size_t)l * (NB + 1) + r) * 6144 + cc] = sum; }
            __syncthreads();
        }
    }
    for (int i = bid * NTH + tidx(); i < 1024; i += G * NTH) { const float ang = (float)(i >> 4) * expf(-(float)(i & 15) * (9.210340371976184f / 16.0f)); float sn, cs; sincosf(ang, &sn, &cs); float* rt = (float*)(p.ws + WS_ROPE); rt[i] = cs; rt[1024 + i] = sn; }
    for (int i = bid * NTH + tidx(); i < NE * 2 * 32 * 64; i += G * NTH) {
        const int pidx = i & 63, g = (i >> 6) & 31, jd = i >> 11;
        const float lre = p.in[I_LAMRE][i], lim = p.in[I_LAMIM][i], dt = expf(p.in[I_LOGDT][jd * 32 + g]);
        const float mag = expf(lre * dt), are = mag * cosf(lim * dt), aim = mag * sinf(lim * dt);
        const float magL = expf(lre * dt * 64.f), aLre = magL * cosf(lim * dt * 64.f), aLim = magL * sinf(lim * dt * 64.f);
        const float den = lre * lre + lim * lim;
        const float fre = ((are - 1.0f) * lre + aim * lim) / den, fim = (aim * lre - (are - 1.0f) * lim) / den;
        float* o = (float*)(p.ws + WS_S5P) + (size_t)i * S5P_STRIDE;
        o[0] = are; o[1] = aim; o[2] = aLre; o[3] = aLim;
        const float* bre = p.in[I_BRE] + (size_t)i * 16; const float* bim = p.in[I_BIM] + (size_t)i * 16;
        for (int h = 0; h < 16; ++h) { o[4 + h] = fre * bre[h] - fim * bim[h]; o[20 + h] = fre * bim[h] + fim * bre[h]; }
    }
}

DEVFN void mod_store_row(const Params& p, int layer, int which  , int row, const float (&h)[16], bf16* dstrow) {
    const int b = row / PT, pp = row % PT, mr = pp < LC ? NB : b, lane = tidx() & 63;
    const float* mv = (const float*)(p.ws + WS_MODV) + ((size_t)layer * (NB + 1) + mr) * 6144 + which * 3072;
#pragma unroll
    for (int i = 0; i < 4; ++i) { const int c = i * 256 + lane * 4; const f32x4 sh = *(const f32x4*)(mv + c), sc = *(const f32x4*)(mv + 1024 + c);
        u32x2 w; w.x = pack2(h[i * 4 + 0] * (1.f + sc[0]) + sh[0], h[i * 4 + 1] * (1.f + sc[1]) + sh[1]); w.y = pack2(h[i * 4 + 2] * (1.f + sc[2]) + sh[2], h[i * 4 + 3] * (1.f + sc[3]) + sh[3]);
        *(u32x2*)(dstrow + c) = w; }
}
DEVFN void phase_init_h(const Params& p) {
    const int wave = tidx() >> 6, lane = tidx() & 63; bf16* H = (bf16*)(p.ws + WS_H); bf16* A = (bf16*)(p.ws + WS_ABF);
    auto srcrow = [&](int row) { const int b = row / PT, pp = row % PT; return pp < LC ? p.in[I_CTX] + ((size_t)b * LC + pp) * D : p.in[I_X] + ((size_t)b * TS + (pp - LC)) * D; };
    f32x4 nx[4];
    int row = blockIdx.x * 8 + wave;
    if (row < MR) { const float* src = srcrow(row);
#pragma unroll
        for (int i = 0; i < 4; ++i) nx[i] = *(const f32x4*)(src + i * 256 + lane * 4); }
    for (; row < MR; row += gridDim.x * 8) { float h[16]; f32x4 cv[4];
#pragma unroll
        for (int i = 0; i < 4; ++i) cv[i] = nx[i];
        if (row + (int)gridDim.x * 8 < MR) { const float* src = srcrow(row + gridDim.x * 8);
#pragma unroll
            for (int i = 0; i < 4; ++i) nx[i] = *(const f32x4*)(src + i * 256 + lane * 4); }
#pragma unroll
        for (int i = 0; i < 4; ++i) { const f32x4 v = cv[i]; { u32x2 w; w.x = pack2(v[0], v[1]); w.y = pack2(v[2], v[3]); *(u32x2*)(H + (size_t)row * D + i * 256 + lane * 4) = w; } h[i * 4] = v[0]; h[i * 4 + 1] = v[1]; h[i * 4 + 2] = v[2]; h[i * 4 + 3] = v[3]; }
        mod_store_row(p, 0, 0, row, h, A + (size_t)row * D); }
}

DEVFN int lds_sw(int row, int ch) { return row * 128 + ((ch ^ (row & 7)) << 4); }
DEVFN void dma16(const void* g, unsigned char* l) {
#ifdef CPU_EMU
    memcpy(l + (emu::cur->lin & 63) * 16, g, 16);
#else
    __builtin_amdgcn_global_load_lds((const unsigned*)g, (LAS unsigned*)l, 16, 0, 0);
#endif
}
template <int N> DEVFN void dma_wait_barrier() {
#ifdef CPU_EMU
    __syncthreads();
#else
    asm volatile("s_waitcnt vmcnt(%0) lgkmcnt(0)" :: "n"(N) : "memory"); __builtin_amdgcn_s_barrier(); asm volatile("" ::: "memory");
#endif
}
template <int WM> struct GemmPtrs { const bf16* pa[WM]; const bf16* pb[2]; };
template <int WM, class RowA>
DEVFN void gemm_begin(unsigned char* lds, RowA rowA, const bf16* Bt, int K, int n0, GemmPtrs<WM>& g) {
    constexpr int NA = WM, ABYTES = WM * 8192, BUF = ABYTES + 16384;
    const int tid = tidx(), wave = tid >> 6;
#ifdef CPU_EMU
    const int wvu = wave;
#else
    const int wvu = __builtin_amdgcn_readfirstlane(wave);
#endif
#pragma unroll
    for (int i = 0; i < NA; ++i) { const int idx = i * NTH + tid, row = idx >> 3, ch = (idx & 7) ^ (row & 7); g.pa[i] = rowA(row) + ch * 8; }
#pragma unroll
    for (int i = 0; i < 2; ++i) { const int idx = i * NTH + tid, row = idx >> 3, ch = (idx & 7) ^ (row & 7); g.pb[i] = Bt + (size_t)(n0 + row) * K + ch * 8; }
#pragma unroll
    for (int t = 0; t < 2; ++t) {
#pragma unroll
        for (int i = 0; i < NA; ++i) dma16(g.pa[i] + t * 64, lds + t * BUF + (i * NTH + wvu * 64) * 16);
#pragma unroll
        for (int i = 0; i < 2; ++i) dma16(g.pb[i] + t * 64, lds + t * BUF + ABYTES + (i * NTH + wvu * 64) * 16); }
}
template <int WM, bool SWAP, class Hook, class Epi>
DEVFN void gemm_run(unsigned char* lds, const GemmPtrs<WM>& g, int K, Hook hook, Epi epi) {
    constexpr int WN = 8 / WM, NG = WM / 2, NA = WM, ABYTES = WM * 8192, BUF = ABYTES + 16384;
    static_assert(3 * BUF <= LDS_BYTES, "GEMM LDS");
    const int tid = tidx(), lane = tid & 63, wave = tid >> 6, wr = wave / WN, wc = wave % WN, fr = lane & 15, fg = lane >> 4;
#ifdef CPU_EMU
    const int wvu = wave;
#else
    const int wvu = __builtin_amdgcn_readfirstlane(wave);
#endif
    f32x4 acc[4][2 * NG];
#pragma unroll
    for (int m = 0; m < 4; ++m)
#pragma unroll
        for (int n = 0; n < 2 * NG; ++n) acc[m][n] = (f32x4){0.f, 0.f, 0.f, 0.f};
    const int nk = K / 64;
#define GM_DMA(kt, buf) do { _Pragma("unroll") for (int i = 0; i < NA; ++i) dma16(g.pa[i] + (kt) * 64, lds + (buf) + (i * NTH + wvu * 64) * 16); \
        _Pragma("unroll") for (int i = 0; i < 2; ++i) dma16(g.pb[i] + (kt) * 64, lds + (buf) + ABYTES + (i * NTH + wvu * 64) * 16); } while (0)
#define GM_COMPUTE(cur) do { _Pragma("unroll") for (int ks = 0; ks < 2; ++ks) { bf16x8 a[4], b[2 * NG]; \
        _Pragma("unroll") for (int m = 0; m < 4; ++m) a[m] = *(const bf16x8*)(lds + (cur) + lds_sw(wr * 64 + m * 16 + fr, ks * 4 + fg)); \
        _Pragma("unroll") for (int n = 0; n < 2 * NG; ++n) b[n] = *(const bf16x8*)(lds + (cur) + ABYTES + lds_sw(wc * 32 * NG + n * 16 + fr, ks * 4 + fg)); \
        _Pragma("unroll") for (int m = 0; m < 4; ++m) _Pragma("unroll") for (int n = 0; n < 2 * NG; ++n) acc[m][n] = SWAP ? mfma16(b[n], a[m], acc[m][n]) : mfma16(a[m], b[n], acc[m][n]); } } while (0)
    dma_wait_barrier<NA + 2>();
    int cur = 0, nxt2 = 2 * BUF;
    for (int kt = 0; kt < nk; ++kt) {
        if (kt + 2 < nk) GM_DMA(kt + 2, nxt2);
        GM_COMPUTE(cur);
        if (kt + 2 < nk) dma_wait_barrier<NA + 2>(); else dma_wait_barrier<0>();
        nxt2 = cur; cur = cur + BUF >= 3 * BUF ? 0 : cur + BUF;
    }
#undef GM_DMA
#undef GM_COMPUTE
    hook();
#pragma unroll
    for (int m = 0; m < 4; ++m)
#pragma unroll
        for (int g2 = 0; g2 < NG; ++g2) { if (SWAP) epi(wr * 64 + m * 16 + fr, wc * 32 * NG + g2 * 32 + 4 * fg, acc[m][2 * g2], acc[m][2 * g2 + 1]); else epi(wr * 64 + m * 16 + 4 * fg, wc * 32 * NG + g2 * 32, acc[m][2 * g2], acc[m][2 * g2 + 1]); }
}

namespace pg8 {
constexpr int BM = 256, BK = 64, HALF = 128, HTB = HALF * BK * 2  , STAGE_BYTES = 8 * HTB, NXCD = 8, WGM = 8;
DEVFN int lds_byte(int r, int c) { const int st = (r >> 4) * 2 + (c >> 5), rr = r & 15, cc = c & 31, ob = rr * 64 + cc * 2; return st * 1024 + (ob ^ (((ob >> 9) & 1) << 5)); }
DEVFN void stage_rc(int b, int& R, int& C) { const int st = b / 1024, sb = b % 1024, swz = sb ^ (((sb >> 9) & 1) << 5); R = (st >> 1) * 16 + swz / 64; C = (st & 1) * 32 + (swz % 64) / 2; }
struct Unit { int pm, pn; };
struct Gemm { const bf16* A; const bf16* Bt; int M, N, K; };
struct StaticOrder {
    int nM, nN, nwg, G, c;
    MEMFN void init(int M, int N, int G_, int c_) { nM = M / BM; nN = N / BM; nwg = nM * nN; G = G_; c = c_; }
    MEMFN bool next(int i, Unit& u) const {
        const long L = (long)i * G + c; if (L >= nwg) return false;
        int wgid = (int)L; { const int q = nwg / NXCD, r = nwg % NXCD, xcd = wgid % NXCD, off = wgid / NXCD; wgid = (xcd < r ? xcd * (q + 1) : r * (q + 1) + (xcd - r) * q) + off; }
        const int nig = WGM * nN, gid = wgid / nig, fm = gid * WGM, gsz = (nM - fm) < WGM ? (nM - fm) : WGM;
        u.pm = fm + ((wgid % nig) % gsz); u.pn = (wgid % nig) / gsz; return true;
    }
};
#ifdef CPU_EMU
#define PG8_WAIT_V(n) do {} while (0)
#define PG8_WAIT_L(n) do {} while (0)
#define PG8_BAR __syncthreads()
#define PG8_SCHED do {} while (0)
#define PG8_PRIO(x) do {} while (0)
#else
#define PG8_WAIT_V(n) asm volatile("s_waitcnt vmcnt(" #n ")" ::: "memory")
#define PG8_WAIT_L(n) asm volatile("s_waitcnt lgkmcnt(" #n ")" ::: "memory")
#define PG8_BAR __builtin_amdgcn_s_barrier()
#define PG8_SCHED __builtin_amdgcn_sched_barrier(0)
#define PG8_PRIO(x) __builtin_amdgcn_s_setprio(x)
#endif
template <class Epi, class Sched>
DEVFN void gemm_phase(unsigned char* lds, const Gemm g, const Sched& S, const Epi& E) {
    const int tid = tidx();
#ifdef CPU_EMU
    const int wid = tid >> 6;
#else
    const int wid = __builtin_amdgcn_readfirstlane(tid >> 6);
#endif
    const int lane = tid & 63, wr = wid >> 2, wc = wid & 3, fr = lane & 15, fq = lane >> 4;
    const int K = g.K, nt = K / BK;
    unsigned voffA[2], voffB[2];
#pragma unroll
    for (int i = 0; i < 2; ++i) { int R, C; stage_rc(tid * 16 + i * 8192, R, C); voffA[i] = (unsigned)(R * K + C) * 2u; voffB[i] = voffA[i]; }
    const size_t kstep = (size_t)(BK * 2);
    const size_t hstep = (size_t)HALF * K * 2;
    const size_t tstep = 2 * hstep;
    const unsigned ldsw = (unsigned)wid * 1024u;
    const int aoff = lds_byte(wr * 64 + fr, fq * 8), boff = lds_byte(wc * 32 + fr, fq * 8);
#define PG8_SA(b, h) (((b) * 2 + (h)) * HTB)
#define PG8_SB(b, h) ((4 + (b) * 2 + (h)) * HTB)
#define PG8_STAGE(bufoff, gbase, voff) do { _Pragma("unroll") for (int _i = 0; _i < 2; ++_i) dma16((const char*)(gbase) + (voff)[_i], lds + (bufoff) + ldsw + _i * 8192); } while (0)
#define PG8_LDA(dst, b, h) do { _Pragma("unroll") for (int m = 0; m < 4; ++m) _Pragma("unroll") for (int k = 0; k < 2; ++k) dst[m][k] = *(const bf16x8*)(lds + PG8_SA(b, h) + aoff + m * 2048 + k * 1024); } while (0)
#define PG8_LDB(dst, b, h) do { _Pragma("unroll") for (int n = 0; n < 2; ++n) _Pragma("unroll") for (int k = 0; k < 2; ++k) dst[n][k] = *(const bf16x8*)(lds + PG8_SB(b, h) + boff + n * 2048 + k * 1024); } while (0)
#define PG8_MMA(ai, bj, At, Bt) do { PG8_PRIO(1); _Pragma("unroll") for (int m = 0; m < 4; ++m) _Pragma("unroll") for (int n = 0; n < 2; ++n) _Pragma("unroll") for (int k = 0; k < 2; ++k) \
        acc[ai][bj][m][n] = mfma16(Bt[n][k], At[m][k], acc[ai][bj][m][n]); PG8_PRIO(0); } while (0)
    Unit cur, nxt; int ui = 0;
    __syncthreads();
    if (!S.next(0, cur)) return;
    f32x4 acc[2][2][4][2];
#pragma unroll
    for (int a = 0; a < 2; ++a)
#pragma unroll
        for (int b = 0; b < 2; ++b)
#pragma unroll
            for (int m = 0; m < 4; ++m)
#pragma unroll
                for (int n = 0; n < 2; ++n) acc[a][b][m][n] = (f32x4){0.f, 0.f, 0.f, 0.f};
    bf16x8 At[4][2], B0[2][2], B1[2][2];
    const char* cA = (const char*)g.A + (size_t)cur.pm * tstep; const char* cB = (const char*)g.Bt + (size_t)cur.pn * tstep;
    PG8_STAGE(PG8_SB(0, 0), cB, voffB); PG8_STAGE(PG8_SA(0, 0), cA, voffA); PG8_STAGE(PG8_SB(0, 1), cB + hstep, voffB); PG8_STAGE(PG8_SA(0, 1), cA + hstep, voffA);
    if (wr == 1) PG8_BAR;
    PG8_WAIT_V(4); PG8_BAR;
    PG8_STAGE(PG8_SB(1, 0), cB + kstep, voffB); PG8_STAGE(PG8_SA(1, 0), cA + kstep, voffA); PG8_STAGE(PG8_SB(1, 1), cB + hstep + kstep, voffB);
    PG8_WAIT_V(6); PG8_BAR;
    for (;;) {
        const bool has_next = S.next(ui + 1, nxt);
        const char* nA = has_next ? (const char*)g.A + (size_t)nxt.pm * tstep : cA; const char* nB = has_next ? (const char*)g.Bt + (size_t)nxt.pn * tstep : cB;
        for (int t = 0; t < nt; t += 2) {
            const bool last = (t == nt - 2);
            const char* a1 = cA + (size_t)(t + 1) * kstep;
            const char* a2 = last ? nA : cA + (size_t)(t + 2) * kstep; const char* b2 = last ? nB : cB + (size_t)(t + 2) * kstep;
            const char* a3 = a2 + kstep; const char* b3 = b2 + kstep;
            PG8_LDB(B0, 0, 0); PG8_SCHED; PG8_LDA(At, 0, 0); PG8_STAGE(PG8_SA(1, 1), a1 + hstep, voffA);
            PG8_WAIT_L(8); PG8_BAR; PG8_WAIT_L(0); PG8_MMA(0, 0, At, B0); PG8_BAR; PG8_SCHED;
            PG8_LDB(B1, 0, 1); PG8_STAGE(PG8_SB(0, 0), b2, voffB);
            PG8_BAR; PG8_WAIT_L(0); PG8_MMA(0, 1, At, B1); PG8_BAR;
            PG8_LDA(At, 0, 1); PG8_STAGE(PG8_SA(0, 0), a2, voffA);
            PG8_BAR; PG8_WAIT_L(0); PG8_MMA(1, 0, At, B0); PG8_BAR; PG8_SCHED;
            PG8_STAGE(PG8_SB(0, 1), b2 + hstep, voffB);
            PG8_WAIT_V(6); PG8_BAR; PG8_MMA(1, 1, At, B1); PG8_BAR;
            PG8_LDB(B0, 1, 0); PG8_SCHED; PG8_LDA(At, 1, 0); PG8_STAGE(PG8_SA(0, 1), a2 + hstep, voffA);
            PG8_WAIT_L(8); PG8_BAR; PG8_WAIT_L(0); PG8_MMA(0, 0, At, B0); PG8_BAR; PG8_SCHED;
            PG8_LDB(B1, 1, 1); PG8_STAGE(PG8_SB(1, 0), b3, voffB);
            PG8_BAR; PG8_WAIT_L(0); PG8_MMA(0, 1, At, B1); PG8_BAR;
            PG8_LDA(At, 1, 1); PG8_STAGE(PG8_SA(1, 0), a3, voffA);
            PG8_BAR; PG8_WAIT_L(0); PG8_MMA(1, 0, At, B0); PG8_BAR; PG8_SCHED;
            PG8_STAGE(PG8_SB(1, 1), b3 + hstep, voffB);
            PG8_WAIT_V(6); PG8_BAR; PG8_MMA(1, 1, At, B1); PG8_BAR;
        }
        E(acc, cur, wr, wc, fr, fq);
        if (!has_next) break;
#pragma unroll
        for (int a = 0; a < 2; ++a)
#pragma unroll
            for (int b = 0; b < 2; ++b)
#pragma unroll
                for (int m = 0; m < 4; ++m)
#pragma unroll
                    for (int n = 0; n < 2; ++n) acc[a][b][m][n] = (f32x4){0.f, 0.f, 0.f, 0.f};
        cur = nxt; cA = nA; cB = nB; ++ui;
    }
    PG8_WAIT_V(0);
    if (wr == 0) PG8_BAR;
    PG8_BAR;
#undef PG8_SA
#undef PG8_SB
#undef PG8_STAGE
#undef PG8_LDA
#undef PG8_LDB
#undef PG8_MMA
}
template <class F> struct EpiFn { F f;
    MEMFN void operator()(const f32x4 (&acc)[2][2][4][2], const Unit& u, int wr, int wc, int fr, int fq) const {
#pragma unroll
        for (int ai = 0; ai < 2; ++ai)
#pragma unroll
            for (int m = 0; m < 4; ++m)
#pragma unroll
                for (int bj = 0; bj < 2; ++bj) f(u.pm * BM + ai * HALF + wr * 64 + m * 16 + fr, u.pn * BM + bj * HALF + wc * 32 + 4 * fq, acc[ai][bj][m][0], acc[ai][bj][m][1]); }
};
struct LatentOrder {
    int nN, nwg, G, c;
    MEMFN void init(int N, int G_, int c_) { nN = N / BM; nwg = (TS / BM) * NB * nN; G = G_; c = c_; }
    MEMFN bool next(int i, Unit& u) const { const long L = (long)i * G + c; if (L >= nwg) return false; const int lp = (int)(L / nN); u.pn = (int)(L % nN); u.pm = (lp / (TS / BM)) * (PT / BM) + LC / BM + lp % (TS / BM); return true; }
};
template <class F> DEVFN void run_latent(unsigned char* lds, const bf16* A, const bf16* Bt, int M, int N, int K, F f) {
    Gemm g{A, Bt, M, N, K}; LatentOrder S; S.init(N, (int)gridDim.x, (int)blockIdx.x); EpiFn<F> E{f}; gemm_phase(lds, g, S, E);
}
template <class F> DEVFN void run(unsigned char* lds, const bf16* A, const bf16* Bt, int M, int N, int K, F f) {
    Gemm g{A, Bt, M, N, K}; StaticOrder S; S.init(M, N, (int)gridDim.x, (int)blockIdx.x); EpiFn<F> E{f}; gemm_phase(lds, g, S, E);
}
}

DEVFN int vperm(int pp) { return (pp & ~12) | ((pp & 4) << 1) | ((pp & 8) >> 1); }
DEVFN f32x4 load4b(const bf16* src) { const u32x2 w = *(const u32x2*)src; return (f32x4){bitsf(w.x << 16), bitsf(w.x & 0xffff0000u), bitsf(w.y << 16), bitsf(w.y & 0xffff0000u)}; }
DEVFN void store4s(bf16* dst, const f32x4& v, float sc) { u32x2 w; w.x = pack2(v[0] * sc, v[1] * sc); w.y = pack2(v[2] * sc, v[3] * sc); *(u32x2*)dst = w; }
DEVFN void store4_t(bf16* dst, const f32x4& v) { u32x2 w; w.x = pack2(v[0], v[1]); w.y = pack2(v[2], v[3]); *(u32x2*)dst = w; }

constexpr int GW_INE = 2, GW_INO = 2, GW_OUT = 2, GW_GLU = 2;
constexpr bool SPLIT_CTX = (LC % 256 == 0) && (PT % 256 == 0);
template <class RB, class F> DEVFN void gemm_small_rows(unsigned char* lds, const bf16* A, int lda, const bf16* Bt, int nnt, int K, int nrt, RB rowbase, F f) {
    const int NU = nrt * nnt; GemmPtrs<2> gp, gq;
    auto begin = [&](int u, GemmPtrs<2>& g) { const int m0 = rowbase(u / nnt), n0 = (u % nnt) * 128; gemm_begin<2>(lds, [&](int r) { return A + (size_t)(m0 + r) * lda; }, Bt, K, n0, g); };
    __syncthreads();
    if ((int)blockIdx.x < NU) begin(blockIdx.x, gp);
    for (int u = blockIdx.x; u < NU; u += gridDim.x, gp = gq) { const int m0 = rowbase(u / nnt), n0 = (u % nnt) * 128;
        gemm_run<2, true>(lds, gp, K, [&]() { if (u + (int)gridDim.x < NU) begin(u + gridDim.x, gq); }, [&](int rl, int cl, const f32x4& a0, const f32x4& a1) { f(m0 + rl, n0 + cl, a0, a1); }); }
}
template <class F> DEVFN void gemm_ctx_rows(unsigned char* lds, const bf16* A, int lda, const bf16* Bt, int N, int K, F f) {
    constexpr int RT = LC / 128; gemm_small_rows(lds, A, lda, Bt, N / 128, K, NB * RT, [&](int rt) { return (rt / RT) * PT + (rt % RT) * 128; }, f);
}
template <class F> DEVFN void dense_gemm(unsigned char* lds, const bf16* A, const bf16* Bt, int N, int K, bool ctx_needed, F f) {
    if constexpr (SPLIT_CTX) { pg8::run_latent(lds, A, Bt, MR, N, K, f); if (ctx_needed) gemm_ctx_rows(lds, A, K, Bt, N, K, f); }
    else pg8::run(lds, A, Bt, MR, N, K, f);
}
DEVFN void scatter4_t(bf16* base, size_t rowstride, const f32x4& v) {
#pragma unroll
    for (int e = 0; e < 4; ++e) base[(size_t)e * rowstride] = f2bf(v[e]);
}
DEVFN void phase_inproj_even(const Params& p, unsigned char* lds, int l) {
    const bf16* A = (const bf16*)(p.ws + WS_ABF); const bf16* Bt = (const bf16*)(p.ws + WS_WIN) + (size_t)l * WIN_LSTRIDE; bf16* Z = (bf16*)(p.ws + WS_Z);
    dense_gemm(lds, A, Bt, EVEN_N, D, true, [&](int row, int col, const f32x4& a0, const f32x4& a1) {
        const int region = col >> 9, cc = col & 511;
        if (region == 3) { const int b = row / PT, pp = row % PT;
            bf16* vb = Z + ZE_VT + ((size_t)(b * 8 + (cc >> 6)) * 64 + (cc & 63)) * PT + vperm(pp); scatter4_t(vb, PT, a0); scatter4_t(vb + (size_t)16 * PT, PT, a1); }
        else { bf16* dst = Z + (region == 0 ? ZE_U : region == 1 ? ZE_Q : ZE_K) + (size_t)row * 512 + cc; const float sc = region == 1 ? QSCALE : 1.0f; store4s(dst, a0, sc); store4s(dst + 16, a1, sc); } });
}

DEVFN void phase_inproj_odd(const Params& p, unsigned char* lds, int l) {
    const bf16* A = (const bf16*)(p.ws + WS_ABF); const bf16* Bt = (const bf16*)(p.ws + WS_WIN) + (size_t)l * WIN_LSTRIDE; bf16* Z = (bf16*)(p.ws + WS_Z);
    const int fg = (tidx() & 63) >> 4;
    const float* rtab = (const float*)(p.ws + WS_ROPE);
    auto epi = [&](int row, int cb, const f32x4& a0, const f32x4& a1) {
        const int b = row / PT, pp = row % PT;
        if (cb < 256) { store4s(Z + ZO_GQ + (size_t)row * 256 + cb, a0, 0.125f); store4s(Z + ZO_GQ + (size_t)row * 256 + cb + 16, a1, 0.125f); }
        else if (cb < 512) { const int c = cb - 256;
            store4s(Z + ZO_GK + (size_t)row * 256 + c, a0, 1.0f); store4s(Z + ZO_GK + (size_t)row * 256 + c + 16, a1, 1.0f);
            bf16* kb = Z + ZO_GKT + ((size_t)(b * 4 + (c >> 6)) * 64 + (c & 63)) * PT + pp; scatter4_t(kb, PT, a0); scatter4_t(kb + (size_t)16 * PT, PT, a1); }
        else if (cb < 1024) { const int c = cb - 512; bf16* vb = Z + ZO_GVT + ((size_t)(b * 4 + (c >> 7)) * 128 + (c & 127)) * PT + pp; scatter4_t(vb, PT, a0); scatter4_t(vb + (size_t)16 * PT, PT, a1); }
        else if (cb < 1536) { store4s(Z + ZO_GR + (size_t)row * 512 + cb - 1024, a0, 1.0f); store4s(Z + ZO_GR + (size_t)row * 512 + cb - 1024 + 16, a1, 1.0f); }
        else if (cb < 2560) {
            const bool isq = cb < 2048; const int c0 = cb - (isq ? 1536 : 2048); const int blk = (c0 >> 5) & 1; bf16* dst = Z + (isq ? ZO_DQ : ZO_DK) + (size_t)row * 512 + c0; const float sc = isq ? QSCALE : 1.0f;
            f32x4 x1 = a0 * sc, x2 = a1 * sc;
            if (pp >= LC) { const int t = pp - LC; const int pos = blk == 0 ? (t >> 6) : (t & 63); const f32x4 cs = *(const f32x4*)(rtab + pos * 16 + 4 * fg), sn = *(const f32x4*)(rtab + 1024 + pos * 16 + 4 * fg);
                const f32x4 o1 = x1 * cs - x2 * sn, o2 = x1 * sn + x2 * cs; x1 = o1; x2 = o2; }
            store4s(dst, x1, 1.0f); store4s(dst + 16, x2, 1.0f); }
        else if (cb < 3072) { const int c = cb - 2560; bf16* vb = Z + ZO_DVT + ((size_t)(b * 4 + (c >> 7)) * 128 + (c & 127)) * PT + vperm(pp); scatter4_t(vb, PT, a0); scatter4_t(vb + (size_t)16 * PT, PT, a1); }
        else if (cb < 3072 + 16) { store4s(Z + ZO_GZ + (size_t)row * 32 + (cb - 3072), a0, 1.0f); store4s(Z + ZO_GZ + (size_t)row * 32 + (cb - 3072) + 16, a1, 1.0f); } };
    if constexpr (SPLIT_CTX) {
        dense_gemm(lds, A, Bt, 3072, D, true, epi);
        gemm_small_rows(lds, A, D, Bt + (size_t)3072 * D, 1, D, MR / 128, [&](int rt) { return rt * 128; },
                        [&](int row, int col, const f32x4& a0, const f32x4& a1) { epi(row, 3072 + col, a0, a1); });
    } else pg8::run(lds, A, Bt, MR, ODD_NP, D, epi);
}

DEVFN void phase_glu(const Params& p, unsigned char* lds, int j) {
    const bf16* A = (const bf16*)(p.ws + WS_SB + SBO_GS); const bf16* Bt = (const bf16*)(p.ws + WS_GLU) + (size_t)j * 1024 * 512; bf16* Y = (bf16*)(p.ws + WS_YMIX);
    const float* gb = p.in[I_GLUB] + (size_t)j * 1024;
    dense_gemm(lds, A, Bt, 1024, 512, true, [&](int row, int col, const f32x4& a0, const f32x4& a1) {
        const int jj = (col >> 5) * 16 + (col & 15); const f32x4 bv = *(const f32x4*)(gb + jj), bg = *(const f32x4*)(gb + 512 + jj); f32x4 o;
#pragma unroll
        for (int r = 0; r < 4; ++r) o[r] = (a0[r] + bv[r]) * sigmoidf_(a1[r] + bg[r]);
        store4s(Y + (size_t)row * D + jj, o, 1.0f); });
}

constexpr int OPS = 4;
constexpr size_t OP_PSTRIDE = (size_t)NB * LC * D;
static_assert(!SPLIT_CTX || OPS * OP_PSTRIDE * 4 <= (size_t)2 * MR * D * 2, "split-K partials must fit the MoE output region");
DEVFN void outproj_ctx_splitk(unsigned char* lds, const bf16* A, const bf16* Bt, float* P) {
    constexpr int RT = LC / 128, NNT = D / 128, NU = NB * RT * NNT * OPS, KS = D / OPS;
    GemmPtrs<2> gp, gq;
    auto begin = [&](int u, GemmPtrs<2>& g) { const int s = u % OPS, t = u / OPS, rt = t / NNT, n0 = (t % NNT) * 128, m0 = (rt / RT) * PT + (rt % RT) * 128;
        gemm_begin<2>(lds, [&](int r) { return A + (size_t)(m0 + r) * D + s * KS; }, Bt + s * KS, D, n0, g); };
    __syncthreads();
    if ((int)blockIdx.x < NU) begin(blockIdx.x, gp);
    for (int u = blockIdx.x; u < NU; u += gridDim.x, gp = gq) { const int s = u % OPS, t = u / OPS, rt = t / NNT, n0 = (t % NNT) * 128, c0 = (rt / RT) * LC + (rt % RT) * 128;
        gemm_run<2, true>(lds, gp, KS, [&]() { if (u + (int)gridDim.x < NU) begin(u + gridDim.x, gq); }, [&](int rl, int cl, const f32x4& a0, const f32x4& a1) {
            float* dst = P + (size_t)s * OP_PSTRIDE + (size_t)(c0 + rl) * D + n0 + cl; *(f32x4*)dst = a0; *(f32x4*)(dst + 16) = a1; }); }
}
DEVFN void phase_outproj(const Params& p, unsigned char* lds, int l) {
    const bf16* A = (const bf16*)(p.ws + WS_YMIX); const bf16* Bt = (const bf16*)(p.ws + WS_WOUT) + (size_t)l * D * D; bf16* C = (bf16*)(p.ws + WS_Z);
    auto epi = [&](int row, int col, const f32x4& a0, const f32x4& a1) { bf16* dst = C + (size_t)row * D + col; store4s(dst, a0, 1.0f); store4s(dst + 16, a1, 1.0f); };
    if constexpr (SPLIT_CTX) { pg8::run_latent(lds, A, Bt, MR, D, D, epi); outproj_ctx_splitk(lds, A, Bt, (float*)(p.ws + WS_SB)); }
    else dense_gemm(lds, A, Bt, D, D, true, epi);
}

struct MoeMap { int e, mt, cnt, off; };
DEVFN bool moe_find(const unsigned* cnt, int tile, MoeMap& mm) {
    int acc = 0;
    for (int e = 0; e < NEXP; ++e) { const int c = (int)cnt[e], nt = (c + 127) >> 7; if (tile < acc + nt) { mm.e = e; mm.mt = tile - acc; mm.cnt = c; mm.off = acc * 128; return true; } acc += nt; }
    return false;
}
DEVFN int moe_off(const unsigned* cnt, int e) { int acc = 0; for (int i = 0; i < e; ++i) acc += ((int)cnt[i] + 127) >> 7; return acc * 128; }
constexpr int MOE_TAB = 3 * 32768;
DEVFN const unsigned* moe_table(unsigned char* lds, const unsigned* cnt) {
    unsigned* tab = (unsigned*)(lds + MOE_TAB);
    __syncthreads();
    if (tidx() < NEXP) tab[tidx()] = cnt[tidx()];
    __syncthreads();
    return tab;
}

DEVFN void phase_moe_up(const Params& p, unsigned char* lds, int l) {
    const bf16* A = (const bf16*)(p.ws + WS_ABF); bf16* ACT = (bf16*)(p.ws + WS_ACT); const unsigned* cnt = (const unsigned*)(p.ws + WS_CTL + CTL_CNT) + l * NEXP;
    const int* ltok = (const int*)(p.ws + WS_LTOK); const float* lw = (const float*)(p.ws + WS_LW); const unsigned* tab = moe_table(lds, cnt);
    GemmPtrs<2> gp, gq; MoeMap mm, mn;
    auto begin = [&](const MoeMap& m, int nt, GemmPtrs<2>& g) { const bf16* Bt = (const bf16*)(p.ws + WS_MGU) + (size_t)(l * NEXP + m.e) * 512 * 1024; const int* lt = ltok + (size_t)m.e * MR;
        gemm_begin<2>(lds, [&](int r) { const int slot = m.mt * 128 + r; const int tok = lt[slot < m.cnt ? slot : 0]; return A + (size_t)tok * D; }, Bt, D, nt * 128, g); };
    int u = blockIdx.x; bool ok = moe_find(tab, u >> 2, mm);
    if (ok) begin(mm, u & 3, gp);
    while (ok) { const int un = u + gridDim.x; const bool okn = moe_find(tab, un >> 2, mn); const int n0 = (u & 3) * 128;
        gemm_run<2, true>(lds, gp, D, [&]() { if (okn) begin(mn, un & 3, gq); }, [&](int rl, int cl, const f32x4& a0, const f32x4& a1) {
            const int jj = ((n0 + cl) >> 5) * 16 + (cl & 15), slot = mm.mt * 128 + rl;
            if (slot < mm.cnt) { const float w = lw[(size_t)mm.e * MR + slot]; f32x4 o;
#pragma unroll
                for (int r = 0; r < 4; ++r) o[r] = siluf_(a0[r]) * a1[r] * w;
                store4s(ACT + (size_t)(mm.off + slot) * 256 + jj, o, 1.0f); } });
        gp = gq; mm = mn; ok = okn; u = un; }
}
DEVFN void phase_moe_down(const Params& p, unsigned char* lds, int l) {
    const bf16* ACT = (const bf16*)(p.ws + WS_ACT); bf16* F2 = (bf16*)(p.ws + WS_SB); const unsigned* cnt = (const unsigned*)(p.ws + WS_CTL + CTL_CNT) + l * NEXP;
    const unsigned* tab = moe_table(lds, cnt);
    GemmPtrs<2> gp, gq; MoeMap mm, mn;
    auto begin = [&](const MoeMap& m, int nt, GemmPtrs<2>& g) { const bf16* Bt = (const bf16*)(p.ws + WS_MDN) + (size_t)(l * NEXP + m.e) * 1024 * 256; const size_t r0 = (size_t)m.off + m.mt * 128;
        gemm_begin<2>(lds, [&](int r) { return ACT + (r0 + r) * 256; }, Bt, 256, nt * 128, g); };
    int u = blockIdx.x; bool ok = moe_find(tab, u >> 3, mm);
    if (ok) begin(mm, u & 7, gp);
    while (ok) { const int un = u + gridDim.x; const bool okn = moe_find(tab, un >> 3, mn); const int n0 = (u & 7) * 128; const size_t r0 = (size_t)mm.off + mm.mt * 128;
        gemm_run<2, true>(lds, gp, 256, [&]() { if (okn) begin(mn, un & 7, gq); }, [&](int rl, int cl, const f32x4& a0, const f32x4& a1) {
            bf16* dst = F2 + (r0 + rl) * D + n0 + cl; store4s(dst, a0, 1.0f); store4s(dst + 16, a1, 1.0f); });
        gp = gq; mm = mn; ok = okn; u = un; }
}

DEVFN void ln_row(float (&v)[16], const float* g, const float* bta, int lane) {
    float s = 0.f;
#pragma unroll
    for (int i = 0; i < 16; ++i) s += v[i];
    const float mu = wave_sum(s) * (1.0f / 1024.0f); float q = 0.f;
#pragma unroll
    for (int i = 0; i < 16; ++i) { const float d = v[i] - mu; q += d * d; }
    const float rstd = 1.0f / sqrtf(wave_sum(q) * (1.0f / 1024.0f) + LN_EPS);
#pragma unroll
    for (int i = 0; i < 4; ++i) { const f32x4 gg = *(const f32x4*)(g + i * 256 + lane * 4), bb = *(const f32x4*)(bta + i * 256 + lane * 4);
#pragma unroll
        for (int e = 0; e < 4; ++e) v[i * 4 + e] = (v[i * 4 + e] - mu) * rstd * gg[e] + bb[e]; }
}

DEVFN void ln_row_r(float (&v)[16], const float (&g)[16], const float (&bta)[16]) {
    float s = 0.f;
#pragma unroll
    for (int i = 0; i < 16; ++i) s += v[i];
    const float mu = wave_sum(s) * (1.0f / 1024.0f); float q = 0.f;
#pragma unroll
    for (int i = 0; i < 16; ++i) { const float d = v[i] - mu; q += d * d; }
    const float rstd = 1.0f / sqrtf(wave_sum(q) * (1.0f / 1024.0f) + LN_EPS);
#pragma unroll
    for (int i = 0; i < 16; ++i) v[i] = (v[i] - mu) * rstd * g[i] + bta[i];
}
DEVFN void ln_load_gb(const float* g, const float* bta, int lane, float (&gr)[16], float (&br)[16]) {
#pragma unroll
    for (int i = 0; i < 4; ++i) { const f32x4 gg = *(const f32x4*)(g + i * 256 + lane * 4), bb = *(const f32x4*)(bta + i * 256 + lane * 4);
#pragma unroll
        for (int e = 0; e < 4; ++e) { gr[i * 4 + e] = gg[e]; br[i * 4 + e] = bb[e]; } }
}

DEVFN void phase_ln1_route(const Params& p, unsigned char* lds, int l) {
    const int wave = tidx() >> 6, lane = tidx() & 63; bf16* H = (bf16*)(p.ws + WS_H); const bf16* C = (const bf16*)(p.ws + WS_Z); bf16* A = (bf16*)(p.ws + WS_ABF);
    unsigned* cnt = (unsigned*)(p.ws + WS_CTL + CTL_CNT) + l * NEXP; int* route = (int*)(p.ws + WS_ROUTE); int* ltok = (int*)(p.ws + WS_LTOK); float* lw = (float*)(p.ws + WS_LW);
    const float* wg = p.in[I_WGRP] + (size_t)l * D * 4; const float* we = p.in[I_WEXP] + (size_t)l * D * 32;
    float* hrow = (float*)lds;
    float* part = (float*)(lds + 32768);
    const int ke = wave * 128 + (lane >> 5) * 64, kg = wave * 128 + (lane >> 2) * 8;
    f32x2 wreg[32], wgr[4];
#pragma unroll
    for (int i = 0; i < 32; ++i) wreg[i] = (f32x2){we[(size_t)(ke + 2 * i) * 32 + (lane & 31)], we[(size_t)(ke + 2 * i + 1) * 32 + (lane & 31)]};
#pragma unroll
    for (int i = 0; i < 4; ++i) wgr[i] = (f32x2){wg[(size_t)(kg + 2 * i) * 4 + (lane & 3)], wg[(size_t)(kg + 2 * i + 1) * 4 + (lane & 3)]};
    const float bias = lane < 32 ? p.in[I_BEXP][l * 32 + lane] : (lane < 36 ? p.in[I_BGRP][l * 4 + lane - 32] : 0.f);
    unsigned* lcnt = (unsigned*)(lds + 49152); unsigned* lbase = lcnt + 32; int* rt = (int*)(lds + 49152 + 256);
    constexpr int RT_MAX = 1024;
    __syncthreads();
    if (tidx() < 32) lcnt[tidx()] = 0u;
    __syncthreads();
    float lng[16], lnb[16]; ln_load_gb(p.in[I_LNG] + (size_t)(l * 2) * D, p.in[I_LNB] + (size_t)(l * 2) * D, lane, lng, lnb);
    int nrec = 0; u32x2 hn[4], yn[4];
    if (blockIdx.x * 8 < MR) {
#pragma unroll
        for (int i = 0; i < 4; ++i) { const size_t o = (size_t)(blockIdx.x * 8 + wave) * D + i * 256 + lane * 4; hn[i] = *(const u32x2*)(H + o); yn[i] = *(const u32x2*)(C + o); } }
    for (int r0 = blockIdx.x * 8; r0 < MR; r0 += gridDim.x * 8, ++nrec) { const int row = r0 + wave; const int b = row / PT, pp = row % PT, mr = pp < LC ? NB : b;
        const float* mv = (const float*)(p.ws + WS_MODV) + ((size_t)l * (NB + 1) + mr) * 6144; float v[16];
        const bool ctxp = SPLIT_CTX && pp < LC; const float* pb = (const float*)(p.ws + WS_SB) + (size_t)(b * LC + (ctxp ? pp : 0)) * D;
#pragma unroll
        for (int i = 0; i < 4; ++i) { const int c = i * 256 + lane * 4; const f32x4 g1 = *(const f32x4*)(mv + 2048 + c);
            const f32x4 h = (f32x4){bitsf(hn[i].x << 16), bitsf(hn[i].x & 0xffff0000u), bitsf(hn[i].y << 16), bitsf(hn[i].y & 0xffff0000u)};
            f32x4 y = (f32x4){bitsf(yn[i].x << 16), bitsf(yn[i].x & 0xffff0000u), bitsf(yn[i].y << 16), bitsf(yn[i].y & 0xffff0000u)};
            if (ctxp) y = (*(const f32x4*)(pb + c) + *(const f32x4*)(pb + OP_PSTRIDE + c)) + (*(const f32x4*)(pb + 2 * OP_PSTRIDE + c) + *(const f32x4*)(pb + 3 * OP_PSTRIDE + c));
#pragma unroll
            for (int e = 0; e < 4; ++e) v[i * 4 + e] = ALPHA * h[e] + g1[e] * y[e]; }
        if (r0 + gridDim.x * 8 < MR) {
#pragma unroll
            for (int i = 0; i < 4; ++i) { const size_t o = (size_t)(row + gridDim.x * 8) * D + i * 256 + lane * 4; hn[i] = *(const u32x2*)(H + o); yn[i] = *(const u32x2*)(C + o); } }
        f32x4 shv[4], scv[4];
#pragma unroll
        for (int i = 0; i < 4; ++i) { const int c = i * 256 + lane * 4; shv[i] = *(const f32x4*)(mv + 3072 + c); scv[i] = *(const f32x4*)(mv + 4096 + c); }
        ln_row_r(v, lng, lnb);
        __syncthreads();
#pragma unroll
        for (int i = 0; i < 4; ++i) { const int c = i * 256 + lane * 4; { u32x2 hw; hw.x = pack2(v[i * 4], v[i * 4 + 1]); hw.y = pack2(v[i * 4 + 2], v[i * 4 + 3]); __builtin_nontemporal_store(hw, (u32x2*)(H + (size_t)row * D + c)); }
            const f32x4 sh = shv[i], sc = scv[i]; f32x4 h2;
#pragma unroll
            for (int e = 0; e < 4; ++e) h2[e] = v[i * 4 + e] * (1.f + sc[e]) + sh[e];
            *(f32x4*)(hrow + wave * 1024 + c) = h2;
            u32x2 w; w.x = pack2(h2[0], h2[1]); w.y = pack2(h2[2], h2[3]); *(u32x2*)(A + (size_t)row * D + c) = w; }
        __syncthreads();
#pragma unroll
        for (int r = 0; r < 8; ++r) { f32x2 ae2 = {0.f, 0.f}, ae3 = {0.f, 0.f}, ag2 = {0.f, 0.f};
#pragma unroll
            for (int i = 0; i < 64; i += 4) { const f32x4 hv = *(const f32x4*)(hrow + r * 1024 + ke + i);
                ae2 = __builtin_elementwise_fma((f32x2){hv[0], hv[1]}, wreg[i >> 1], ae2); ae3 = __builtin_elementwise_fma((f32x2){hv[2], hv[3]}, wreg[(i >> 1) + 1], ae3); }
#pragma unroll
            for (int i = 0; i < 8; i += 4) { const f32x4 hv = *(const f32x4*)(hrow + r * 1024 + kg + i);
                ag2 = __builtin_elementwise_fma((f32x2){hv[0], hv[1]}, wgr[i >> 1], ag2); ag2 = __builtin_elementwise_fma((f32x2){hv[2], hv[3]}, wgr[(i >> 1) + 1], ag2); }
            float ae = (ae2[0] + ae3[0]) + (ae2[1] + ae3[1]), ag = ag2[0] + ag2[1];
            ae += __shfl_xor(ae, 32);
            ag += __shfl_xor(ag, 4); ag += __shfl_xor(ag, 8); ag += __shfl_xor(ag, 16); ag += __shfl_xor(ag, 32);
            if (lane < 32) part[(wave * 8 + r) * 64 + lane] = ae; else if (lane < 36) part[(wave * 8 + r) * 64 + lane] = ag;
        }
        __syncthreads();
        float logit = bias;
#pragma unroll
        for (int w8 = 0; w8 < 8; ++w8) logit += part[(w8 * 8 + wave) * 64 + lane];
        float lg[4];
#pragma unroll
        for (int o = 0; o < 4; ++o) lg[o] = __shfl(logit, 32 + o);
        int gs = 0; float gm = lg[0];
#pragma unroll
        for (int o = 1; o < 4; ++o) if (lg[o] > gm) { gm = lg[o]; gs = o; }
        float den = 0.f;
#pragma unroll
        for (int o = 0; o < 4; ++o) den += fexp(lg[o] - gm);
        const float pg = 1.0f / den;
        float li[8];
#pragma unroll
        for (int e = 0; e < 8; ++e) li[e] = __shfl(logit, gs * 8 + e);
        int i0 = 0; float v0 = li[0];
#pragma unroll
        for (int e = 1; e < 8; ++e) if (li[e] > v0) { v0 = li[e]; i0 = e; }
        int i1 = -1; float v1 = -3.0e38f;
#pragma unroll
        for (int e = 0; e < 8; ++e) if (e != i0 && li[e] > v1) { v1 = li[e]; i1 = e; }
        if (i1 < 0) i1 = (i0 + 1) & 7;
        const float w0 = 1.0f / (1.0f + fexp(v1 - v0)), w1 = 1.0f - w0;
        if (lane == 0) { const int e0 = gs * 8 + i0, e1 = gs * 8 + i1; const int rec = nrec * 8 + wave;
            if (rec < RT_MAX) { int* q = rt + rec * 6; q[0] = e0; q[1] = e1; q[2] = (int)fbits(w0 * pg); q[3] = (int)fbits(w1 * pg); q[4] = (int)atomicAdd(&lcnt[e0], 1u); q[5] = (int)atomicAdd(&lcnt[e1], 1u); } }
    }
    __syncthreads();
    if (tidx() < 32) lbase[tidx()] = atomicAdd(&cnt[tidx()], lcnt[tidx()]);
    __syncthreads();
    for (int rec = tidx(); rec < nrec * 8 && rec < RT_MAX; rec += NTH) { const int row = (blockIdx.x + (rec >> 3) * gridDim.x) * 8 + (rec & 7); const int* q = rt + rec * 6;
        const int e0 = q[0], e1 = q[1], s0 = (int)lbase[e0] + q[4], s1 = (int)lbase[e1] + q[5];
        ltok[(size_t)e0 * MR + s0] = row; lw[(size_t)e0 * MR + s0] = bitsf((unsigned)q[2]); ltok[(size_t)e1 * MR + s1] = row; lw[(size_t)e1 * MR + s1] = bitsf((unsigned)q[3]);
        route[row * 4 + 0] = e0; route[row * 4 + 1] = e1; route[row * 4 + 2] = s0; route[row * 4 + 3] = s1; }
}

DEVFN void phase_ln2(const Params& p, unsigned char* lds, int l) {
    const int wave = tidx() >> 6, lane = tidx() & 63; bf16* H = (bf16*)(p.ws + WS_H); const bf16* F2 = (const bf16*)(p.ws + WS_SB); bf16* A = (bf16*)(p.ws + WS_ABF);
    const unsigned* cnt = (const unsigned*)(p.ws + WS_CTL + CTL_CNT) + l * NEXP; const int* route = (const int*)(p.ws + WS_ROUTE);
    int* offs = (int*)lds;
    __syncthreads();
    if (tidx() < NEXP) offs[tidx()] = moe_off(cnt, tidx());
    __syncthreads();
    float lng[16], lnb[16]; ln_load_gb(p.in[I_LNG] + (size_t)(l * 2 + 1) * D, p.in[I_LNB] + (size_t)(l * 2 + 1) * D, lane, lng, lnb);
    for (int rw = (blockIdx.x * 8 + wave) * 2; rw < MR; rw += gridDim.x * 16) {
        float v[2][16]; size_t r0[2], r1[2];
#pragma unroll
        for (int q = 0; q < 2; ++q) { const int row = rw + q; const int e0 = route[row * 4], e1 = route[row * 4 + 1]; r0[q] = (size_t)offs[e0] + route[row * 4 + 2]; r1[q] = (size_t)offs[e1] + route[row * 4 + 3]; }
#pragma unroll
        for (int q = 0; q < 2; ++q) { const int row = rw + q; const int b = row / PT, pp = row % PT, mr = pp < LC ? NB : b; const float* mv = (const float*)(p.ws + WS_MODV) + ((size_t)l * (NB + 1) + mr) * 6144;
#pragma unroll
            for (int i = 0; i < 4; ++i) { const int c = i * 256 + lane * 4; const f32x4 h = load4b(H + (size_t)row * D + c), g2 = *(const f32x4*)(mv + 5120 + c);
                const u32x2 fa = *(const u32x2*)(F2 + r0[q] * D + c), fb = *(const u32x2*)(F2 + r1[q] * D + c);
                const float f0 = bitsf(fa.x << 16) + bitsf(fb.x << 16), f1 = bitsf(fa.x & 0xffff0000u) + bitsf(fb.x & 0xffff0000u), f2 = bitsf(fa.y << 16) + bitsf(fb.y << 16), f3 = bitsf(fa.y & 0xffff0000u) + bitsf(fb.y & 0xffff0000u);
                v[q][i * 4] = ALPHA * h[0] + g2[0] * f0; v[q][i * 4 + 1] = ALPHA * h[1] + g2[1] * f1; v[q][i * 4 + 2] = ALPHA * h[2] + g2[2] * f2; v[q][i * 4 + 3] = ALPHA * h[3] + g2[3] * f3; } }
#pragma unroll
        for (int q = 0; q < 2; ++q) { const int row = rw + q; const int b = row / PT, pp = row % PT;
            ln_row_r(v[q], lng, lnb);
#pragma unroll
            for (int i = 0; i < 4; ++i) { const int c = i * 256 + lane * 4; const f32x4 o = (f32x4){v[q][i * 4], v[q][i * 4 + 1], v[q][i * 4 + 2], v[q][i * 4 + 3]};
                if (l + 1 < NL) { u32x2 hw; hw.x = pack2(o[0], o[1]); hw.y = pack2(o[2], o[3]); __builtin_nontemporal_store(hw, (u32x2*)(H + (size_t)row * D + c)); }
                else if (pp >= LC) __builtin_nontemporal_store(o, (f32x4*)(p.out + ((size_t)b * TS + (pp - LC)) * D + c)); }
            if (l + 1 < NL) mod_store_row(p, l + 1, 0, row, v[q], A + (size_t)row * D); }
    }
}

DEVFN void wave_sync() {
#ifdef CPU_EMU
    (void)__shfl(0, 0);
#else
    __builtin_amdgcn_fence(__ATOMIC_RELEASE, "wavefront"); asm volatile("s_waitcnt lgkmcnt(0)" ::: "memory"); __builtin_amdgcn_wave_barrier(); __builtin_amdgcn_fence(__ATOMIC_ACQUIRE, "wavefront");
#endif
}
DEVFN bf16x8 cvt8(const f32x4 lo, const f32x4 hi, float sg) { u32x4 w; w[0] = pack2(lo[0] * sg, lo[1] * sg); w[1] = pack2(lo[2] * sg, lo[3] * sg); w[2] = pack2(hi[0] * sg, hi[1] * sg); w[3] = pack2(hi[2] * sg, hi[3] * sg); return __builtin_bit_cast(bf16x8, w); }
constexpr int S5_WAVE_LDS = 16 * 132 * 4;
DEVFN void s5_chunk(const Params& p, float* buf, int j, int b, int g, int c, int lane, const bool READOUT, int dlo = 0, int dhi = 2, float* xch = nullptr) {
    const int fr = lane & 15, fg = lane >> 4; const bf16* U = (const bf16*)(p.ws + WS_Z) + ZE_U + ((size_t)b * PT + c * 64) * 512 + g * 16;
    f32x4 y[4], y2[4];
#pragma unroll
    for (int sb = 0; sb < 4; ++sb) { y[sb] = (f32x4){0.f, 0.f, 0.f, 0.f}; y2[sb] = (f32x4){0.f, 0.f, 0.f, 0.f}; }
#pragma unroll 1
    for (int d = dlo; d < dhi; ++d) { const size_t pbase = (size_t)((j * 2 + d) * 32 + g) * 64; const float* prm = (const float*)(p.ws + WS_S5P);
        bf16x8 bbf[8];
#pragma unroll
        for (int n = 0; n < 8; ++n) { const int pp = (n & 3) * 16 + fr; const float* src = prm + (pbase + pp) * S5P_STRIDE + (n < 4 ? 4 : 20) + (fg & 1) * 8;
            f32x4 lo = *(const f32x4*)src, hi = *(const f32x4*)(src + 4); if (fg >= 2) { lo = (f32x4){0.f, 0.f, 0.f, 0.f}; hi = lo; } bbf[n] = cvt8(lo, hi, 1.0f); }
        bf16x8 cf[4];
        if (READOUT) {
#pragma unroll
            for (int ks = 0; ks < 4; ++ks) { const float* src = (ks < 2 ? p.in[I_CRE] : p.in[I_CIM]) + (((size_t)(j * 2 + d) * 32 + g) * 16 + fr) * 64 + (ks & 1) * 32 + fg * 8;
                cf[ks] = cvt8(*(const f32x4*)src, *(const f32x4*)(src + 4), ks < 2 ? 1.0f : -1.0f); } }
        const float are = prm[(pbase + lane) * S5P_STRIDE], aim = prm[(pbase + lane) * S5P_STRIDE + 1];
        float hr = 0.f, hi = 0.f;
        if (READOUT) { const f32x2 h0 = *(const f32x2*)((const float*)(p.ws + WS_SB + SBO_S5H) + ((size_t)((b * 32 + g) * 2 + d) * NCH + c) * 128 + lane * 2); hr = h0[0]; hi = h0[1]; }
#pragma unroll
        for (int sbi = 0; sbi < 4; ++sbi) { const int sb = d ? 3 - sbi : sbi;
            u32x4 uv = (u32x4){0u, 0u, 0u, 0u}; if (fg < 2) uv = *(const u32x4*)(U + (size_t)(sb * 16 + fr) * 512 + fg * 8); const bf16x8 ua = __builtin_bit_cast(bf16x8, uv);
            f32x4 yy = (f32x4){0.f, 0.f, 0.f, 0.f};
            wave_sync();
#pragma unroll
            for (int n = 0; n < 8; ++n) { const f32x4 t4 = mfma16(ua, bbf[n], (f32x4){0.f, 0.f, 0.f, 0.f});
#pragma unroll
                for (int r = 0; r < 4; ++r) buf[(fg * 4 + r) * 132 + n * 16 + fr] = t4[r]; }
            wave_sync();
            for (int t0 = 0; t0 < 16; ++t0) { const int tt = d ? 15 - t0 : t0; const float ur = buf[tt * 132 + lane], ui = buf[tt * 132 + 64 + lane];
                const float nr = are * hr - aim * hi + ur, ni = are * hi + aim * hr + ui; hr = nr; hi = ni;
                buf[tt * 132 + lane] = hr; buf[tt * 132 + 64 + lane] = hi; }
            if (READOUT) { wave_sync();
#pragma unroll
                for (int ks = 0; ks < 4; ++ks) { const float* hp = buf + fr * 132 + ks * 32 + fg * 8; yy = mfma16(cf[ks], cvt8(*(const f32x4*)hp, *(const f32x4*)(hp + 4), 1.0f), yy); }
                if (d == 0) y[sbi] += yy; else y2[sbi] += yy; }
        }
        if (!READOUT) *(f32x2*)((float*)(p.ws + WS_SB + SBO_S5E) + ((size_t)((b * 32 + g) * 2 + d) * NCH + c) * 128 + lane * 2) = (f32x2){hr, hi};
    }
    if (READOUT && xch) {
        if (dlo == 1) {
#pragma unroll
            for (int sb = 0; sb < 4; ++sb) *(f32x4*)(xch + (sb * 64 + lane) * 4) = y2[sb];
            __syncthreads(); return; }
        __syncthreads();
#pragma unroll
        for (int sb = 0; sb < 4; ++sb) y2[sb] = *(const f32x4*)(xch + (sb * 64 + lane) * 4); }
    if (READOUT) { bf16* GS = (bf16*)(p.ws + WS_SB + SBO_GS); const f32x4 dsk = *(const f32x4*)(p.in[I_S5D] + (size_t)j * 512 + g * 16 + fg * 4);
#pragma unroll
        for (int sb = 0; sb < 4; ++sb) { const int t = sb * 16 + fr; const u32x2 uu = *(const u32x2*)(U + (size_t)t * 512 + fg * 4); f32x4 o; y[sb] += y2[3 - sb];
            o[0] = geluf_(y[sb][0] + dsk[0] * bitsf(uu.x << 16)); o[1] = geluf_(y[sb][1] + dsk[1] * bitsf(uu.x & 0xffff0000u));
            o[2] = geluf_(y[sb][2] + dsk[2] * bitsf(uu.y << 16)); o[3] = geluf_(y[sb][3] + dsk[3] * bitsf(uu.y & 0xffff0000u));
            store4_t(GS + ((size_t)b * PT + c * 64 + t) * 512 + g * 16 + fg * 4, o); } }
}
DEVFN void phase_s5a(const Params& p, unsigned char* lds, int j) {
    const int wave = tidx() >> 6, lane = tidx() & 63; float* buf = (float*)(lds + wave * S5_WAVE_LDS);
    const int NIT = NB * 32 * NCH, GW = gridDim.x * 8, full = (NIT / GW) * GW, wid = blockIdx.x * 8 + wave;
    for (int it = wid; it < full; it += GW) { const int c = it % NCH, g = (it / NCH) % 32, b = it / (NCH * 32); s5_chunk(p, buf, j, b, g, c, lane, false); }
    for (int pi = wid; pi < 2 * (NIT - full); pi += GW) { const int it = full + (pi >> 1), d = pi & 1; const int c = it % NCH, g = (it / NCH) % 32, b = it / (NCH * 32); s5_chunk(p, buf, j, b, g, c, lane, false, d, d + 1); }
}
constexpr int S5B_BS = 17;
DEVFN int chunk_order(int d, int k);
DEVFN void phase_s5b(const Params& p, int j) {
    const float* E = (const float*)(p.ws + WS_SB + SBO_S5E); float* Hin = (float*)(p.ws + WS_SB + SBO_S5H);
    constexpr int NBT = (NCH + S5B_BS - 1) / S5B_BS;
    int vb = blockIdx.x, vstep = gridDim.x;
    if (gridDim.x == 256 && NB * 32 * 2 * 64 == 32 * NTH) { const int m = blockIdx.x & 15; if (m != 0 && m != 15) return; vb = (blockIdx.x >> 4) * 2 + (m == 15 ? 1 : 0); vstep = 32; }
    for (int i = vb * NTH + tidx(); i < NB * 32 * 2 * 64; i += vstep * NTH) { const int pi = i & 63, d = (i >> 6) & 1, g = (i >> 7) & 31, b = i >> 12;
        const float* pr = (const float*)(p.ws + WS_S5P) + ((size_t)((j * 2 + d) * 32 + g) * 64 + pi) * S5P_STRIDE; const float aLr = pr[2], aLi = pr[3];
        const size_t base = (size_t)((b * 32 + g) * 2 + d) * NCH; float hr = 0.f, hi = 0.f;
        f32x2 en[S5B_BS];
#pragma unroll
        for (int x = 0; x < S5B_BS; ++x) { const int k = x < NCH ? x : NCH - 1; const int c = chunk_order(d, k); en[x] = *(const f32x2*)(E + (base + c) * 128 + pi * 2); }
#pragma unroll 1
        for (int kb = 0; kb < NBT; ++kb) { f32x2 e[S5B_BS];
#pragma unroll
            for (int x = 0; x < S5B_BS; ++x) e[x] = en[x];
            if (kb + 1 < NBT) {
#pragma unroll
                for (int x = 0; x < S5B_BS; ++x) { const int k = (kb + 1) * S5B_BS + x < NCH ? (kb + 1) * S5B_BS + x : NCH - 1; const int c = chunk_order(d, k); en[x] = *(const f32x2*)(E + (base + c) * 128 + pi * 2); } }
#pragma unroll
            for (int x = 0; x < S5B_BS; ++x) { const int k = kb * S5B_BS + x; if (k < NCH) { const int c = chunk_order(d, k);
                *(f32x2*)(Hin + (base + c) * 128 + pi * 2) = (f32x2){hr, hi};
                const float nr = aLr * hr - aLi * hi + e[x][0], ni = aLr * hi + aLi * hr + e[x][1]; hr = nr; hi = ni; } } }
    }
}
DEVFN void phase_s5c(const Params& p, unsigned char* lds, int j) {
    const int wave = tidx() >> 6, lane = tidx() & 63; float* buf = (float*)(lds + wave * S5_WAVE_LDS);
    const int NIT = NB * 32 * NCH, GW = gridDim.x * 8, full = (NIT / GW) * GW, rem = NIT - full;
    for (int it = blockIdx.x * 8 + wave; it < full; it += GW) { const int c = it % NCH, g = (it / NCH) % 32, b = it / (NCH * 32); s5_chunk(p, buf, j, b, g, c, lane, true); }
    float* xch = (float*)(lds + 8 * S5_WAVE_LDS) + (wave & 3) * 1024;
    for (int base = blockIdx.x * 4; base < rem; base += gridDim.x * 4) { const int ri = base + (wave & 3), d = wave >> 2;
        if (ri < rem) { const int it = full + ri; const int c = it % NCH, g = (it / NCH) % 32, b = it / (NCH * 32); s5_chunk(p, buf, j, b, g, c, lane, true, d, d + 1, xch); }
        else __syncthreads();
        __syncthreads(); }
}

template <int NDV> struct AttnState { float m, l; f32x16 o[NDV]; };
template <int NDV> DEVFN void attn_init(AttnState<NDV>& st) { st.m = -INFINITY; st.l = 0.f;
#pragma unroll
    for (int i = 0; i < NDV; ++i)
#pragma unroll
        for (int r = 0; r < 16; ++r) st.o[i][r] = 0.f; }
DEVFN float attn_softmax(float& m, float& l, f32x16 s, bf16x8 (&pb)[2]) {
    float mx = fmaxf(fmaxf(fmaxf(s[0], s[1]), fmaxf(s[2], s[3])), fmaxf(fmaxf(s[4], s[5]), fmaxf(s[6], s[7])));
    mx = fmaxf(mx, fmaxf(fmaxf(fmaxf(s[8], s[9]), fmaxf(s[10], s[11])), fmaxf(fmaxf(s[12], s[13]), fmaxf(s[14], s[15]))));
    mx = fmaxf(mx, __shfl_xor(mx, 32));
    const float mn = fmaxf(m, mx), ms = mn == -INFINITY ? 0.f : mn, corr = fexp2(m - ms);
    m = mn; float ps = 0.f;
#pragma unroll
    for (int r = 0; r < 16; ++r) { s[r] = fexp2(s[r] - ms); ps += s[r]; }
    ps += __shfl_xor(ps, 32);
    l = l * corr + ps;
#pragma unroll
    for (int ks = 0; ks < 2; ++ks) { u32x4 w;
#pragma unroll
        for (int jj = 0; jj < 4; ++jj) w[jj] = pack2(s[8 * ks + 2 * jj], s[8 * ks + 2 * jj + 1]);
        pb[ks] = __builtin_bit_cast(bf16x8, w); }
    return corr;
}
DEVFN bf16x8 cat4(const bf16x4 a, const bf16x4 b) { bf16x8 o;
#pragma unroll
    for (int jj = 0; jj < 4; ++jj) { o[jj] = a[jj]; o[4 + jj] = b[jj]; }
    return o; }
template <int NDV, class VLoad>
DEVFN void attn_update(AttnState<NDV>& st, f32x16 s, VLoad vload) {
    bf16x8 pb[2]; const float corr = attn_softmax(st.m, st.l, s, pb);
    if (!wave_all(corr == 1.0f)) {
#pragma unroll
        for (int i = 0; i < NDV; ++i)
#pragma unroll
            for (int r = 0; r < 16; ++r) st.o[i][r] *= corr; }
#pragma unroll
    for (int ks = 0; ks < 2; ++ks)
#pragma unroll
        for (int mt = 0; mt < NDV; ++mt) st.o[mt] = mfma32(vload(mt, ks), pb[ks], st.o[mt]);
}

DEVFN float attn_softmax2(float& m, float& l, f32x16 s0, f32x16 s1, bf16x8 (&pb0)[2], bf16x8 (&pb1)[2]) {
    float mx = fmaxf(s0[0], s1[0]);
#pragma unroll
    for (int r = 1; r < 16; ++r) mx = fmaxf(mx, fmaxf(s0[r], s1[r]));
    mx = fmaxf(mx, __shfl_xor(mx, 32));
    const float mn = fmaxf(m, mx), ms = mn == -INFINITY ? 0.f : mn, corr = fexp2(m - ms);
    m = mn; float ps = 0.f;
#pragma unroll
    for (int r = 0; r < 16; ++r) { s0[r] = fexp2(s0[r] - ms); s1[r] = fexp2(s1[r] - ms); ps += s0[r] + s1[r]; }
    ps += __shfl_xor(ps, 32);
    l = l * corr + ps;
#pragma unroll
    for (int ks = 0; ks < 2; ++ks) { u32x4 w0, w1;
#pragma unroll
        for (int jj = 0; jj < 4; ++jj) { w0[jj] = pack2(s0[8 * ks + 2 * jj], s0[8 * ks + 2 * jj + 1]); w1[jj] = pack2(s1[8 * ks + 2 * jj], s1[8 * ks + 2 * jj + 1]); }
        pb0[ks] = __builtin_bit_cast(bf16x8, w0); pb1[ks] = __builtin_bit_cast(bf16x8, w1); }
    return corr;
}
template <int NDV, class VLoad>
DEVFN void attn_update2(AttnState<NDV>& st, f32x16 s0, f32x16 s1, VLoad vload) {
    bf16x8 pb0[2], pb1[2]; const float corr = attn_softmax2(st.m, st.l, s0, s1, pb0, pb1);
    if (!wave_all(corr == 1.0f)) {
#pragma unroll
        for (int i = 0; i < NDV; ++i)
#pragma unroll
            for (int r = 0; r < 16; ++r) st.o[i][r] *= corr; }
#pragma unroll
    for (int ks = 0; ks < 2; ++ks)
#pragma unroll
        for (int mt = 0; mt < NDV; ++mt) { st.o[mt] = mfma32(vload(0, mt, ks), pb0[ks], st.o[mt]); st.o[mt] = mfma32(vload(1, mt, ks), pb1[ks], st.o[mt]); }
}

constexpr int NAT_STAGE = 16384, NAT_RING = 4, NAT_RPB = NAT_RING * NAT_STAGE;
DEVFN void phase_natten(const Params& p, unsigned char* lds, int j) {
    const int tid = tidx(), wave = tid >> 6, lane = tid & 63, ql = lane & 31, hh = lane >> 5;
#ifdef CPU_EMU
    const int wvu = wave;
#else
    const int wvu = __builtin_amdgcn_readfirstlane(wave);
#endif
    const bf16* Z = (const bf16*)(p.ws + WS_Z); const bf16* Q = Z + ZE_Q; const bf16* K = Z + ZE_K; const bf16* VT = Z + ZE_VT; bf16* Y = (bf16*)(p.ws + WS_YMIX);
    float* rpbs = (float*)(lds + NAT_RPB);
    constexpr int NRG = GROWS / 4, NLAT = NB * 8 * NRG, NCQ = (LC + 255) / 256, NCTX = NB * 8 * NCQ, NCT = LC / 64;
    const bool remap = gridDim.x == 256 && NLAT == 512 && NCTX == 32 && NRG == 16;
    for (int uu = blockIdx.x; uu < NLAT + (remap ? (int)gridDim.x : NCTX); uu += gridDim.x) { int u = uu;
        if (remap && uu >= NLAT) { const int m = blockIdx.x & 15; if (m != 0 && m != 15) break; u = NLAT + (blockIdx.x >> 4) * 2 + (m == 15 ? 1 : 0); }
        const bool lat = u < NLAT;
        int b, hd, r = 0, rs = 0, klo = 0, nloc = 0, qp; bool qvalid = true;
        if (lat) { const int rg = u % NRG; hd = (u / NRG) & 7; b = u / (NRG * 8); r = rg * 4 + (wave >> 1); rs = r - 4 < 0 ? 0 : (r - 4 > GROWS - 8 ? GROWS - 8 : r - 4);
            const int ra = rg * 4, rb = rg * 4 + 3; klo = ra - 4 < 0 ? 0 : (ra - 4 > GROWS - 8 ? GROWS - 8 : ra - 4); const int khi = (rb - 4 < 0 ? 0 : (rb - 4 > GROWS - 8 ? GROWS - 8 : rb - 4)) + 7; nloc = khi - klo + 1;
            qp = LC + r * 64 + (wave & 1) * 32 + ql; }
        else { const int v = u - NLAT; const int qt = v % NCQ; hd = (v / NCQ) & 7; b = v / (NCQ * 8); qp = qt * 256 + wave * 32 + ql; qvalid = qp < LC; if (!qvalid) qp = 0; }
        const size_t qrow = (size_t)b * PT + qp; const int ntile = nloc + NCT;
        __syncthreads();
        if (lat) for (int i = tid; i < 15 * 31; i += NTH) rpbs[i] = LOG2E * p.in[I_RPB][(size_t)(j * 8 + hd) * 15 * 31 + i];
        bf16x8 qf[4];
#pragma unroll
        for (int ks = 0; ks < 4; ++ks) qf[ks] = *(const bf16x8*)(Q + qrow * 512 + hd * 64 + ks * 16 + hh * 8);
        const int drow = tid >> 3, dch = (tid & 7) ^ (drow & 7);
        const bf16* ksrc = K + ((size_t)b * PT + drow) * 512 + hd * 64 + dch * 8; const bf16* vsrc = VT + ((size_t)(b * 8 + hd) * 64 + drow) * PT + dch * 8;
        auto tile_tok = [&](int t) { return t < nloc ? LC + (klo + t) * 64 : (t - nloc) * 64; };
#define NAT_DMA(t) do { const int tok_ = tile_tok(t); unsigned char* st_ = lds + ((t) & (NAT_RING - 1)) * NAT_STAGE + (wvu * 64) * 16; dma16(ksrc + (size_t)tok_ * 512, st_); dma16(vsrc + tok_, st_ + 8192); } while (0)
        AttnState<2> st; attn_init(st);
        const int cq = (wave & 1) * 32 + ql, cstart = cq - 8 < 0 ? 0 : (cq - 8 > 48 ? 48 : cq - 8);
        for (int t = 0; t < 3 && t < ntile; ++t) NAT_DMA(t);
        if (ntile >= 3) dma_wait_barrier<4>(); else if (ntile == 2) dma_wait_barrier<2>(); else dma_wait_barrier<0>();
        for (int t = 0; t < ntile; ++t) {
            if (t + 3 < ntile) NAT_DMA(t + 3);
            const bool loc = t < nloc; const int krow = klo + t; const bool active = !loc || (krow >= rs && krow <= rs + 7);
            if (active) { const unsigned char* sb = lds + (t & (NAT_RING - 1)) * NAT_STAGE;
#pragma unroll
                for (int s2 = 0; s2 < 2; ++s2) { f32x16 s;
#pragma unroll
                    for (int i = 0; i < 16; ++i) s[i] = 0.f;
#pragma unroll
                    for (int ks = 0; ks < 4; ++ks) s = mfma32(*(const bf16x8*)(sb + lds_sw(s2 * 32 + ql, ks * 2 + hh)), qf[ks], s);
                    if (loc) {
#pragma unroll
                        for (int i = 0; i < 16; ++i) { const int ck = s2 * 32 + (i & 3) + 8 * (i >> 2) + 4 * hh; const bool ok = ck >= cstart && ck < cstart + 16; const int dc = ok ? ck - cq + 15 : 0;
                            s[i] = ok ? s[i] + rpbs[(krow - r + 7) * 31 + dc] : -INFINITY; } }
                    attn_update<2>(st, s, [&](int mt, int ks) { return *(const bf16x8*)(sb + 8192 + lds_sw(mt * 32 + ql, s2 * 4 + ks * 2 + hh)); }); } }
            const int inflight = (t + 3 < ntile ? t + 3 : ntile - 1) - (t + 1);
            if (inflight >= 2) dma_wait_barrier<4>(); else if (inflight == 1) dma_wait_barrier<2>(); else dma_wait_barrier<0>();
        }
#undef NAT_DMA
        const float il = 1.0f / st.l;
        if (qvalid) {
#pragma unroll
            for (int mt = 0; mt < 2; ++mt)
#pragma unroll
                for (int q4 = 0; q4 < 4; ++q4) { const int dv = mt * 32 + 8 * q4 + 4 * hh; f32x4 o;
#pragma unroll
                    for (int k = 0; k < 4; ++k) o[k] = st.o[mt][q4 * 4 + k] * il;
                    store4_t(Y + qrow * D + 512 + hd * 64 + dv, o); } }
    }
}

DEVFN int chunk_order(int d, int k) { return d == 0 ? k : (k < NCC ? NCC - 1 - k : NCH - 1 - (k - NCC)); }
constexpr int GLR = 144;
constexpr int GL_CUM = 0, GL_ZZ = 32768, GL_PART = 32768 + 8192, GL_KT = 45056, GL_VT = GL_KT + 64 * GLR, GL_K = GL_VT + 128 * GLR, GL_Q = GL_K + 64 * GLR, GL_S = GL_Q + 64 * GLR, GL_SSQ = GL_S + 256 * GLR;
static_assert(GL_SSQ + 512 <= LDS_BYTES, "GLA LDS");
DEVFN bf16x8 scale8(const u32x4 raw, const float (&f)[8]) { u32x4 w;
#pragma unroll
    for (int i = 0; i < 4; ++i) w[i] = pack2(bitsf(raw[i] << 16) * f[2 * i], bitsf(raw[i] & 0xffff0000u) * f[2 * i + 1]);
    return __builtin_bit_cast(bf16x8, w); }
DEVFN void gl_stage(unsigned char* dst, const bf16* src, size_t ld, int rows, int tid) {
    for (int i = tid; i < rows * 8; i += NTH) { const int r = i >> 3, ch = i & 7; *(u32x4*)(dst + r * GLR + ch * 16) = *(const u32x4*)(src + (size_t)r * ld + ch * 8); }
}

DEVFN void phase_gla_a(const Params& p, unsigned char* lds, int j) {
    const int tid = tidx(), lane = tid & 63, wave = tid >> 6, fr = lane & 15, fg = lane >> 4; float* cum = (float*)(lds + GL_CUM); float* zz = (float*)(lds + GL_ZZ); float* part = (float*)(lds + GL_PART);
    const bf16* Z = (const bf16*)(p.ws + WS_Z); float* GU = (float*)(p.ws + WS_SB + SBO_GU); float* GDEC = (float*)(p.ws + WS_SB + SBO_GDEC); float* GCUM = (float*)(p.ws + WS_SB + SBO_GCUM);
    u32x2 pz; u32x4 pk, pv0, pv1; float pw[16], pgb;
#define GLA_A_FETCH(itx) { const int c_ = (itx) % NCH, hd_ = ((itx) / NCH) & 3, b_ = (itx) / (NCH * 4); \
        pz = *(const u32x2*)(Z + ZO_GZ + ((size_t)b_ * PT + c_ * 64) * 32 + tid * 4); \
        pk = *(const u32x4*)(Z + ZO_GKT + (size_t)(b_ * 4 + hd_) * 64 * PT + c_ * 64 + (size_t)(tid >> 3) * PT + (tid & 7) * 8); \
        const bf16* vs_ = Z + ZO_GVT + (size_t)(b_ * 4 + hd_) * 128 * PT + c_ * 64; \
        pv0 = *(const u32x4*)(vs_ + (size_t)(tid >> 3) * PT + (tid & 7) * 8); pv1 = *(const u32x4*)(vs_ + (size_t)(64 + (tid >> 3)) * PT + (tid & 7) * 8); \
        { const int d_ = tid >> 8, dk_ = (tid >> 2) & 63; const float* gw_ = p.in[I_GGW] + ((size_t)(j * 2 + d_) * 16) * 256 + hd_ * 64 + dk_; pgb = p.in[I_GGB][(size_t)(j * 2 + d_) * 256 + hd_ * 64 + dk_]; \
          _Pragma("unroll") for (int r = 0; r < 16; ++r) pw[r] = gw_[(size_t)r * 256]; } }
    if (blockIdx.x < NB * 4 * NCH) GLA_A_FETCH(blockIdx.x)
    for (int it = blockIdx.x; it < NB * 4 * NCH; it += gridDim.x) { const int c = it % NCH, hd = (it / NCH) & 3, b = it / (NCH * 4);
        __syncthreads();
        { f32x4 zf = (f32x4){bitsf(pz.x << 16), bitsf(pz.x & 0xffff0000u), bitsf(pz.y << 16), bitsf(pz.y & 0xffff0000u)}; *(f32x4*)(zz + tid * 4) = zf;
          *(u32x4*)(lds + GL_KT + (tid >> 3) * GLR + (tid & 7) * 16) = pk;
          *(u32x4*)(lds + GL_VT + (tid >> 3) * GLR + (tid & 7) * 16) = pv0; *(u32x4*)(lds + GL_VT + (64 + (tid >> 3)) * GLR + (tid & 7) * 16) = pv1; }
        float w[16]; const float gb = pgb;
#pragma unroll
        for (int r = 0; r < 16; ++r) w[r] = pw[r];
        if (it + (int)gridDim.x < NB * 4 * NCH) GLA_A_FETCH(it + gridDim.x)
        __syncthreads();
        { const int d = tid >> 8, dk = (tid >> 2) & 63, tg = tid & 3; float gl[16];
#pragma unroll
            for (int t = 0; t < 16; ++t) { float x = gb;
#pragma unroll
                for (int r = 0; r < 16; ++r) x += zz[(tg * 16 + t) * 32 + d * 16 + r] * w[r];
                gl[t] = logsigf_(x) * (1.0f / 16.0f); }
            if (d == 0) {
#pragma unroll
                for (int t = 1; t < 16; ++t) gl[t] += gl[t - 1];
                part[(d * 64 + dk) * 4 + tg] = gl[15];
            } else {
#pragma unroll
                for (int t = 14; t >= 0; --t) gl[t] += gl[t + 1];
                part[(d * 64 + dk) * 4 + tg] = gl[0]; }
            __syncthreads();
            float pre = 0.f;
#pragma unroll
            for (int q = 0; q < 4; ++q) { const bool inc = d == 0 ? q < tg : q > tg; pre += inc ? part[(d * 64 + dk) * 4 + q] : 0.f; }
            float* gc = GCUM + ((size_t)((b * 4 + hd) * NCH + c) * 2 + d) * 4096;
#pragma unroll
            for (int t = 0; t < 16; ++t) { const float v = gl[t] + pre; cum[(d * 64 + tg * 16 + t) * 64 + dk] = v; gc[(tg * 16 + t) * 64 + dk] = v; } }
        __syncthreads();
        bf16x8 va[2];
#pragma unroll
        for (int ks = 0; ks < 2; ++ks) va[ks] = *(const bf16x8*)(lds + GL_VT + (wave * 16 + fr) * GLR + (ks * 32 + fg * 8) * 2);
#pragma unroll
        for (int d = 0; d < 2; ++d) { const int tend = d ? 0 : 63;
#pragma unroll
            for (int n = 0; n < 4; ++n) { const int dk = n * 16 + fr; const float cend = cum[(d * 64 + tend) * 64 + dk]; f32x4 acc = (f32x4){0.f, 0.f, 0.f, 0.f};
#pragma unroll
                for (int ks = 0; ks < 2; ++ks) { const u32x4 raw = *(const u32x4*)(lds + GL_KT + dk * GLR + (ks * 32 + fg * 8) * 2); float f[8];
#pragma unroll
                    for (int e = 0; e < 8; ++e) f[e] = fexp(cend - cum[(d * 64 + ks * 32 + fg * 8 + e) * 64 + dk]);
                    acc = mfma16(va[ks], scale8(raw, f), acc); }
                float* dst = GU + ((size_t)(((b * 4 + hd) * 2 + d) * NCH + c) * 128 + wave * 16 + fg * 4) * 64 + dk;
#pragma unroll
                for (int r = 0; r < 4; ++r) dst[r * 64] = acc[r]; } }
        if (tid < 128) { const int d = tid >> 6, dk = tid & 63; GDEC[(size_t)(((b * 4 + hd) * 2 + d) * NCH + c) * 64 + dk] = fexp(cum[(d * 64 + (d ? 0 : 63)) * 64 + dk]); }
    }
#undef GLA_A_FETCH
}
constexpr int GLB_BS = 17;
DEVFN void phase_gla_b(const Params& p) {
    const float* GU = (const float*)(p.ws + WS_SB + SBO_GU); const float* GDEC = (const float*)(p.ws + WS_SB + SBO_GDEC); bf16* GSB = (bf16*)(p.ws + WS_H + (size_t)MR * D * 2);
    constexpr int NBT = (NCH + GLB_BS - 1) / GLB_BS, TOT = NB * 4 * 2 * 8192;
    const int GT = gridDim.x * NTH;
    for (int i = blockIdx.x * NTH + tidx(); i < TOT; i += 2 * GT) { int e[2], seq[2], dk[2], d[2]; bool ok[2]; float s[2] = {0.f, 0.f};
#pragma unroll
        for (int q = 0; q < 2; ++q) { const int iq = i + q * GT; ok[q] = iq < TOT; const int ic = ok[q] ? iq : i; e[q] = ic & 8191; seq[q] = ic >> 13; dk[q] = e[q] & 63; d[q] = seq[q] & 1; }
        float un[2][GLB_BS], dn[2][GLB_BS];
#pragma unroll
        for (int q = 0; q < 2; ++q)
#pragma unroll
            for (int x = 0; x < GLB_BS; ++x) { const int k = x < NCH ? x : NCH - 1; const int c = chunk_order(d[q], k); un[q][x] = GU[((size_t)seq[q] * NCH + c) * 8192 + e[q]]; dn[q][x] = GDEC[((size_t)seq[q] * NCH + c) * 64 + dk[q]]; }
#pragma unroll 1
        for (int kb = 0; kb < NBT; ++kb) { float u[2][GLB_BS], dc[2][GLB_BS];
#pragma unroll
            for (int q = 0; q < 2; ++q)
#pragma unroll
                for (int x = 0; x < GLB_BS; ++x) { u[q][x] = un[q][x]; dc[q][x] = dn[q][x]; }
            if (kb + 1 < NBT) {
#pragma unroll
                for (int q = 0; q < 2; ++q)
#pragma unroll
                    for (int x = 0; x < GLB_BS; ++x) { const int k = (kb + 1) * GLB_BS + x < NCH ? (kb + 1) * GLB_BS + x : NCH - 1; const int c = chunk_order(d[q], k); un[q][x] = GU[((size_t)seq[q] * NCH + c) * 8192 + e[q]]; dn[q][x] = GDEC[((size_t)seq[q] * NCH + c) * 64 + dk[q]]; } }
#pragma unroll
            for (int x = 0; x < GLB_BS; ++x) { const int k = kb * GLB_BS + x; if (k < NCH) {
#pragma unroll
                for (int q = 0; q < 2; ++q) { const int c = chunk_order(d[q], k); if (ok[q]) GSB[((size_t)seq[q] * NCH + c) * 8192 + e[q]] = f2bf(s[q]); s[q] = dc[q][x] * s[q] + u[q][x]; } } } }
    }
}
DEVFN void phase_gla_c(const Params& p, unsigned char* lds, int j) {
    const int tid = tidx(), lane = tid & 63, wave = tid >> 6, fr = lane & 15, fg = lane >> 4, itl = wave & 3, half = wave >> 2;
    float* cum = (float*)(lds + GL_CUM); float* ssq = (float*)(lds + GL_SSQ);
    const bf16* Z = (const bf16*)(p.ws + WS_Z); const bf16* GSB = (const bf16*)(p.ws + WS_H + (size_t)MR * D * 2); const float* GCUM = (const float*)(p.ws + WS_SB + SBO_GCUM); bf16* Y = (bf16*)(p.ws + WS_YMIX);
    f32x4 pc[4]; u32x4 pkq[2], pvt[2];
#define GLA_C_FETCH(itx) { const int c_ = (itx) % NCH, hd_ = ((itx) / NCH) & 3, b_ = (itx) / (NCH * 4); const size_t row0_ = (size_t)b_ * PT + c_ * 64; \
        const float* gc_ = GCUM + (size_t)((b_ * 4 + hd_) * NCH + c_) * 8192; \
        _Pragma("unroll") for (int x = 0; x < 4; ++x) pc[x] = *(const f32x4*)(gc_ + (x * NTH + tid) * 4); \
        pkq[0] = *(const u32x4*)(Z + ZO_GK + (row0_ + (tid >> 3)) * 256 + hd_ * 64 + (tid & 7) * 8); pkq[1] = *(const u32x4*)(Z + ZO_GQ + (row0_ + (tid >> 3)) * 256 + hd_ * 64 + (tid & 7) * 8); \
        const bf16* vs_ = Z + ZO_GVT + (size_t)(b_ * 4 + hd_) * 128 * PT + c_ * 64; \
        pvt[0] = *(const u32x4*)(vs_ + (size_t)(tid >> 3) * PT + (tid & 7) * 8); pvt[1] = *(const u32x4*)(vs_ + (size_t)(64 + (tid >> 3)) * PT + (tid & 7) * 8); }
    if (blockIdx.x < NB * 4 * NCH) GLA_C_FETCH(blockIdx.x)
    for (int it = blockIdx.x; it < NB * 4 * NCH; it += gridDim.x) { const int c = it % NCH, hd = (it / NCH) & 3, b = it / (NCH * 4);
        const size_t row0 = (size_t)b * PT + c * 64;
        __syncthreads();
#pragma unroll
        for (int x = 0; x < 4; ++x) *(f32x4*)(cum + (x * NTH + tid) * 4) = pc[x];
        *(u32x4*)(lds + GL_K + (tid >> 3) * GLR + (tid & 7) * 16) = pkq[0]; *(u32x4*)(lds + GL_Q + (tid >> 3) * GLR + (tid & 7) * 16) = pkq[1];
        *(u32x4*)(lds + GL_VT + (tid >> 3) * GLR + (tid & 7) * 16) = pvt[0]; *(u32x4*)(lds + GL_VT + (64 + (tid >> 3)) * GLR + (tid & 7) * 16) = pvt[1];
        for (int i = tid; i < 2 * 128 * 8; i += NTH) { const int d = i >> 10, r = (i >> 3) & 127, ch = i & 7;
            *(u32x4*)(lds + GL_S + (d * 128 + r) * GLR + ch * 16) = *(const u32x4*)(GSB + ((size_t)(((b * 4 + hd) * 2 + d) * NCH + c) * 128 + r) * 64 + ch * 8); }
        if (it + (int)gridDim.x < NB * 4 * NCH) GLA_C_FETCH(it + gridDim.x)
        __syncthreads();
        const int ti = itl * 16 + fr;
        f32x4 o[4];
#pragma unroll
        for (int mt = 0; mt < 4; ++mt) o[mt] = (f32x4){0.f, 0.f, 0.f, 0.f};
#pragma unroll 1
        for (int d = 0; d < 2; ++d) {
            bf16x8 qd[2];
#pragma unroll
            for (int ks = 0; ks < 2; ++ks) { const u32x4 raw = *(const u32x4*)(lds + GL_Q + ti * GLR + (ks * 32 + fg * 8) * 2); float f[8];
#pragma unroll
                for (int e = 0; e < 8; ++e) f[e] = fexp(cum[(d * 64 + ti) * 64 + ks * 32 + fg * 8 + e]);
                qd[ks] = scale8(raw, f); }
            f32x4 att[4];
#pragma unroll
            for (int jt = 0; jt < 4; ++jt) { const int tj = jt * 16 + fr; f32x4 a = (f32x4){0.f, 0.f, 0.f, 0.f};
#pragma unroll
                for (int ks = 0; ks < 2; ++ks) { const u32x4 raw = *(const u32x4*)(lds + GL_K + tj * GLR + (ks * 32 + fg * 8) * 2); float f[8];
#pragma unroll
                    for (int e = 0; e < 8; ++e) f[e] = fexp(-cum[(d * 64 + tj) * 64 + ks * 32 + fg * 8 + e]);
                    a = mfma16(scale8(raw, f), qd[ks], a); }
#pragma unroll
                for (int r = 0; r < 4; ++r) { const int jrow = jt * 16 + fg * 4 + r; const bool keep = d ? (jrow >= ti) : (jrow <= ti); a[r] = keep ? a[r] : 0.f; }
                att[jt] = a; }
#pragma unroll
            for (int s2 = 0; s2 < 2; ++s2) { bf16x8 pb;
#pragma unroll
                for (int e = 0; e < 0; ++e) {}
                { u32x4 w; w[0] = pack2(att[2 * s2][0], att[2 * s2][1]); w[1] = pack2(att[2 * s2][2], att[2 * s2][3]); w[2] = pack2(att[2 * s2 + 1][0], att[2 * s2 + 1][1]); w[3] = pack2(att[2 * s2 + 1][2], att[2 * s2 + 1][3]); pb = __builtin_bit_cast(bf16x8, w); }
#pragma unroll
                for (int mt = 0; mt < 4; ++mt) { const unsigned char* vp = lds + GL_VT + (half * 64 + mt * 16 + fr) * GLR + (s2 * 32 + fg * 4) * 2;
                    o[mt] = mfma16(cat4(*(const bf16x4*)vp, *(const bf16x4*)(vp + 32)), pb, o[mt]); } }
#pragma unroll
            for (int ks = 0; ks < 2; ++ks)
#pragma unroll
                for (int mt = 0; mt < 4; ++mt) o[mt] = mfma16(*(const bf16x8*)(lds + GL_S + (d * 128 + half * 64 + mt * 16 + fr) * GLR + (ks * 32 + fg * 8) * 2), qd[ks], o[mt]);
        }
        float ss = 0.f;
#pragma unroll
        for (int mt = 0; mt < 4; ++mt)
#pragma unroll
            for (int r = 0; r < 4; ++r) ss += o[mt][r] * o[mt][r];
        ss += __shfl_xor(ss, 16); ss += __shfl_xor(ss, 32);
        if (fg == 0) ssq[half * 64 + ti] = ss;
        __syncthreads();
        const float rstd = 1.0f / sqrtf((ssq[ti] + ssq[64 + ti]) * (1.0f / 128.0f) + LN_EPS);
#pragma unroll
        for (int mt = 0; mt < 4; ++mt) { const int dv = hd * 128 + half * 64 + mt * 16 + fg * 4; const f32x4 ng = *(const f32x4*)(p.in[I_GNG] + (size_t)j * 512 + dv);
            const u32x2 rr = *(const u32x2*)(Z + ZO_GR + (row0 + ti) * 512 + dv); f32x4 y;
            y[0] = o[mt][0] * rstd * ng[0] * siluf_(bitsf(rr.x << 16)); y[1] = o[mt][1] * rstd * ng[1] * siluf_(bitsf(rr.x & 0xffff0000u));
            y[2] = o[mt][2] * rstd * ng[2] * siluf_(bitsf(rr.y << 16)); y[3] = o[mt][3] * rstd * ng[3] * siluf_(bitsf(rr.y & 0xffff0000u));
            store4_t(Y + (row0 + ti) * D + dv, y); }
    }
#undef GLA_C_FETCH
}

constexpr int DK_ROW = 272, DV_ROW = 144, DF_VOFF = 64 * DK_ROW, DF_BUF = DF_VOFF + 128 * DV_ROW, DF_Q = 2 * DF_BUF;
DEVFN int dk_off(int key, int ch) { return key * DK_ROW + ch * 16; }
DEVFN int dv_off(int dv, int ch) { return dv * DV_ROW + ch * 16; }
DEVFN void phase_diff(const Params& p, unsigned char* lds, int l, int part) {
    const int j = l >> 1, tid = tidx(), lane = tid & 63, wave = tid >> 6, ql = lane & 31, hh = lane >> 5, qg = wave >> 1, m = wave & 1;
    const bf16* Z = (const bf16*)(p.ws + WS_Z); bf16* Y = (bf16*)(p.ws + WS_YMIX);
    constexpr int NQT = TS / 128, NQC = (LC + 127) / 128, NU = NB * 4 * (NQT + NQC);
    constexpr int NUL = NB * 4 * NQT;
    const int G_ = gridDim.x, u0 = part == 0 ? (int)blockIdx.x : NUL + ((int)blockIdx.x + G_ - (64 % G_)) % G_, uend = part == 0 ? NUL : NU;
    if (u0 >= uend) return;
    const float laminit = 0.8f - 0.6f * expf(-0.3f * (float)l);
    const float d1 = wave_sum(p.in[I_LQ1][j * 64 + lane] * p.in[I_LK1][j * 64 + lane]), d2 = wave_sum(p.in[I_LQ2][j * 64 + lane] * p.in[I_LK2][j * 64 + lane]);
    const float lam = expf(d1) - expf(d2) + laminit;
    for (int u = u0; u < uend; u += gridDim.x) { const bool isctx = u >= NUL; const int v = isctx ? u - NUL : u, per = isctx ? NQC : NQT;
        const int qt = isctx ? NQT + v % per : v % per, hd = (v / per) & 3, b = v / (per * 4);
        const int q0 = isctx ? (qt - NQT) * 128 : LC + qt * 128, nkt = (isctx ? LC : PT) / 64; const int qp = q0 + qg * 32 + ql; const size_t qrow = (size_t)b * PT + qp;
        const bool qvalid = !isctx || qp < LC;
        bf16x8 qf[4];
#pragma unroll
        for (int ks = 0; ks < 4; ++ks) qf[ks] = *(const bf16x8*)(Z + ZO_DQ + qrow * 512 + hd * 128 + m * 64 + ks * 16 + hh * 8);
        AttnState<4> st; attn_init(st);
        const bf16* ksrc[2]; const bf16* vsrc[2]; int klo[2], vlo[2];
#pragma unroll
        for (int i = 0; i < 2; ++i) { const int idx = i * NTH + tid; const int key = idx >> 4, kch = idx & 15, dv = idx >> 3, vch = idx & 7;
            ksrc[i] = Z + ZO_DK + ((size_t)b * PT + key) * 512 + hd * 128 + kch * 8; klo[i] = dk_off(key, kch);
            vsrc[i] = Z + ZO_DVT + ((size_t)(b * 4 + hd) * 128 + dv) * PT + vch * 8; vlo[i] = DF_VOFF + dv_off(dv, vch); }
        u32x4 rk0[2], rv0[2], rk1[2], rv1[2];
#define DF_LOAD(RK, RV, t) do { _Pragma("unroll") for (int i = 0; i < 2; ++i) { RK[i] = *(const u32x4*)(ksrc[i] + (size_t)(t) * 64 * 512); RV[i] = *(const u32x4*)(vsrc[i] + (t) * 64); } } while (0)
#define DF_STORE(RK, RV, buf) do { _Pragma("unroll") for (int i = 0; i < 2; ++i) { *(u32x4*)(lds + (buf) + klo[i]) = RK[i]; *(u32x4*)(lds + (buf) + vlo[i]) = RV[i]; } } while (0)
#define DF_COMPUTE(cur) do { f32x16 sA, sB; _Pragma("unroll") for (int i = 0; i < 16; ++i) { sA[i] = 0.f; sB[i] = 0.f; } \
            _Pragma("unroll") for (int ks = 0; ks < 4; ++ks) { sA = mfma32(*(const bf16x8*)(lds + (cur) + dk_off(ql, m * 8 + ks * 2 + hh)), qf[ks], sA); sB = mfma32(*(const bf16x8*)(lds + (cur) + dk_off(32 + ql, m * 8 + ks * 2 + hh)), qf[ks], sB); } \
            const unsigned char* vb = lds + (cur) + DF_VOFF + 16 * hh; \
            attn_update2<4>(st, sA, sB, [&](int st2, int mt, int ks) { return *(const bf16x8*)(vb + dv_off(mt * 32 + ql, st2 * 4 + ks * 2)); }); } while (0)
        __syncthreads();
        DF_LOAD(rk0, rv0, 0); DF_LOAD(rk1, rv1, 1);
        DF_STORE(rk0, rv0, 0);
        __syncthreads();
        for (int t = 0; t < nkt; t += 2) {
            if (t + 2 < nkt) DF_LOAD(rk0, rv0, t + 2);
            DF_COMPUTE(0);
            DF_STORE(rk1, rv1, DF_BUF);
            __syncthreads();
            if (t + 3 < nkt) DF_LOAD(rk1, rv1, t + 3);
            DF_COMPUTE(DF_BUF);
            if (t + 2 < nkt) DF_STORE(rk0, rv0, 0);
            __syncthreads();
        }
#undef DF_LOAD
#undef DF_STORE
#undef DF_COMPUTE
        float* xch = (float*)lds + (size_t)qg * 4096 + lane;
        if (m == 1) { const float f = lam / st.l;
#pragma unroll
            for (int mt = 0; mt < 4; ++mt)
#pragma unroll
                for (int r = 0; r < 16; ++r) xch[(mt * 16 + r) * 64] = st.o[mt][r] * f; }
        __syncthreads();
        if (m == 0) { const float i0 = 1.0f / st.l; float ss = 0.f;
#pragma unroll
            for (int mt = 0; mt < 4; ++mt)
#pragma unroll
                for (int r = 0; r < 16; ++r) { const float o = st.o[mt][r] * i0 - xch[(mt * 16 + r) * 64]; st.o[mt][r] = o; ss += o * o; }
            ss += __shfl_xor(ss, 32);
            const float rstd = (1.0f - laminit) / sqrtf(ss * (1.0f / 128.0f) + LN_EPS);
            if (qvalid) {
#pragma unroll
                for (int mt = 0; mt < 4; ++mt)
#pragma unroll
                    for (int q4 = 0; q4 < 4; ++q4) { const int dv = mt * 32 + 8 * q4 + 4 * hh; const f32x4 ng = *(const f32x4*)(p.in[I_DNG] + (size_t)j * 128 + dv); f32x4 o;
#pragma unroll
                        for (int k = 0; k < 4; ++k) o[k] = st.o[mt][q4 * 4 + k] * rstd * ng[k];
                        store4_t(Y + qrow * D + 512 + hd * 128 + dv, o); } }
        }
    }
}

enum { PH_CONVERT = 0, PH_INIT, PH_INPROJ_E, PH_S5A, PH_S5B_NAT, PH_S5C, PH_GLU, PH_INPROJ_O, PH_GLA_A, PH_GLAB_DIFF, PH_GLA_C, PH_GLA_B, PH_DIFF, PH_OUTPROJ, PH_LN1, PH_MOE_UP, PH_MOE_DOWN, PH_LN2, PH_COUNT };

#ifdef CPU_EMU
#define PHASEFN static
#else
#define PHASEFN __device__ __forceinline__
#endif
template <int PH> PHASEFN void run_phase(const Params& p, unsigned char* lds, int l) {
    if constexpr (PH == PH_CONVERT) phase_convert(p, lds);
    else if constexpr (PH == PH_INIT) phase_init_h(p);
    else if constexpr (PH == PH_INPROJ_E) phase_inproj_even(p, lds, l);
    else if constexpr (PH == PH_S5A) phase_s5a(p, lds, l >> 1);
    else if constexpr (PH == PH_S5B_NAT) { phase_s5b(p, l >> 1); phase_natten(p, lds, l >> 1); }
    else if constexpr (PH == PH_S5C) phase_s5c(p, lds, l >> 1);
    else if constexpr (PH == PH_GLU) phase_glu(p, lds, l >> 1);
    else if constexpr (PH == PH_INPROJ_O) phase_inproj_odd(p, lds, l);
    else if constexpr (PH == PH_GLA_A) { phase_gla_a(p, lds, l >> 1); phase_diff(p, lds, l, 1); }
    else if constexpr (PH == PH_GLAB_DIFF) { phase_gla_b(p); phase_diff(p, lds, l, 0); }
    else if constexpr (PH == PH_GLA_C) phase_gla_c(p, lds, l >> 1);
    else if constexpr (PH == PH_GLA_B) phase_gla_b(p);
    else if constexpr (PH == PH_DIFF) phase_diff(p, lds, l, 0);
    else if constexpr (PH == PH_OUTPROJ) phase_outproj(p, lds, l);
    else if constexpr (PH == PH_LN1) phase_ln1_route(p, lds, l);
    else if constexpr (PH == PH_MOE_UP) phase_moe_up(p, lds, l);
    else if constexpr (PH == PH_MOE_DOWN) phase_moe_down(p, lds, l);
    else if constexpr (PH == PH_LN2) phase_ln2(p, lds, l);
}

template <int PH> __global__ void __launch_bounds__(NTH, 2) k_phase(Params p, int l) { DECL_LDS; run_phase<PH>(p, lds, l); }

#ifdef CPU_EMU
static int g_grid = 8; static int g_stop_layer = 1000, g_stop_phase = 1000;
template <int PH> static bool launch_phase(const Params& p, int l, hipStream_t) {
    if (l > g_stop_layer || (l == g_stop_layer && PH > g_stop_phase)) return false;
    fprintf(stderr, "[emu] layer %d phase %d\n", l, PH);
    emu::launch([=] { k_phase<PH>(p, l); }, dim3(g_grid), dim3(NTH), LDS_BYTES); return true;
}
static void hipMemsetAsync(void* d, int v, size_t n, hipStream_t) { memset(d, v, n); }
#else
static int g_grid = 0;
template <int PH> static bool launch_phase(const Params& p, int l, hipStream_t s) {
    static bool attr = false;
    if (!attr) { (void)hipFuncSetAttribute((const void*)k_phase<PH>, hipFuncAttributeMaxDynamicSharedMemorySize, LDS_BYTES); attr = true; }
    hipLaunchKernelGGL(k_phase<PH>, dim3(g_grid), dim3(NTH), LDS_BYTES, s, p, l); return true;
}
#endif


__global__ void __launch_bounds__(NTH, 2) k_mega(Params p_arg) {
    DECL_LDS;
#ifdef CPU_EMU
    const Params& p = p_arg;
#else
    const Params& p = *(const Params*)(uintptr_t)__builtin_amdgcn_kernarg_segment_ptr();
#endif
#ifndef CPU_EMU
    if (threadIdx.x == 0) *(uint4*)(lds + LDS_BYTES) = make_uint4(0u, 0u, 0u, 0u);
    __syncthreads();
    XcdBarrier gbar = xcd_barrier_post((unsigned*)(p.ws + WS_CTL + CTL_BAR), (volatile LAS unsigned*)(lds + LDS_BYTES));
#endif
    run_phase<PH_CONVERT>(p, lds, -1); GRID_SYNC();
    if (PROBE_MASK & 2048) { run_phase<PH_CONVERT>(p, lds, -1); GRID_SYNC(); }
    run_phase<PH_INIT>(p, lds, -1); GRID_SYNC();
#define RP(ph, l, bit) do { run_phase<ph>(p, lds, l); GRID_SYNC(); if (PROBE_MASK & (bit)) { run_phase<ph>(p, lds, l); GRID_SYNC(); } } while (0)
#define MK_EVEN(l) do { RP(PH_INPROJ_E, l, 1); RP(PH_S5A, l, 2); RP(PH_S5B_NAT, l, 4); RP(PH_S5C, l, 8); RP(PH_GLU, l, 16); } while (0)
#define MK_ODD(l) do { RP(PH_INPROJ_O, l, 1); RP(PH_GLA_A, l, 32); run_phase<PH_GLA_B>(p, lds, l); RP(PH_DIFF, l, 64); RP(PH_GLA_C, l, 128); } while (0)
#define MK_TAIL(l) do { RP(PH_OUTPROJ, l, 256); run_phase<PH_LN1>(p, lds, l); GRID_SYNC(); RP(PH_MOE_UP, l, 512); RP(PH_MOE_DOWN, l, 1024); run_phase<PH_LN2>(p, lds, l); if ((l) + 1 < NL) GRID_SYNC(); } while (0)
    MK_EVEN(0); MK_TAIL(0);
    if (NL > 1) { MK_ODD(1); MK_TAIL(1); }
    if (NL > 2) { MK_EVEN(2); MK_TAIL(2); }
    if (NL > 3) { MK_ODD(3); MK_TAIL(3); }
}
#ifdef CPU_EMU
static void launch_mega(const Params& p, hipStream_t) { emu::launch([=] { k_mega(p); }, dim3(g_grid), dim3(NTH), LDS_TOTAL); }
#else
static void launch_mega(const Params& p, hipStream_t s) {
    static bool attr = false;
    if (!attr) { (void)hipFuncSetAttribute((const void*)k_mega, hipFuncAttributeMaxDynamicSharedMemorySize, LDS_TOTAL); attr = true; }
    hipLaunchKernelGGL(k_mega, dim3(g_grid), dim3(NTH), LDS_TOTAL, s, p);
}
#endif

extern "C" void kernel_launch(void* const* d_in, const int* in_sizes, int n_in, void* d_out, int out_size, void* d_ws, size_t ws_size, hipStream_t stream) {
#ifndef CPU_EMU
    if (g_grid == 0) { int dev = 0, cus = 0; (void)hipGetDevice(&dev); (void)hipDeviceGetAttribute(&cus, hipDeviceAttributeMultiprocessorCount, dev); g_grid = cus > 0 ? cus : 256; }
#endif
    if (n_in != N_IN || ws_size < WS_END) { fprintf(stderr, "kernel_launch: unexpected inputs (n_in %d) or workspace (%zu < %zu)\n", n_in, ws_size, (size_t)WS_END); return; }
    Params p{};
    for (int i = 0; i < N_IN; ++i) p.in[i] = (const float*)d_in[i];
    p.out = (float*)d_out; p.ws = (unsigned char*)d_ws;
    (void)hipMemsetAsync((char*)d_ws + WS_CTL, 0, CTL_BYTES, stream);
#if defined(MK_MULTI)
    launch_phase<PH_CONVERT>(p, -1, stream);
    launch_phase<PH_INIT>(p, -1, stream);
    for (int l = 0; l < NL; ++l) {
        if ((l & 1) == 0) { launch_phase<PH_INPROJ_E>(p, l, stream); launch_phase<PH_S5A>(p, l, stream); launch_phase<PH_S5B_NAT>(p, l, stream); launch_phase<PH_S5C>(p, l, stream); launch_phase<PH_GLU>(p, l, stream); }
        else { launch_phase<PH_INPROJ_O>(p, l, stream); launch_phase<PH_GLA_A>(p, l, stream); launch_phase<PH_GLAB_DIFF>(p, l, stream); launch_phase<PH_GLA_C>(p, l, stream); }
        launch_phase<PH_OUTPROJ>(p, l, stream); launch_phase<PH_LN1>(p, l, stream); launch_phase<PH_MOE_UP>(p, l, stream); launch_phase<PH_MOE_DOWN>(p, l, stream); launch_phase<PH_LN2>(p, l, stream);
    }
#else
    launch_mega(p, stream);
#endif
}

#ifdef CPU_EMU_MAIN
#include <string>
#include <fstream>
#include <sys/mman.h>
static void* guard_alloc(size_t n) { const size_t pg = 4096, tot = ((n + pg - 1) / pg + 2) * pg; char* b = (char*)mmap(nullptr, tot, PROT_READ | PROT_WRITE, MAP_PRIVATE | MAP_ANONYMOUS, -1, 0); mprotect(b, pg, PROT_NONE); mprotect(b + tot - pg, pg, PROT_NONE); return b + tot - pg - ((n + 255) & ~(size_t)255); }
static std::vector<float> load_npy(const std::string& fn, bool& ok) {
    std::ifstream f(fn, std::ios::binary); std::vector<float> v; ok = false; if (!f) return v;
    char hdr[10]; f.read(hdr, 10); int hl = (unsigned char)hdr[8] | ((unsigned char)hdr[9] << 8); std::string h(hl, ' '); f.read(&h[0], hl);
    f.seekg(0, std::ios::end); size_t n = ((size_t)f.tellg() - 10 - hl) / 4; f.seekg(10 + hl); v.resize(n); f.read((char*)v.data(), n * 4); ok = true; return v;
}
template <class G> static void check(const char* name, const std::vector<float>& ref, size_t rows, size_t cols, size_t ref_ld, size_t ref_c0, G get) {
    double num = 0, den = 0, mx = 0; size_t wr = 0, wc = 0;
    for (size_t r = 0; r < rows; ++r) for (size_t c = 0; c < cols; ++c) { const double a = get(r, c), b = ref[r * ref_ld + ref_c0 + c], e = a - b; num += e * e; den += b * b; if (fabs(e) > mx) { mx = fabs(e); wr = r; wc = c; } }
    printf("CHECK %-14s rvr=%.3e  maxabs=%.4f at (%zu,%zu) refrms=%.4f\n", name, num / (den + 1e-30), mx, wr, wc, sqrt(den / (rows * cols)));
}
int main(int argc, char** argv) {
    std::string dir = argv[1]; if (argc > 2) g_stop_layer = atoi(argv[2]); if (argc > 3) g_stop_phase = atoi(argv[3]); if (const char* e = getenv("EMU_GRID")) g_grid = atoi(e);
    std::vector<int> sizes; { std::ifstream f(dir + "/sizes.txt"); int s; while (f >> s) sizes.push_back(s); }
    if ((int)sizes.size() != N_IN) { printf("bad sizes\n"); return 1; }
    std::vector<void*> din(N_IN); { std::ifstream f(dir + "/inputs.bin", std::ios::binary); for (int i = 0; i < N_IN; ++i) { din[i] = guard_alloc((size_t)sizes[i] * 4); f.read((char*)din[i], (size_t)sizes[i] * 4); } }
    printf("WS_END = %.1f MB\n", WS_END / 1048576.0);
    unsigned char* ws = (unsigned char*)guard_alloc(WS_END); memset(ws, 0x7F, WS_END);
    std::vector<float> out((size_t)NB * TS * D, NAN);
    kernel_launch(din.data(), sizes.data(), N_IN, out.data(), (int)out.size(), ws, WS_END, nullptr);
    const int L = g_stop_layer < NL ? g_stop_layer : NL - 1; const int PHS = g_stop_layer < NL ? g_stop_phase : 1000; bool ok; char nm[64];
    const bf16* Z = (const bf16*)(ws + WS_Z); const bf16* Y = (const bf16*)(ws + WS_YMIX); const bf16* H = (const bf16*)(ws + WS_H);
    auto ref = [&](const char* what) { snprintf(nm, 64, "/L%d_%s.npy", L, what); return load_npy(dir + nm, ok); };
    if (PHS >= PH_INPROJ_E || PHS >= PH_INPROJ_O) {
        auto a = ref("a"); if (ok && PHS < PH_LN1) check("abf", a, MR, D, D, 0, [&](size_t r, size_t c) { return bf2f(((const bf16*)(ws + WS_ABF))[r * D + c]); });
        auto z = ref("z");
        if (ok && (L & 1) == 0 && PHS < PH_OUTPROJ) {
            check("z.u", z, MR, 512, 2048, 0, [&](size_t r, size_t c) { return bf2f(Z[ZE_U + r * 512 + c]); });
            check("z.q", z, MR, 512, 2048, 512, [&](size_t r, size_t c) { return bf2f(Z[ZE_Q + r * 512 + c]) / QSCALE; });
            check("z.k", z, MR, 512, 2048, 1024, [&](size_t r, size_t c) { return bf2f(Z[ZE_K + r * 512 + c]); });
            check("z.v", z, MR, 512, 2048, 1536, [&](size_t r, size_t c) { size_t b = r / PT, pp = r % PT; return bf2f(Z[ZE_VT + ((b * 8 + c / 64) * 64 + c % 64) * PT + vperm((int)pp)]); });
        }
        if (ok && (L & 1) == 1 && PHS < PH_OUTPROJ) {
            check("z.gq", z, MR, 256, ODD_N, 0, [&](size_t r, size_t c) { return bf2f(Z[ZO_GQ + r * 256 + c]) * 8.f; });
            check("z.gk", z, MR, 256, ODD_N, 256, [&](size_t r, size_t c) { return bf2f(Z[ZO_GK + r * 256 + c]); });
            check("z.gkt", z, MR, 256, ODD_N, 256, [&](size_t r, size_t c) { size_t b = r / PT, pp = r % PT; return bf2f(Z[ZO_GKT + ((b * 4 + c / 64) * 64 + c % 64) * PT + pp]); });
            check("z.gvt", z, MR, 512, ODD_N, 512, [&](size_t r, size_t c) { size_t b = r / PT, pp = r % PT; return bf2f(Z[ZO_GVT + ((b * 4 + c / 128) * 128 + c % 128) * PT + pp]); });
            check("z.gr", z, MR, 512, ODD_N, 1024, [&](size_t r, size_t c) { return bf2f(Z[ZO_GR + r * 512 + c]); });
            check("z.gz", z, MR, 32, ODD_N, 1536, [&](size_t r, size_t c) { return bf2f(Z[ZO_GZ + r * 32 + c]); });
            check("z.dvt", z, MR, 512, ODD_N, 2592, [&](size_t r, size_t c) { size_t b = r / PT, pp = r % PT; return bf2f(Z[ZO_DVT + ((b * 4 + c / 128) * 128 + c % 128) * PT + vperm((int)pp)]); });
            check("z.dq(ctx rows)", z, LC, 512, ODD_N, 1568, [&](size_t r, size_t c) { return bf2f(Z[ZO_DQ + r * 512 + c]) / QSCALE; });
            check("z.dk(ctx rows)", z, LC, 512, ODD_N, 2080, [&](size_t r, size_t c) { return bf2f(Z[ZO_DK + r * 512 + c]); });
        }
    }
    if ((L & 1) == 0 && PHS >= PH_S5C && PHS < PH_MOE_DOWN) { auto s = ref("s5pre"); for (auto& x : s) x = geluf_(x); if (ok) check("gelu(s5pre)", s, MR, 512, 512, 0, [&](size_t r, size_t c) { return bf2f(((const bf16*)(ws + WS_SB + SBO_GS))[r * 512 + c]); }); }
    if (PHS >= PH_GLU && PHS >= PH_GLA_C) { auto m = ref("mix"); if (ok) { check("mix[0:512]", m, MR, 512, D, 0, [&](size_t r, size_t c) { return bf2f(Y[r * D + c]); }); check("mix[512:]", m, MR, 512, D, 512, [&](size_t r, size_t c) { return bf2f(Y[r * D + 512 + c]); }); } }
    else if (PHS >= PH_S5B_NAT) { auto m = ref("mix"); if (ok) { check("mix[0:512]", m, MR, 512, D, 0, [&](size_t r, size_t c) { return bf2f(Y[r * D + c]); }); check("mix[512:]", m, MR, 512, D, 512, [&](size_t r, size_t c) { return bf2f(Y[r * D + 512 + c]); }); } }
    if (PHS >= PH_OUTPROJ && PHS < PH_LN2) { auto y = ref("y"); if (ok && PHS < PH_MOE_UP) check("y", y, MR, D, D, 0, [&](size_t r, size_t c) { return bf2f(((const bf16*)(ws + WS_Z))[r * D + c]); }); }
    if (PHS >= PH_LN1 && PHS < PH_LN2) { auto h = ref("h1"); if (ok) check("h1", h, MR, D, D, 0, [&](size_t r, size_t c) { return bf2f(H[r * D + c]); });
        std::vector<int> eid; { snprintf(nm, 64, "/L%d_eid.npy", L); auto e = load_npy(dir + nm, ok); if (ok) { const int* ep = (const int*)e.data(); const int* rt = (const int*)(ws + WS_ROUTE); int bad = 0; for (int r = 0; r < MR; ++r) if (rt[r * 4] != ep[r * 2] || rt[r * 4 + 1] != ep[r * 2 + 1]) ++bad; printf("CHECK routing mismatches: %d / %d\n", bad, MR); } } }
    if (PHS >= PH_MOE_DOWN && PHS < PH_LN2) { auto f = ref("f"); if (ok) { const unsigned* cnt = (const unsigned*)(ws + WS_CTL + CTL_CNT) + L * NEXP; const int* rt = (const int*)(ws + WS_ROUTE); const bf16* F2 = (const bf16*)(ws + WS_SB);
        check("moe f", f, MR, D, D, 0, [&](size_t r, size_t c) { size_t r0 = (size_t)moe_off(cnt, rt[r * 4]) + rt[r * 4 + 2], r1 = (size_t)moe_off(cnt, rt[r * 4 + 1]) + rt[r * 4 + 3]; return bf2f(F2[r0 * D + c]) + bf2f(F2[r1 * D + c]); }); } }
    if (PHS >= PH_LN2 && L + 1 < NL) { auto h = ref("h2"); if (ok) check("h2", h, MR, D, D, 0, [&](size_t r, size_t c) { return bf2f(H[r * D + c]); }); }
    if (g_stop_layer >= NL) { auto o = load_npy(dir + "/ref_out.npy", ok); if (ok) { std::vector<float> of(o.size() / 2); const double* od = (const double*)o.data(); for (size_t i = 0; i < of.size(); ++i) of[i] = (float)od[i];
        check("FINAL out", of, (size_t)NB * TS, D, D, 0, [&](size_t r, size_t c) { return out[r * D + c]; }); } }
    return 0;
}
#endif
```

```cpp
#ifdef CPU_EMU
#include "emu.h"
#else
#include <hip/hip_runtime.h>
#include <cstdio>
#include <cstdint>
#include <cmath>
#endif

#ifndef PROBE_MASK
#define PROBE_MASK 0
#endif
#ifndef CFG_BATCH
#define CFG_BATCH 4
#endif
#ifndef CFG_SEQ
#define CFG_SEQ 4096
#endif
#ifndef CFG_CTX
#define CFG_CTX 256
#endif
#ifndef CFG_DEPTH
#define CFG_DEPTH 4
#endif

typedef unsigned short bf16;
typedef short bf16x8 __attribute__((ext_vector_type(8)));
typedef short bf16x4 __attribute__((ext_vector_type(4)));
typedef float f32x4 __attribute__((ext_vector_type(4)));
typedef float f32x2 __attribute__((ext_vector_type(2)));
typedef float f32x16 __attribute__((ext_vector_type(16)));
typedef unsigned u32x4 __attribute__((ext_vector_type(4)));
typedef unsigned u32x2 __attribute__((ext_vector_type(2)));

constexpr int NB = CFG_BATCH, TS = CFG_SEQ, LC = CFG_CTX, NL = CFG_DEPTH;
constexpr int PT = LC + TS;
constexpr int MR = NB * PT;
constexpr int D = 1024;
constexpr int NE = (NL + 1) / 2, NO = NL / 2;
constexpr int GW = 64;
constexpr int GROWS = TS / GW;
constexpr int NCH = PT / 64, NCC = LC / 64;
constexpr int NTH = 512;
constexpr int EVEN_N = 2048, ODD_N = 3104, ODD_NP = 3328;
constexpr int NEXP = 32;
constexpr float LN_EPS = 1e-5f;
constexpr float ALPHA = 1.681792830507429f;
constexpr float LOG2E = 1.4426950408889634f, QSCALE = 0.125f * LOG2E;
static_assert(MR % 256 == 0 && LC % 128 == 0 && TS % 128 == 0 && GROWS >= 8, "shape");

enum { I_X = 0, I_C, I_CTX, I_CCTX, I_MODW, I_MODB, I_LNG, I_LNB, I_EWIN, I_EWOUT, I_LAMRE, I_LAMIM, I_LOGDT, I_BRE, I_BIM, I_CRE, I_CIM, I_S5D,
       I_GLUW, I_GLUB, I_RPB, I_OWIN, I_OWOUT, I_GGW, I_GGB, I_GNG, I_LQ1, I_LK1, I_LQ2, I_LK2, I_DNG, I_WGRP, I_BGRP, I_WEXP, I_BEXP, I_WGATE, I_WUP, I_WDOWN, N_IN };

constexpr size_t al256(size_t x) { return (x + 255) & ~(size_t)255; }
constexpr size_t WS_CTL = 0;
constexpr size_t CTL_BAR = 0;
constexpr size_t CTL_CNT = 16384;
constexpr size_t CTL_BYTES = 16384 + 4096;
constexpr size_t WS_MODV = al256(WS_CTL + CTL_BYTES);
constexpr size_t WS_S5P = al256(WS_MODV + (size_t)NL * (NB + 1) * 6144 * 4);
constexpr int S5P_STRIDE = 36;
constexpr size_t WS_ROPE = al256(WS_S5P + (size_t)NE * 2 * 32 * 64 * S5P_STRIDE * 4);
constexpr size_t WS_WIN = al256(WS_ROPE + 8192);
constexpr size_t WIN_LSTRIDE = (size_t)ODD_NP * D;
constexpr size_t WS_WOUT = al256(WS_WIN + (size_t)NL * WIN_LSTRIDE * 2);
constexpr size_t WS_GLU = al256(WS_WOUT + (size_t)NL * D * D * 2);
constexpr size_t WS_MGU = al256(WS_GLU + (size_t)NE * 1024 * 512 * 2);
constexpr size_t WS_MDN = al256(WS_MGU + (size_t)NL * NEXP * 512 * 1024 * 2);
constexpr size_t WS_H = al256(WS_MDN + (size_t)NL * NEXP * 1024 * 256 * 2);
constexpr size_t WS_ABF = al256(WS_H + (size_t)MR * D * 4);
constexpr size_t WS_Z = al256(WS_ABF + (size_t)MR * D * 2);
constexpr size_t Z_BYTES = (size_t)MR * 3360 * 2;
constexpr size_t WS_YMIX = al256(WS_Z + Z_BYTES);
constexpr size_t WS_SB = al256(WS_YMIX + (size_t)MR * D * 2);
constexpr size_t MOE_ROWS = (size_t)2 * MR + NEXP * 128;
constexpr size_t SB_GLA = (size_t)NB * 4 * 2 * NCH * 128 * 64 * 4 + (size_t)NB * 4 * 2 * NCH * 64 * 4 + (size_t)NB * 4 * NCH * 2 * 64 * 64 * 4 + 8192;
constexpr size_t SB_S5 = (size_t)2 * NB * 32 * 2 * NCH * 128 * 4 + (size_t)MR * 512 * 2 + 4096;
constexpr size_t SB_F2 = MOE_ROWS * D * 2;
constexpr size_t SB_BYTES = SB_GLA > SB_F2 ? (SB_GLA > SB_S5 ? SB_GLA : SB_S5) : (SB_F2 > SB_S5 ? SB_F2 : SB_S5);
constexpr size_t WS_ACT = al256(WS_SB + SB_BYTES);
constexpr size_t WS_ROUTE = al256(WS_ACT + MOE_ROWS * 256 * 2);
constexpr size_t WS_LTOK = al256(WS_ROUTE + (size_t)MR * 16);
constexpr size_t WS_LW = al256(WS_LTOK + (size_t)NEXP * MR * 4);
constexpr size_t WS_END = al256(WS_LW + (size_t)NEXP * MR * 4);
constexpr size_t ZE_U = 0, ZE_Q = (size_t)MR * 512, ZE_K = (size_t)MR * 1024, ZE_VT = (size_t)MR * 1536;
constexpr size_t ZO_GQ = 0, ZO_GK = (size_t)MR * 256, ZO_GKT = (size_t)MR * 512, ZO_GVT = (size_t)MR * 768, ZO_GR = (size_t)MR * 1280,
                 ZO_GZ = (size_t)MR * 1792, ZO_DQ = (size_t)MR * 1824, ZO_DK = (size_t)MR * 2336, ZO_DVT = (size_t)MR * 2848;
constexpr size_t SBO_S5E = 0;
constexpr size_t SBO_S5H = (size_t)NB * 32 * 2 * NCH * 128 * 4;
constexpr size_t SBO_GS = al256(2 * SBO_S5H);
constexpr size_t SBO_GU = 0;
constexpr size_t SBO_GDEC = al256((size_t)NB * 4 * 2 * NCH * 128 * 64 * 4);
constexpr size_t SBO_GCUM = al256(SBO_GDEC + (size_t)NB * 4 * 2 * NCH * 64 * 4);

#ifdef CPU_EMU
#define DEVFN static inline
#define MEMFN inline
#else
#define DEVFN __device__ __forceinline__
#define MEMFN __device__ __forceinline__
#endif
DEVFN unsigned fbits(float f) { return __builtin_bit_cast(unsigned, f); }
DEVFN float bitsf(unsigned u) { return __builtin_bit_cast(float, u); }
DEVFN bf16 f2bf(float f) { unsigned u = fbits(f); u += 0x7fffu + ((u >> 16) & 1u); return (bf16)(u >> 16); }
DEVFN float bf2f(bf16 h) { return bitsf((unsigned)h << 16); }
DEVFN unsigned pack2(float lo, float hi) {
#ifdef CPU_EMU
    return (unsigned)f2bf(lo) | ((unsigned)f2bf(hi) << 16);
#else
    typedef __bf16 bf16v2_ __attribute__((ext_vector_type(2)));
    return __builtin_bit_cast(unsigned, __builtin_convertvector((f32x2){lo, hi}, bf16v2_));
#endif
}
DEVFN float fexp2(float x) {
#ifdef CPU_EMU
    return exp2f(x);
#else
    return __builtin_amdgcn_exp2f(x);
#endif
}
DEVFN float fexp(float x) { return fexp2(x * 1.4426950408889634f); }
DEVFN float flog2(float x) {
#ifdef CPU_EMU
    return log2f(x);
#else
    return __builtin_amdgcn_logf(x);
#endif
}
DEVFN float sigmoidf_(float x) { return 1.0f / (1.0f + fexp(-x)); }
DEVFN float siluf_(float x) { return x / (1.0f + fexp(-x)); }
DEVFN float geluf_(float x) { const float u = 0.7978845608028654f * (x + 0.044715f * x * x * x); return x / (1.0f + fexp(-2.0f * u)); }

DEVFN float logsigf_(float x) { return fminf(x, 0.f) - 0.6931471805599453f * flog2(1.0f + fexp(-fabsf(x))); }
DEVFN f32x4 mfma16(bf16x8 a, bf16x8 b, f32x4 c) {
#ifdef CPU_EMU
    return emu_mfma16(a, b, c);
#else
    return __builtin_amdgcn_mfma_f32_16x16x32_bf16(a, b, c, 0, 0, 0);
#endif
}
DEVFN f32x16 mfma32(bf16x8 a, bf16x8 b, f32x16 c) {
#ifdef CPU_EMU
    return emu_mfma32(a, b, c);
#else
    return __builtin_amdgcn_mfma_f32_32x32x16_bf16(a, b, c, 0, 0, 0);
#endif
}
DEVFN void sched_fence() {
#ifndef CPU_EMU
    __builtin_amdgcn_sched_barrier(0);
#endif
}
DEVFN bool wave_all(bool c) {
#ifdef CPU_EMU
    int v = c ? 1 : 0; v &= __shfl_xor(v, 32); v &= __shfl_xor(v, 16); v &= __shfl_xor(v, 8); v &= __shfl_xor(v, 4); v &= __shfl_xor(v, 2); v &= __shfl_xor(v, 1); return v != 0;
#else
    return __all(c);
#endif
}
DEVFN float wave_sum(float v) {
#ifdef CPU_EMU
    v += __shfl_xor(v, 32); v += __shfl_xor(v, 16); v += __shfl_xor(v, 8); v += __shfl_xor(v, 4); v += __shfl_xor(v, 2); v += __shfl_xor(v, 1); return v;
#else
#define WS_DPP(x, ctrl) bitsf((unsigned)__builtin_amdgcn_update_dpp(0, (int)fbits(x), ctrl, 0xF, 0xF, true))
    v += WS_DPP(v, 0xB1); v += WS_DPP(v, 0x4E); v += WS_DPP(v, 0x141); v += WS_DPP(v, 0x140);
#undef WS_DPP
    const int iv = (int)fbits(v);
    return bitsf((unsigned)__builtin_amdgcn_readlane(iv, 0)) + bitsf((unsigned)__builtin_amdgcn_readlane(iv, 16)) + bitsf((unsigned)__builtin_amdgcn_readlane(iv, 32)) + bitsf((unsigned)__builtin_amdgcn_readlane(iv, 48));
#endif
}

struct Params { const float* in[N_IN]; float* out; unsigned char* ws; };

constexpr int LDS_BYTES = 128 * 1024;
constexpr int LDS_TOTAL = LDS_BYTES + 16;
#ifdef CPU_EMU
#define DECL_LDS unsigned char* lds = emu::cur_blk->lds
#define GRID_SYNC() emu::grid_barrier()
#else
#define DECL_LDS extern __shared__ __attribute__((aligned(16))) unsigned char lds[]
#define XB_TMO      128
#define XB_XCNT(j)  (256  + 64 * (j))
#define XB_XSUB(j)  (1280 + 64 * (j))
#define XB_XGEN(j)  (2304 + 64 * (j))
#define XB_TOP      3328
#define XB_TOPGEN   3392
#define XCD_BAR_WORDS 3456
#define XB_SPIN_CAP (1u << 18)
#define LAS __attribute__((address_space(3)))

__device__ __forceinline__ unsigned xb_ld(unsigned* p)              { return __hip_atomic_load(p, __ATOMIC_RELAXED, __HIP_MEMORY_SCOPE_AGENT); }
__device__ __forceinline__ unsigned xb_add(unsigned* p, unsigned v) { return __hip_atomic_fetch_add(p, v, __ATOMIC_RELAXED, __HIP_MEMORY_SCOPE_AGENT); }
__device__ __forceinline__ unsigned xb_xcc_id() { return (unsigned)__builtin_amdgcn_s_getreg((3 << 11) | 20) & 0xFu; }
#define XB_SPIN(cond, bar) do { unsigned _sp = 0; while (cond) { __builtin_amdgcn_s_sleep(1); \
    if ((++_sp & 255u) == 0u) { if (xb_ld(&(bar)[XB_TMO])) break; if (_sp > XB_SPIN_CAP) { atomicAdd(&(bar)[XB_TMO], 1u); break; } } } } while (0)

struct XcdBarrier {
    unsigned* bar; unsigned x;
    volatile LAS unsigned* st;
};

__device__ __forceinline__ XcdBarrier xcd_barrier_post(unsigned* bar, volatile LAS unsigned* st) {
    XcdBarrier b; b.bar = bar; b.x = xb_xcc_id(); b.st = st;
    if (threadIdx.x == 0) (void)xb_add(&bar[XB_XCNT(b.x)], 1u);
    return b;
}
__device__ __forceinline__ void xcd_barrier_complete(unsigned* bar, unsigned x, unsigned& nloc, unsigned& nx) {
    const unsigned G = gridDim.x * gridDim.y * gridDim.z;
    unsigned sum, cnt, mine, sp = 0u;
    for (;;) {
        sum = 0u; cnt = 0u; mine = 0u;
#pragma unroll
        for (unsigned j = 0; j < 16; ++j) { const unsigned c = xb_ld(&bar[XB_XCNT(j)]); sum += c; cnt += (c > 0u) ? 1u : 0u; mine = (j == x) ? c : mine; }
        if (sum == G) break;
        __builtin_amdgcn_s_sleep(1);
        if ((++sp & 255u) == 0u) { if (xb_ld(&bar[XB_TMO])) break; if (sp > XB_SPIN_CAP) { atomicAdd(&bar[XB_TMO], 1u); break; } }
    }
    nloc = mine > 0u ? mine : 1u; nx = cnt > 0u ? cnt : 1u;
}

__device__ __forceinline__ void xcd_barrier(const XcdBarrier& b) {
    asm volatile("s_waitcnt vmcnt(0)" ::: "memory");
    __syncthreads();
    if (threadIdx.x == 0) {
        unsigned* bar = b.bar;
        __builtin_amdgcn_s_waitcnt(0);
        unsigned nloc = b.st[0], nx = b.st[1];
        if (nloc == 0u) { xcd_barrier_complete(bar, b.x, nloc, nx); b.st[0] = nloc; b.st[1] = nx; }
        const unsigned old = xb_add(&bar[XB_XSUB(b.x)], 1u);
        const unsigned gen = old / nloc;
        if (old + 1u == (gen + 1u) * nloc) {
            __builtin_amdgcn_fence(__ATOMIC_RELEASE, "agent");
            asm volatile("s_waitcnt vmcnt(0)" ::: "memory");
            const unsigned og = xb_add(&bar[XB_TOP], 1u);
            const unsigned tg = og / nx;
            if (og + 1u == (tg + 1u) * nx) xb_add(&bar[XB_TOPGEN], 1u);
            else XB_SPIN(xb_ld(&bar[XB_TOPGEN]) == tg, bar);
            __builtin_amdgcn_fence(__ATOMIC_ACQUIRE, "agent");
            xb_add(&bar[XB_XGEN(b.x)], 1u);
            asm volatile("s_waitcnt vmcnt(0)" ::: "memory");
        } else {
            XB_SPIN(xb_ld(&bar[XB_XGEN(b.x)]) == gen, bar);
            __builtin_amdgcn_fence(__ATOMIC_ACQUIRE, "agent");
            asm volatile("s_waitcnt vmcnt(0)" ::: "memory");
        }
    }
    __syncthreads();
}

#define GRID_SYNC() xcd_barrier(gbar)
#endif

DEVFN int tidx() { int t = (int)threadIdx.x;
#ifndef CPU_EMU
    asm volatile("" : "+v"(t));
#endif
    return t; }
template <class ColSrc, class DstFn>
DEVFN void conv_group(unsigned char* lds, int nmat, int K, int N, int ld_src, ColSrc colsrc, DstFn dstfn) {
    float* t = (float*)lds;
    const int tid = tidx(), G = gridDim.x, nkt = K / 64, nnt = N / 128, units = nmat * nkt * nnt; float r[16];
    auto load = [&](int u) { const int mat = u / (nkt * nnt), rem = u % (nkt * nnt), k0 = (rem % nkt) * 64, n0 = (rem / nkt) * 128;
#pragma unroll
        for (int it = 0; it < 16; ++it) { const int idx = it * NTH + tid, kl = idx >> 7, nl = idx & 127; const float* sp = colsrc(mat, n0 + nl); r[it] = sp ? __builtin_nontemporal_load(sp + (size_t)(k0 + kl) * ld_src) : 0.f; } };
    int u = blockIdx.x; if (u < units) load(u);
    for (; u < units; u += G) {
        __syncthreads();
#pragma unroll
        for (int it = 0; it < 16; ++it) { const int idx = it * NTH + tid, kl = idx >> 7, nl = idx & 127; t[kl * 129 + nl] = r[it]; }
        if (u + G < units) load(u + G);
        __syncthreads();
        const int mat = u / (nkt * nnt), rem = u % (nkt * nnt), k0 = (rem % nkt) * 64, n0 = (rem / nkt) * 128; bf16* dst = dstfn(mat);
#pragma unroll
        for (int it = 0; it < 8; ++it) { const int idx = it * NTH + tid, nl = idx >> 5, kp = idx & 31; __builtin_nontemporal_store(pack2(t[(2 * kp) * 129 + nl], t[(2 * kp + 1) * 129 + nl]), (unsigned*)(dst + (size_t)(n0 + nl) * K + k0 + 2 * kp)); }
    }
}

DEVFN void phase_convert(const Params& p, unsigned char* lds) {
    const int G = gridDim.x, bid = blockIdx.x;
    conv_group(lds, NE, D, EVEN_N, EVEN_N, [&](int j, int n) { return p.in[I_EWIN] + (size_t)j * D * EVEN_N + n; }, [&](int j) { return (bf16*)(p.ws + WS_WIN) + (size_t)(2 * j) * WIN_LSTRIDE; });
    if (NO > 0) conv_group(lds, NO, D, ODD_NP, ODD_N, [&](int j, int n) -> const float* { const float* src = p.in[I_OWIN] + (size_t)j * D * ODD_N; return n < 1536 ? src + n : (n < 3072 ? src + n + 32 : (n < 3104 ? src + 1536 + (n - 3072) : nullptr)); },
                           [&](int j) { return (bf16*)(p.ws + WS_WIN) + (size_t)(2 * j + 1) * WIN_LSTRIDE; });
    conv_group(lds, NL, D, D, D, [&](int l, int n) { return ((l & 1) ? p.in[I_OWOUT] : p.in[I_EWOUT]) + (size_t)(l >> 1) * D * D + n; }, [&](int l) { return (bf16*)(p.ws + WS_WOUT) + (size_t)l * D * D; });
    conv_group(lds, NE, 512, 1024, 1024, [&](int j, int n) { return p.in[I_GLUW] + (size_t)j * 512 * 1024 + ((n & 31) >> 4) * 512 + (n >> 5) * 16 + (n & 15); }, [&](int j) { return (bf16*)(p.ws + WS_GLU) + (size_t)j * 1024 * 512; });
    conv_group(lds, NL * NEXP, D, 512, 256, [&](int e, int n) { return (((n & 31) >> 4) ? p.in[I_WUP] : p.in[I_WGATE]) + (size_t)e * D * 256 + (n >> 5) * 16 + (n & 15); }, [&](int e) { return (bf16*)(p.ws + WS_MGU) + (size_t)e * 512 * 1024; });
    conv_group(lds, NL * NEXP, 256, D, D, [&](int e, int n) { return p.in[I_WDOWN] + (size_t)e * 256 * D + n; }, [&](int e) { return (bf16*)(p.ws + WS_MDN) + (size_t)e * 1024 * 256; });
    {
        float* sv = (float*)lds;
        __syncthreads();
        for (int i = tidx(); i < (NB + 1) * D; i += NTH) { const int r = i / D, k = i % D; const float v = r < NB ? p.in[I_C][r * D + k] : p.in[I_CCTX][k]; sv[i] = siluf_(v); }
        __syncthreads();
        float* modv = (float*)(p.ws + WS_MODV);
        for (int u = bid; u < NL * 96; u += G) { const int l = u / 96, cg = u % 96; const int cl = tidx() & 63, col = cg * 64 + cl, ks = tidx() >> 6;
            const float* w = p.in[I_MODW] + (size_t)l * D * 6144 + col; float acc[NB + 1];
#pragma unroll
            for (int r = 0; r <= NB; ++r) acc[r] = 0.f;
#pragma unroll 8
            for (int k = ks * 128; k < ks * 128 + 128; ++k) { const float wv = w[(size_t)k * 6144];
#pragma unroll
                for (int r = 0; r <= NB; ++r) acc[r] += sv[r * D + k] * wv; }
            float* red = (float*)(lds + 32768);
            __syncthreads();
#pragma unroll
            for (int r = 0; r <= NB; ++r) red[(ks * (NB + 1) + r) * 64 + cl] = acc[r];
            __syncthreads();
            for (int i = tidx(); i < (NB + 1) * 64; i += NTH) { const int r = i >> 6, c = i & 63; const int cc = cg * 64 + c; float sum = p.in[I_MODB][(size_t)l * 6144 + cc];
#pragma unroll
                for (int q = 0; q < 8; ++q) sum += red[(q * (NB + 1) + r) * 64 + c];
                modv[((size_t)l * (NB + 1) + r) * 6144 + cc] = sum; }
            __syncthreads();
        }
    }
    for (int i = bid * NTH + tidx(); i < 1024; i += G * NTH) { const float ang = (float)(i >> 4) * expf(-(float)(i & 15) * (9.210340371976184f / 16.0f)); float sn, cs; sincosf(ang, &sn, &cs); float* rt = (float*)(p.ws + WS_ROPE); rt[i] = cs; rt[1024 + i] = sn; }
    for (int i = bid * NTH + tidx(); i < NE * 2 * 32 * 64; i += G * NTH) {
        const int pidx = i & 63, g = (i >> 6) & 31, jd = i >> 11;
        const float lre = p.in[I_LAMRE][i], lim = p.in[I_LAMIM][i], dt = expf(p.in[I_LOGDT][jd * 32 + g]);
        const float mag = expf(lre * dt), are = mag * cosf(lim * dt), aim = mag * sinf(lim * dt);
        const float magL = expf(lre * dt * 64.f), aLre = magL * cosf(lim * dt * 64.f), aLim = magL * sinf(lim * dt * 64.f);
        const float den = lre * lre + lim * lim;
        const float fre = ((are - 1.0f) * lre + aim * lim) / den, fim = (aim * lre - (are - 1.0f) * lim) / den;
        float* o = (float*)(p.ws + WS_S5P) + (size_t)i * S5P_STRIDE;
        o[0] = are; o[1] = aim; o[2] = aLre; o[3] = aLim;
        const float* bre = p.in[I_BRE] + (size_t)i * 16; const float* bim = p.in[I_BIM] + (size_t)i * 16;
        for (int h = 0; h < 16; ++h) { o[4 + h] = fre * bre[h] - fim * bim[h]; o[20 + h] = fre * bim[h] + fim * bre[h]; }
    }
}

DEVFN void mod_store_row(const Params& p, int layer, int which  , int row, const float (&h)[16], bf16* dstrow) {
    const int b = row / PT, pp = row % PT, mr = pp < LC ? NB : b, lane = tidx() & 63;
    const float* mv = (const float*)(p.ws + WS_MODV) + ((size_t)layer * (NB + 1) + mr) * 6144 + which * 3072;
#pragma unroll
    for (int i = 0; i < 4; ++i) { const int c = i * 256 + lane * 4; const f32x4 sh = *(const f32x4*)(mv + c), sc = *(const f32x4*)(mv + 1024 + c);
        u32x2 w; w.x = pack2(h[i * 4 + 0] * (1.f + sc[0]) + sh[0], h[i * 4 + 1] * (1.f + sc[1]) + sh[1]); w.y = pack2(h[i * 4 + 2] * (1.f + sc[2]) + sh[2], h[i * 4 + 3] * (1.f + sc[3]) + sh[3]);
        *(u32x2*)(dstrow + c) = w; }
}
DEVFN void phase_init_h(const Params& p) {
    const int wave = tidx() >> 6, lane = tidx() & 63; bf16* H = (bf16*)(p.ws + WS_H); bf16* A = (bf16*)(p.ws + WS_ABF);
    auto srcrow = [&](int row) { const int b = row / PT, pp = row % PT; return pp < LC ? p.in[I_CTX] + ((size_t)b * LC + pp) * D : p.in[I_X] + ((size_t)b * TS + (pp - LC)) * D; };
    f32x4 nx[4];
    int row = blockIdx.x * 8 + wave;
    if (row < MR) { const float* src = srcrow(row);
#pragma unroll
        for (int i = 0; i < 4; ++i) nx[i] = *(const f32x4*)(src + i * 256 + lane * 4); }
    for (; row < MR; row += gridDim.x * 8) { float h[16]; f32x4 cv[4];
#pragma unroll
        for (int i = 0; i < 4; ++i) cv[i] = nx[i];
        if (row + (int)gridDim.x * 8 < MR) { const float* src = srcrow(row + gridDim.x * 8);
#pragma unroll
            for (int i = 0; i < 4; ++i) nx[i] = *(const f32x4*)(src + i * 256 + lane * 4); }
#pragma unroll
        for (int i = 0; i < 4; ++i) { const f32x4 v = cv[i]; { u32x2 w; w.x = pack2(v[0], v[1]); w.y = pack2(v[2], v[3]); *(u32x2*)(H + (size_t)row * D + i * 256 + lane * 4) = w; } h[i * 4] = v[0]; h[i * 4 + 1] = v[1]; h[i * 4 + 2] = v[2]; h[i * 4 + 3] = v[3]; }
        mod_store_row(p, 0, 0, row, h, A + (size_t)row * D); }
}

DEVFN int lds_sw(int row, int ch) { return row * 128 + ((ch ^ (row & 7)) << 4); }
DEVFN void dma16(const void* g, unsigned char* l) {
#ifdef CPU_EMU
    memcpy(l + (emu::cur->lin & 63) * 16, g, 16);
#else
    __builtin_amdgcn_global_load_lds((const unsigned*)g, (LAS unsigned*)l, 16, 0, 0);
#endif
}
template <int N> DEVFN void dma_wait_barrier() {
#ifdef CPU_EMU
    __syncthreads();
#else
    asm volatile("s_waitcnt vmcnt(%0) lgkmcnt(0)" :: "n"(N) : "memory"); __builtin_amdgcn_s_barrier(); asm volatile("" ::: "memory");
#endif
}
template <int WM> struct GemmPtrs { const bf16* pa[WM]; const bf16* pb[2]; };
template <int WM, class RowA>
DEVFN void gemm_begin(unsigned char* lds, RowA rowA, const bf16* Bt, int K, int n0, GemmPtrs<WM>& g) {
    constexpr int NA = WM, ABYTES = WM * 8192, BUF = ABYTES + 16384;
    const int tid = tidx(), wave = tid >> 6;
#ifdef CPU_EMU
    const int wvu = wave;
#else
    const int wvu = __builtin_amdgcn_readfirstlane(wave);
#endif
#pragma unroll
    for (int i = 0; i < NA; ++i) { const int idx = i * NTH + tid, row = idx >> 3, ch = (idx & 7) ^ (row & 7); g.pa[i] = rowA(row) + ch * 8; }
#pragma unroll
    for (int i = 0; i < 2; ++i) { const int idx = i * NTH + tid, row = idx >> 3, ch = (idx & 7) ^ (row & 7); g.pb[i] = Bt + (size_t)(n0 + row) * K + ch * 8; }
#pragma unroll
    for (int t = 0; t < 2; ++t) {
#pragma unroll
        for (int i = 0; i < NA; ++i) dma16(g.pa[i] + t * 64, lds + t * BUF + (i * NTH + wvu * 64) * 16);
#pragma unroll
        for (int i = 0; i < 2; ++i) dma16(g.pb[i] + t * 64, lds + t * BUF + ABYTES + (i * NTH + wvu * 64) * 16); }
}
template <int WM, bool SWAP, class Hook, class Epi>
DEVFN void gemm_run(unsigned char* lds, const GemmPtrs<WM>& g, int K, Hook hook, Epi epi) {
    constexpr int WN = 8 / WM, NG = WM / 2, NA = WM, ABYTES = WM * 8192, BUF = ABYTES + 16384;
    static_assert(3 * BUF <= LDS_BYTES, "GEMM LDS");
    const int tid = tidx(), lane = tid & 63, wave = tid >> 6, wr = wave / WN, wc = wave % WN, fr = lane & 15, fg = lane >> 4;
#ifdef CPU_EMU
    const int wvu = wave;
#else
    const int wvu = __builtin_amdgcn_readfirstlane(wave);
#endif
    f32x4 acc[4][2 * NG];
#pragma unroll
    for (int m = 0; m < 4; ++m)
#pragma unroll
        for (int n = 0; n < 2 * NG; ++n) acc[m][n] = (f32x4){0.f, 0.f, 0.f, 0.f};
    const int nk = K / 64;
#define GM_DMA(kt, buf) do { _Pragma("unroll") for (int i = 0; i < NA; ++i) dma16(g.pa[i] + (kt) * 64, lds + (buf) + (i * NTH + wvu * 64) * 16); \
        _Pragma("unroll") for (int i = 0; i < 2; ++i) dma16(g.pb[i] + (kt) * 64, lds + (buf) + ABYTES + (i * NTH + wvu * 64) * 16); } while (0)
#define GM_COMPUTE(cur) do { _Pragma("unroll") for (int ks = 0; ks < 2; ++ks) { bf16x8 a[4], b[2 * NG]; \
        _Pragma("unroll") for (int m = 0; m < 4; ++m) a[m] = *(const bf16x8*)(lds + (cur) + lds_sw(wr * 64 + m * 16 + fr, ks * 4 + fg)); \
        _Pragma("unroll") for (int n = 0; n < 2 * NG; ++n) b[n] = *(const bf16x8*)(lds + (cur) + ABYTES + lds_sw(wc * 32 * NG + n * 16 + fr, ks * 4 + fg)); \
        _Pragma("unroll") for (int m = 0; m < 4; ++m) _Pragma("unroll") for (int n = 0; n < 2 * NG; ++n) acc[m][n] = SWAP ? mfma16(b[n], a[m], acc[m][n]) : mfma16(a[m], b[n], acc[m][n]); } } while (0)
    dma_wait_barrier<NA + 2>();
    int cur = 0, nxt2 = 2 * BUF;
    for (int kt = 0; kt < nk; ++kt) {
        if (kt + 2 < nk) GM_DMA(kt + 2, nxt2);
        GM_COMPUTE(cur);
        if (kt + 2 < nk) dma_wait_barrier<NA + 2>(); else dma_wait_barrier<0>();
        nxt2 = cur; cur = cur + BUF >= 3 * BUF ? 0 : cur + BUF;
    }
#undef GM_DMA
#undef GM_COMPUTE
    hook();
#pragma unroll
    for (int m = 0; m < 4; ++m)
#pragma unroll
        for (int g2 = 0; g2 < NG; ++g2) { if (SWAP) epi(wr * 64 + m * 16 + fr, wc * 32 * NG + g2 * 32 + 4 * fg, acc[m][2 * g2], acc[m][2 * g2 + 1]); else epi(wr * 64 + m * 16 + 4 * fg, wc * 32 * NG + g2 * 32, acc[m][2 * g2], acc[m][2 * g2 + 1]); }
}

namespace pg8 {
constexpr int BM = 256, BK = 64, HALF = 128, HTB = HALF * BK * 2  , STAGE_BYTES = 8 * HTB, NXCD = 8, WGM = 8;
DEVFN int lds_byte(int r, int c) { const int st = (r >> 4) * 2 + (c >> 5), rr = r & 15, cc = c & 31, ob = rr * 64 + cc * 2; return st * 1024 + (ob ^ (((ob >> 9) & 1) << 5)); }
DEVFN void stage_rc(int b, int& R, int& C) { const int st = b / 1024, sb = b % 1024, swz = sb ^ (((sb >> 9) & 1) << 5); R = (st >> 1) * 16 + swz / 64; C = (st & 1) * 32 + (swz % 64) / 2; }
struct Unit { int pm, pn; };
struct Gemm { const bf16* A; const bf16* Bt; int M, N, K; };
struct StaticOrder {
    int nM, nN, nwg, G, c;
    MEMFN void init(int M, int N, int G_, int c_) { nM = M / BM; nN = N / BM; nwg = nM * nN; G = G_; c = c_; }
    MEMFN bool next(int i, Unit& u) const {
        const long L = (long)i * G + c; if (L >= nwg) return false;
        int wgid = (int)L; { const int q = nwg / NXCD, r = nwg % NXCD, xcd = wgid % NXCD, off = wgid / NXCD; wgid = (xcd < r ? xcd * (q + 1) : r * (q + 1) + (xcd - r) * q) + off; }
        const int nig = WGM * nN, gid = wgid / nig, fm = gid * WGM, gsz = (nM - fm) < WGM ? (nM - fm) : WGM;
        u.pm = fm + ((wgid % nig) % gsz); u.pn = (wgid % nig) / gsz; return true;
    }
};
#ifdef CPU_EMU
#define PG8_WAIT_V(n) do {} while (0)
#define PG8_WAIT_L(n) do {} while (0)
#define PG8_BAR __syncthreads()
#define PG8_SCHED do {} while (0)
#define PG8_PRIO(x) do {} while (0)
#else
#define PG8_WAIT_V(n) asm volatile("s_waitcnt vmcnt(" #n ")" ::: "memory")
#define PG8_WAIT_L(n) asm volatile("s_waitcnt lgkmcnt(" #n ")" ::: "memory")
#define PG8_BAR __builtin_amdgcn_s_barrier()
#define PG8_SCHED __builtin_amdgcn_sched_barrier(0)
#define PG8_PRIO(x) __builtin_amdgcn_s_setprio(x)
#endif
template <class Epi, class Sched>
DEVFN void gemm_phase(unsigned char* lds, const Gemm g, const Sched& S, const Epi& E) {
    const int tid = tidx();
#ifdef CPU_EMU
    const int wid = tid >> 6;
#else
    const int wid = __builtin_amdgcn_readfirstlane(tid >> 6);
#endif
    const int lane = tid & 63, wr = wid >> 2, wc = wid & 3, fr = lane & 15, fq = lane >> 4;
    const int K = g.K, nt = K / BK;
    unsigned voffA[2], voffB[2];
#pragma unroll
    for (int i = 0; i < 2; ++i) { int R, C; stage_rc(tid * 16 + i * 8192, R, C); voffA[i] = (unsigned)(R * K + C) * 2u; voffB[i] = voffA[i]; }
    const size_t kstep = (size_t)(BK * 2);
    const size_t hstep = (size_t)HALF * K * 2;
    const size_t tstep = 2 * hstep;
    const unsigned ldsw = (unsigned)wid * 1024u;
    const int aoff = lds_byte(wr * 64 + fr, fq * 8), boff = lds_byte(wc * 32 + fr, fq * 8);
#define PG8_SA(b, h) (((b) * 2 + (h)) * HTB)
#define PG8_SB(b, h) ((4 + (b) * 2 + (h)) * HTB)
#define PG8_STAGE(bufoff, gbase, voff) do { _Pragma("unroll") for (int _i = 0; _i < 2; ++_i) dma16((const char*)(gbase) + (voff)[_i], lds + (bufoff) + ldsw + _i * 8192); } while (0)
#define PG8_LDA(dst, b, h) do { _Pragma("unroll") for (int m = 0; m < 4; ++m) _Pragma("unroll") for (int k = 0; k < 2; ++k) dst[m][k] = *(const bf16x8*)(lds + PG8_SA(b, h) + aoff + m * 2048 + k * 1024); } while (0)
#define PG8_LDB(dst, b, h) do { _Pragma("unroll") for (int n = 0; n < 2; ++n) _Pragma("unroll") for (int k = 0; k < 2; ++k) dst[n][k] = *(const bf16x8*)(lds + PG8_SB(b, h) + boff + n * 2048 + k * 1024); } while (0)
#define PG8_MMA(ai, bj, At, Bt) do { PG8_PRIO(1); _Pragma("unroll") for (int m = 0; m < 4; ++m) _Pragma("unroll") for (int n = 0; n < 2; ++n) _Pragma("unroll") for (int k = 0; k < 2; ++k) \
        acc[ai][bj][m][n] = mfma16(Bt[n][k], At[m][k], acc[ai][bj][m][n]); PG8_PRIO(0); } while (0)
    Unit cur, nxt; int ui = 0;
    __syncthreads();
    if (!S.next(0, cur)) return;
    f32x4 acc[2][2][4][2];
#pragma unroll
    for (int a = 0; a < 2; ++a)
#pragma unroll
        for (int b = 0; b < 2; ++b)
#pragma unroll
            for (int m = 0; m < 4; ++m)
#pragma unroll
                for (int n = 0; n < 2; ++n) acc[a][b][m][n] = (f32x4){0.f, 0.f, 0.f, 0.f};
    bf16x8 At[4][2], B0[2][2], B1[2][2];
    const char* cA = (const char*)g.A + (size_t)cur.pm * tstep; const char* cB = (const char*)g.Bt + (size_t)cur.pn * tstep;
    PG8_STAGE(PG8_SB(0, 0), cB, voffB); PG8_STAGE(PG8_SA(0, 0), cA, voffA); PG8_STAGE(PG8_SB(0, 1), cB + hstep, voffB); PG8_STAGE(PG8_SA(0, 1), cA + hstep, voffA);
    if (wr == 1) PG8_BAR;
    PG8_WAIT_V(4); PG8_BAR;
    PG8_STAGE(PG8_SB(1, 0), cB + kstep, voffB); PG8_STAGE(PG8_SA(1, 0), cA + kstep, voffA); PG8_STAGE(PG8_SB(1, 1), cB + hstep + kstep, voffB);
    PG8_WAIT_V(6); PG8_BAR;
    for (;;) {
        const bool has_next = S.next(ui + 1, nxt);
        const char* nA = has_next ? (const char*)g.A + (size_t)nxt.pm * tstep : cA; const char* nB = has_next ? (const char*)g.Bt + (size_t)nxt.pn * tstep : cB;
        for (int t = 0; t < nt; t += 2) {
            const bool last = (t == nt - 2);
            const char* a1 = cA + (size_t)(t + 1) * kstep;
            const char* a2 = last ? nA : cA + (size_t)(t + 2) * kstep; const char* b2 = last ? nB : cB + (size_t)(t + 2) * kstep;
            const char* a3 = a2 + kstep; const char* b3 = b2 + kstep;
            PG8_LDB(B0, 0, 0); PG8_SCHED; PG8_LDA(At, 0, 0); PG8_STAGE(PG8_SA(1, 1), a1 + hstep, voffA);
            PG8_WAIT_L(8); PG8_BAR; PG8_WAIT_L(0); PG8_MMA(0, 0, At, B0); PG8_BAR; PG8_SCHED;
            PG8_LDB(B1, 0, 1); PG8_STAGE(PG8_SB(0, 0), b2, voffB);
            PG8_BAR; PG8_WAIT_L(0); PG8_MMA(0, 1, At, B1); PG8_BAR;
            PG8_LDA(At, 0, 1); PG8_STAGE(PG8_SA(0, 0), a2, voffA);
            PG8_BAR; PG8_WAIT_L(0); PG8_MMA(1, 0, At, B0); PG8_BAR; PG8_SCHED;
            PG8_STAGE(PG8_SB(0, 1), b2 + hstep, voffB);
            PG8_WAIT_V(6); PG8_BAR; PG8_MMA(1, 1, At, B1); PG8_BAR;
            PG8_LDB(B0, 1, 0); PG8_SCHED; PG8_LDA(At, 1, 0); PG8_STAGE(PG8_SA(0, 1), a2 + hstep, voffA);
            PG8_WAIT_L(8); PG8_BAR; PG8_WAIT_L(0); PG8_MMA(0, 0, At, B0); PG8_BAR; PG8_SCHED;
            PG8_LDB(B1, 1, 1); PG8_STAGE(PG8_SB(1, 0), b3, voffB);
            PG8_BAR; PG8_WAIT_L(0); PG8_MMA(0, 1, At, B1); PG8_BAR;
            PG8_LDA(At, 1, 1); PG8_STAGE(PG8_SA(1, 0), a3, voffA);
            PG8_BAR; PG8_WAIT_L(0); PG8_MMA(1, 0, At, B0); PG8_BAR; PG8_SCHED;
            PG8_STAGE(PG8_SB(1, 1), b3 + hstep, voffB);
            PG8_WAIT_V(6); PG8_BAR; PG8_MMA(1, 1, At, B1); PG8_BAR;
        }
        E(acc, cur, wr, wc, fr, fq);
        if (!has_next) break;
#pragma unroll
        for (int a = 0; a < 2; ++a)
#pragma unroll
            for (int b = 0; b < 2; ++b)
#pragma unroll
                for (int m = 0; m < 4; ++m)
#pragma unroll
                    for (int n = 0; n < 2; ++n) acc[a][b][m][n] = (f32x4){0.f, 0.f, 0.f, 0.f};
        cur = nxt; cA = nA; cB = nB; ++ui;
    }
    PG8_WAIT_V(0);
    if (wr == 0) PG8_BAR;
    PG8_BAR;
#undef PG8_SA
#undef PG8_SB
#undef PG8_STAGE
#undef PG8_LDA
#undef PG8_LDB
#undef PG8_MMA
}
template <class F> struct EpiFn { F f;
    MEMFN void operator()(const f32x4 (&acc)[2][2][4][2], const Unit& u, int wr, int wc, int fr, int fq) const {
#pragma unroll
        for (int ai = 0; ai < 2; ++ai)
#pragma unroll
            for (int m = 0; m < 4; ++m)
#pragma unroll
                for (int bj = 0; bj < 2; ++bj) f(u.pm * BM + ai * HALF + wr * 64 + m * 16 + fr, u.pn * BM + bj * HALF + wc * 32 + 4 * fq, acc[ai][bj][m][0], acc[ai][bj][m][1]); }
};
struct LatentOrder {
    int nN, nwg, G, c;
    MEMFN void init(int N, int G_, int c_) { nN = N / BM; nwg = (TS / BM) * NB * nN; G = G_; c = c_; }
    MEMFN bool next(int i, Unit& u) const { const long L = (long)i * G + c; if (L >= nwg) return false; const int lp = (int)(L / nN); u.pn = (int)(L % nN); u.pm = (lp / (TS / BM)) * (PT / BM) + LC / BM + lp % (TS / BM); return true; }
};
template <class F> DEVFN void run_latent(unsigned char* lds, const bf16* A, const bf16* Bt, int M, int N, int K, F f) {
    Gemm g{A, Bt, M, N, K}; LatentOrder S; S.init(N, (int)gridDim.x, (int)blockIdx.x); EpiFn<F> E{f}; gemm_phase(lds, g, S, E);
}
template <class F> DEVFN void run(unsigned char* lds, const bf16* A, const bf16* Bt, int M, int N, int K, F f) {
    Gemm g{A, Bt, M, N, K}; StaticOrder S; S.init(M, N, (int)gridDim.x, (int)blockIdx.x); EpiFn<F> E{f}; gemm_phase(lds, g, S, E);
}
}

DEVFN int vperm(int pp) { return (pp & ~12) | ((pp & 4) << 1) | ((pp & 8) >> 1); }
DEVFN f32x4 load4b(const bf16* src) { const u32x2 w = *(const u32x2*)src; return (f32x4){bitsf(w.x << 16), bitsf(w.x & 0xffff0000u), bitsf(w.y << 16), bitsf(w.y & 0xffff0000u)}; }
DEVFN void store4s(bf16* dst, const f32x4& v, float sc) { u32x2 w; w.x = pack2(v[0] * sc, v[1] * sc); w.y = pack2(v[2] * sc, v[3] * sc); *(u32x2*)dst = w; }
DEVFN void store4_t(bf16* dst, const f32x4& v) { u32x2 w; w.x = pack2(v[0], v[1]); w.y = pack2(v[2], v[3]); *(u32x2*)dst = w; }

constexpr int GW_INE = 2, GW_INO = 2, GW_OUT = 2, GW_GLU = 2;
constexpr bool SPLIT_CTX = (LC % 256 == 0) && (PT % 256 == 0);
template <class RB, class F> DEVFN void gemm_small_rows(unsigned char* lds, const bf16* A, int lda, const bf16* Bt, int nnt, int K, int nrt, RB rowbase, F f) {
    const int NU = nrt * nnt; GemmPtrs<2> gp, gq;
    auto begin = [&](int u, GemmPtrs<2>& g) { const int m0 = rowbase(u / nnt), n0 = (u % nnt) * 128; gemm_begin<2>(lds, [&](int r) { return A + (size_t)(m0 + r) * lda; }, Bt, K, n0, g); };
    __syncthreads();
    if ((int)blockIdx.x < NU) begin(blockIdx.x, gp);
    for (int u = blockIdx.x; u < NU; u += gridDim.x, gp = gq) { const int m0 = rowbase(u / nnt), n0 = (u % nnt) * 128;
        gemm_run<2, true>(lds, gp, K, [&]() { if (u + (int)gridDim.x < NU) begin(u + gridDim.x, gq); }, [&](int rl, int cl, const f32x4& a0, const f32x4& a1) { f(m0 + rl, n0 + cl, a0, a1); }); }
}
template <class F> DEVFN void gemm_ctx_rows(unsigned char* lds, const bf16* A, int lda, const bf16* Bt, int N, int K, F f) {
    constexpr int RT = LC / 128; gemm_small_rows(lds, A, lda, Bt, N / 128, K, NB * RT, [&](int rt) { return (rt / RT) * PT + (rt % RT) * 128; }, f);
}
template <class F> DEVFN void dense_gemm(unsigned char* lds, const bf16* A, const bf16* Bt, int N, int K, bool ctx_needed, F f) {
    if constexpr (SPLIT_CTX) { pg8::run_latent(lds, A, Bt, MR, N, K, f); if (ctx_needed) gemm_ctx_rows(lds, A, K, Bt, N, K, f); }
    else pg8::run(lds, A, Bt, MR, N, K, f);
}
DEVFN void scatter4_t(bf16* base, size_t rowstride, const f32x4& v) {
#pragma unroll
    for (int e = 0; e < 4; ++e) base[(size_t)e * rowstride] = f2bf(v[e]);
}
DEVFN void phase_inproj_even(const Params& p, unsigned char* lds, int l) {
    const bf16* A = (const bf16*)(p.ws + WS_ABF); const bf16* Bt = (const bf16*)(p.ws + WS_WIN) + (size_t)l * WIN_LSTRIDE; bf16* Z = (bf16*)(p.ws + WS_Z);
    dense_gemm(lds, A, Bt, EVEN_N, D, true, [&](int row, int col, const f32x4& a0, const f32x4& a1) {
        const int region = col >> 9, cc = col & 511;
        if (region == 3) { const int b = row / PT, pp = row % PT;
            bf16* vb = Z + ZE_VT + ((size_t)(b * 8 + (cc >> 6)) * 64 + (cc & 63)) * PT + vperm(pp); scatter4_t(vb, PT, a0); scatter4_t(vb + (size_t)16 * PT, PT, a1); }
        else { bf16* dst = Z + (region == 0 ? ZE_U : region == 1 ? ZE_Q : ZE_K) + (size_t)row * 512 + cc; const float sc = region == 1 ? QSCALE : 1.0f; store4s(dst, a0, sc); store4s(dst + 16, a1, sc); } });
}

DEVFN void phase_inproj_odd(const Params& p, unsigned char* lds, int l) {
    const bf16* A = (const bf16*)(p.ws + WS_ABF); const bf16* Bt = (const bf16*)(p.ws + WS_WIN) + (size_t)l * WIN_LSTRIDE; bf16* Z = (bf16*)(p.ws + WS_Z);
    const int fg = (tidx() & 63) >> 4;
    const float* rtab = (const float*)(p.ws + WS_ROPE);
    auto epi = [&](int row, int cb, const f32x4& a0, const f32x4& a1) {
        const int b = row / PT, pp = row % PT;
        if (cb < 256) { store4s(Z + ZO_GQ + (size_t)row * 256 + cb, a0, 0.125f); store4s(Z + ZO_GQ + (size_t)row * 256 + cb + 16, a1, 0.125f); }
        else if (cb < 512) { const int c = cb - 256;
            store4s(Z + ZO_GK + (size_t)row * 256 + c, a0, 1.0f); store4s(Z + ZO_GK + (size_t)row * 256 + c + 16, a1, 1.0f);
            bf16* kb = Z + ZO_GKT + ((size_t)(b * 4 + (c >> 6)) * 64 + (c & 63)) * PT + pp; scatter4_t(kb, PT, a0); scatter4_t(kb + (size_t)16 * PT, PT, a1); }
        else if (cb < 1024) { const int c = cb - 512; bf16* vb = Z + ZO_GVT + ((size_t)(b * 4 + (c >> 7)) * 128 + (c & 127)) * PT + pp; scatter4_t(vb, PT, a0); scatter4_t(vb + (size_t)16 * PT, PT, a1); }
        else if (cb < 1536) { store4s(Z + ZO_GR + (size_t)row * 512 + cb - 1024, a0, 1.0f); store4s(Z + ZO_GR + (size_t)row * 512 + cb - 1024 + 16, a1, 1.0f); }
        else if (cb < 2560) {
            const bool isq = cb < 2048; const int c0 = cb - (isq ? 1536 : 2048); const int blk = (c0 >> 5) & 1; bf16* dst = Z + (isq ? ZO_DQ : ZO_DK) + (size_t)row * 512 + c0; const float sc = isq ? QSCALE : 1.0f;
            f32x4 x1 = a0 * sc, x2 = a1 * sc;
            if (pp >= LC) { const int t = pp - LC; const int pos = blk == 0 ? (t >> 6) : (t & 63); const f32x4 cs = *(const f32x4*)(rtab + pos * 16 + 4 * fg), sn = *(const f32x4*)(rtab + 1024 + pos * 16 + 4 * fg);
                const f32x4 o1 = x1 * cs - x2 * sn, o2 = x1 * sn + x2 * cs; x1 = o1; x2 = o2; }
            store4s(dst, x1, 1.0f); store4s(dst + 16, x2, 1.0f); }
        else if (cb < 3072) { const int c = cb - 2560; bf16* vb = Z + ZO_DVT + ((size_t)(b * 4 + (c >> 7)) * 128 + (c & 127)) * PT + vperm(pp); scatter4_t(vb, PT, a0); scatter4_t(vb + (size_t)16 * PT, PT, a1); }
        else if (cb < 3072 + 16) { store4s(Z + ZO_GZ + (size_t)row * 32 + (cb - 3072), a0, 1.0f); store4s(Z + ZO_GZ + (size_t)row * 32 + (cb - 3072) + 16, a1, 1.0f); } };
    if constexpr (SPLIT_CTX) {
        dense_gemm(lds, A, Bt, 3072, D, true, epi);
        gemm_small_rows(lds, A, D, Bt + (size_t)3072 * D, 1, D, MR / 128, [&](int rt) { return rt * 128; },
                        [&](int row, int col, const f32x4& a0, const f32x4& a1) { epi(row, 3072 + col, a0, a1); });
    } else pg8::run(lds, A, Bt, MR, ODD_NP, D, epi);
}

DEVFN void phase_glu(const Params& p, unsigned char* lds, int j) {
    const bf16* A = (const bf16*)(p.ws + WS_SB + SBO_GS); const bf16* Bt = (const bf16*)(p.ws + WS_GLU) + (size_t)j * 1024 * 512; bf16* Y = (bf16*)(p.ws + WS_YMIX);
    const float* gb = p.in[I_GLUB] + (size_t)j * 1024;
    dense_gemm(lds, A, Bt, 1024, 512, true, [&](int row, int col, const f32x4& a0, const f32x4& a1) {
        const int jj = (col >> 5) * 16 + (col & 15); const f32x4 bv = *(const f32x4*)(gb + jj), bg = *(const f32x4*)(gb + 512 + jj); f32x4 o;
#pragma unroll
        for (int r = 0; r < 4; ++r) o[r] = (a0[r] + bv[r]) * sigmoidf_(a1[r] + bg[r]);
        store4s(Y + (size_t)row * D + jj, o, 1.0f); });
}

constexpr int OPS = 4;
constexpr size_t OP_PSTRIDE = (size_t)NB * LC * D;
static_assert(!SPLIT_CTX || OPS * OP_PSTRIDE * 4 <= (size_t)2 * MR * D * 2, "split-K partials must fit the MoE output region");
DEVFN void outproj_ctx_splitk(unsigned char* lds, const bf16* A, const bf16* Bt, float* P) {
    constexpr int RT = LC / 128, NNT = D / 128, NU = NB * RT * NNT * OPS, KS = D / OPS;
    GemmPtrs<2> gp, gq;
    auto begin = [&](int u, GemmPtrs<2>& g) { const int s = u % OPS, t = u / OPS, rt = t / NNT, n0 = (t % NNT) * 128, m0 = (rt / RT) * PT + (rt % RT) * 128;
        gemm_begin<2>(lds, [&](int r) { return A + (size_t)(m0 + r) * D + s * KS; }, Bt + s * KS, D, n0, g); };
    __syncthreads();
    if ((int)blockIdx.x < NU) begin(blockIdx.x, gp);
    for (int u = blockIdx.x; u < NU; u += gridDim.x, gp = gq) { const int s = u % OPS, t = u / OPS, rt = t / NNT, n0 = (t % NNT) * 128, c0 = (rt / RT) * LC + (rt % RT) * 128;
        gemm_run<2, true>(lds, gp, KS, [&]() { if (u + (int)gridDim.x < NU) begin(u + gridDim.x, gq); }, [&](int rl, int cl, const f32x4& a0, const f32x4& a1) {
            float* dst = P + (size_t)s * OP_PSTRIDE + (size_t)(c0 + rl) * D + n0 + cl; *(f32x4*)dst = a0; *(f32x4*)(dst + 16) = a1; }); }
}
DEVFN void phase_outproj(const Params& p, unsigned char* lds, int l) {
    const bf16* A = (const bf16*)(p.ws + WS_YMIX); const bf16* Bt = (const bf16*)(p.ws + WS_WOUT) + (size_t)l * D * D; bf16* C = (bf16*)(p.ws + WS_Z);
    auto epi = [&](int row, int col, const f32x4& a0, const f32x4& a1) { bf16* dst = C + (size_t)row * D + col; store4s(dst, a0, 1.0f); store4s(dst + 16, a1, 1.0f); };
    if constexpr (SPLIT_CTX) { pg8::run_latent(lds, A, Bt, MR, D, D, epi); outproj_ctx_splitk(lds, A, Bt, (float*)(p.ws + WS_SB)); }
    else dense_gemm(lds, A, Bt, D, D, true, epi);
}

struct MoeMap { int e, mt, cnt, off; };
DEVFN bool moe_find(const unsigned* cnt, int tile, MoeMap& mm) {
    int acc = 0;
    for (int e = 0; e < NEXP; ++e) { const int c = (int)cnt[e], nt = (c + 127) >> 7; if (tile < acc + nt) { mm.e = e; mm.mt = tile - acc; mm.cnt = c; mm.off = acc * 128; return true; } acc += nt; }
    return false;
}
DEVFN int moe_off(const unsigned* cnt, int e) { int acc = 0; for (int i = 0; i < e; ++i) acc += ((int)cnt[i] + 127) >> 7; return acc * 128; }
constexpr int MOE_TAB = 3 * 32768;
DEVFN const unsigned* moe_table(unsigned char* lds, const unsigned* cnt) {
    unsigned* tab = (unsigned*)(lds + MOE_TAB);
    __syncthreads();
    if (tidx() < NEXP) tab[tidx()] = cnt[tidx()];
    __syncthreads();
    return tab;
}

DEVFN void phase_moe_up(const Params& p, unsigned char* lds, int l) {
    const bf16* A = (const bf16*)(p.ws + WS_ABF); bf16* ACT = (bf16*)(p.ws + WS_ACT); const unsigned* cnt = (const unsigned*)(p.ws + WS_CTL + CTL_CNT) + l * NEXP;
    const int* ltok = (const int*)(p.ws + WS_LTOK); const float* lw = (const float*)(p.ws + WS_LW); const unsigned* tab = moe_table(lds, cnt);
    GemmPtrs<2> gp, gq; MoeMap mm, mn;
    auto begin = [&](const MoeMap& m, int nt, GemmPtrs<2>& g) { const bf16* Bt = (const bf16*)(p.ws + WS_MGU) + (size_t)(l * NEXP + m.e) * 512 * 1024; const int* lt = ltok + (size_t)m.e * MR;
        gemm_begin<2>(lds, [&](int r) { const int slot = m.mt * 128 + r; const int tok = lt[slot < m.cnt ? slot : 0]; return A + (size_t)tok * D; }, Bt, D, nt * 128, g); };
    int u = blockIdx.x; bool ok = moe_find(tab, u >> 2, mm);
    if (ok) begin(mm, u & 3, gp);
    while (ok) { const int un = u + gridDim.x; const bool okn = moe_find(tab, un >> 2, mn); const int n0 = (u & 3) * 128;
        gemm_run<2, true>(lds, gp, D, [&]() { if (okn) begin(mn, un & 3, gq); }, [&](int rl, int cl, const f32x4& a0, const f32x4& a1) {
            const int jj = ((n0 + cl) >> 5) * 16 + (cl & 15), slot = mm.mt * 128 + rl;
            if (slot < mm.cnt) { const float w = lw[(size_t)mm.e * MR + slot]; f32x4 o;
#pragma unroll
                for (int r = 0; r < 4; ++r) o[r] = siluf_(a0[r]) * a1[r] * w;
                store4s(ACT + (size_t)(mm.off + slot) * 256 + jj, o, 1.0f); } });
        gp = gq; mm = mn; ok = okn; u = un; }
}
DEVFN void phase_moe_down(const Params& p, unsigned char* lds, int l) {
    const bf16* ACT = (const bf16*)(p.ws + WS_ACT); bf16* F2 = (bf16*)(p.ws + WS_SB); const unsigned* cnt = (const unsigned*)(p.ws + WS_CTL + CTL_CNT) + l * NEXP;
    const unsigned* tab = moe_table(lds, cnt);
    GemmPtrs<2> gp, gq; MoeMap mm, mn;
    auto begin = [&](const MoeMap& m, int nt, GemmPtrs<2>& g) { const bf16* Bt = (const bf16*)(p.ws + WS_MDN) + (size_t)(l * NEXP + m.e) * 1024 * 256; const size_t r0 = (size_t)m.off + m.mt * 128;
        gemm_begin<2>(lds, [&](int r) { return ACT + (r0 + r) * 256; }, Bt, 256, nt * 128, g); };
    int u = blockIdx.x; bool ok = moe_find(tab, u >> 3, mm);
    if (ok) begin(mm, u & 7, gp);
    while (ok) { const int un = u + gridDim.x; const bool okn = moe_find(tab, un >> 3, mn); const int n0 = (u & 7) * 128; const size_t r0 = (size_t)mm.off + mm.mt * 128;
        gemm_run<2, true>(lds, gp, 256, [&]() { if (okn) begin(mn, un & 7, gq); }, [&](int rl, int cl, const f32x4& a0, const f32x4& a1) {
            bf16* dst = F2 + (r0 + rl) * D + n0 + cl; store4s(dst, a0, 1.0f); store4s(dst + 16, a1, 1.0f); });
        gp = gq; mm = mn; ok = okn; u = un; }
}

DEVFN void ln_row(float (&v)[16], const float* g, const float* bta, int lane) {
    float s = 0.f;
#pragma unroll
    for (int i = 0; i < 16; ++i) s += v[i];
    const float mu = wave_sum(s) * (1.0f / 1024.0f); float q = 0.f;
#pragma unroll
    for (int i = 0; i < 16; ++i) { const float d = v[i] - mu; q += d * d; }
    const float rstd = 1.0f / sqrtf(wave_sum(q) * (1.0f / 1024.0f) + LN_EPS);
#pragma unroll
    for (int i = 0; i < 4; ++i) { const f32x4 gg = *(const f32x4*)(g + i * 256 + lane * 4), bb = *(const f32x4*)(bta + i * 256 + lane * 4);
#pragma unroll
        for (int e = 0; e < 4; ++e) v[i * 4 + e] = (v[i * 4 + e] - mu) * rstd * gg[e] + bb[e]; }
}

DEVFN void ln_row_r(float (&v)[16], const float (&g)[16], const float (&bta)[16]) {
    float s = 0.f;
#pragma unroll
    for (int i = 0; i < 16; ++i) s += v[i];
    const float mu = wave_sum(s) * (1.0f / 1024.0f); float q = 0.f;
#pragma unroll
    for (int i = 0; i < 16; ++i) { const float d = v[i] - mu; q += d * d; }
    const float rstd = 1.0f / sqrtf(wave_sum(q) * (1.0f / 1024.0f) + LN_EPS);
#pragma unroll
    for (int i = 0; i < 16; ++i) v[i] = (v[i] - mu) * rstd * g[i] + bta[i];
}
DEVFN void ln_load_gb(const float* g, const float* bta, int lane, float (&gr)[16], float (&br)[16]) {
#pragma unroll
    for (int i = 0; i < 4; ++i) { const f32x4 gg = *(const f32x4*)(g + i * 256 + lane * 4), bb = *(const f32x4*)(bta + i * 256 + lane * 4);
#pragma unroll
        for (int e = 0; e < 4; ++e) { gr[i * 4 + e] = gg[e]; br[i * 4 + e] = bb[e]; } }
}

DEVFN void phase_ln1_route(const Params& p, unsigned char* lds, int l) {
    const int wave = tidx() >> 6, lane = tidx() & 63; bf16* H = (bf16*)(p.ws + WS_H); const bf16* C = (const bf16*)(p.ws + WS_Z); bf16* A = (bf16*)(p.ws + WS_ABF);
    unsigned* cnt = (unsigned*)(p.ws + WS_CTL + CTL_CNT) + l * NEXP; int* route = (int*)(p.ws + WS_ROUTE); int* ltok = (int*)(p.ws + WS_LTOK); float* lw = (float*)(p.ws + WS_LW);
    const float* wg = p.in[I_WGRP] + (size_t)l * D * 4; const float* we = p.in[I_WEXP] + (size_t)l * D * 32;
    float* hrow = (float*)lds;
    float* part = (float*)(lds + 32768);
    const int ke = wave * 128 + (lane >> 5) * 64, kg = wave * 128 + (lane >> 2) * 8;
    f32x2 wreg[32], wgr[4];
#pragma unroll
    for (int i = 0; i < 32; ++i) wreg[i] = (f32x2){we[(size_t)(ke + 2 * i) * 32 + (lane & 31)], we[(size_t)(ke + 2 * i + 1) * 32 + (lane & 31)]};
#pragma unroll
    for (int i = 0; i < 4; ++i) wgr[i] = (f32x2){wg[(size_t)(kg + 2 * i) * 4 + (lane & 3)], wg[(size_t)(kg + 2 * i + 1) * 4 + (lane & 3)]};
    const float bias = lane < 32 ? p.in[I_BEXP][l * 32 + lane] : (lane < 36 ? p.in[I_BGRP][l * 4 + lane - 32] : 0.f);
    unsigned* lcnt = (unsigned*)(lds + 49152); unsigned* lbase = lcnt + 32; int* rt = (int*)(lds + 49152 + 256);
    constexpr int RT_MAX = 1024;
    __syncthreads();
    if (tidx() < 32) lcnt[tidx()] = 0u;
    __syncthreads();
    float lng[16], lnb[16]; ln_load_gb(p.in[I_LNG] + (size_t)(l * 2) * D, p.in[I_LNB] + (size_t)(l * 2) * D, lane, lng, lnb);
    int nrec = 0; u32x2 hn[4], yn[4];
    if (blockIdx.x * 8 < MR) {
#pragma unroll
        for (int i = 0; i < 4; ++i) { const size_t o = (size_t)(blockIdx.x * 8 + wave) * D + i * 256 + lane * 4; hn[i] = __builtin_nontemporal_load((const u32x2*)(H + o)); yn[i] = __builtin_nontemporal_load((const u32x2*)(C + o)); } }
    for (int r0 = blockIdx.x * 8; r0 < MR; r0 += gridDim.x * 8, ++nrec) { const int row = r0 + wave; const int b = row / PT, pp = row % PT, mr = pp < LC ? NB : b;
        const float* mv = (const float*)(p.ws + WS_MODV) + ((size_t)l * (NB + 1) + mr) * 6144; float v[16];
        const bool ctxp = SPLIT_CTX && pp < LC; const float* pb = (const float*)(p.ws + WS_SB) + (size_t)(b * LC + (ctxp ? pp : 0)) * D;
#pragma unroll
        for (int i = 0; i < 4; ++i) { const int c = i * 256 + lane * 4; const f32x4 g1 = *(const f32x4*)(mv + 2048 + c);
            const f32x4 h = (f32x4){bitsf(hn[i].x << 16), bitsf(hn[i].x & 0xffff0000u), bitsf(hn[i].y << 16), bitsf(hn[i].y & 0xffff0000u)};
            f32x4 y = (f32x4){bitsf(yn[i].x << 16), bitsf(yn[i].x & 0xffff0000u), bitsf(yn[i].y << 16), bitsf(yn[i].y & 0xffff0000u)};
            if (ctxp) y = (*(const f32x4*)(pb + c) + *(const f32x4*)(pb + OP_PSTRIDE + c)) + (*(const f32x4*)(pb + 2 * OP_PSTRIDE + c) + *(const f32x4*)(pb + 3 * OP_PSTRIDE + c));
#pragma unroll
            for (int e = 0; e < 4; ++e) v[i * 4 + e] = ALPHA * h[e] + g1[e] * y[e]; }
        if (r0 + gridDim.x * 8 < MR) {
#pragma unroll
            for (int i = 0; i < 4; ++i) { const size_t o = (size_t)(row + gridDim.x * 8) * D + i * 256 + lane * 4; hn[i] = __builtin_nontemporal_load((const u32x2*)(H + o)); yn[i] = __builtin_nontemporal_load((const u32x2*)(C + o)); } }
        f32x4 shv[4], scv[4];
#pragma unroll
        for (int i = 0; i < 4; ++i) { const int c = i * 256 + lane * 4; shv[i] = *(const f32x4*)(mv + 3072 + c); scv[i] = *(const f32x4*)(mv + 4096 + c); }
        ln_row_r(v, lng, lnb);
        __syncthreads();
#pragma unroll
        for (int i = 0; i < 4; ++i) { const int c = i * 256 + lane * 4; { u32x2 hw; hw.x = pack2(v[i * 4], v[i * 4 + 1]); hw.y = pack2(v[i * 4 + 2], v[i * 4 + 3]); __builtin_nontemporal_store(hw, (u32x2*)(H + (size_t)row * D + c)); }
            const f32x4 sh = shv[i], sc = scv[i]; f32x4 h2;
#pragma unroll
            for (int e = 0; e < 4; ++e) h2[e] = v[i * 4 + e] * (1.f + sc[e]) + sh[e];
            *(f32x4*)(hrow + wave * 1024 + c) = h2;
            u32x2 w; w.x = pack2(h2[0], h2[1]); w.y = pack2(h2[2], h2[3]); *(u32x2*)(A + (size_t)row * D + c) = w; }
        __syncthreads();
#pragma unroll
        for (int r = 0; r < 8; ++r) { f32x2 ae2 = {0.f, 0.f}, ae3 = {0.f, 0.f}, ag2 = {0.f, 0.f};
#pragma unroll
            for (int i = 0; i < 64; i += 4) { const f32x4 hv = *(const f32x4*)(hrow + r * 1024 + ke + i);
                ae2 = __builtin_elementwise_fma((f32x2){hv[0], hv[1]}, wreg[i >> 1], ae2); ae3 = __builtin_elementwise_fma((f32x2){hv[2], hv[3]}, wreg[(i >> 1) + 1], ae3); }
#pragma unroll
            for (int i = 0; i < 8; i += 4) { const f32x4 hv = *(const f32x4*)(hrow + r * 1024 + kg + i);
                ag2 = __builtin_elementwise_fma((f32x2){hv[0], hv[1]}, wgr[i >> 1], ag2); ag2 = __builtin_elementwise_fma((f32x2){hv[2], hv[3]}, wgr[(i >> 1) + 1], ag2); }
            float ae = (ae2[0] + ae3[0]) + (ae2[1] + ae3[1]), ag = ag2[0] + ag2[1];
            ae += __shfl_xor(ae, 32);
            ag += __shfl_xor(ag, 4); ag += __shfl_xor(ag, 8); ag += __shfl_xor(ag, 16); ag += __shfl_xor(ag, 32);
            if (lane < 32) part[(wave * 8 + r) * 64 + lane] = ae; else if (lane < 36) part[(wave * 8 + r) * 64 + lane] = ag;
        }
        __syncthreads();
        float logit = bias;
#pragma unroll
        for (int w8 = 0; w8 < 8; ++w8) logit += part[(w8 * 8 + wave) * 64 + lane];
        float lg[4];
#pragma unroll
        for (int o = 0; o < 4; ++o) lg[o] = __shfl(logit, 32 + o);
        int gs = 0; float gm = lg[0];
#pragma unroll
        for (int o = 1; o < 4; ++o) if (lg[o] > gm) { gm = lg[o]; gs = o; }
        float den = 0.f;
#pragma unroll
        for (int o = 0; o < 4; ++o) den += fexp(lg[o] - gm);
        const float pg = 1.0f / den;
        float li[8];
#pragma unroll
        for (int e = 0; e < 8; ++e) li[e] = __shfl(logit, gs * 8 + e);
        int i0 = 0; float v0 = li[0];
#pragma unroll
        for (int e = 1; e < 8; ++e) if (li[e] > v0) { v0 = li[e]; i0 = e; }
        int i1 = -1; float v1 = -3.0e38f;
#pragma unroll
        for (int e = 0; e < 8; ++e) if (e != i0 && li[e] > v1) { v1 = li[e]; i1 = e; }
        if (i1 < 0) i1 = (i0 + 1) & 7;
        const float w0 = 1.0f / (1.0f + fexp(v1 - v0)), w1 = 1.0f - w0;
        if (lane == 0) { const int e0 = gs * 8 + i0, e1 = gs * 8 + i1; const int rec = nrec * 8 + wave;
            if (rec < RT_MAX) { int* q = rt + rec * 6; q[0] = e0; q[1] = e1; q[2] = (int)fbits(w0 * pg); q[3] = (int)fbits(w1 * pg); q[4] = (int)atomicAdd(&lcnt[e0], 1u); q[5] = (int)atomicAdd(&lcnt[e1], 1u); } }
    }
    __syncthreads();
    if (tidx() < 32) lbase[tidx()] = atomicAdd(&cnt[tidx()], lcnt[tidx()]);
    __syncthreads();
    for (int rec = tidx(); rec < nrec * 8 && rec < RT_MAX; rec += NTH) { const int row = (blockIdx.x + (rec >> 3) * gridDim.x) * 8 + (rec & 7); const int* q = rt + rec * 6;
        const int e0 = q[0], e1 = q[1], s0 = (int)lbase[e0] + q[4], s1 = (int)lbase[e1] + q[5];
        ltok[(size_t)e0 * MR + s0] = row; lw[(size_t)e0 * MR + s0] = bitsf((unsigned)q[2]); ltok[(size_t)e1 * MR + s1] = row; lw[(size_t)e1 * MR + s1] = bitsf((unsigned)q[3]);
        route[row * 4 + 0] = e0; route[row * 4 + 1] = e1; route[row * 4 + 2] = s0; route[row * 4 + 3] = s1; }
}

DEVFN void phase_ln2(const Params& p, unsigned char* lds, int l) {
    const int wave = tidx() >> 6, lane = tidx() & 63; bf16* H = (bf16*)(p.ws + WS_H); const bf16* F2 = (const bf16*)(p.ws + WS_SB); bf16* A = (bf16*)(p.ws + WS_ABF);
    const unsigned* cnt = (const unsigned*)(p.ws + WS_CTL + CTL_CNT) + l * NEXP; const int* route = (const int*)(p.ws + WS_ROUTE);
    int* offs = (int*)lds;
    __syncthreads();
    if (tidx() < NEXP) offs[tidx()] = moe_off(cnt, tidx());
    __syncthreads();
    float lng[16], lnb[16]; ln_load_gb(p.in[I_LNG] + (size_t)(l * 2 + 1) * D, p.in[I_LNB] + (size_t)(l * 2 + 1) * D, lane, lng, lnb);
    for (int rw = (blockIdx.x * 8 + wave) * 2; rw < MR; rw += gridDim.x * 16) {
        float v[2][16]; size_t r0[2], r1[2];
#pragma unroll
        for (int q = 0; q < 2; ++q) { const int row = rw + q; const int e0 = route[row * 4], e1 = route[row * 4 + 1]; r0[q] = (size_t)offs[e0] + route[row * 4 + 2]; r1[q] = (size_t)offs[e1] + route[row * 4 + 3]; }
#pragma unroll
        for (int q = 0; q < 2; ++q) { const int row = rw + q; const int b = row / PT, pp = row % PT, mr = pp < LC ? NB : b; const float* mv = (const float*)(p.ws + WS_MODV) + ((size_t)l * (NB + 1) + mr) * 6144;
#pragma unroll
            for (int i = 0; i < 4; ++i) { const int c = i * 256 + lane * 4; const f32x4 h = load4b(H + (size_t)row * D + c), g2 = *(const f32x4*)(mv + 5120 + c);
                const u32x2 fa = __builtin_nontemporal_load((const u32x2*)(F2 + r0[q] * D + c)), fb = __builtin_nontemporal_load((const u32x2*)(F2 + r1[q] * D + c));
                const float f0 = bitsf(fa.x << 16) + bitsf(fb.x << 16), f1 = bitsf(fa.x & 0xffff0000u) + bitsf(fb.x & 0xffff0000u), f2 = bitsf(fa.y << 16) + bitsf(fb.y << 16), f3 = bitsf(fa.y & 0xffff0000u) + bitsf(fb.y & 0xffff0000u);
                v[q][i * 4] = ALPHA * h[0] + g2[0] * f0; v[q][i * 4 + 1] = ALPHA * h[1] + g2[1] * f1; v[q][i * 4 + 2] = ALPHA * h[2] + g2[2] * f2; v[q][i * 4 + 3] = ALPHA * h[3] + g2[3] * f3; } }
#pragma unroll
        for (int q = 0; q < 2; ++q) { const int row = rw + q; const int b = row / PT, pp = row % PT;
            ln_row_r(v[q], lng, lnb);
#pragma unroll
            for (int i = 0; i < 4; ++i) { const int c = i * 256 + lane * 4; const f32x4 o = (f32x4){v[q][i * 4], v[q][i * 4 + 1], v[q][i * 4 + 2], v[q][i * 4 + 3]};
                if (l + 1 < NL) { u32x2 hw; hw.x = pack2(o[0], o[1]); hw.y = pack2(o[2], o[3]); __builtin_nontemporal_store(hw, (u32x2*)(H + (size_t)row * D + c)); }
                else if (pp >= LC) __builtin_nontemporal_store(o, (f32x4*)(p.out + ((size_t)b * TS + (pp - LC)) * D + c)); }
            if (l + 1 < NL) mod_store_row(p, l + 1, 0, row, v[q], A + (size_t)row * D); }
    }
}

DEVFN void wave_sync() {
#ifdef CPU_EMU
    (void)__shfl(0, 0);
#else
    __builtin_amdgcn_fence(__ATOMIC_RELEASE, "wavefront"); asm volatile("s_waitcnt lgkmcnt(0)" ::: "memory"); __builtin_amdgcn_wave_barrier(); __builtin_amdgcn_fence(__ATOMIC_ACQUIRE, "wavefront");
#endif
}
DEVFN bf16x8 cvt8(const f32x4 lo, const f32x4 hi, float sg) { u32x4 w; w[0] = pack2(lo[0] * sg, lo[1] * sg); w[1] = pack2(lo[2] * sg, lo[3] * sg); w[2] = pack2(hi[0] * sg, hi[1] * sg); w[3] = pack2(hi[2] * sg, hi[3] * sg); return __builtin_bit_cast(bf16x8, w); }
constexpr int S5_WAVE_LDS = 16 * 132 * 4;
DEVFN void s5_chunk(const Params& p, float* buf, int j, int b, int g, int c, int lane, const bool READOUT, int dlo = 0, int dhi = 2, float* xch = nullptr) {
    const int fr = lane & 15, fg = lane >> 4; const bf16* U = (const bf16*)(p.ws + WS_Z) + ZE_U + ((size_t)b * PT + c * 64) * 512 + g * 16;
    f32x4 y[4], y2[4];
#pragma unroll
    for (int sb = 0; sb < 4; ++sb) { y[sb] = (f32x4){0.f, 0.f, 0.f, 0.f}; y2[sb] = (f32x4){0.f, 0.f, 0.f, 0.f}; }
#pragma unroll 1
    for (int d = dlo; d < dhi; ++d) { const size_t pbase = (size_t)((j * 2 + d) * 32 + g) * 64; const float* prm = (const float*)(p.ws + WS_S5P);
        bf16x8 bbf[8];
#pragma unroll
        for (int n = 0; n < 8; ++n) { const int pp = (n & 3) * 16 + fr; const float* src = prm + (pbase + pp) * S5P_STRIDE + (n < 4 ? 4 : 20) + (fg & 1) * 8;
            f32x4 lo = *(const f32x4*)src, hi = *(const f32x4*)(src + 4); if (fg >= 2) { lo = (f32x4){0.f, 0.f, 0.f, 0.f}; hi = lo; } bbf[n] = cvt8(lo, hi, 1.0f); }
        bf16x8 cf[4];
        if (READOUT) {
#pragma unroll
            for (int ks = 0; ks < 4; ++ks) { const float* src = (ks < 2 ? p.in[I_CRE] : p.in[I_CIM]) + (((size_t)(j * 2 + d) * 32 + g) * 16 + fr) * 64 + (ks & 1) * 32 + fg * 8;
                cf[ks] = cvt8(*(const f32x4*)src, *(const f32x4*)(src + 4), ks < 2 ? 1.0f : -1.0f); } }
        const float are = prm[(pbase + lane) * S5P_STRIDE], aim = prm[(pbase + lane) * S5P_STRIDE + 1];
        float hr = 0.f, hi = 0.f;
        if (READOUT) { const f32x2 h0 = *(const f32x2*)((const float*)(p.ws + WS_SB + SBO_S5H) + ((size_t)((b * 32 + g) * 2 + d) * NCH + c) * 128 + lane * 2); hr = h0[0]; hi = h0[1]; }
#pragma unroll
        for (int sbi = 0; sbi < 4; ++sbi) { const int sb = d ? 3 - sbi : sbi;
            u32x4 uv = (u32x4){0u, 0u, 0u, 0u}; if (fg < 2) uv = *(const u32x4*)(U + (size_t)(sb * 16 + fr) * 512 + fg * 8); const bf16x8 ua = __builtin_bit_cast(bf16x8, uv);
            f32x4 yy = (f32x4){0.f, 0.f, 0.f, 0.f};
            wave_sync();
#pragma unroll
            for (int n = 0; n < 8; ++n) { const f32x4 t4 = mfma16(ua, bbf[n], (f32x4){0.f, 0.f, 0.f, 0.f});
#pragma unroll
                for (int r = 0; r < 4; ++r) buf[(fg * 4 + r) * 132 + n * 16 + fr] = t4[r]; }
            wave_sync();
            for (int t0 = 0; t0 < 16; ++t0) { const int tt = d ? 15 - t0 : t0; const float ur = buf[tt * 132 + lane], ui = buf[tt * 132 + 64 + lane];
                const float nr = are * hr - aim * hi + ur, ni = are * hi + aim * hr + ui; hr = nr; hi = ni;
                buf[tt * 132 + lane] = hr; buf[tt * 132 + 64 + lane] = hi; }
            if (READOUT) { wave_sync();
#pragma unroll
                for (int ks = 0; ks < 4; ++ks) { const float* hp = buf + fr * 132 + ks * 32 + fg * 8; yy = mfma16(cf[ks], cvt8(*(const f32x4*)hp, *(const f32x4*)(hp + 4), 1.0f), yy); }
                if (d == 0) y[sbi] += yy; else y2[sbi] += yy; }
        }
        if (!READOUT) *(f32x2*)((float*)(p.ws + WS_SB + SBO_S5E) + ((size_t)((b * 32 + g) * 2 + d) * NCH + c) * 128 + lane * 2) = (f32x2){hr, hi};
    }
    if (READOUT && xch) {
        if (dlo == 1) {
#pragma unroll
            for (int sb = 0; sb < 4; ++sb) *(f32x4*)(xch + (sb * 64 + lane) * 4) = y2[sb];
            __syncthreads(); return; }
        __syncthreads();
#pragma unroll
        for (int sb = 0; sb < 4; ++sb) y2[sb] = *(const f32x4*)(xch + (sb * 64 + lane) * 4); }
    if (READOUT) { bf16* GS = (bf16*)(p.ws + WS_SB + SBO_GS); const f32x4 dsk = *(const f32x4*)(p.in[I_S5D] + (size_t)j * 512 + g * 16 + fg * 4);
#pragma unroll
        for (int sb = 0; sb < 4; ++sb) { const int t = sb * 16 + fr; const u32x2 uu = *(const u32x2*)(U + (size_t)t * 512 + fg * 4); f32x4 o; y[sb] += y2[3 - sb];
            o[0] = geluf_(y[sb][0] + dsk[0] * bitsf(uu.x << 16)); o[1] = geluf_(y[sb][1] + dsk[1] * bitsf(uu.x & 0xffff0000u));
            o[2] = geluf_(y[sb][2] + dsk[2] * bitsf(uu.y << 16)); o[3] = geluf_(y[sb][3] + dsk[3] * bitsf(uu.y & 0xffff0000u));
            store4_t(GS + ((size_t)b * PT + c * 64 + t) * 512 + g * 16 + fg * 4, o); } }
}
DEVFN void phase_s5a(const Params& p, unsigned char* lds, int j) {
    const int wave = tidx() >> 6, lane = tidx() & 63; float* buf = (float*)(lds + wave * S5_WAVE_LDS);
    const int NIT = NB * 32 * NCH, GW = gridDim.x * 8, full = (NIT / GW) * GW, wid = blockIdx.x * 8 + wave;
    for (int it = wid; it < full; it += GW) { const int c = it % NCH, g = (it / NCH) % 32, b = it / (NCH * 32); s5_chunk(p, buf, j, b, g, c, lane, false); }
    for (int pi = wid; pi < 2 * (NIT - full); pi += GW) { const int it = full + (pi >> 1), d = pi & 1; const int c = it % NCH, g = (it / NCH) % 32, b = it / (NCH * 32); s5_chunk(p, buf, j, b, g, c, lane, false, d, d + 1); }
}
constexpr int S5B_BS = 17;
DEVFN int chunk_order(int d, int k);
DEVFN void phase_s5b(const Params& p, int j) {
    const float* E = (const float*)(p.ws + WS_SB + SBO_S5E); float* Hin = (float*)(p.ws + WS_SB + SBO_S5H);
    constexpr int NBT = (NCH + S5B_BS - 1) / S5B_BS;
    int vb = blockIdx.x, vstep = gridDim.x;
    if (gridDim.x == 256 && NB * 32 * 2 * 64 == 32 * NTH) { const int m = blockIdx.x & 15; if (m != 0 && m != 15) return; vb = (blockIdx.x >> 4) * 2 + (m == 15 ? 1 : 0); vstep = 32; }
    for (int i = vb * NTH + tidx(); i < NB * 32 * 2 * 64; i += vstep * NTH) { const int pi = i & 63, d = (i >> 6) & 1, g = (i >> 7) & 31, b = i >> 12;
        const float* pr = (const float*)(p.ws + WS_S5P) + ((size_t)((j * 2 + d) * 32 + g) * 64 + pi) * S5P_STRIDE; const float aLr = pr[2], aLi = pr[3];
        const size_t base = (size_t)((b * 32 + g) * 2 + d) * NCH; float hr = 0.f, hi = 0.f;
        f32x2 en[S5B_BS];
#pragma unroll
        for (int x = 0; x < S5B_BS; ++x) { const int k = x < NCH ? x : NCH - 1; const int c = chunk_order(d, k); en[x] = *(const f32x2*)(E + (base + c) * 128 + pi * 2); }
#pragma unroll 1
        for (int kb = 0; kb < NBT; ++kb) { f32x2 e[S5B_BS];
#pragma unroll
            for (int x = 0; x < S5B_BS; ++x) e[x] = en[x];
            if (kb + 1 < NBT) {
#pragma unroll
                for (int x = 0; x < S5B_BS; ++x) { const int k = (kb + 1) * S5B_BS + x < NCH ? (kb + 1) * S5B_BS + x : NCH - 1; const int c = chunk_order(d, k); en[x] = *(const f32x2*)(E + (base + c) * 128 + pi * 2); } }
#pragma unroll
            for (int x = 0; x < S5B_BS; ++x) { const int k = kb * S5B_BS + x; if (k < NCH) { const int c = chunk_order(d, k);
                *(f32x2*)(Hin + (base + c) * 128 + pi * 2) = (f32x2){hr, hi};
                const float nr = aLr * hr - aLi * hi + e[x][0], ni = aLr * hi + aLi * hr + e[x][1]; hr = nr; hi = ni; } } }
    }
}
DEVFN void phase_s5c(const Params& p, unsigned char* lds, int j) {
    const int wave = tidx() >> 6, lane = tidx() & 63; float* buf = (float*)(lds + wave * S5_WAVE_LDS);
    const int NIT = NB * 32 * NCH, GW = gridDim.x * 8, full = (NIT / GW) * GW, rem = NIT - full;
    for (int it = blockIdx.x * 8 + wave; it < full; it += GW) { const int c = it % NCH, g = (it / NCH) % 32, b = it / (NCH * 32); s5_chunk(p, buf, j, b, g, c, lane, true); }
    float* xch = (float*)(lds + 8 * S5_WAVE_LDS) + (wave & 3) * 1024;
    for (int base = blockIdx.x * 4; base < rem; base += gridDim.x * 4) { const int ri = base + (wave & 3), d = wave >> 2;
        if (ri < rem) { const int it = full + ri; const int c = it % NCH, g = (it / NCH) % 32, b = it / (NCH * 32); s5_chunk(p, buf, j, b, g, c, lane, true, d, d + 1, xch); }
        else __syncthreads();
        __syncthreads(); }
}

template <int NDV> struct AttnState { float m, l; f32x16 o[NDV]; };
template <int NDV> DEVFN void attn_init(AttnState<NDV>& st) { st.m = -INFINITY; st.l = 0.f;
#pragma unroll
    for (int i = 0; i < NDV; ++i)
#pragma unroll
        for (int r = 0; r < 16; ++r) st.o[i][r] = 0.f; }
DEVFN float attn_softmax(float& m, float& l, f32x16 s, bf16x8 (&pb)[2]) {
    float mx = fmaxf(fmaxf(fmaxf(s[0], s[1]), fmaxf(s[2], s[3])), fmaxf(fmaxf(s[4], s[5]), fmaxf(s[6], s[7])));
    mx = fmaxf(mx, fmaxf(fmaxf(fmaxf(s[8], s[9]), fmaxf(s[10], s[11])), fmaxf(fmaxf(s[12], s[13]), fmaxf(s[14], s[15]))));
    mx = fmaxf(mx, __shfl_xor(mx, 32));
    const float mn = fmaxf(m, mx), ms = mn == -INFINITY ? 0.f : mn, corr = fexp2(m - ms);
    m = mn; float ps = 0.f;
#pragma unroll
    for (int r = 0; r < 16; ++r) { s[r] = fexp2(s[r] - ms); ps += s[r]; }
    ps += __shfl_xor(ps, 32);
    l = l * corr + ps;
#pragma unroll
    for (int ks = 0; ks < 2; ++ks) { u32x4 w;
#pragma unroll
        for (int jj = 0; jj < 4; ++jj) w[jj] = pack2(s[8 * ks + 2 * jj], s[8 * ks + 2 * jj + 1]);
        pb[ks] = __builtin_bit_cast(bf16x8, w); }
    return corr;
}
DEVFN bf16x8 cat4(const bf16x4 a, const bf16x4 b) { bf16x8 o;
#pragma unroll
    for (int jj = 0; jj < 4; ++jj) { o[jj] = a[jj]; o[4 + jj] = b[jj]; }
    return o; }
template <int NDV, class VLoad>
DEVFN void attn_update(AttnState<NDV>& st, f32x16 s, VLoad vload) {
    bf16x8 pb[2]; const float corr = attn_softmax(st.m, st.l, s, pb);
    if (!wave_all(corr == 1.0f)) {
#pragma unroll
        for (int i = 0; i < NDV; ++i)
#pragma unroll
            for (int r = 0; r < 16; ++r) st.o[i][r] *= corr; }
#pragma unroll
    for (int ks = 0; ks < 2; ++ks)
#pragma unroll
        for (int mt = 0; mt < NDV; ++mt) st.o[mt] = mfma32(vload(mt, ks), pb[ks], st.o[mt]);
}

DEVFN float attn_softmax2(float& m, float& l, f32x16 s0, f32x16 s1, bf16x8 (&pb0)[2], bf16x8 (&pb1)[2]) {
    float mx = fmaxf(s0[0], s1[0]);
#pragma unroll
    for (int r = 1; r < 16; ++r) mx = fmaxf(mx, fmaxf(s0[r], s1[r]));
    mx = fmaxf(mx, __shfl_xor(mx, 32));
    const float mn = fmaxf(m, mx), ms = mn == -INFINITY ? 0.f : mn, corr = fexp2(m - ms);
    m = mn; float ps = 0.f;
#pragma unroll
    for (int r = 0; r < 16; ++r) { s0[r] = fexp2(s0[r] - ms); s1[r] = fexp2(s1[r] - ms); ps += s0[r] + s1[r]; }
    ps += __shfl_xor(ps, 32);
    l = l * corr + ps;
#pragma unroll
    for (int ks = 0; ks < 2; ++ks) { u32x4 w0, w1;
#pragma unroll
        for (int jj = 0; jj < 4; ++jj) { w0[jj] = pack2(s0[8 * ks + 2 * jj], s0[8 * ks + 2 * jj + 1]); w1[jj] = pack2(s1[8 * ks + 2 * jj], s1[8 * ks + 2 * jj + 1]); }
        pb0[ks] = __builtin_bit_cast(bf16x8, w0); pb1[ks] = __builtin_bit_cast(bf16x8, w1); }
    return corr;
}
template <int NDV, class VLoad>
DEVFN void attn_update2(AttnState<NDV>& st, f32x16 s0, f32x16 s1, VLoad vload) {
    bf16x8 pb0[2], pb1[2]; const float corr = attn_softmax2(st.m, st.l, s0, s1, pb0, pb1);
    if (!wave_all(corr == 1.0f)) {
#pragma unroll
        for (int i = 0; i < NDV; ++i)
#pragma unroll
            for (int r = 0; r < 16; ++r) st.o[i][r] *= corr; }
#pragma unroll
    for (int ks = 0; ks < 2; ++ks)
#pragma unroll
        for (int mt = 0; mt < NDV; ++mt) { st.o[mt] = mfma32(vload(0, mt, ks), pb0[ks], st.o[mt]); st.o[mt] = mfma32(vload(1, mt, ks), pb1[ks], st.o[mt]); }
}

constexpr int NAT_STAGE = 16384, NAT_RING = 4, NAT_RPB = NAT_RING * NAT_STAGE;
DEVFN void phase_natten(const Params& p, unsigned char* lds, int j) {
    const int tid = tidx(), wave = tid >> 6, lane = tid & 63, ql = lane & 31, hh = lane >> 5;
#ifdef CPU_EMU
    const int wvu = wave;
#else
    const int wvu = __builtin_amdgcn_readfirstlane(wave);
#endif
    const bf16* Z = (const bf16*)(p.ws + WS_Z); const bf16* Q = Z + ZE_Q; const bf16* K = Z + ZE_K; const bf16* VT = Z + ZE_VT; bf16* Y = (bf16*)(p.ws + WS_YMIX);
    float* rpbs = (float*)(lds + NAT_RPB);
    constexpr int NRG = GROWS / 4, NLAT = NB * 8 * NRG, NCQ = (LC + 255) / 256, NCTX = NB * 8 * NCQ, NCT = LC / 64;
    const bool remap = gridDim.x == 256 && NLAT == 512 && NCTX == 32 && NRG == 16;
    for (int uu = blockIdx.x; uu < NLAT + (remap ? (int)gridDim.x : NCTX); uu += gridDim.x) { int u = uu;
        if (remap && uu >= NLAT) { const int m = blockIdx.x & 15; if (m != 0 && m != 15) break; u = NLAT + (blockIdx.x >> 4) * 2 + (m == 15 ? 1 : 0); }
        const bool lat = u < NLAT;
        int b, hd, r = 0, rs = 0, klo = 0, nloc = 0, qp; bool qvalid = true;
        if (lat) { const int rg = u % NRG; hd = (u / NRG) & 7; b = u / (NRG * 8); r = rg * 4 + (wave >> 1); rs = r - 4 < 0 ? 0 : (r - 4 > GROWS - 8 ? GROWS - 8 : r - 4);
            const int ra = rg * 4, rb = rg * 4 + 3; klo = ra - 4 < 0 ? 0 : (ra - 4 > GROWS - 8 ? GROWS - 8 : ra - 4); const int khi = (rb - 4 < 0 ? 0 : (rb - 4 > GROWS - 8 ? GROWS - 8 : rb - 4)) + 7; nloc = khi - klo + 1;
            qp = LC + r * 64 + (wave & 1) * 32 + ql; }
        else { const int v = u - NLAT; const int qt = v % NCQ; hd = (v / NCQ) & 7; b = v / (NCQ * 8); qp = qt * 256 + wave * 32 + ql; qvalid = qp < LC; if (!qvalid) qp = 0; }
        const size_t qrow = (size_t)b * PT + qp; const int ntile = nloc + NCT;
        __syncthreads();
        if (lat) for (int i = tid; i < 15 * 31; i += NTH) rpbs[i] = LOG2E * p.in[I_RPB][(size_t)(j * 8 + hd) * 15 * 31 + i];
        bf16x8 qf[4];
#pragma unroll
        for (int ks = 0; ks < 4; ++ks) qf[ks] = *(const bf16x8*)(Q + qrow * 512 + hd * 64 + ks * 16 + hh * 8);
        const int drow = tid >> 3, dch = (tid & 7) ^ (drow & 7);
        const bf16* ksrc = K + ((size_t)b * PT + drow) * 512 + hd * 64 + dch * 8; const bf16* vsrc = VT + ((size_t)(b * 8 + hd) * 64 + drow) * PT + dch * 8;
        auto tile_tok = [&](int t) { return t < nloc ? LC + (klo + t) * 64 : (t - nloc) * 64; };
#define NAT_DMA(t) do { const int tok_ = tile_tok(t); unsigned char* st_ = lds + ((t) & (NAT_RING - 1)) * NAT_STAGE + (wvu * 64) * 16; dma16(ksrc + (size_t)tok_ * 512, st_); dma16(vsrc + tok_, st_ + 8192); } while (0)
        AttnState<2> st; attn_init(st);
        const int cq = (wave & 1) * 32 + ql, cstart = cq - 8 < 0 ? 0 : (cq - 8 > 48 ? 48 : cq - 8);
        for (int t = 0; t < 3 && t < ntile; ++t) NAT_DMA(t);
        if (ntile >= 3) dma_wait_barrier<4>(); else if (ntile == 2) dma_wait_barrier<2>(); else dma_wait_barrier<0>();
        for (int t = 0; t < ntile; ++t) {
            if (t + 3 < ntile) NAT_DMA(t + 3);
            const bool loc = t < nloc; const int krow = klo + t; const bool active = !loc || (krow >= rs && krow <= rs + 7);
            if (active) { const unsigned char* sb = lds + (t & (NAT_RING - 1)) * NAT_STAGE;
#pragma unroll
                for (int s2 = 0; s2 < 2; ++s2) { f32x16 s;
#pragma unroll
                    for (int i = 0; i < 16; ++i) s[i] = 0.f;
#pragma unroll
                    for (int ks = 0; ks < 4; ++ks) s = mfma32(*(const bf16x8*)(sb + lds_sw(s2 * 32 + ql, ks * 2 + hh)), qf[ks], s);
                    if (loc) {
#pragma unroll
                        for (int i = 0; i < 16; ++i) { const int ck = s2 * 32 + (i & 3) + 8 * (i >> 2) + 4 * hh; const bool ok = ck >= cstart && ck < cstart + 16; const int dc = ok ? ck - cq + 15 : 0;
                            s[i] = ok ? s[i] + rpbs[(krow - r + 7) * 31 + dc] : -INFINITY; } }
                    attn_update<2>(st, s, [&](int mt, int ks) { return *(const bf16x8*)(sb + 8192 + lds_sw(mt * 32 + ql, s2 * 4 + ks * 2 + hh)); }); } }
            const int inflight = (t + 3 < ntile ? t + 3 : ntile - 1) - (t + 1);
            if (inflight >= 2) dma_wait_barrier<4>(); else if (inflight == 1) dma_wait_barrier<2>(); else dma_wait_barrier<0>();
        }
#undef NAT_DMA
        const float il = 1.0f / st.l;
        if (qvalid) {
#pragma unroll
            for (int mt = 0; mt < 2; ++mt)
#pragma unroll
                for (int q4 = 0; q4 < 4; ++q4) { const int dv = mt * 32 + 8 * q4 + 4 * hh; f32x4 o;
#pragma unroll
                    for (int k = 0; k < 4; ++k) o[k] = st.o[mt][q4 * 4 + k] * il;
                    store4_t(Y + qrow * D + 512 + hd * 64 + dv, o); } }
    }
}

DEVFN int chunk_order(int d, int k) { return d == 0 ? k : (k < NCC ? NCC - 1 - k : NCH - 1 - (k - NCC)); }
constexpr int GLR = 144;
constexpr int GL_CUM = 0, GL_ZZ = 32768, GL_PART = 32768 + 8192, GL_KT = 45056, GL_VT = GL_KT + 64 * GLR, GL_K = GL_VT + 128 * GLR, GL_Q = GL_K + 64 * GLR, GL_S = GL_Q + 64 * GLR, GL_SSQ = GL_S + 256 * GLR;
static_assert(GL_SSQ + 512 <= LDS_BYTES, "GLA LDS");
DEVFN bf16x8 scale8(const u32x4 raw, const float (&f)[8]) { u32x4 w;
#pragma unroll
    for (int i = 0; i < 4; ++i) w[i] = pack2(bitsf(raw[i] << 16) * f[2 * i], bitsf(raw[i] & 0xffff0000u) * f[2 * i + 1]);
    return __builtin_bit_cast(bf16x8, w); }
DEVFN void gl_stage(unsigned char* dst, const bf16* src, size_t ld, int rows, int tid) {
    for (int i = tid; i < rows * 8; i += NTH) { const int r = i >> 3, ch = i & 7; *(u32x4*)(dst + r * GLR + ch * 16) = *(const u32x4*)(src + (size_t)r * ld + ch * 8); }
}

DEVFN void phase_gla_a(const Params& p, unsigned char* lds, int j) {
    const int tid = tidx(), lane = tid & 63, wave = tid >> 6, fr = lane & 15, fg = lane >> 4; float* cum = (float*)(lds + GL_CUM); float* zz = (float*)(lds + GL_ZZ); float* part = (float*)(lds + GL_PART);
    const bf16* Z = (const bf16*)(p.ws + WS_Z); float* GU = (float*)(p.ws + WS_SB + SBO_GU); float* GDEC = (float*)(p.ws + WS_SB + SBO_GDEC); float* GCUM = (float*)(p.ws + WS_SB + SBO_GCUM);
    u32x2 pz; u32x4 pk, pv0, pv1; float pw[16], pgb;
#define GLA_A_FETCH(itx) { const int c_ = (itx) % NCH, hd_ = ((itx) / NCH) & 3, b_ = (itx) / (NCH * 4); \
        pz = *(const u32x2*)(Z + ZO_GZ + ((size_t)b_ * PT + c_ * 64) * 32 + tid * 4); \
        pk = *(const u32x4*)(Z + ZO_GKT + (size_t)(b_ * 4 + hd_) * 64 * PT + c_ * 64 + (size_t)(tid >> 3) * PT + (tid & 7) * 8); \
        const bf16* vs_ = Z + ZO_GVT + (size_t)(b_ * 4 + hd_) * 128 * PT + c_ * 64; \
        pv0 = *(const u32x4*)(vs_ + (size_t)(tid >> 3) * PT + (tid & 7) * 8); pv1 = *(const u32x4*)(vs_ + (size_t)(64 + (tid >> 3)) * PT + (tid & 7) * 8); \
        { const int d_ = tid >> 8, dk_ = (tid >> 2) & 63; const float* gw_ = p.in[I_GGW] + ((size_t)(j * 2 + d_) * 16) * 256 + hd_ * 64 + dk_; pgb = p.in[I_GGB][(size_t)(j * 2 + d_) * 256 + hd_ * 64 + dk_]; \
          _Pragma("unroll") for (int r = 0; r < 16; ++r) pw[r] = gw_[(size_t)r * 256]; } }
    if (blockIdx.x < NB * 4 * NCH) GLA_A_FETCH(blockIdx.x)
    for (int it = blockIdx.x; it < NB * 4 * NCH; it += gridDim.x) { const int c = it % NCH, hd = (it / NCH) & 3, b = it / (NCH * 4);
        __syncthreads();
        { f32x4 zf = (f32x4){bitsf(pz.x << 16), bitsf(pz.x & 0xffff0000u), bitsf(pz.y << 16), bitsf(pz.y & 0xffff0000u)}; *(f32x4*)(zz + tid * 4) = zf;
          *(u32x4*)(lds + GL_KT + (tid >> 3) * GLR + (tid & 7) * 16) = pk;
          *(u32x4*)(lds + GL_VT + (tid >> 3) * GLR + (tid & 7) * 16) = pv0; *(u32x4*)(lds + GL_VT + (64 + (tid >> 3)) * GLR + (tid & 7) * 16) = pv1; }
        float w[16]; const float gb = pgb;
#pragma unroll
        for (int r = 0; r < 16; ++r) w[r] = pw[r];
        if (it + (int)gridDim.x < NB * 4 * NCH) GLA_A_FETCH(it + gridDim.x)
        __syncthreads();
        { const int d = tid >> 8, dk = (tid >> 2) & 63, tg = tid & 3; float gl[16];
#pragma unroll
            for (int t = 0; t < 16; ++t) { float x = gb;
#pragma unroll
                for (int r = 0; r < 16; ++r) x += zz[(tg * 16 + t) * 32 + d * 16 + r] * w[r];
                gl[t] = logsigf_(x) * (1.0f / 16.0f); }
            if (d == 0) {
#pragma unroll
                for (int t = 1; t < 16; ++t) gl[t] += gl[t - 1];
                part[(d * 64 + dk) * 4 + tg] = gl[15];
            } else {
#pragma unroll
                for (int t = 14; t >= 0; --t) gl[t] += gl[t + 1];
                part[(d * 64 + dk) * 4 + tg] = gl[0]; }
            __syncthreads();
            float pre = 0.f;
#pragma unroll
            for (int q = 0; q < 4; ++q) { const bool inc = d == 0 ? q < tg : q > tg; pre += inc ? part[(d * 64 + dk) * 4 + q] : 0.f; }
            float* gc = GCUM + ((size_t)((b * 4 + hd) * NCH + c) * 2 + d) * 4096;
#pragma unroll
            for (int t = 0; t < 16; ++t) { const float v = gl[t] + pre; cum[(d * 64 + tg * 16 + t) * 64 + dk] = v; gc[(tg * 16 + t) * 64 + dk] = v; } }
        __syncthreads();
        bf16x8 va[2];
#pragma unroll
        for (int ks = 0; ks < 2; ++ks) va[ks] = *(const bf16x8*)(lds + GL_VT + (wave * 16 + fr) * GLR + (ks * 32 + fg * 8) * 2);
#pragma unroll
        for (int d = 0; d < 2; ++d) { const int tend = d ? 0 : 63;
#pragma unroll
            for (int n = 0; n < 4; ++n) { const int dk = n * 16 + fr; const float cend = cum[(d * 64 + tend) * 64 + dk]; f32x4 acc = (f32x4){0.f, 0.f, 0.f, 0.f};
#pragma unroll
                for (int ks = 0; ks < 2; ++ks) { const u32x4 raw = *(const u32x4*)(lds + GL_KT + dk * GLR + (ks * 32 + fg * 8) * 2); float f[8];
#pragma unroll
                    for (int e = 0; e < 8; ++e) f[e] = fexp(cend - cum[(d * 64 + ks * 32 + fg * 8 + e) * 64 + dk]);
                    acc = mfma16(va[ks], scale8(raw, f), acc); }
                float* dst = GU + ((size_t)(((b * 4 + hd) * 2 + d) * NCH + c) * 128 + wave * 16 + fg * 4) * 64 + dk;
#pragma unroll
                for (int r = 0; r < 4; ++r) dst[r * 64] = acc[r]; } }
        if (tid < 128) { const int d = tid >> 6, dk = tid & 63; GDEC[(size_t)(((b * 4 + hd) * 2 + d) * NCH + c) * 64 + dk] = fexp(cum[(d * 64 + (d ? 0 : 63)) * 64 + dk]); }
    }
#undef GLA_A_FETCH
}
constexpr int GLB_BS = 17;
DEVFN void phase_gla_b(const Params& p) {
    const float* GU = (const float*)(p.ws + WS_SB + SBO_GU); const float* GDEC = (const float*)(p.ws + WS_SB + SBO_GDEC); bf16* GSB = (bf16*)(p.ws + WS_H + (size_t)MR * D * 2);
    constexpr int NBT = (NCH + GLB_BS - 1) / GLB_BS, TOT = NB * 4 * 2 * 8192;
    const int GT = gridDim.x * NTH;
    for (int i = blockIdx.x * NTH + tidx(); i < TOT; i += 2 * GT) { int e[2], seq[2], dk[2], d[2]; bool ok[2]; float s[2] = {0.f, 0.f};
#pragma unroll
        for (int q = 0; q < 2; ++q) { const int iq = i + q * GT; ok[q] = iq < TOT; const int ic = ok[q] ? iq : i; e[q] = ic & 8191; seq[q] = ic >> 13; dk[q] = e[q] & 63; d[q] = seq[q] & 1; }
        float un[2][GLB_BS], dn[2][GLB_BS];
#pragma unroll
        for (int q = 0; q < 2; ++q)
#pragma unroll
            for (int x = 0; x < GLB_BS; ++x) { const int k = x < NCH ? x : NCH - 1; const int c = chunk_order(d[q], k); un[q][x] = GU[((size_t)seq[q] * NCH + c) * 8192 + e[q]]; dn[q][x] = GDEC[((size_t)seq[q] * NCH + c) * 64 + dk[q]]; }
#pragma unroll 1
        for (int kb = 0; kb < NBT; ++kb) { float u[2][GLB_BS], dc[2][GLB_BS];
#pragma unroll
            for (int q = 0; q < 2; ++q)
#pragma unroll
                for (int x = 0; x < GLB_BS; ++x) { u[q][x] = un[q][x]; dc[q][x] = dn[q][x]; }
            if (kb + 1 < NBT) {
#pragma unroll
                for (int q = 0; q < 2; ++q)
#pragma unroll
                    for (int x = 0; x < GLB_BS; ++x) { const int k = (kb + 1) * GLB_BS + x < NCH ? (kb + 1) * GLB_BS + x : NCH - 1; const int c = chunk_order(d[q], k); un[q][x] = GU[((size_t)seq[q] * NCH + c) * 8192 + e[q]]; dn[q][x] = GDEC[((size_t)seq[q] * NCH + c) * 64 + dk[q]]; } }
#pragma unroll
            for (int x = 0; x < GLB_BS; ++x) { const int k = kb * GLB_BS + x; if (k < NCH) {
#pragma unroll
                for (int q = 0; q < 2; ++q) { const int c = chunk_order(d[q], k); if (ok[q]) GSB[((size_t)seq[q] * NCH + c) * 8192 + e[q]] = f2bf(s[q]); s[q] = dc[q][x] * s[q] + u[q][x]; } } } }
    }
}
DEVFN void phase_gla_c(const Params& p, unsigned char* lds, int j) {
    const int tid = tidx(), lane = tid & 63, wave = tid >> 6, fr = lane & 15, fg = lane >> 4, itl = wave & 3, half = wave >> 2;
    float* cum = (float*)(lds + GL_CUM); float* ssq = (float*)(lds + GL_SSQ);
    const bf16* Z = (const bf16*)(p.ws + WS_Z); const bf16* GSB = (const bf16*)(p.ws + WS_H + (size_t)MR * D * 2); const float* GCUM = (const float*)(p.ws + WS_SB + SBO_GCUM); bf16* Y = (bf16*)(p.ws + WS_YMIX);
    f32x4 pc[4]; u32x4 pkq[2], pvt[2];
#define GLA_C_FETCH(itx) { const int c_ = (itx) % NCH, hd_ = ((itx) / NCH) & 3, b_ = (itx) / (NCH * 4); const size_t row0_ = (size_t)b_ * PT + c_ * 64; \
        const float* gc_ = GCUM + (size_t)((b_ * 4 + hd_) * NCH + c_) * 8192; \
        _Pragma("unroll") for (int x = 0; x < 4; ++x) pc[x] = *(const f32x4*)(gc_ + (x * NTH + tid) * 4); \
        pkq[0] = *(const u32x4*)(Z + ZO_GK + (row0_ + (tid >> 3)) * 256 + hd_ * 64 + (tid & 7) * 8); pkq[1] = *(const u32x4*)(Z + ZO_GQ + (row0_ + (tid >> 3)) * 256 + hd_ * 64 + (tid & 7) * 8); \
        const bf16* vs_ = Z + ZO_GVT + (size_t)(b_ * 4 + hd_) * 128 * PT + c_ * 64; \
        pvt[0] = *(const u32x4*)(vs_ + (size_t)(tid >> 3) * PT + (tid & 7) * 8); pvt[1] = *(const u32x4*)(vs_ + (size_t)(64 + (tid >> 3)) * PT + (tid & 7) * 8); }
    if (blockIdx.x < NB * 4 * NCH) GLA_C_FETCH(blockIdx.x)
    for (int it = blockIdx.x; it < NB * 4 * NCH; it += gridDim.x) { const int c = it % NCH, hd = (it / NCH) & 3, b = it / (NCH * 4);
        const size_t row0 = (size_t)b * PT + c * 64;
        __syncthreads();
#pragma unroll
        for (int x = 0; x < 4; ++x) *(f32x4*)(cum + (x * NTH + tid) * 4) = pc[x];
        *(u32x4*)(lds + GL_K + (tid >> 3) * GLR + (tid & 7) * 16) = pkq[0]; *(u32x4*)(lds + GL_Q + (tid >> 3) * GLR + (tid & 7) * 16) = pkq[1];
        *(u32x4*)(lds + GL_VT + (tid >> 3) * GLR + (tid & 7) * 16) = pvt[0]; *(u32x4*)(lds + GL_VT + (64 + (tid >> 3)) * GLR + (tid & 7) * 16) = pvt[1];
        for (int i = tid; i < 2 * 128 * 8; i += NTH) { const int d = i >> 10, r = (i >> 3) & 127, ch = i & 7;
            *(u32x4*)(lds + GL_S + (d * 128 + r) * GLR + ch * 16) = *(const u32x4*)(GSB + ((size_t)(((b * 4 + hd) * 2 + d) * NCH + c) * 128 + r) * 64 + ch * 8); }
        if (it + (int)gridDim.x < NB * 4 * NCH) GLA_C_FETCH(it + gridDim.x)
        __syncthreads();
        const int ti = itl * 16 + fr;
        f32x4 o[4];
#pragma unroll
        for (int mt = 0; mt < 4; ++mt) o[mt] = (f32x4){0.f, 0.f, 0.f, 0.f};
#pragma unroll 1
        for (int d = 0; d < 2; ++d) {
            bf16x8 qd[2];
#pragma unroll
            for (int ks = 0; ks < 2; ++ks) { const u32x4 raw = *(const u32x4*)(lds + GL_Q + ti * GLR + (ks * 32 + fg * 8) * 2); float f[8];
#pragma unroll
                for (int e = 0; e < 8; ++e) f[e] = fexp(cum[(d * 64 + ti) * 64 + ks * 32 + fg * 8 + e]);
                qd[ks] = scale8(raw, f); }
            f32x4 att[4];
#pragma unroll
            for (int jt = 0; jt < 4; ++jt) { const int tj = jt * 16 + fr; f32x4 a = (f32x4){0.f, 0.f, 0.f, 0.f};
#pragma unroll
                for (int ks = 0; ks < 2; ++ks) { const u32x4 raw = *(const u32x4*)(lds + GL_K + tj * GLR + (ks * 32 + fg * 8) * 2); float f[8];
#pragma unroll
                    for (int e = 0; e < 8; ++e) f[e] = fexp(-cum[(d * 64 + tj) * 64 + ks * 32 + fg * 8 + e]);
                    a = mfma16(scale8(raw, f), qd[ks], a); }
#pragma unroll
                for (int r = 0; r < 4; ++r) { const int jrow = jt * 16 + fg * 4 + r; const bool keep = d ? (jrow >= ti) : (jrow <= ti); a[r] = keep ? a[r] : 0.f; }
                att[jt] = a; }
#pragma unroll
            for (int s2 = 0; s2 < 2; ++s2) { bf16x8 pb;
#pragma unroll
                for (int e = 0; e < 0; ++e) {}
                { u32x4 w; w[0] = pack2(att[2 * s2][0], att[2 * s2][1]); w[1] = pack2(att[2 * s2][2], att[2 * s2][3]); w[2] = pack2(att[2 * s2 + 1][0], att[2 * s2 + 1][1]); w[3] = pack2(att[2 * s2 + 1][2], att[2 * s2 + 1][3]); pb = __builtin_bit_cast(bf16x8, w); }
#pragma unroll
                for (int mt = 0; mt < 4; ++mt) { const unsigned char* vp = lds + GL_VT + (half * 64 + mt * 16 + fr) * GLR + (s2 * 32 + fg * 4) * 2;
                    o[mt] = mfma16(cat4(*(const bf16x4*)vp, *(const bf16x4*)(vp + 32)), pb, o[mt]); } }
#pragma unroll
            for (int ks = 0; ks < 2; ++ks)
#pragma unroll
                for (int mt = 0; mt < 4; ++mt) o[mt] = mfma16(*(const bf16x8*)(lds + GL_S + (d * 128 + half * 64 + mt * 16 + fr) * GLR + (ks * 32 + fg * 8) * 2), qd[ks], o[mt]);
        }
        float ss = 0.f;
#pragma unroll
        for (int mt = 0; mt < 4; ++mt)
#pragma unroll
            for (int r = 0; r < 4; ++r) ss += o[mt][r] * o[mt][r];
        ss += __shfl_xor(ss, 16); ss += __shfl_xor(ss, 32);
        if (fg == 0) ssq[half * 64 + ti] = ss;
        __syncthreads();
        const float rstd = 1.0f / sqrtf((ssq[ti] + ssq[64 + ti]) * (1.0f / 128.0f) + LN_EPS);
#pragma unroll
        for (int mt = 0; mt < 4; ++mt) { const int dv = hd * 128 + half * 64 + mt * 16 + fg * 4; const f32x4 ng = *(const f32x4*)(p.in[I_GNG] + (size_t)j * 512 + dv);
            const u32x2 rr = *(const u32x2*)(Z + ZO_GR + (row0 + ti) * 512 + dv); f32x4 y;
            y[0] = o[mt][0] * rstd * ng[0] * siluf_(bitsf(rr.x << 16)); y[1] = o[mt][1] * rstd * ng[1] * siluf_(bitsf(rr.x & 0xffff0000u));
            y[2] = o[mt][2] * rstd * ng[2] * siluf_(bitsf(rr.y << 16)); y[3] = o[mt][3] * rstd * ng[3] * siluf_(bitsf(rr.y & 0xffff0000u));
            store4_t(Y + (row0 + ti) * D + dv, y); }
    }
#undef GLA_C_FETCH
}

constexpr int DK_ROW = 272, DV_ROW = 144, DF_VOFF = 64 * DK_ROW, DF_BUF = DF_VOFF + 128 * DV_ROW, DF_Q = 2 * DF_BUF;
DEVFN int dk_off(int key, int ch) { return key * DK_ROW + ch * 16; }
DEVFN int dv_off(int dv, int ch) { return dv * DV_ROW + ch * 16; }
DEVFN void phase_diff(const Params& p, unsigned char* lds, int l, int part) {
    const int j = l >> 1, tid = tidx(), lane = tid & 63, wave = tid >> 6, ql = lane & 31, hh = lane >> 5, qg = wave >> 1, m = wave & 1;
    const bf16* Z = (const bf16*)(p.ws + WS_Z); bf16* Y = (bf16*)(p.ws + WS_YMIX);
    constexpr int NQT = TS / 128, NQC = (LC + 127) / 128, NU = NB * 4 * (NQT + NQC);
    constexpr int NUL = NB * 4 * NQT;
    const int G_ = gridDim.x, u0 = part == 0 ? (int)blockIdx.x : NUL + ((int)blockIdx.x + G_ - (64 % G_)) % G_, uend = part == 0 ? NUL : NU;
    if (u0 >= uend) return;
    const float laminit = 0.8f - 0.6f * expf(-0.3f * (float)l);
    const float d1 = wave_sum(p.in[I_LQ1][j * 64 + lane] * p.in[I_LK1][j * 64 + lane]), d2 = wave_sum(p.in[I_LQ2][j * 64 + lane] * p.in[I_LK2][j * 64 + lane]);
    const float lam = expf(d1) - expf(d2) + laminit;
    for (int u = u0; u < uend; u += gridDim.x) { const bool isctx = u >= NUL; const int v = isctx ? u - NUL : u, per = isctx ? NQC : NQT;
        const int qt = isctx ? NQT + v % per : v % per, hd = (v / per) & 3, b = v / (per * 4);
        const int q0 = isctx ? (qt - NQT) * 128 : LC + qt * 128, nkt = (isctx ? LC : PT) / 64; const int qp = q0 + qg * 32 + ql; const size_t qrow = (size_t)b * PT + qp;
        const bool qvalid = !isctx || qp < LC;
        bf16x8 qf[4];
#pragma unroll
        for (int ks = 0; ks < 4; ++ks) qf[ks] = *(const bf16x8*)(Z + ZO_DQ + qrow * 512 + hd * 128 + m * 64 + ks * 16 + hh * 8);
        AttnState<4> st; attn_init(st);
        const bf16* ksrc[2]; const bf16* vsrc[2]; int klo[2], vlo[2];
#pragma unroll
        for (int i = 0; i < 2; ++i) { const int idx = i * NTH + tid; const int key = idx >> 4, kch = idx & 15, dv = idx >> 3, vch = idx & 7;
            ksrc[i] = Z + ZO_DK + ((size_t)b * PT + key) * 512 + hd * 128 + kch * 8; klo[i] = dk_off(key, kch);
            vsrc[i] = Z + ZO_DVT + ((size_t)(b * 4 + hd) * 128 + dv) * PT + vch * 8; vlo[i] = DF_VOFF + dv_off(dv, vch); }
        u32x4 rk0[2], rv0[2], rk1[2], rv1[2];
#define DF_LOAD(RK, RV, t) do { _Pragma("unroll") for (int i = 0; i < 2; ++i) { RK[i] = *(const u32x4*)(ksrc[i] + (size_t)(t) * 64 * 512); RV[i] = *(const u32x4*)(vsrc[i] + (t) * 64); } } while (0)
#define DF_STORE(RK, RV, buf) do { _Pragma("unroll") for (int i = 0; i < 2; ++i) { *(u32x4*)(lds + (buf) + klo[i]) = RK[i]; *(u32x4*)(lds + (buf) + vlo[i]) = RV[i]; } } while (0)
#define DF_COMPUTE(cur) do { f32x16 sA, sB; _Pragma("unroll") for (int i = 0; i < 16; ++i) { sA[i] = 0.f; sB[i] = 0.f; } \
            _Pragma("unroll") for (int ks = 0; ks < 4; ++ks) { sA = mfma32(*(const bf16x8*)(lds + (cur) + dk_off(ql, m * 8 + ks * 2 + hh)), qf[ks], sA); sB = mfma32(*(const bf16x8*)(lds + (cur) + dk_off(32 + ql, m * 8 + ks * 2 + hh)), qf[ks], sB); } \
            const unsigned char* vb = lds + (cur) + DF_VOFF + 16 * hh; \
            attn_update2<4>(st, sA, sB, [&](int st2, int mt, int ks) { return *(const bf16x8*)(vb + dv_off(mt * 32 + ql, st2 * 4 + ks * 2)); }); } while (0)
        __syncthreads();
        DF_LOAD(rk0, rv0, 0); DF_LOAD(rk1, rv1, 1);
        DF_STORE(rk0, rv0, 0);
        __syncthreads();
        for (int t = 0; t < nkt; t += 2) {
            if (t + 2 < nkt) DF_LOAD(rk0, rv0, t + 2);
            DF_COMPUTE(0);
            DF_STORE(rk1, rv1, DF_BUF);
            __syncthreads();
            if (t + 3 < nkt) DF_LOAD(rk1, rv1, t + 3);
            DF_COMPUTE(DF_BUF);
            if (t + 2 < nkt) DF_STORE(rk0, rv0, 0);
            __syncthreads();
        }
#undef DF_LOAD
#undef DF_STORE
#undef DF_COMPUTE
        float* xch = (float*)lds + (size_t)qg * 4096 + lane;
        if (m == 1) { const float f = lam / st.l;
#pragma unroll
            for (int mt = 0; mt < 4; ++mt)
#pragma unroll
                for (int r = 0; r < 16; ++r) xch[(mt * 16 + r) * 64] = st.o[mt][r] * f; }
        __syncthreads();
        if (m == 0) { const float i0 = 1.0f / st.l; float ss = 0.f;
#pragma unroll
            for (int mt = 0; mt < 4; ++mt)
#pragma unroll
                for (int r = 0; r < 16; ++r) { const float o = st.o[mt][r] * i0 - xch[(mt * 16 + r) * 64]; st.o[mt][r] = o; ss += o * o; }
            ss += __shfl_xor(ss, 32);
            const float rstd = (1.0f - laminit) / sqrtf(ss * (1.0f / 128.0f) + LN_EPS);
            if (qvalid) {
#pragma unroll
                for (int mt = 0; mt < 4; ++mt)
#pragma unroll
                    for (int q4 = 0; q4 < 4; ++q4) { const int dv = mt * 32 + 8 * q4 + 4 * hh; const f32x4 ng = *(const f32x4*)(p.in[I_DNG] + (size_t)j * 128 + dv); f32x4 o;
#pragma unroll
                        for (int k = 0; k < 4; ++k) o[k] = st.o[mt][q4 * 4 + k] * rstd * ng[k];
                        store4_t(Y + qrow * D + 512 + hd * 128 + dv, o); } }
        }
    }
}

enum { PH_CONVERT = 0, PH_INIT, PH_INPROJ_E, PH_S5A, PH_S5B_NAT, PH_S5C, PH_GLU, PH_INPROJ_O, PH_GLA_A, PH_GLAB_DIFF, PH_GLA_C, PH_GLA_B, PH_DIFF, PH_OUTPROJ, PH_LN1, PH_MOE_UP, PH_MOE_DOWN, PH_LN2, PH_COUNT };

#ifdef CPU_EMU
#define PHASEFN static
#else
#define PHASEFN __device__ __forceinline__
#endif
template <int PH> PHASEFN void run_phase(const Params& p, unsigned char* lds, int l) {
    if constexpr (PH == PH_CONVERT) phase_convert(p, lds);
    else if constexpr (PH == PH_INIT) phase_init_h(p);
    else if constexpr (PH == PH_INPROJ_E) phase_inproj_even(p, lds, l);
    else if constexpr (PH == PH_S5A) phase_s5a(p, lds, l >> 1);
    else if constexpr (PH == PH_S5B_NAT) { phase_s5b(p, l >> 1); phase_natten(p, lds, l >> 1); }
    else if constexpr (PH == PH_S5C) phase_s5c(p, lds, l >> 1);
    else if constexpr (PH == PH_GLU) phase_glu(p, lds, l >> 1);
    else if constexpr (PH == PH_INPROJ_O) phase_inproj_odd(p, lds, l);
    else if constexpr (PH == PH_GLA_A) { phase_gla_a(p, lds, l >> 1); phase_diff(p, lds, l, 1); }
    else if constexpr (PH == PH_GLAB_DIFF) { phase_gla_b(p); phase_diff(p, lds, l, 0); }
    else if constexpr (PH == PH_GLA_C) phase_gla_c(p, lds, l >> 1);
    else if constexpr (PH == PH_GLA_B) phase_gla_b(p);
    else if constexpr (PH == PH_DIFF) phase_diff(p, lds, l, 0);
    else if constexpr (PH == PH_OUTPROJ) phase_outproj(p, lds, l);
    else if constexpr (PH == PH_LN1) phase_ln1_route(p, lds, l);
    else if constexpr (PH == PH_MOE_UP) phase_moe_up(p, lds, l);
    else if constexpr (PH == PH_MOE_DOWN) phase_moe_down(p, lds, l);
    else if constexpr (PH == PH_LN2) phase_ln2(p, lds, l);
}

template <int PH> __global__ void __launch_bounds__(NTH, 2) k_phase(Params p, int l) { DECL_LDS; run_phase<PH>(p, lds, l); }

#ifdef CPU_EMU
static int g_grid = 8; static int g_stop_layer = 1000, g_stop_phase = 1000;
template <int PH> static bool launch_phase(const Params& p, int l, hipStream_t) {
    if (l > g_stop_layer || (l == g_stop_layer && PH > g_stop_phase)) return false;
    fprintf(stderr, "[emu] layer %d phase %d\n", l, PH);
    emu::launch([=] { k_phase<PH>(p, l); }, dim3(g_grid), dim3(NTH), LDS_BYTES); return true;
}
static void hipMemsetAsync(void* d, int v, size_t n, hipStream_t) { memset(d, v, n); }
#else
static int g_grid = 0;
template <int PH> static bool launch_phase(const Params& p, int l, hipStream_t s) {
    static bool attr = false;
    if (!attr) { (void)hipFuncSetAttribute((const void*)k_phase<PH>, hipFuncAttributeMaxDynamicSharedMemorySize, LDS_BYTES); attr = true; }
    hipLaunchKernelGGL(k_phase<PH>, dim3(g_grid), dim3(NTH), LDS_BYTES, s, p, l); return true;
}
#endif


__global__ void __launch_bounds__(NTH, 2) k_mega(Params p_arg) {
    DECL_LDS;
#ifdef CPU_EMU
    const Params& p = p_arg;
#else
    const Params& p = *(const Params*)(uintptr_t)__builtin_amdgcn_kernarg_segment_ptr();
#endif
#ifndef CPU_EMU
    if (threadIdx.x == 0) *(uint4*)(lds + LDS_BYTES) = make_uint4(0u, 0u, 0u, 0u);
    __syncthreads();
    XcdBarrier gbar = xcd_barrier_post((unsigned*)(p.ws + WS_CTL + CTL_BAR), (volatile LAS unsigned*)(lds + LDS_BYTES));
#endif
    run_phase<PH_CONVERT>(p, lds, -1); GRID_SYNC();
    if (PROBE_MASK & 2048) { run_phase<PH_CONVERT>(p, lds, -1); GRID_SYNC(); }
    run_phase<PH_INIT>(p, lds, -1); GRID_SYNC();
#define RP(ph, l, bit) do { run_phase<ph>(p, lds, l); GRID_SYNC(); if (PROBE_MASK & (bit)) { run_phase<ph>(p, lds, l); GRID_SYNC(); } } while (0)
#define MK_EVEN(l) do { RP(PH_INPROJ_E, l, 1); RP(PH_S5A, l, 2); RP(PH_S5B_NAT, l, 4); RP(PH_S5C, l, 8); RP(PH_GLU, l, 16); } while (0)
#define MK_ODD(l) do { RP(PH_INPROJ_O, l, 1); RP(PH_GLA_A, l, 32); run_phase<PH_GLA_B>(p, lds, l); RP(PH_DIFF, l, 64); RP(PH_GLA_C, l, 128); } while (0)
#define MK_TAIL(l) do { RP(PH_OUTPROJ, l, 256); run_phase<PH_LN1>(p, lds, l); GRID_SYNC(); RP(PH_MOE_UP, l, 512); RP(PH_MOE_DOWN, l, 1024); run_phase<PH_LN2>(p, lds, l); if ((l) + 1 < NL) GRID_SYNC(); } while (0)
    MK_EVEN(0); MK_TAIL(0);
    if (NL > 1) { MK_ODD(1); MK_TAIL(1); }
    if (NL > 2) { MK_EVEN(2); MK_TAIL(2); }
    if (NL > 3) { MK_ODD(3); MK_TAIL(3); }
}
#ifdef CPU_EMU
static void launch_mega(const Params& p, hipStream_t) { emu::launch([=] { k_mega(p); }, dim3(g_grid), dim3(NTH), LDS_TOTAL); }
#else
static void launch_mega(const Params& p, hipStream_t s) {
    static bool attr = false;
    if (!attr) { (void)hipFuncSetAttribute((const void*)k_mega, hipFuncAttributeMaxDynamicSharedMemorySize, LDS_TOTAL); attr = true; }
    hipLaunchKernelGGL(k_mega, dim3(g_grid), dim3(NTH), LDS_TOTAL, s, p);
}
#endif

extern "C" void kernel_launch(void* const* d_in, const int* in_sizes, int n_in, void* d_out, int out_size, void* d_ws, size_t ws_size, hipStream_t stream) {
#ifndef CPU_EMU
    if (g_grid == 0) { int dev = 0, cus = 0; (void)hipGetDevice(&dev); (void)hipDeviceGetAttribute(&cus, hipDeviceAttributeMultiprocessorCount, dev); g_grid = cus > 0 ? cus : 256; }
#endif
    if (n_in != N_IN || ws_size < WS_END) { fprintf(stderr, "kernel_launch: unexpected inputs (n_in %d) or workspace (%zu < %zu)\n", n_in, ws_size, (size_t)WS_END); return; }
    Params p{};
    for (int i = 0; i < N_IN; ++i) p.in[i] = (const float*)d_in[i];
    p.out = (float*)d_out; p.ws = (unsigned char*)d_ws;
    (void)hipMemsetAsync((char*)d_ws + WS_CTL, 0, CTL_BYTES, stream);
#if defined(MK_MULTI)
    launch_phase<PH_CONVERT>(p, -1, stream);
    launch_phase<PH_INIT>(p, -1, stream);
    for (int l = 0; l < NL; ++l) {
        if ((l & 1) == 0) { launch_phase<PH_INPROJ_E>(p, l, stream); launch_phase<PH_S5A>(p, l, stream); launch_phase<PH_S5B_NAT>(p, l, stream); launch_phase<PH_S5C>(p, l, stream); launch_phase<PH_GLU>(p, l, stream); }
        else { launch_phase<PH_INPROJ_O>(p, l, stream); launch_phase<PH_GLA_A>(p, l, stream); launch_phase<PH_GLAB_DIFF>(p, l, stream); launch_phase<PH_GLA_C>(p, l, stream); }
        launch_phase<PH_OUTPROJ>(p, l, stream); launch_phase<PH_LN1>(p, l, stream); launch_phase<PH_MOE_UP>(p, l, stream); launch_phase<PH_MOE_DOWN>(p, l, stream); launch_phase<PH_LN2>(p, l, stream);
    }
#else
    launch_mega(p, stream);
#endif
}

#ifdef CPU_EMU_MAIN
#include <string>
#include <fstream>
#include <sys/mman.h>
static void* guard_alloc(size_t n) { const size_t pg = 4096, tot = ((n + pg - 1) / pg + 2) * pg; char* b = (char*)mmap(nullptr, tot, PROT_READ | PROT_WRITE, MAP_PRIVATE | MAP_ANONYMOUS, -1, 0); mprotect(b, pg, PROT_NONE); mprotect(b + tot - pg, pg, PROT_NONE); return b + tot - pg - ((n + 255) & ~(size_t)255); }
static std::vector<float> load_npy(const std::string& fn, bool& ok) {
    std::ifstream f(fn, std::ios::binary); std::vector<float> v; ok = false; if (!f) return v;
    char hdr[10]; f.read(hdr, 10); int hl = (unsigned char)hdr[8] | ((unsigned char)hdr[9] << 8); std::string h(hl, ' '); f.read(&h[0], hl);
    f.seekg(0, std::ios::end); size_t n = ((size_t)f.tellg() - 10 - hl) / 4; f.seekg(10 + hl); v.resize(n); f.read((char*)v.data(), n * 4); ok = true; return v;
}
template <class G> static void check(const char* name, const std::vector<float>& ref, size_t rows, size_t cols, size_t ref_ld, size_t ref_c0, G get) {
    double num = 0, den = 0, mx = 0; size_t wr = 0, wc = 0;
    for (size_t r = 0; r < rows; ++r) for (size_t c = 0; c < cols; ++c) { const double a = get(r, c), b = ref[r * ref_ld + ref_c0 + c], e = a - b; num += e * e; den += b * b; if (fabs(e) > mx) { mx = fabs(e); wr = r; wc = c; } }
    printf("CHECK %-14s rvr=%.3e  maxabs=%.4f at (%zu,%zu) refrms=%.4f\n", name, num / (den + 1e-30), mx, wr, wc, sqrt(den / (rows * cols)));
}
int main(int argc, char** argv) {
    std::string dir = argv[1]; if (argc > 2) g_stop_layer = atoi(argv[2]); if (argc > 3) g_stop_phase = atoi(argv[3]); if (const char* e = getenv("EMU_GRID")) g_grid = atoi(e);
    std::vector<int> sizes; { std::ifstream f(dir + "/sizes.txt"); int s; while (f >> s) sizes.push_back(s); }
    if ((int)sizes.size() != N_IN) { printf("bad sizes\n"); return 1; }
    std::vector<void*> din(N_IN); { std::ifstream f(dir + "/inputs.bin", std::ios::binary); for (int i = 0; i < N_IN; ++i) { din[i] = guard_alloc((size_t)sizes[i] * 4); f.read((char*)din[i], (size_t)sizes[i] * 4); } }
    printf("WS_END = %.1f MB\n", WS_END / 1048576.0);
    unsigned char* ws = (unsigned char*)guard_alloc(WS_END); memset(ws, 0x7F, WS_END);
    std::vector<float> out((size_t)NB * TS * D, NAN);
    kernel_launch(din.data(), sizes.data(), N_IN, out.data(), (int)out.size(), ws, WS_END, nullptr);
    const int L = g_stop_layer < NL ? g_stop_layer : NL - 1; const int PHS = g_stop_layer < NL ? g_stop_phase : 1000; bool ok; char nm[64];
    const bf16* Z = (const bf16*)(ws + WS_Z); const bf16* Y = (const bf16*)(ws + WS_YMIX); const bf16* H = (const bf16*)(ws + WS_H);
    auto ref = [&](const char* what) { snprintf(nm, 64, "/L%d_%s.npy", L, what); return load_npy(dir + nm, ok); };
    if (PHS >= PH_INPROJ_E || PHS >= PH_INPROJ_O) {
        auto a = ref("a"); if (ok && PHS < PH_LN1) check("abf", a, MR, D, D, 0, [&](size_t r, size_t c) { return bf2f(((const bf16*)(ws + WS_ABF))[r * D + c]); });
        auto z = ref("z");
        if (ok && (L & 1) == 0 && PHS < PH_OUTPROJ) {
            check("z.u", z, MR, 512, 2048, 0, [&](size_t r, size_t c) { return bf2f(Z[ZE_U + r * 512 + c]); });
            check("z.q", z, MR, 512, 2048, 512, [&](size_t r, size_t c) { return bf2f(Z[ZE_Q + r * 512 + c]) / QSCALE; });
            check("z.k", z, MR, 512, 2048, 1024, [&](size_t r, size_t c) { return bf2f(Z[ZE_K + r * 512 + c]); });
            check("z.v", z, MR, 512, 2048, 1536, [&](size_t r, size_t c) { size_t b = r / PT, pp = r % PT; return bf2f(Z[ZE_VT + ((b * 8 + c / 64) * 64 + c % 64) * PT + vperm((int)pp)]); });
        }
        if (ok && (L & 1) == 1 && PHS < PH_OUTPROJ) {
            check("z.gq", z, MR, 256, ODD_N, 0, [&](size_t r, size_t c) { return bf2f(Z[ZO_GQ + r * 256 + c]) * 8.f; });
            check("z.gk", z, MR, 256, ODD_N, 256, [&](size_t r, size_t c) { return bf2f(Z[ZO_GK + r * 256 + c]); });
            check("z.gkt", z, MR, 256, ODD_N, 256, [&](size_t r, size_t c) { size_t b = r / PT, pp = r % PT; return bf2f(Z[ZO_GKT + ((b * 4 + c / 64) * 64 + c % 64) * PT + pp]); });
            check("z.gvt", z, MR, 512, ODD_N, 512, [&](size_t r, size_t c) { size_t b = r / PT, pp = r % PT; return bf2f(Z[ZO_GVT + ((b * 4 + c / 128) * 128 + c % 128) * PT + pp]); });
            check("z.gr", z, MR, 512, ODD_N, 1024, [&](size_t r, size_t c) { return bf2f(Z[ZO_GR + r * 512 + c]); });
            check("z.gz", z, MR, 32, ODD_N, 1536, [&](size_t r, size_t c) { return bf2f(Z[ZO_GZ + r * 32 + c]); });
            check("z.dvt", z, MR, 512, ODD_N, 2592, [&](size_t r, size_t c) { size_t b = r / PT, pp = r % PT; return bf2f(Z[ZO_DVT + ((b * 4 + c / 128) * 128 + c % 128) * PT + vperm((int)pp)]); });
            check("z.dq(ctx rows)", z, LC, 512, ODD_N, 1568, [&](size_t r, size_t c) { return bf2f(Z[ZO_DQ + r * 512 + c]) / QSCALE; });
            check("z.dk(ctx rows)", z, LC, 512, ODD_N, 2080, [&](size_t r, size_t c) { return bf2f(Z[ZO_DK + r * 512 + c]); });
        }
    }
    if ((L & 1) == 0 && PHS >= PH_S5C && PHS < PH_MOE_DOWN) { auto s = ref("s5pre"); for (auto& x : s) x = geluf_(x); if (ok) check("gelu(s5pre)", s, MR, 512, 512, 0, [&](size_t r, size_t c) { return bf2f(((const bf16*)(ws + WS_SB + SBO_GS))[r * 512 + c]); }); }
    if (PHS >= PH_GLU && PHS >= PH_GLA_C) { auto m = ref("mix"); if (ok) { check("mix[0:512]", m, MR, 512, D, 0, [&](size_t r, size_t c) { return bf2f(Y[r * D + c]); }); check("mix[512:]", m, MR, 512, D, 512, [&](size_t r, size_t c) { return bf2f(Y[r * D + 512 + c]); }); } }
    else if (PHS >= PH_S5B_NAT) { auto m = ref("mix"); if (ok) { check("mix[0:512]", m, MR, 512, D, 0, [&](size_t r, size_t c) { return bf2f(Y[r * D + c]); }); check("mix[512:]", m, MR, 512, D, 512, [&](size_t r, size_t c) { return bf2f(Y[r * D + 512 + c]); }); } }
    if (PHS >= PH_OUTPROJ && PHS < PH_LN2) { auto y = ref("y"); if (ok && PHS < PH_MOE_UP) check("y", y, MR, D, D, 0, [&](size_t r, size_t c) { return bf2f(((const bf16*)(ws + WS_Z))[r * D + c]); }); }
    if (PHS >= PH_LN1 && PHS < PH_LN2) { auto h = ref("h1"); if (ok) check("h1", h, MR, D, D, 0, [&](size_t r, size_t c) { return bf2f(H[r * D + c]); });
        std::vector<int> eid; { snprintf(nm, 64, "/L%d_eid.npy", L); auto e = load_npy(dir + nm, ok); if (ok) { const int* ep = (const int*)e.data(); const int* rt = (const int*)(ws + WS_ROUTE); int bad = 0; for (int r = 0; r < MR; ++r) if (rt[r * 4] != ep[r * 2] || rt[r * 4 + 1] != ep[r * 2 + 1]) ++bad; printf("CHECK routing mismatches: %d / %d\n", bad, MR); } } }
    if (PHS >= PH_MOE_DOWN && PHS < PH_LN2) { auto f = ref("f"); if (ok) { const unsigned* cnt = (const unsigned*)(ws + WS_CTL + CTL_CNT) + L * NEXP; const int* rt = (const int*)(ws + WS_ROUTE); const bf16* F2 = (const bf16*)(ws + WS_SB);
        check("moe f", f, MR, D, D, 0, [&](size_t r, size_t c) { size_t r0 = (size_t)moe_off(cnt, rt[r * 4]) + rt[r * 4 + 2], r1 = (size_t)moe_off(cnt, rt[r * 4 + 1]) + rt[r * 4 + 3]; return bf2f(F2[r0 * D + c]) + bf2f(F2[r1 * D + c]); }); } }
    if (PHS >= PH_LN2 && L + 1 < NL) { auto h = ref("h2"); if (ok) check("h2", h, MR, D, D, 0, [&](size_t r, size_t c) { return bf2f(H[r * D + c]); }); }
    if (g_stop_layer >= NL) { auto o = load_npy(dir + "/ref_out.npy", ok); if (ok) { std::vector<float> of(o.size() / 2); const double* od = (const double*)o.data(); for (size_t i = 0; i < of.size(); ++i) of[i] = (float)od[i];
        check("FINAL out", of, (size_t)NB * TS, D, D, 0, [&](size_t r, size_t c) { return out[r * D + c]; }); } }
    return 0;
}
#endif
```

```cpp
#ifdef CPU_EMU
#include "emu.h"
#else
#include <hip/hip_runtime.h>
#include <cstdio>
#include <cstdint>
#include <cmath>
#endif

#ifndef PROBE_MASK
#define PROBE_MASK 0
#endif
#ifndef CFG_BATCH
#define CFG_BATCH 4
#endif
#ifndef CFG_SEQ
#define CFG_SEQ 4096
#endif
#ifndef CFG_CTX
#define CFG_CTX 256
#endif
#ifndef CFG_DEPTH
#define CFG_DEPTH 4
#endif

typedef unsigned short bf16;
typedef short bf16x8 __attribute__((ext_vector_type(8)));
typedef short bf16x4 __attribute__((ext_vector_type(4)));
typedef float f32x4 __attribute__((ext_vector_type(4)));
typedef float f32x2 __attribute__((ext_vector_type(2)));
typedef float f32x16 __attribute__((ext_vector_type(16)));
typedef unsigned u32x4 __attribute__((ext_vector_type(4)));
typedef unsigned u32x2 __attribute__((ext_vector_type(2)));

constexpr int NB = CFG_BATCH, TS = CFG_SEQ, LC = CFG_CTX, NL = CFG_DEPTH;
constexpr int PT = LC + TS;
constexpr int MR = NB * PT;
constexpr int D = 1024;
constexpr int NE = (NL + 1) / 2, NO = NL / 2;
constexpr int GW = 64;
constexpr int GROWS = TS / GW;
constexpr int NCH = PT / 64, NCC = LC / 64;
constexpr int NTH = 512;
constexpr int EVEN_N = 2048, ODD_N = 3104, ODD_NP = 3328;
constexpr int NEXP = 32;
constexpr float LN_EPS = 1e-5f;
constexpr float ALPHA = 1.681792830507429f;
constexpr float LOG2E = 1.4426950408889634f, QSCALE = 0.125f * LOG2E;
static_assert(MR % 256 == 0 && LC % 128 == 0 && TS % 128 == 0 && GROWS >= 8, "shape");

enum { I_X = 0, I_C, I_CTX, I_CCTX, I_MODW, I_MODB, I_LNG, I_LNB, I_EWIN, I_EWOUT, I_LAMRE, I_LAMIM, I_LOGDT, I_BRE, I_BIM, I_CRE, I_CIM, I_S5D,
       I_GLUW, I_GLUB, I_RPB, I_OWIN, I_OWOUT, I_GGW, I_GGB, I_GNG, I_LQ1, I_LK1, I_LQ2, I_LK2, I_DNG, I_WGRP, I_BGRP, I_WEXP, I_BEXP, I_WGATE, I_WUP, I_WDOWN, N_IN };

constexpr size_t al256(size_t x) { return (x + 255) & ~(size_t)255; }
constexpr size_t WS_CTL = 0;
constexpr size_t CTL_BAR = 0;
constexpr size_t CTL_CNT = 16384;
constexpr size_t CTL_BYTES = 16384 + 4096;
constexpr size_t WS_MODV = al256(WS_CTL + CTL_BYTES);
constexpr size_t WS_S5P = al256(WS_MODV + (size_t)NL * (NB + 1) * 6144 * 4);
constexpr int S5P_STRIDE = 36;
constexpr size_t WS_ROPE = al256(WS_S5P + (size_t)NE * 2 * 32 * 64 * S5P_STRIDE * 4);
constexpr size_t WS_WIN = al256(WS_ROPE + 8192);
constexpr size_t WIN_LSTRIDE = (size_t)ODD_NP * D;
constexpr size_t WS_WOUT = al256(WS_WIN + (size_t)NL * WIN_LSTRIDE * 2);
constexpr size_t WS_GLU = al256(WS_WOUT + (size_t)NL * D * D * 2);
constexpr size_t WS_MGU = al256(WS_GLU + (size_t)NE * 1024 * 512 * 2);
constexpr size_t WS_MDN = al256(WS_MGU + (size_t)NL * NEXP * 512 * 1024 * 2);
constexpr size_t WS_H = al256(WS_MDN + (size_t)NL * NEXP * 1024 * 256 * 2);
constexpr size_t WS_ABF = al256(WS_H + (size_t)MR * D * 4);
constexpr size_t WS_Z = al256(WS_ABF + (size_t)MR * D * 2);
constexpr size_t Z_BYTES = (size_t)MR * 3360 * 2;
constexpr size_t WS_YMIX = al256(WS_Z + Z_BYTES);
constexpr size_t WS_SB = al256(WS_YMIX + (size_t)MR * D * 2);
constexpr size_t MOE_ROWS = (size_t)2 * MR + NEXP * 128;
constexpr size_t SB_GLA = (size_t)NB * 4 * 2 * NCH * 128 * 64 * 4 + (size_t)NB * 4 * 2 * NCH * 64 * 4 + (size_t)NB * 4 * NCH * 2 * 64 * 64 * 4 + 8192;
constexpr size_t SB_S5 = (size_t)2 * NB * 32 * 2 * NCH * 128 * 4 + (size_t)MR * 512 * 2 + 4096;
constexpr size_t SB_F2 = MOE_ROWS * D * 2;
constexpr size_t SB_BYTES = SB_GLA > SB_F2 ? (SB_GLA > SB_S5 ? SB_GLA : SB_S5) : (SB_F2 > SB_S5 ? SB_F2 : SB_S5);
constexpr size_t WS_ACT = al256(WS_SB + SB_BYTES);
constexpr size_t WS_ROUTE = al256(WS_ACT + MOE_ROWS * 256 * 2);
constexpr size_t WS_LTOK = al256(WS_ROUTE + (size_t)MR * 16);
constexpr size_t WS_LW = al256(WS_LTOK + (size_t)NEXP * MR * 4);
constexpr size_t WS_END = al256(WS_LW + (size_t)NEXP * MR * 4);
constexpr size_t ZE_U = 0, ZE_Q = (size_t)MR * 512, ZE_K = (size_t)MR * 1024, ZE_VT = (size_t)MR * 1536;
constexpr size_t ZO_GQ = 0, ZO_GK = (size_t)MR * 256, ZO_GKT = (size_t)MR * 512, ZO_GVT = (size_t)MR * 768, ZO_GR = (size_t)MR * 1280,
                 ZO_GZ = (size_t)MR * 1792, ZO_DQ = (size_t)MR * 1824, ZO_DK = (size_t)MR * 2336, ZO_DVT = (size_t)MR * 2848;
constexpr size_t SBO_S5E = 0;
constexpr size_t SBO_S5H = (size_t)NB * 32 * 2 * NCH * 128 * 4;
constexpr size_t SBO_GS = al256(2 * SBO_S5H);
constexpr size_t SBO_GU = 0;
constexpr size_t SBO_GDEC = al256((size_t)NB * 4 * 2 * NCH * 128 * 64 * 4);
constexpr size_t SBO_GCUM = al256(SBO_GDEC + (size_t)NB * 4 * 2 * NCH * 64 * 4);

#ifdef CPU_EMU
#define DEVFN static inline
#define MEMFN inline
#else
#define DEVFN __device__ __forceinline__
#define MEMFN __device__ __forceinline__
#endif
DEVFN unsigned fbits(float f) { return __builtin_bit_cast(unsigned, f); }
DEVFN float bitsf(unsigned u) { return __builtin_bit_cast(float, u); }
DEVFN bf16 f2bf(float f) { unsigned u = fbits(f); u += 0x7fffu + ((u >> 16) & 1u); return (bf16)(u >> 16); }
DEVFN float bf2f(bf16 h) { return bitsf((unsigned)h << 16); }
DEVFN unsigned pack2(float lo, float hi) {
#ifdef CPU_EMU
    return (unsigned)f2bf(lo) | ((unsigned)f2bf(hi) << 16);
#else
    typedef __bf16 bf16v2_ __attribute__((ext_vector_type(2)));
    return __builtin_bit_cast(unsigned, __builtin_convertvector((f32x2){lo, hi}, bf16v2_));
#endif
}
DEVFN float fexp2(float x) {
#ifdef CPU_EMU
    return exp2f(x);
#else
    return __builtin_amdgcn_exp2f(x);
#endif
}
DEVFN float fexp(float x) { return fexp2(x * 1.4426950408889634f); }
DEVFN float flog2(float x) {
#ifdef CPU_EMU
    return log2f(x);
#else
    return __builtin_amdgcn_logf(x);
#endif
}
DEVFN float sigmoidf_(float x) { return 1.0f / (1.0f + fexp(-x)); }
DEVFN float siluf_(float x) { return x / (1.0f + fexp(-x)); }
DEVFN float geluf_(float x) { const float u = 0.7978845608028654f * (x + 0.044715f * x * x * x); return x / (1.0f + fexp(-2.0f * u)); }

DEVFN float logsigf_(float x) { return fminf(x, 0.f) - 0.6931471805599453f * flog2(1.0f + fexp(-fabsf(x))); }
DEVFN f32x4 mfma16(bf16x8 a, bf16x8 b, f32x4 c) {
#ifdef CPU_EMU
    return emu_mfma16(a, b, c);
#else
    return __builtin_amdgcn_mfma_f32_16x16x32_bf16(a, b, c, 0, 0, 0);
#endif
}
DEVFN f32x16 mfma32(bf16x8 a, bf16x8 b, f32x16 c) {
#ifdef CPU_EMU
    return emu_mfma32(a, b, c);
#else
    return __builtin_amdgcn_mfma_f32_32x32x16_bf16(a, b, c, 0, 0, 0);
#endif
}
DEVFN void sched_fence() {
#ifndef CPU_EMU
    __builtin_amdgcn_sched_barrier(0);
#endif
}
DEVFN bool wave_all(bool c) {
#ifdef CPU_EMU
    int v = c ? 1 : 0; v &= __shfl_xor(v, 32); v &= __shfl_xor(v, 16); v &= __shfl_xor(v, 8); v &= __shfl_xor(v, 4); v &= __shfl_xor(v, 2); v &= __shfl_xor(v, 1); return v != 0;
#else
    return __all(c);
#endif
}
DEVFN float wave_sum(float v) {
#ifdef CPU_EMU
    v += __shfl_xor(v, 32); v += __shfl_xor(v, 16); v += __shfl_xor(v, 8); v += __shfl_xor(v, 4); v += __shfl_xor(v, 2); v += __shfl_xor(v, 1); return v;
#else
#define WS_DPP(x, ctrl) bitsf((unsigned)__builtin_amdgcn_update_dpp(0, (int)fbits(x), ctrl, 0xF, 0xF, true))
    v += WS_DPP(v, 0xB1); v += WS_DPP(v, 0x4E); v += WS_DPP(v, 0x141); v += WS_DPP(v, 0x140);
#undef WS_DPP
    const int iv = (int)fbits(v);
    return bitsf((unsigned)__builtin_amdgcn_readlane(iv, 0)) + bitsf((unsigned)__builtin_amdgcn_readlane(iv, 16)) + bitsf((unsigned)__builtin_amdgcn_readlane(iv, 32)) + bitsf((unsigned)__builtin_amdgcn_readlane(iv, 48));
#endif
}

struct Params { const float* in[N_IN]; float* out; unsigned char* ws; };

constexpr int LDS_BYTES = 128 * 1024;
constexpr int LDS_TOTAL = LDS_BYTES + 16;
#ifdef CPU_EMU
#define DECL_LDS unsigned char* lds = emu::cur_blk->lds
#define GRID_SYNC() emu::grid_barrier()
#else
#define DECL_LDS extern __shared__ __attribute__((aligned(16))) unsigned char lds[]
#define XB_TMO      128
#define XB_XCNT(j)  (256  + 64 * (j))
#define XB_XSUB(j)  (1280 + 64 * (j))
#define XB_XGEN(j)  (2304 + 64 * (j))
#define XB_TOP      3328
#define XB_TOPGEN   3392
#define XCD_BAR_WORDS 3456
#define XB_SPIN_CAP (1u << 18)
#define LAS __attribute__((address_space(3)))

__device__ __forceinline__ unsigned xb_ld(unsigned* p)              { return __hip_atomic_load(p, __ATOMIC_RELAXED, __HIP_MEMORY_SCOPE_AGENT); }
__device__ __forceinline__ unsigned xb_add(unsigned* p, unsigned v) { return __hip_atomic_fetch_add(p, v, __ATOMIC_RELAXED, __HIP_MEMORY_SCOPE_AGENT); }
__device__ __forceinline__ unsigned xb_xcc_id() { return (unsigned)__builtin_amdgcn_s_getreg((3 << 11) | 20) & 0xFu; }
#define XB_SPIN(cond, bar) do { unsigned _sp = 0; while (cond) { __builtin_amdgcn_s_sleep(1); \
    if ((++_sp & 255u) == 0u) { if (xb_ld(&(bar)[XB_TMO])) break; if (_sp > XB_SPIN_CAP) { atomicAdd(&(bar)[XB_TMO], 1u); break; } } } } while (0)

struct XcdBarrier {
    unsigned* bar; unsigned x;
    volatile LAS unsigned* st;
};

__device__ __forceinline__ XcdBarrier xcd_barrier_post(unsigned* bar, volatile LAS unsigned* st) {
    XcdBarrier b; b.bar = bar; b.x = xb_xcc_id(); b.st = st;
    if (threadIdx.x == 0) (void)xb_add(&bar[XB_XCNT(b.x)], 1u);
    return b;
}
__device__ __forceinline__ void xcd_barrier_complete(unsigned* bar, unsigned x, unsigned& nloc, unsigned& nx) {
    const unsigned G = gridDim.x * gridDim.y * gridDim.z;
    unsigned sum, cnt, mine, sp = 0u;
    for (;;) {
        sum = 0u; cnt = 0u; mine = 0u;
#pragma unroll
        for (unsigned j = 0; j < 16; ++j) { const unsigned c = xb_ld(&bar[XB_XCNT(j)]); sum += c; cnt += (c > 0u) ? 1u : 0u; mine = (j == x) ? c : mine; }
        if (sum == G) break;
        __builtin_amdgcn_s_sleep(1);
        if ((++sp & 255u) == 0u) { if (xb_ld(&bar[XB_TMO])) break; if (sp > XB_SPIN_CAP) { atomicAdd(&bar[XB_TMO], 1u); break; } }
    }
    nloc = mine > 0u ? mine : 1u; nx = cnt > 0u ? cnt : 1u;
}

__device__ __forceinline__ void xcd_barrier(const XcdBarrier& b) {
    asm volatile("s_waitcnt vmcnt(0)" ::: "memory");
    __syncthreads();
    if (threadIdx.x == 0) {
        unsigned* bar = b.bar;
        __builtin_amdgcn_s_waitcnt(0);
        unsigned nloc = b.st[0], nx = b.st[1];
        if (nloc == 0u) { xcd_barrier_complete(bar, b.x, nloc, nx); b.st[0] = nloc; b.st[1] = nx; }
        const unsigned old = xb_add(&bar[XB_XSUB(b.x)], 1u);
        const unsigned gen = old / nloc;
        if (old + 1u == (gen + 1u) * nloc) {
            __builtin_amdgcn_fence(__ATOMIC_RELEASE, "agent");
            asm volatile("s_waitcnt vmcnt(0)" ::: "memory");
            const unsigned og = xb_add(&bar[XB_TOP], 1u);
            const unsigned tg = og / nx;
            if (og + 1u == (tg + 1u) * nx) xb_add(&bar[XB_TOPGEN], 1u);
            else XB_SPIN(xb_ld(&bar[XB_TOPGEN]) == tg, bar);
            __builtin_amdgcn_fence(__ATOMIC_ACQUIRE, "agent");
            xb_add(&bar[XB_XGEN(b.x)], 1u);
            asm volatile("s_waitcnt vmcnt(0)" ::: "memory");
        } else {
            XB_SPIN(xb_ld(&bar[XB_XGEN(b.x)]) == gen, bar);
            __builtin_amdgcn_fence(__ATOMIC_ACQUIRE, "agent");
            asm volatile("s_waitcnt vmcnt(0)" ::: "memory");
        }
    }
    __syncthreads();
}

#define GRID_SYNC() xcd_barrier(gbar)
#endif

DEVFN int tidx() { int t = (int)threadIdx.x;
#ifndef CPU_EMU
    asm volatile("" : "+v"(t));
#endif
    return t; }
template <class ColSrc, class DstFn>
DEVFN void conv_group(unsigned char* lds, int nmat, int K, int N, int ld_src, ColSrc colsrc, DstFn dstfn) {
    float* t = (float*)lds;
    const int tid = tidx(), G = gridDim.x, nkt = K / 64, nnt = N / 128, units = nmat * nkt * nnt; float r[16];
    auto load = [&](int u) { const int mat = u / (nkt * nnt), rem = u % (nkt * nnt), k0 = (rem % nkt) * 64, n0 = (rem / nkt) * 128;
#pragma unroll
        for (int it = 0; it < 16; ++it) { const int idx = it * NTH + tid, kl = idx >> 7, nl = idx & 127; const float* sp = colsrc(mat, n0 + nl); r[it] = sp ? __builtin_nontemporal_load(sp + (size_t)(k0 + kl) * ld_src) : 0.f; } };
    int u = blockIdx.x; if (u < units) load(u);
    for (; u < units; u += G) {
        __syncthreads();
#pragma unroll
        for (int it = 0; it < 16; ++it) { const int idx = it * NTH + tid, kl = idx >> 7, nl = idx & 127; t[kl * 129 + nl] = r[it]; }
        if (u + G < units) load(u + G);
        __syncthreads();
        const int mat = u / (nkt * nnt), rem = u % (nkt * nnt), k0 = (rem % nkt) * 64, n0 = (rem / nkt) * 128; bf16* dst = dstfn(mat);
#pragma unroll
        for (int it = 0; it < 8; ++it) { const int idx = it * NTH + tid, nl = idx >> 5, kp = idx & 31; __builtin_nontemporal_store(pack2(t[(2 * kp) * 129 + nl], t[(2 * kp + 1) * 129 + nl]), (unsigned*)(dst + (size_t)(n0 + nl) * K + k0 + 2 * kp)); }
    }
}

DEVFN void phase_convert(const Params& p, unsigned char* lds) {
    const int G = gridDim.x, bid = blockIdx.x;
    conv_group(lds, NE, D, EVEN_N, EVEN_N, [&](int j, int n) { return p.in[I_EWIN] + (size_t)j * D * EVEN_N + n; }, [&](int j) { return (bf16*)(p.ws + WS_WIN) + (size_t)(2 * j) * WIN_LSTRIDE; });
    if (NO > 0) conv_group(lds, NO, D, ODD_NP, ODD_N, [&](int j, int n) -> const float* { const float* src = p.in[I_OWIN] + (size_t)j * D * ODD_N; return n < 1536 ? src + n : (n < 3072 ? src + n + 32 : (n < 3104 ? src + 1536 + (n - 3072) : nullptr)); },
                           [&](int j) { return (bf16*)(p.ws + WS_WIN) + (size_t)(2 * j + 1) * WIN_LSTRIDE; });
    conv_group(lds, NL, D, D, D, [&](int l, int n) { return ((l & 1) ? p.in[I_OWOUT] : p.in[I_EWOUT]) + (size_t)(l >> 1) * D * D + n; }, [&](int l) { return (bf16*)(p.ws + WS_WOUT) + (size_t)l * D * D; });
    conv_group(lds, NE, 512, 1024, 1024, [&](int j, int n) { return p.in[I_GLUW] + (size_t)j * 512 * 1024 + ((n & 31) >> 4) * 512 + (n >> 5) * 16 + (n & 15); }, [&](int j) { return (bf16*)(p.ws + WS_GLU) + (size_t)j * 1024 * 512; });
    conv_group(lds, NL * NEXP, D, 512, 256, [&](int e, int n) { return (((n & 31) >> 4) ? p.in[I_WUP] : p.in[I_WGATE]) + (size_t)e * D * 256 + (n >> 5) * 16 + (n & 15); }, [&](int e) { return (bf16*)(p.ws + WS_MGU) + (size_t)e * 512 * 1024; });
    conv_group(lds, NL * NEXP, 256, D, D, [&](int e, int n) { return p.in[I_WDOWN] + (size_t)e * 256 * D + n; }, [&](int e) { return (bf16*)(p.ws + WS_MDN) + (size_t)e * 1024 * 256; });
    {
        float* sv = (float*)lds;
        __syncthreads();
        for (int i = tidx(); i < (NB + 1) * D; i += NTH) { const int r = i / D, k = i % D; const float v = r < NB ? p.in[I_C][r * D + k] : p.in[I_CCTX][k]; sv[i] = siluf_(v); }
        __syncthreads();
        float* modv = (float*)(p.ws + WS_MODV);
        for (int u = bid; u < NL * 96; u += G) { const int l = u / 96, cg = u % 96; const int cl = tidx() & 63, col = cg * 64 + cl, ks = tidx() >> 6;
            const float* w = p.in[I_MODW] + (size_t)l * D * 6144 + col; float acc[NB + 1];
#pragma unroll
            for (int r = 0; r <= NB; ++r) acc[r] = 0.f;
#pragma unroll 8
            for (int k = ks * 128; k < ks * 128 + 128; ++k) { const float wv = w[(size_t)k * 6144];
#pragma unroll
                for (int r = 0; r <= NB; ++r) acc[r] += sv[r * D + k] * wv; }
            float* red = (float*)(lds + 32768);
            __syncthreads();
#pragma unroll
            for (int r = 0; r <= NB; ++r) red[(ks * (NB + 1) + r) * 64 + cl] = acc[r];
            __syncthreads();
            for (int i = tidx(); i < (NB + 1) * 64; i += NTH) { const int r = i >> 6, c = i & 63; const int cc = cg * 64 + c; float sum = p.in[I_MODB][(size_t)l * 6144 + cc];
#pragma unroll
                for (int q = 0; q < 8; ++q) sum += red[(q * (NB + 1) + r) * 64 + c];
                modv[((size_t)l * (NB + 1) + r) * 6144 + cc] = sum; }
            __syncthreads();
        }
    }
    for (int i = bid * NTH + tidx(); i < 1024; i += G * NTH) { const float ang = (float)(i >> 4) * expf(-(float)(i & 15) * (9.210340371976184f / 16.0f)); float sn, cs; sincosf(ang, &sn, &cs); float* rt = (float*)(p.ws + WS_ROPE); rt[i] = cs; rt[1024 + i] = sn; }
    for (int i = bid * NTH + tidx(); i < NE * 2 * 32 * 64; i += G * NTH) {
        const int pidx = i & 63, g = (i >> 6) & 31, jd = i >> 11;
        const float lre = p.in[I_LAMRE][i], lim = p.in[I_LAMIM][i], dt = expf(p.in[I_LOGDT][jd * 32 + g]);
        const float mag = expf(lre * dt), are = mag * cosf(lim * dt), aim = mag * sinf(lim * dt);
        const float magL = expf(lre * dt * 64.f), aLre = magL * cosf(lim * dt * 64.f), aLim = magL * sinf(lim * dt * 64.f);
        const float den = lre * lre + lim * lim;
        const float fre = ((are - 1.0f) * lre + aim * lim) / den, fim = (aim * lre - (are - 1.0f) * lim) / den;
        float* o = (float*)(p.ws + WS_S5P) + (size_t)i * S5P_STRIDE;
        o[0] = are; o[1] = aim; o[2] = aLre; o[3] = aLim;
        const float* bre = p.in[I_BRE] + (size_t)i * 16; const float* bim = p.in[I_BIM] + (size_t)i * 16;
        for (int h = 0; h < 16; ++h) { o[4 + h] = fre * bre[h] - fim * bim[h]; o[20 + h] = fre * bim[h] + fim * bre[h]; }
    }
}

DEVFN void mod_store_row(const Params& p, int layer, int which  , int row, const float (&h)[16], bf16* dstrow) {
    const int b = row / PT, pp = row % PT, mr = pp < LC ? NB : b, lane = tidx() & 63;
    const float* mv = (const float*)(p.ws + WS_MODV) + ((size_t)layer * (NB + 1) + mr) * 6144 + which * 3072;
#pragma unroll
    for (int i = 0; i < 4; ++i) { const int c = i * 256 + lane * 4; const f32x4 sh = *(const f32x4*)(mv + c), sc = *(const f32x4*)(mv + 1024 + c);
        u32x2 w; w.x = pack2(h[i * 4 + 0] * (1.f + sc[0]) + sh[0], h[i * 4 + 1] * (1.f + sc[1]) + sh[1]); w.y = pack2(h[i * 4 + 2] * (1.f + sc[2]) + sh[2], h[i * 4 + 3] * (1.f + sc[3]) + sh[3]);
        *(u32x2*)(dstrow + c) = w; }
}
DEVFN void phase_init_h(const Params& p) {
    const int wave = tidx() >> 6, lane = tidx() & 63; bf16* H = (bf16*)(p.ws + WS_H); bf16* A = (bf16*)(p.ws + WS_ABF);
    auto srcrow = [&](int row) { const int b = row / PT, pp = row % PT; return pp < LC ? p.in[I_CTX] + ((size_t)b * LC + pp) * D : p.in[I_X] + ((size_t)b * TS + (pp - LC)) * D; };
    f32x4 nx[4];
    int row = blockIdx.x * 8 + wave;
    if (row < MR) { const float* src = srcrow(row);
#pragma unroll
        for (int i = 0; i < 4; ++i) nx[i] = __builtin_nontemporal_load((const f32x4*)(src + i * 256 + lane * 4)); }
    for (; row < MR; row += gridDim.x * 8) { float h[16]; f32x4 cv[4];
#pragma unroll
        for (int i = 0; i < 4; ++i) cv[i] = nx[i];
        if (row + (int)gridDim.x * 8 < MR) { const float* src = srcrow(row + gridDim.x * 8);
#pragma unroll
            for (int i = 0; i < 4; ++i) nx[i] = __builtin_nontemporal_load((const f32x4*)(src + i * 256 + lane * 4)); }
#pragma unroll
        for (int i = 0; i < 4; ++i) { const f32x4 v = cv[i]; { u32x2 w; w.x = pack2(v[0], v[1]); w.y = pack2(v[2], v[3]); *(u32x2*)(H + (size_t)row * D + i * 256 + lane * 4) = w; } h[i * 4] = v[0]; h[i * 4 + 1] = v[1]; h[i * 4 + 2] = v[2]; h[i * 4 + 3] = v[3]; }
        mod_store_row(p, 0, 0, row, h, A + (size_t)row * D); }
}

DEVFN int lds_sw(int row, int ch) { return row * 128 + ((ch ^ (row & 7)) << 4); }
DEVFN void dma16(const void* g, unsigned char* l) {
#ifdef CPU_EMU
    memcpy(l + (emu::cur->lin & 63) * 16, g, 16);
#else
    __builtin_amdgcn_global_load_lds((const unsigned*)g, (LAS unsigned*)l, 16, 0, 0);
#endif
}
template <int N> DEVFN void dma_wait_barrier() {
#ifdef CPU_EMU
    __syncthreads();
#else
    asm volatile("s_waitcnt vmcnt(%0) lgkmcnt(0)" :: "n"(N) : "memory"); __builtin_amdgcn_s_barrier(); asm volatile("" ::: "memory");
#endif
}
template <int WM> struct GemmPtrs { const bf16* pa[WM]; const bf16* pb[2]; };
template <int WM, class RowA>
DEVFN void gemm_begin(unsigned char* lds, RowA rowA, const bf16* Bt, int K, int n0, GemmPtrs<WM>& g) {
    constexpr int NA = WM, ABYTES = WM * 8192, BUF = ABYTES + 16384;
    const int tid = tidx(), wave = tid >> 6;
#ifdef CPU_EMU
    const int wvu = wave;
#else
    const int wvu = __builtin_amdgcn_readfirstlane(wave);
#endif
#pragma unroll
    for (int i = 0; i < NA; ++i) { const int idx = i * NTH + tid, row = idx >> 3, ch = (idx & 7) ^ (row & 7); g.pa[i] = rowA(row) + ch * 8; }
#pragma unroll
    for (int i = 0; i < 2; ++i) { const int idx = i * NTH + tid, row = idx >> 3, ch = (idx & 7) ^ (row & 7); g.pb[i] = Bt + (size_t)(n0 + row) * K + ch * 8; }
#pragma unroll
    for (int t = 0; t < 2; ++t) {
#pragma unroll
        for (int i = 0; i < NA; ++i) dma16(g.pa[i] + t * 64, lds + t * BUF + (i * NTH + wvu * 64) * 16);
#pragma unroll
        for (int i = 0; i < 2; ++i) dma16(g.pb[i] + t * 64, lds + t * BUF + ABYTES + (i * NTH + wvu * 64) * 16); }
}
template <int WM, bool SWAP, class Hook, class Epi>
DEVFN void gemm_run(unsigned char* lds, const GemmPtrs<WM>& g, int K, Hook hook, Epi epi) {
    constexpr int WN = 8 / WM, NG = WM / 2, NA = WM, ABYTES = WM * 8192, BUF = ABYTES + 16384;
    static_assert(3 * BUF <= LDS_BYTES, "GEMM LDS");
    const int tid = tidx(), lane = tid & 63, wave = tid >> 6, wr = wave / WN, wc = wave % WN, fr = lane & 15, fg = lane >> 4;
#ifdef CPU_EMU
    const int wvu = wave;
#else
    const int wvu = __builtin_amdgcn_readfirstlane(wave);
#endif
    f32x4 acc[4][2 * NG];
#pragma unroll
    for (int m = 0; m < 4; ++m)
#pragma unroll
        for (int n = 0; n < 2 * NG; ++n) acc[m][n] = (f32x4){0.f, 0.f, 0.f, 0.f};
    const int nk = K / 64;
#define GM_DMA(kt, buf) do { _Pragma("unroll") for (int i = 0; i < NA; ++i) dma16(g.pa[i] + (kt) * 64, lds + (buf) + (i * NTH + wvu * 64) * 16); \
        _Pragma("unroll") for (int i = 0; i < 2; ++i) dma16(g.pb[i] + (kt) * 64, lds + (buf) + ABYTES + (i * NTH + wvu * 64) * 16); } while (0)
#define GM_COMPUTE(cur) do { _Pragma("unroll") for (int ks = 0; ks < 2; ++ks) { bf16x8 a[4], b[2 * NG]; \
        _Pragma("unroll") for (int m = 0; m < 4; ++m) a[m] = *(const bf16x8*)(lds + (cur) + lds_sw(wr * 64 + m * 16 + fr, ks * 4 + fg)); \
        _Pragma("unroll") for (int n = 0; n < 2 * NG; ++n) b[n] = *(const bf16x8*)(lds + (cur) + ABYTES + lds_sw(wc * 32 * NG + n * 16 + fr, ks * 4 + fg)); \
        _Pragma("unroll") for (int m = 0; m < 4; ++m) _Pragma("unroll") for (int n = 0; n < 2 * NG; ++n) acc[m][n] = SWAP ? mfma16(b[n], a[m], acc[m][n]) : mfma16(a[m], b[n], acc[m][n]); } } while (0)
    dma_wait_barrier<NA + 2>();
    int cur = 0, nxt2 = 2 * BUF;
    for (int kt = 0; kt < nk; ++kt) {
        if (kt + 2 < nk) GM_DMA(kt + 2, nxt2);
        GM_COMPUTE(cur);
        if (kt + 2 < nk) dma_wait_barrier<NA + 2>(); else dma_wait_barrier<0>();
        nxt2 = cur; cur = cur + BUF >= 3 * BUF ? 0 : cur + BUF;
    }
#undef GM_DMA
#undef GM_COMPUTE
    hook();
#pragma unroll
    for (int m = 0; m < 4; ++m)
#pragma unroll
        for (int g2 = 0; g2 < NG; ++g2) { if (SWAP) epi(wr * 64 + m * 16 + fr, wc * 32 * NG + g2 * 32 + 4 * fg, acc[m][2 * g2], acc[m][2 * g2 + 1]); else epi(wr * 64 + m * 16 + 4 * fg, wc * 32 * NG + g2 * 32, acc[m][2 * g2], acc[m][2 * g2 + 1]); }
}

namespace pg8 {
constexpr int BM = 256, BK = 64, HALF = 128, HTB = HALF * BK * 2  , STAGE_BYTES = 8 * HTB, NXCD = 8, WGM = 8;
DEVFN int lds_byte(int r, int c) { const int st = (r >> 4) * 2 + (c >> 5), rr = r & 15, cc = c & 31, ob = rr * 64 + cc * 2; return st * 1024 + (ob ^ (((ob >> 9) & 1) << 5)); }
DEVFN void stage_rc(int b, int& R, int& C) { const int st = b / 1024, sb = b % 1024, swz = sb ^ (((sb >> 9) & 1) << 5); R = (st >> 1) * 16 + swz / 64; C = (st & 1) * 32 + (swz % 64) / 2; }
struct Unit { int pm, pn; };
struct Gemm { const bf16* A; const bf16* Bt; int M, N, K; };
struct StaticOrder {
    int nM, nN, nwg, G, c;
    MEMFN void init(int M, int N, int G_, int c_) { nM = M / BM; nN = N / BM; nwg = nM * nN; G = G_; c = c_; }
    MEMFN bool next(int i, Unit& u) const {
        const long L = (long)i * G + c; if (L >= nwg) return false;
        int wgid = (int)L; { const int q = nwg / NXCD, r = nwg % NXCD, xcd = wgid % NXCD, off = wgid / NXCD; wgid = (xcd < r ? xcd * (q + 1) : r * (q + 1) + (xcd - r) * q) + off; }
        const int nig = WGM * nN, gid = wgid / nig, fm = gid * WGM, gsz = (nM - fm) < WGM ? (nM - fm) : WGM;
        u.pm = fm + ((wgid % nig) % gsz); u.pn = (wgid % nig) / gsz; return true;
    }
};
#ifdef CPU_EMU
#define PG8_WAIT_V(n) do {} while (0)
#define PG8_WAIT_L(n) do {} while (0)
#define PG8_BAR __syncthreads()
#define PG8_SCHED do {} while (0)
#define PG8_PRIO(x) do {} while (0)
#else
#define PG8_WAIT_V(n) asm volatile("s_waitcnt vmcnt(" #n ")" ::: "memory")
#define PG8_WAIT_L(n) asm volatile("s_waitcnt lgkmcnt(" #n ")" ::: "memory")
#define PG8_BAR __builtin_amdgcn_s_barrier()
#define PG8_SCHED __builtin_amdgcn_sched_barrier(0)
#define PG8_PRIO(x) __builtin_amdgcn_s_setprio(x)
#endif
template <class Epi, class Sched>
DEVFN void gemm_phase(unsigned char* lds, const Gemm g, const Sched& S, const Epi& E) {
    const int tid = tidx();
#ifdef CPU_EMU
    const int wid = tid >> 6;
#else
    const int wid = __builtin_amdgcn_readfirstlane(tid >> 6);
#endif
    const int lane = tid & 63, wr = wid >> 2, wc = wid & 3, fr = lane & 15, fq = lane >> 4;
    const int K = g.K, nt = K / BK;
    unsigned voffA[2], voffB[2];
#pragma unroll
    for (int i = 0; i < 2; ++i) { int R, C; stage_rc(tid * 16 + i * 8192, R, C); voffA[i] = (unsigned)(R * K + C) * 2u; voffB[i] = voffA[i]; }
    const size_t kstep = (size_t)(BK * 2);
    const size_t hstep = (size_t)HALF * K * 2;
    const size_t tstep = 2 * hstep;
    const unsigned ldsw = (unsigned)wid * 1024u;
    const int aoff = lds_byte(wr * 64 + fr, fq * 8), boff = lds_byte(wc * 32 + fr, fq * 8);
#define PG8_SA(b, h) (((b) * 2 + (h)) * HTB)
#define PG8_SB(b, h) ((4 + (b) * 2 + (h)) * HTB)
#define PG8_STAGE(bufoff, gbase, voff) do { _Pragma("unroll") for (int _i = 0; _i < 2; ++_i) dma16((const char*)(gbase) + (voff)[_i], lds + (bufoff) + ldsw + _i * 8192); } while (0)
#define PG8_LDA(dst, b, h) do { _Pragma("unroll") for (int m = 0; m < 4; ++m) _Pragma("unroll") for (int k = 0; k < 2; ++k) dst[m][k] = *(const bf16x8*)(lds + PG8_SA(b, h) + aoff + m * 2048 + k * 1024); } while (0)
#define PG8_LDB(dst, b, h) do { _Pragma("unroll") for (int n = 0; n < 2; ++n) _Pragma("unroll") for (int k = 0; k < 2; ++k) dst[n][k] = *(const bf16x8*)(lds + PG8_SB(b, h) + boff + n * 2048 + k * 1024); } while (0)
#define PG8_MMA(ai, bj, At, Bt) do { PG8_PRIO(1); _Pragma("unroll") for (int m = 0; m < 4; ++m) _Pragma("unroll") for (int n = 0; n < 2; ++n) _Pragma("unroll") for (int k = 0; k < 2; ++k) \
        acc[ai][bj][m][n] = mfma16(Bt[n][k], At[m][k], acc[ai][bj][m][n]); PG8_PRIO(0); } while (0)
    Unit cur, nxt; int ui = 0;
    __syncthreads();
    if (!S.next(0, cur)) return;
    f32x4 acc[2][2][4][2];
#pragma unroll
    for (int a = 0; a < 2; ++a)
#pragma unroll
        for (int b = 0; b < 2; ++b)
#pragma unroll
            for (int m = 0; m < 4; ++m)
#pragma unroll
                for (int n = 0; n < 2; ++n) acc[a][b][m][n] = (f32x4){0.f, 0.f, 0.f, 0.f};
    bf16x8 At[4][2], B0[2][2], B1[2][2];
    const char* cA = (const char*)g.A + (size_t)cur.pm * tstep; const char* cB = (const char*)g.Bt + (size_t)cur.pn * tstep;
    PG8_STAGE(PG8_SB(0, 0), cB, voffB); PG8_STAGE(PG8_SA(0, 0), cA, voffA); PG8_STAGE(PG8_SB(0, 1), cB + hstep, voffB); PG8_STAGE(PG8_SA(0, 1), cA + hstep, voffA);
    if (wr == 1) PG8_BAR;
    PG8_WAIT_V(4); PG8_BAR;
    PG8_STAGE(PG8_SB(1, 0), cB + kstep, voffB); PG8_STAGE(PG8_SA(1, 0), cA + kstep, voffA); PG8_STAGE(PG8_SB(1, 1), cB + hstep + kstep, voffB);
    PG8_WAIT_V(6); PG8_BAR;
    for (;;) {
        const bool has_next = S.next(ui + 1, nxt);
        const char* nA = has_next ? (const char*)g.A + (size_t)nxt.pm * tstep : cA; const char* nB = has_next ? (const char*)g.Bt + (size_t)nxt.pn * tstep : cB;
        for (int t = 0; t < nt; t += 2) {
            const bool last = (t == nt - 2);
            const char* a1 = cA + (size_t)(t + 1) * kstep;
            const char* a2 = last ? nA : cA + (size_t)(t + 2) * kstep; const char* b2 = last ? nB : cB + (size_t)(t + 2) * kstep;
            const char* a3 = a2 + kstep; const char* b3 = b2 + kstep;
            PG8_LDB(B0, 0, 0); PG8_SCHED; PG8_LDA(At, 0, 0); PG8_STAGE(PG8_SA(1, 1), a1 + hstep, voffA);
            PG8_WAIT_L(8); PG8_BAR; PG8_WAIT_L(0); PG8_MMA(0, 0, At, B0); PG8_BAR; PG8_SCHED;
            PG8_LDB(B1, 0, 1); PG8_STAGE(PG8_SB(0, 0), b2, voffB);
            PG8_BAR; PG8_WAIT_L(0); PG8_MMA(0, 1, At, B1); PG8_BAR;
            PG8_LDA(At, 0, 1); PG8_STAGE(PG8_SA(0, 0), a2, voffA);
            PG8_BAR; PG8_WAIT_L(0); PG8_MMA(1, 0, At, B0); PG8_BAR; PG8_SCHED;
            PG8_STAGE(PG8_SB(0, 1), b2 + hstep, voffB);
            PG8_WAIT_V(6); PG8_BAR; PG8_MMA(1, 1, At, B1); PG8_BAR;
            PG8_LDB(B0, 1, 0); PG8_SCHED; PG8_LDA(At, 1, 0); PG8_STAGE(PG8_SA(0, 1), a2 + hstep, voffA);
            PG8_WAIT_L(8); PG8_BAR; PG8_WAIT_L(0); PG8_MMA(0, 0, At, B0); PG8_BAR; PG8_SCHED;
            PG8_LDB(B1, 1, 1); PG8_STAGE(PG8_SB(1, 0), b3, voffB);
            PG8_BAR; PG8_WAIT_L(0); PG8_MMA(0, 1, At, B1); PG8_BAR;
            PG8_LDA(At, 1, 1); PG8_STAGE(PG8_SA(1, 0), a3, voffA);
            PG8_BAR; PG8_WAIT_L(0); PG8_MMA(1, 0, At, B0); PG8_BAR; PG8_SCHED;
            PG8_STAGE(PG8_SB(1, 1), b3 + hstep, voffB);
            PG8_WAIT_V(6); PG8_BAR; PG8_MMA(1, 1, At, B1); PG8_BAR;
        }
        E(acc, cur, wr, wc, fr, fq);
        if (!has_next) break;
#pragma unroll
        for (int a = 0; a < 2; ++a)
#pragma unroll
            for (int b = 0; b < 2; ++b)
#pragma unroll
                for (int m = 0; m < 4; ++m)
#pragma unroll
                    for (int n = 0; n < 2; ++n) acc[a][b][m][n] = (f32x4){0.f, 0.f, 0.f, 0.f};
        cur = nxt; cA = nA; cB = nB; ++ui;
    }
    PG8_WAIT_V(0);
    if (wr == 0) PG8_BAR;
    PG8_BAR;
#undef PG8_SA
#undef PG8_SB
#undef PG8_STAGE
#undef PG8_LDA
#undef PG8_LDB
#undef PG8_MMA
}
template <class F> struct EpiFn { F f;
    MEMFN void operator()(const f32x4 (&acc)[2][2][4][2], const Unit& u, int wr, int wc, int fr, int fq) const {
#pragma unroll
        for (int ai = 0; ai < 2; ++ai)
#pragma unroll
            for (int m = 0; m < 4; ++m)
#pragma unroll
                for (int bj = 0; bj < 2; ++bj) f(u.pm * BM + ai * HALF + wr * 64 + m * 16 + fr, u.pn * BM + bj * HALF + wc * 32 + 4 * fq, acc[ai][bj][m][0], acc[ai][bj][m][1]); }
};
struct LatentOrder {
    int nN, nwg, G, c;
    MEMFN void init(int N, int G_, int c_) { nN = N / BM; nwg = (TS / BM) * NB * nN; G = G_; c = c_; }
    MEMFN bool next(int i, Unit& u) const { const long L = (long)i * G + c; if (L >= nwg) return false; const int lp = (int)(L / nN); u.pn = (int)(L % nN); u.pm = (lp / (TS / BM)) * (PT / BM) + LC / BM + lp % (TS / BM); return true; }
};
template <class F> DEVFN void run_latent(unsigned char* lds, const bf16* A, const bf16* Bt, int M, int N, int K, F f) {
    Gemm g{A, Bt, M, N, K}; LatentOrder S; S.init(N, (int)gridDim.x, (int)blockIdx.x); EpiFn<F> E{f}; gemm_phase(lds, g, S, E);
}
template <class F> DEVFN void run(unsigned char* lds, const bf16* A, const bf16* Bt, int M, int N, int K, F f) {
    Gemm g{A, Bt, M, N, K}; StaticOrder S; S.init(M, N, (int)gridDim.x, (int)blockIdx.x); EpiFn<F> E{f}; gemm_phase(lds, g, S, E);
}
}

DEVFN int vperm(int pp) { return (pp & ~12) | ((pp & 4) << 1) | ((pp & 8) >> 1); }
DEVFN f32x4 load4b(const bf16* src) { const u32x2 w = *(const u32x2*)src; return (f32x4){bitsf(w.x << 16), bitsf(w.x & 0xffff0000u), bitsf(w.y << 16), bitsf(w.y & 0xffff0000u)}; }
DEVFN void store4s(bf16* dst, const f32x4& v, float sc) { u32x2 w; w.x = pack2(v[0] * sc, v[1] * sc); w.y = pack2(v[2] * sc, v[3] * sc); *(u32x2*)dst = w; }
DEVFN void store4_t(bf16* dst, const f32x4& v) { u32x2 w; w.x = pack2(v[0], v[1]); w.y = pack2(v[2], v[3]); *(u32x2*)dst = w; }

constexpr int GW_INE = 2, GW_INO = 2, GW_OUT = 2, GW_GLU = 2;
constexpr bool SPLIT_CTX = (LC % 256 == 0) && (PT % 256 == 0);
template <class RB, class F> DEVFN void gemm_small_rows(unsigned char* lds, const bf16* A, int lda, const bf16* Bt, int nnt, int K, int nrt, RB rowbase, F f) {
    const int NU = nrt * nnt; GemmPtrs<2> gp, gq;
    auto begin = [&](int u, GemmPtrs<2>& g) { const int m0 = rowbase(u / nnt), n0 = (u % nnt) * 128; gemm_begin<2>(lds, [&](int r) { return A + (size_t)(m0 + r) * lda; }, Bt, K, n0, g); };
    __syncthreads();
    if ((int)blockIdx.x < NU) begin(blockIdx.x, gp);
    for (int u = blockIdx.x; u < NU; u += gridDim.x, gp = gq) { const int m0 = rowbase(u / nnt), n0 = (u % nnt) * 128;
        gemm_run<2, true>(lds, gp, K, [&]() { if (u + (int)gridDim.x < NU) begin(u + gridDim.x, gq); }, [&](int rl, int cl, const f32x4& a0, const f32x4& a1) { f(m0 + rl, n0 + cl, a0, a1); }); }
}
template <class F> DEVFN void gemm_ctx_rows(unsigned char* lds, const bf16* A, int lda, const bf16* Bt, int N, int K, F f) {
    constexpr int RT = LC / 128; gemm_small_rows(lds, A, lda, Bt, N / 128, K, NB * RT, [&](int rt) { return (rt / RT) * PT + (rt % RT) * 128; }, f);
}
template <class F> DEVFN void dense_gemm(unsigned char* lds, const bf16* A, const bf16* Bt, int N, int K, bool ctx_needed, F f) {
    if constexpr (SPLIT_CTX) { pg8::run_latent(lds, A, Bt, MR, N, K, f); if (ctx_needed) gemm_ctx_rows(lds, A, K, Bt, N, K, f); }
    else pg8::run(lds, A, Bt, MR, N, K, f);
}
DEVFN void scatter4_t(bf16* base, size_t rowstride, const f32x4& v) {
#pragma unroll
    for (int e = 0; e < 4; ++e) base[(size_t)e * rowstride] = f2bf(v[e]);
}
DEVFN void phase_inproj_even(const Params& p, unsigned char* lds, int l) {
    const bf16* A = (const bf16*)(p.ws + WS_ABF); const bf16* Bt = (const bf16*)(p.ws + WS_WIN) + (size_t)l * WIN_LSTRIDE; bf16* Z = (bf16*)(p.ws + WS_Z);
    dense_gemm(lds, A, Bt, EVEN_N, D, true, [&](int row, int col, const f32x4& a0, const f32x4& a1) {
        const int region = col >> 9, cc = col & 511;
        if (region == 3) { const int b = row / PT, pp = row % PT;
            bf16* vb = Z + ZE_VT + ((size_t)(b * 8 + (cc >> 6)) * 64 + (cc & 63)) * PT + vperm(pp); scatter4_t(vb, PT, a0); scatter4_t(vb + (size_t)16 * PT, PT, a1); }
        else { bf16* dst = Z + (region == 0 ? ZE_U : region == 1 ? ZE_Q : ZE_K) + (size_t)row * 512 + cc; const float sc = region == 1 ? QSCALE : 1.0f; store4s(dst, a0, sc); store4s(dst + 16, a1, sc); } });
}

DEVFN void phase_inproj_odd(const Params& p, unsigned char* lds, int l) {
    const bf16* A = (const bf16*)(p.ws + WS_ABF); const bf16* Bt = (const bf16*)(p.ws + WS_WIN) + (size_t)l * WIN_LSTRIDE; bf16* Z = (bf16*)(p.ws + WS_Z);
    const int fg = (tidx() & 63) >> 4;
    const float* rtab = (const float*)(p.ws + WS_ROPE);
    auto epi = [&](int row, int cb, const f32x4& a0, const f32x4& a1) {
        const int b = row / PT, pp = row % PT;
        if (cb < 256) { store4s(Z + ZO_GQ + (size_t)row * 256 + cb, a0, 0.125f); store4s(Z + ZO_GQ + (size_t)row * 256 + cb + 16, a1, 0.125f); }
        else if (cb < 512) { const int c = cb - 256;
            store4s(Z + ZO_GK + (size_t)row * 256 + c, a0, 1.0f); store4s(Z + ZO_GK + (size_t)row * 256 + c + 16, a1, 1.0f);
            bf16* kb = Z + ZO_GKT + ((size_t)(b * 4 + (c >> 6)) * 64 + (c & 63)) * PT + pp; scatter4_t(kb, PT, a0); scatter4_t(kb + (size_t)16 * PT, PT, a1); }
        else if (cb < 1024) { const int c = cb - 512; bf16* vb = Z + ZO_GVT + ((size_t)(b * 4 + (c >> 7)) * 128 + (c & 127)) * PT + pp; scatter4_t(vb, PT, a0); scatter4_t(vb + (size_t)16 * PT, PT, a1); }
        else if (cb < 1536) { store4s(Z + ZO_GR + (size_t)row * 512 + cb - 1024, a0, 1.0f); store4s(Z + ZO_GR + (size_t)row * 512 + cb - 1024 + 16, a1, 1.0f); }
        else if (cb < 2560) {
            const bool isq = cb < 2048; const int c0 = cb - (isq ? 1536 : 2048); const int blk = (c0 >> 5) & 1; bf16* dst = Z + (isq ? ZO_DQ : ZO_DK) + (size_t)row * 512 + c0; const float sc = isq ? QSCALE : 1.0f;
            f32x4 x1 = a0 * sc, x2 = a1 * sc;
            if (pp >= LC) { const int t = pp - LC; const int pos = blk == 0 ? (t >> 6) : (t & 63); const f32x4 cs = *(const f32x4*)(rtab + pos * 16 + 4 * fg), sn = *(const f32x4*)(rtab + 1024 + pos * 16 + 4 * fg);
                const f32x4 o1 = x1 * cs - x2 * sn, o2 = x1 * sn + x2 * cs; x1 = o1; x2 = o2; }
            store4s(dst, x1, 1.0f); store4s(dst + 16, x2, 1.0f); }
        else if (cb < 3072) { const int c = cb - 2560; bf16* vb = Z + ZO_DVT + ((size_t)(b * 4 + (c >> 7)) * 128 + (c & 127)) * PT + vperm(pp); scatter4_t(vb, PT, a0); scatter4_t(vb + (size_t)16 * PT, PT, a1); }
        else if (cb < 3072 + 16) { store4s(Z + ZO_GZ + (size_t)row * 32 + (cb - 3072), a0, 1.0f); store4s(Z + ZO_GZ + (size_t)row * 32 + (cb - 3072) + 16, a1, 1.0f); } };
    if constexpr (SPLIT_CTX) {
        dense_gemm(lds, A, Bt, 3072, D, true, epi);
        gemm_small_rows(lds, A, D, Bt + (size_t)3072 * D, 1, D, MR / 128, [&](int rt) { return rt * 128; },
                        [&](int row, int col, const f32x4& a0, const f32x4& a1) { epi(row, 3072 + col, a0, a1); });
    } else pg8::run(lds, A, Bt, MR, ODD_NP, D, epi);
}

DEVFN void phase_glu(const Params& p, unsigned char* lds, int j) {
    const bf16* A = (const bf16*)(p.ws + WS_SB + SBO_GS); const bf16* Bt = (const bf16*)(p.ws + WS_GLU) + (size_t)j * 1024 * 512; bf16* Y = (bf16*)(p.ws + WS_YMIX);
    const float* gb = p.in[I_GLUB] + (size_t)j * 1024;
    dense_gemm(lds, A, Bt, 1024, 512, true, [&](int row, int col, const f32x4& a0, const f32x4& a1) {
        const int jj = (col >> 5) * 16 + (col & 15); const f32x4 bv = *(const f32x4*)(gb + jj), bg = *(const f32x4*)(gb + 512 + jj); f32x4 o;
#pragma unroll
        for (int r = 0; r < 4; ++r) o[r] = (a0[r] + bv[r]) * sigmoidf_(a1[r] + bg[r]);
        store4s(Y + (size_t)row * D + jj, o, 1.0f); });
}

constexpr int OPS = 4;
constexpr size_t OP_PSTRIDE = (size_t)NB * LC * D;
static_assert(!SPLIT_CTX || OPS * OP_PSTRIDE * 4 <= (size_t)2 * MR * D * 2, "split-K partials must fit the MoE output region");
DEVFN void outproj_ctx_splitk(unsigned char* lds, const bf16* A, const bf16* Bt, float* P) {
    constexpr int RT = LC / 128, NNT = D / 128, NU = NB * RT * NNT * OPS, KS = D / OPS;
    GemmPtrs<2> gp, gq;
    auto begin = [&](int u, GemmPtrs<2>& g) { const int s = u % OPS, t = u / OPS, rt = t / NNT, n0 = (t % NNT) * 128, m0 = (rt / RT) * PT + (rt % RT) * 128;
        gemm_begin<2>(lds, [&](int r) { return A + (size_t)(m0 + r) * D + s * KS; }, Bt + s * KS, D, n0, g); };
    __syncthreads();
    if ((int)blockIdx.x < NU) begin(blockIdx.x, gp);
    for (int u = blockIdx.x; u < NU; u += gridDim.x, gp = gq) { const int s = u % OPS, t = u / OPS, rt = t / NNT, n0 = (t % NNT) * 128, c0 = (rt / RT) * LC + (rt % RT) * 128;
        gemm_run<2, true>(lds, gp, KS, [&]() { if (u + (int)gridDim.x < NU) begin(u + gridDim.x, gq); }, [&](int rl, int cl, const f32x4& a0, const f32x4& a1) {
            float* dst = P + (size_t)s * OP_PSTRIDE + (size_t)(c0 + rl) * D + n0 + cl; *(f32x4*)dst = a0; *(f32x4*)(dst + 16) = a1; }); }
}
DEVFN void phase_outproj(const Params& p, unsigned char* lds, int l) {
    const bf16* A = (const bf16*)(p.ws + WS_YMIX); const bf16* Bt = (const bf16*)(p.ws + WS_WOUT) + (size_t)l * D * D; bf16* C = (bf16*)(p.ws + WS_Z);
    auto epi = [&](int row, int col, const f32x4& a0, const f32x4& a1) { bf16* dst = C + (size_t)row * D + col; store4s(dst, a0, 1.0f); store4s(dst + 16, a1, 1.0f); };
    if constexpr (SPLIT_CTX) { pg8::run_latent(lds, A, Bt, MR, D, D, epi); outproj_ctx_splitk(lds, A, Bt, (float*)(p.ws + WS_SB)); }
    else dense_gemm(lds, A, Bt, D, D, true, epi);
}

struct MoeMap { int e, mt, cnt, off; };
DEVFN bool moe_find(const unsigned* cnt, int tile, MoeMap& mm) {
    int acc = 0;
    for (int e = 0; e < NEXP; ++e) { const int c = (int)cnt[e], nt = (c + 127) >> 7; if (tile < acc + nt) { mm.e = e; mm.mt = tile - acc; mm.cnt = c; mm.off = acc * 128; return true; } acc += nt; }
    return false;
}
DEVFN int moe_off(const unsigned* cnt, int e) { int acc = 0; for (int i = 0; i < e; ++i) acc += ((int)cnt[i] + 127) >> 7; return acc * 128; }
constexpr int MOE_TAB = 3 * 32768;
DEVFN const unsigned* moe_table(unsigned char* lds, const unsigned* cnt) {
    unsigned* tab = (unsigned*)(lds + MOE_TAB);
    __syncthreads();
    if (tidx() < NEXP) tab[tidx()] = cnt[tidx()];
    __syncthreads();
    return tab;
}

DEVFN void phase_moe_up(const Params& p, unsigned char* lds, int l) {
    const bf16* A = (const bf16*)(p.ws + WS_ABF); bf16* ACT = (bf16*)(p.ws + WS_ACT); const unsigned* cnt = (const unsigned*)(p.ws + WS_CTL + CTL_CNT) + l * NEXP;
    const int* ltok = (const int*)(p.ws + WS_LTOK); const float* lw = (const float*)(p.ws + WS_LW); const unsigned* tab = moe_table(lds, cnt);
    GemmPtrs<2> gp, gq; MoeMap mm, mn;
    auto begin = [&](const MoeMap& m, int nt, GemmPtrs<2>& g) { const bf16* Bt = (const bf16*)(p.ws + WS_MGU) + (size_t)(l * NEXP + m.e) * 512 * 1024; const int* lt = ltok + (size_t)m.e * MR;
        gemm_begin<2>(lds, [&](int r) { const int slot = m.mt * 128 + r; const int tok = lt[slot < m.cnt ? slot : 0]; return A + (size_t)tok * D; }, Bt, D, nt * 128, g); };
    int u = blockIdx.x; bool ok = moe_find(tab, u >> 2, mm);
    if (ok) begin(mm, u & 3, gp);
    while (ok) { const int un = u + gridDim.x; const bool okn = moe_find(tab, un >> 2, mn); const int n0 = (u & 3) * 128;
        gemm_run<2, true>(lds, gp, D, [&]() { if (okn) begin(mn, un & 3, gq); }, [&](int rl, int cl, const f32x4& a0, const f32x4& a1) {
            const int jj = ((n0 + cl) >> 5) * 16 + (cl & 15), slot = mm.mt * 128 + rl;
            if (slot < mm.cnt) { const float w = lw[(size_t)mm.e * MR + slot]; f32x4 o;
#pragma unroll
                for (int r = 0; r < 4; ++r) o[r] = siluf_(a0[r]) * a1[r] * w;
                store4s(ACT + (size_t)(mm.off + slot) * 256 + jj, o, 1.0f); } });
        gp = gq; mm = mn; ok = okn; u = un; }
}
DEVFN void phase_moe_down(const Params& p, unsigned char* lds, int l) {
    const bf16* ACT = (const bf16*)(p.ws + WS_ACT); bf16* F2 = (bf16*)(p.ws + WS_SB); const unsigned* cnt = (const unsigned*)(p.ws + WS_CTL + CTL_CNT) + l * NEXP;
    const unsigned* tab = moe_table(lds, cnt);
    GemmPtrs<2> gp, gq; MoeMap mm, mn;
    auto begin = [&](const MoeMap& m, int nt, GemmPtrs<2>& g) { const bf16* Bt = (const bf16*)(p.ws + WS_MDN) + (size_t)(l * NEXP + m.e) * 1024 * 256; const size_t r0 = (size_t)m.off + m.mt * 128;
        gemm_begin<2>(lds, [&](int r) { return ACT + (r0 + r) * 256; }, Bt, 256, nt * 128, g); };
    int u = blockIdx.x; bool ok = moe_find(tab, u >> 3, mm);
    if (ok) begin(mm, u & 7, gp);
    while (ok) { const int un = u + gridDim.x; const bool okn = moe_find(tab, un >> 3, mn); const int n0 = (u & 7) * 128; const size_t r0 = (size_t)mm.off + mm.mt * 128;
        gemm_run<2, true>(lds, gp, 256, [&]() { if (okn) begin(mn, un & 7, gq); }, [&](int rl, int cl, const f32x4& a0, const f32x4& a1) {
            bf16* dst = F2 + (r0 + rl) * D + n0 + cl; store4s(dst, a0, 1.0f); store4s(dst + 16, a1, 1.0f); });
        gp = gq; mm = mn; ok = okn; u = un; }
}

DEVFN void ln_row(float (&v)[16], const float* g, const float* bta, int lane) {
    float s = 0.f;
#pragma unroll
    for (int i = 0; i < 16; ++i) s += v[i];
    const float mu = wave_sum(s) * (1.0f / 1024.0f); float q = 0.f;
#pragma unroll
    for (int i = 0; i < 16; ++i) { const float d = v[i] - mu; q += d * d; }
    const float rstd = 1.0f / sqrtf(wave_sum(q) * (1.0f / 1024.0f) + LN_EPS);
#pragma unroll
    for (int i = 0; i < 4; ++i) { const f32x4 gg = *(const f32x4*)(g + i * 256 + lane * 4), bb = *(const f32x4*)(bta + i * 256 + lane * 4);
#pragma unroll
        for (int e = 0; e < 4; ++e) v[i * 4 + e] = (v[i * 4 + e] - mu) * rstd * gg[e] + bb[e]; }
}

DEVFN void ln_row_r(float (&v)[16], const float (&g)[16], const float (&bta)[16]) {
    float s = 0.f;
#pragma unroll
    for (int i = 0; i < 16; ++i) s += v[i];
    const float mu = wave_sum(s) * (1.0f / 1024.0f); float q = 0.f;
#pragma unroll
    for (int i = 0; i < 16; ++i) { const float d = v[i] - mu; q += d * d; }
    const float rstd = 1.0f / sqrtf(wave_sum(q) * (1.0f / 1024.0f) + LN_EPS);
#pragma unroll
    for (int i = 0; i < 16; ++i) v[i] = (v[i] - mu) * rstd * g[i] + bta[i];
}
DEVFN void ln_load_gb(const float* g, const float* bta, int lane, float (&gr)[16], float (&br)[16]) {
#pragma unroll
    for (int i = 0; i < 4; ++i) { const f32x4 gg = *(const f32x4*)(g + i * 256 + lane * 4), bb = *(const f32x4*)(bta + i * 256 + lane * 4);
#pragma unroll
        for (int e = 0; e < 4; ++e) { gr[i * 4 + e] = gg[e]; br[i * 4 + e] = bb[e]; } }
}

DEVFN void phase_ln1_route(const Params& p, unsigned char* lds, int l) {
    const int wave = tidx() >> 6, lane = tidx() & 63; bf16* H = (bf16*)(p.ws + WS_H); const bf16* C = (const bf16*)(p.ws + WS_Z); bf16* A = (bf16*)(p.ws + WS_ABF);
    unsigned* cnt = (unsigned*)(p.ws + WS_CTL + CTL_CNT) + l * NEXP; int* route = (int*)(p.ws + WS_ROUTE); int* ltok = (int*)(p.ws + WS_LTOK); float* lw = (float*)(p.ws + WS_LW);
    const float* wg = p.in[I_WGRP] + (size_t)l * D * 4; const float* we = p.in[I_WEXP] + (size_t)l * D * 32;
    float* hrow = (float*)lds;
    float* part = (float*)(lds + 32768);
    const int ke = wave * 128 + (lane >> 5) * 64, kg = wave * 128 + (lane >> 2) * 8;
    f32x2 wreg[32], wgr[4];
#pragma unroll
    for (int i = 0; i < 32; ++i) wreg[i] = (f32x2){we[(size_t)(ke + 2 * i) * 32 + (lane & 31)], we[(size_t)(ke + 2 * i + 1) * 32 + (lane & 31)]};
#pragma unroll
    for (int i = 0; i < 4; ++i) wgr[i] = (f32x2){wg[(size_t)(kg + 2 * i) * 4 + (lane & 3)], wg[(size_t)(kg + 2 * i + 1) * 4 + (lane & 3)]};
    const float bias = lane < 32 ? p.in[I_BEXP][l * 32 + lane] : (lane < 36 ? p.in[I_BGRP][l * 4 + lane - 32] : 0.f);
    unsigned* lcnt = (unsigned*)(lds + 49152); unsigned* lbase = lcnt + 32; int* rt = (int*)(lds + 49152 + 256);
    constexpr int RT_MAX = 1024;
    __syncthreads();
    if (tidx() < 32) lcnt[tidx()] = 0u;
    __syncthreads();
    float lng[16], lnb[16]; ln_load_gb(p.in[I_LNG] + (size_t)(l * 2) * D, p.in[I_LNB] + (size_t)(l * 2) * D, lane, lng, lnb);
    int nrec = 0; u32x2 hn[4], yn[4];
    if (blockIdx.x * 8 < MR) {
#pragma unroll
        for (int i = 0; i < 4; ++i) { const size_t o = (size_t)(blockIdx.x * 8 + wave) * D + i * 256 + lane * 4; hn[i] = __builtin_nontemporal_load((const u32x2*)(H + o)); yn[i] = __builtin_nontemporal_load((const u32x2*)(C + o)); } }
    for (int r0 = blockIdx.x * 8; r0 < MR; r0 += gridDim.x * 8, ++nrec) { const int row = r0 + wave; const int b = row / PT, pp = row % PT, mr = pp < LC ? NB : b;
        const float* mv = (const float*)(p.ws + WS_MODV) + ((size_t)l * (NB + 1) + mr) * 6144; float v[16];
        const bool ctxp = SPLIT_CTX && pp < LC; const float* pb = (const float*)(p.ws + WS_SB) + (size_t)(b * LC + (ctxp ? pp : 0)) * D;
#pragma unroll
        for (int i = 0; i < 4; ++i) { const int c = i * 256 + lane * 4; const f32x4 g1 = *(const f32x4*)(mv + 2048 + c);
            const f32x4 h = (f32x4){bitsf(hn[i].x << 16), bitsf(hn[i].x & 0xffff0000u), bitsf(hn[i].y << 16), bitsf(hn[i].y & 0xffff0000u)};
            f32x4 y = (f32x4){bitsf(yn[i].x << 16), bitsf(yn[i].x & 0xffff0000u), bitsf(yn[i].y << 16), bitsf(yn[i].y & 0xffff0000u)};
            if (ctxp) y = (*(const f32x4*)(pb + c) + *(const f32x4*)(pb + OP_PSTRIDE + c)) + (*(const f32x4*)(pb + 2 * OP_PSTRIDE + c) + *(const f32x4*)(pb + 3 * OP_PSTRIDE + c));
#pragma unroll
            for (int e = 0; e < 4; ++e) v[i * 4 + e] = ALPHA * h[e] + g1[e] * y[e]; }
        if (r0 + gridDim.x * 8 < MR) {
#pragma unroll
            for (int i = 0; i < 4; ++i) { const size_t o = (size_t)(row + gridDim.x * 8) * D + i * 256 + lane * 4; hn[i] = __builtin_nontemporal_load((const u32x2*)(H + o)); yn[i] = __builtin_nontemporal_load((const u32x2*)(C + o)); } }
        f32x4 shv[4], scv[4];
#pragma unroll
        for (int i = 0; i < 4; ++i) { const int c = i * 256 + lane * 4; shv[i] = *(const f32x4*)(mv + 3072 + c); scv[i] = *(const f32x4*)(mv + 4096 + c); }
        ln_row_r(v, lng, lnb);
        __syncthreads();
#pragma unroll
        for (int i = 0; i < 4; ++i) { const int c = i * 256 + lane * 4; { u32x2 hw; hw.x = pack2(v[i * 4], v[i * 4 + 1]); hw.y = pack2(v[i * 4 + 2], v[i * 4 + 3]); __builtin_nontemporal_store(hw, (u32x2*)(H + (size_t)row * D + c)); }
            const f32x4 sh = shv[i], sc = scv[i]; f32x4 h2;
#pragma unroll
            for (int e = 0; e < 4; ++e) h2[e] = v[i * 4 + e] * (1.f + sc[e]) + sh[e];
            *(f32x4*)(hrow + wave * 1024 + c) = h2;
            u32x2 w; w.x = pack2(h2[0], h2[1]); w.y = pack2(h2[2], h2[3]); *(u32x2*)(A + (size_t)row * D + c) = w; }
        __syncthreads();
#pragma unroll
        for (int r = 0; r < 8; ++r) { f32x2 ae2 = {0.f, 0.f}, ae3 = {0.f, 0.f}, ag2 = {0.f, 0.f};
#pragma unroll
            for (int i = 0; i < 64; i += 4) { const f32x4 hv = *(const f32x4*)(hrow + r * 1024 + ke + i);
                ae2 = __builtin_elementwise_fma((f32x2){hv[0], hv[1]}, wreg[i >> 1], ae2); ae3 = __builtin_elementwise_fma((f32x2){hv[2], hv[3]}, wreg[(i >> 1) + 1], ae3); }
#pragma unroll
            for (int i = 0; i < 8; i += 4) { const f32x4 hv = *(const f32x4*)(hrow + r * 1024 + kg + i);
                ag2 = __builtin_elementwise_fma((f32x2){hv[0], hv[1]}, wgr[i >> 1], ag2); ag2 = __builtin_elementwise_fma((f32x2){hv[2], hv[3]}, wgr[(i >> 1) + 1], ag2); }
            float ae = (ae2[0] + ae3[0]) + (ae2[1] + ae3[1]), ag = ag2[0] + ag2[1];
            ae += __shfl_xor(ae, 32);
            ag += __shfl_xor(ag, 4); ag += __shfl_xor(ag, 8); ag += __shfl_xor(ag, 16); ag += __shfl_xor(ag, 32);
            if (lane < 32) part[(wave * 8 + r) * 64 + lane] = ae; else if (lane < 36) part[(wave * 8 + r) * 64 + lane] = ag;
        }
        __syncthreads();
        float logit = bias;
#pragma unroll
        for (int w8 = 0; w8 < 8; ++w8) logit += part[(w8 * 8 + wave) * 64 + lane];
        float lg[4];
#pragma unroll
        for (int o = 0; o < 4; ++o) lg[o] = __shfl(logit, 32 + o);
        int gs = 0; float gm = lg[0];
#pragma unroll
        for (int o = 1; o < 4; ++o) if (lg[o] > gm) { gm = lg[o]; gs = o; }
        float den = 0.f;
#pragma unroll
        for (int o = 0; o < 4; ++o) den += fexp(lg[o] - gm);
        const float pg = 1.0f / den;
        float li[8];
#pragma unroll
        for (int e = 0; e < 8; ++e) li[e] = __shfl(logit, gs * 8 + e);
        int i0 = 0; float v0 = li[0];
#pragma unroll
        for (int e = 1; e < 8; ++e) if (li[e] > v0) { v0 = li[e]; i0 = e; }
        int i1 = -1; float v1 = -3.0e38f;
#pragma unroll
        for (int e = 0; e < 8; ++e) if (e != i0 && li[e] > v1) { v1 = li[e]; i1 = e; }
        if (i1 < 0) i1 = (i0 + 1) & 7;
        const float w0 = 1.0f / (1.0f + fexp(v1 - v0)), w1 = 1.0f - w0;
        if (lane == 0) { const int e0 = gs * 8 + i0, e1 = gs * 8 + i1; const int rec = nrec * 8 + wave;
            if (rec < RT_MAX) { int* q = rt + rec * 6; q[0] = e0; q[1] = e1; q[2] = (int)fbits(w0 * pg); q[3] = (int)fbits(w1 * pg); q[4] = (int)atomicAdd(&lcnt[e0], 1u); q[5] = (int)atomicAdd(&lcnt[e1], 1u); } }
    }
    __syncthreads();
    if (tidx() < 32) lbase[tidx()] = atomicAdd(&cnt[tidx()], lcnt[tidx()]);
    __syncthreads();
    for (int rec = tidx(); rec < nrec * 8 && rec < RT_MAX; rec += NTH) { const int row = (blockIdx.x + (rec >> 3) * gridDim.x) * 8 + (rec & 7); const int* q = rt + rec * 6;
        const int e0 = q[0], e1 = q[1], s0 = (int)lbase[e0] + q[4], s1 = (int)lbase[e1] + q[5];
        ltok[(size_t)e0 * MR + s0] = row; lw[(size_t)e0 * MR + s0] = bitsf((unsigned)q[2]); ltok[(size_t)e1 * MR + s1] = row; lw[(size_t)e1 * MR + s1] = bitsf((unsigned)q[3]);
        route[row * 4 + 0] = e0; route[row * 4 + 1] = e1; route[row * 4 + 2] = s0; route[row * 4 + 3] = s1; }
}

DEVFN void phase_ln2(const Params& p, unsigned char* lds, int l) {
    const int wave = tidx() >> 6, lane = tidx() & 63; bf16* H = (bf16*)(p.ws + WS_H); const bf16* F2 = (const bf16*)(p.ws + WS_SB); bf16* A = (bf16*)(p.ws + WS_ABF);
    const unsigned* cnt = (const unsigned*)(p.ws + WS_CTL + CTL_CNT) + l * NEXP; const int* route = (const int*)(p.ws + WS_ROUTE);
    int* offs = (int*)lds;
    __syncthreads();
    if (tidx() < NEXP) offs[tidx()] = moe_off(cnt, tidx());
    __syncthreads();
    float lng[16], lnb[16]; ln_load_gb(p.in[I_LNG] + (size_t)(l * 2 + 1) * D, p.in[I_LNB] + (size_t)(l * 2 + 1) * D, lane, lng, lnb);
    for (int rw = (blockIdx.x * 8 + wave) * 2; rw < MR; rw += gridDim.x * 16) {
        float v[2][16]; size_t r0[2], r1[2];
#pragma unroll
        for (int q = 0; q < 2; ++q) { const int row = rw + q; const int e0 = route[row * 4], e1 = route[row * 4 + 1]; r0[q] = (size_t)offs[e0] + route[row * 4 + 2]; r1[q] = (size_t)offs[e1] + route[row * 4 + 3]; }
#pragma unroll
        for (int q = 0; q < 2; ++q) { const int row = rw + q; const int b = row / PT, pp = row % PT, mr = pp < LC ? NB : b; const float* mv = (const float*)(p.ws + WS_MODV) + ((size_t)l * (NB + 1) + mr) * 6144;
#pragma unroll
            for (int i = 0; i < 4; ++i) { const int c = i * 256 + lane * 4; const f32x4 h = load4b(H + (size_t)row * D + c), g2 = *(const f32x4*)(mv + 5120 + c);
                const u32x2 fa = __builtin_nontemporal_load((const u32x2*)(F2 + r0[q] * D + c)), fb = __builtin_nontemporal_load((const u32x2*)(F2 + r1[q] * D + c));
                const float f0 = bitsf(fa.x << 16) + bitsf(fb.x << 16), f1 = bitsf(fa.x & 0xffff0000u) + bitsf(fb.x & 0xffff0000u), f2 = bitsf(fa.y << 16) + bitsf(fb.y << 16), f3 = bitsf(fa.y & 0xffff0000u) + bitsf(fb.y & 0xffff0000u);
                v[q][i * 4] = ALPHA * h[0] + g2[0] * f0; v[q][i * 4 + 1] = ALPHA * h[1] + g2[1] * f1; v[q][i * 4 + 2] = ALPHA * h[2] + g2[2] * f2; v[q][i * 4 + 3] = ALPHA * h[3] + g2[3] * f3; } }
#pragma unroll
        for (int q = 0; q < 2; ++q) { const int row = rw + q; const int b = row / PT, pp = row % PT;
            ln_row_r(v[q], lng, lnb);
#pragma unroll
            for (int i = 0; i < 4; ++i) { const int c = i * 256 + lane * 4; const f32x4 o = (f32x4){v[q][i * 4], v[q][i * 4 + 1], v[q][i * 4 + 2], v[q][i * 4 + 3]};
                if (l + 1 < NL) { u32x2 hw; hw.x = pack2(o[0], o[1]); hw.y = pack2(o[2], o[3]); __builtin_nontemporal_store(hw, (u32x2*)(H + (size_t)row * D + c)); }
                else if (pp >= LC) __builtin_nontemporal_store(o, (f32x4*)(p.out + ((size_t)b * TS + (pp - LC)) * D + c)); }
            if (l + 1 < NL) mod_store_row(p, l + 1, 0, row, v[q], A + (size_t)row * D); }
    }
}

DEVFN void wave_sync() {
#ifdef CPU_EMU
    (void)__shfl(0, 0);
#else
    __builtin_amdgcn_fence(__ATOMIC_RELEASE, "wavefront"); asm volatile("s_waitcnt lgkmcnt(0)" ::: "memory"); __builtin_amdgcn_wave_barrier(); __builtin_amdgcn_fence(__ATOMIC_ACQUIRE, "wavefront");
#endif
}
DEVFN bf16x8 cvt8(const f32x4 lo, const f32x4 hi, float sg) { u32x4 w; w[0] = pack2(lo[0] * sg, lo[1] * sg); w[1] = pack2(lo[2] * sg, lo[3] * sg); w[2] = pack2(hi[0] * sg, hi[1] * sg); w[3] = pack2(hi[2] * sg, hi[3] * sg); return __builtin_bit_cast(bf16x8, w); }
constexpr int S5_WAVE_LDS = 16 * 132 * 4;
DEVFN void s5_chunk(const Params& p, float* buf, int j, int b, int g, int c, int lane, const bool READOUT, int dlo = 0, int dhi = 2, float* xch = nullptr) {
    const int fr = lane & 15, fg = lane >> 4; const bf16* U = (const bf16*)(p.ws + WS_Z) + ZE_U + ((size_t)b * PT + c * 64) * 512 + g * 16;
    f32x4 y[4], y2[4];
#pragma unroll
    for (int sb = 0; sb < 4; ++sb) { y[sb] = (f32x4){0.f, 0.f, 0.f, 0.f}; y2[sb] = (f32x4){0.f, 0.f, 0.f, 0.f}; }
#pragma unroll 1
    for (int d = dlo; d < dhi; ++d) { const size_t pbase = (size_t)((j * 2 + d) * 32 + g) * 64; const float* prm = (const float*)(p.ws + WS_S5P);
        bf16x8 bbf[8];
#pragma unroll
        for (int n = 0; n < 8; ++n) { const int pp = (n & 3) * 16 + fr; const float* src = prm + (pbase + pp) * S5P_STRIDE + (n < 4 ? 4 : 20) + (fg & 1) * 8;
            f32x4 lo = *(const f32x4*)src, hi = *(const f32x4*)(src + 4); if (fg >= 2) { lo = (f32x4){0.f, 0.f, 0.f, 0.f}; hi = lo; } bbf[n] = cvt8(lo, hi, 1.0f); }
        bf16x8 cf[4];
        if (READOUT) {
#pragma unroll
            for (int ks = 0; ks < 4; ++ks) { const float* src = (ks < 2 ? p.in[I_CRE] : p.in[I_CIM]) + (((size_t)(j * 2 + d) * 32 + g) * 16 + fr) * 64 + (ks & 1) * 32 + fg * 8;
                cf[ks] = cvt8(*(const f32x4*)src, *(const f32x4*)(src + 4), ks < 2 ? 1.0f : -1.0f); } }
        const float are = prm[(pbase + lane) * S5P_STRIDE], aim = prm[(pbase + lane) * S5P_STRIDE + 1];
        float hr = 0.f, hi = 0.f;
        if (READOUT) { const f32x2 h0 = *(const f32x2*)((const float*)(p.ws + WS_SB + SBO_S5H) + ((size_t)((b * 32 + g) * 2 + d) * NCH + c) * 128 + lane * 2); hr = h0[0]; hi = h0[1]; }
#pragma unroll
        for (int sbi = 0; sbi < 4; ++sbi) { const int sb = d ? 3 - sbi : sbi;
            u32x4 uv = (u32x4){0u, 0u, 0u, 0u}; if (fg < 2) uv = *(const u32x4*)(U + (size_t)(sb * 16 + fr) * 512 + fg * 8); const bf16x8 ua = __builtin_bit_cast(bf16x8, uv);
            f32x4 yy = (f32x4){0.f, 0.f, 0.f, 0.f};
            wave_sync();
#pragma unroll
            for (int n = 0; n < 8; ++n) { const f32x4 t4 = mfma16(ua, bbf[n], (f32x4){0.f, 0.f, 0.f, 0.f});
#pragma unroll
                for (int r = 0; r < 4; ++r) buf[(fg * 4 + r) * 132 + n * 16 + fr] = t4[r]; }
            wave_sync();
            for (int t0 = 0; t0 < 16; ++t0) { const int tt = d ? 15 - t0 : t0; const float ur = buf[tt * 132 + lane], ui = buf[tt * 132 + 64 + lane];
                const float nr = are * hr - aim * hi + ur, ni = are * hi + aim * hr + ui; hr = nr; hi = ni;
                buf[tt * 132 + lane] = hr; buf[tt * 132 + 64 + lane] = hi; }
            if (READOUT) { wave_sync();
#pragma unroll
                for (int ks = 0; ks < 4; ++ks) { const float* hp = buf + fr * 132 + ks * 32 + fg * 8; yy = mfma16(cf[ks], cvt8(*(const f32x4*)hp, *(const f32x4*)(hp + 4), 1.0f), yy); }
                if (d == 0) y[sbi] += yy; else y2[sbi] += yy; }
        }
        if (!READOUT) *(f32x2*)((float*)(p.ws + WS_SB + SBO_S5E) + ((size_t)((b * 32 + g) * 2 + d) * NCH + c) * 128 + lane * 2) = (f32x2){hr, hi};
    }
    if (READOUT && xch) {
        if (dlo == 1) {
#pragma unroll
            for (int sb = 0; sb < 4; ++sb) *(f32x4*)(xch + (sb * 64 + lane) * 4) = y2[sb];
            __syncthreads(); return; }
        __syncthreads();
#pragma unroll
        for (int sb = 0; sb < 4; ++sb) y2[sb] = *(const f32x4*)(xch + (sb * 64 + lane) * 4); }
    if (READOUT) { bf16* GS = (bf16*)(p.ws + WS_SB + SBO_GS); const f32x4 dsk = *(const f32x4*)(p.in[I_S5D] + (size_t)j * 512 + g * 16 + fg * 4);
#pragma unroll
        for (int sb = 0; sb < 4; ++sb) { const int t = sb * 16 + fr; const u32x2 uu = *(const u32x2*)(U + (size_t)t * 512 + fg * 4); f32x4 o; y[sb] += y2[3 - sb];
            o[0] = geluf_(y[sb][0] + dsk[0] * bitsf(uu.x << 16)); o[1] = geluf_(y[sb][1] + dsk[1] * bitsf(uu.x & 0xffff0000u));
            o[2] = geluf_(y[sb][2] + dsk[2] * bitsf(uu.y << 16)); o[3] = geluf_(y[sb][3] + dsk[3] * bitsf(uu.y & 0xffff0000u));
            store4_t(GS + ((size_t)b * PT + c * 64 + t) * 512 + g * 16 + fg * 4, o); } }
}
DEVFN void phase_s5a(const Params& p, unsigned char* lds, int j) {
    const int wave = tidx() >> 6, lane = tidx() & 63; float* buf = (float*)(lds + wave * S5_WAVE_LDS);
    const int NIT = NB * 32 * NCH, GW = gridDim.x * 8, full = (NIT / GW) * GW, wid = blockIdx.x * 8 + wave;
    for (int it = wid; it < full; it += GW) { const int c = it % NCH, g = (it / NCH) % 32, b = it / (NCH * 32); s5_chunk(p, buf, j, b, g, c, lane, false); }
    for (int pi = wid; pi < 2 * (NIT - full); pi += GW) { const int it = full + (pi >> 1), d = pi & 1; const int c = it % NCH, g = (it / NCH) % 32, b = it / (NCH * 32); s5_chunk(p, buf, j, b, g, c, lane, false, d, d + 1); }
}
constexpr int S5B_BS = 17;
DEVFN int chunk_order(int d, int k);
DEVFN void phase_s5b(const Params& p, int j) {
    const float* E = (const float*)(p.ws + WS_SB + SBO_S5E); float* Hin = (float*)(p.ws + WS_SB + SBO_S5H);
    constexpr int NBT = (NCH + S5B_BS - 1) / S5B_BS;
    int vb = blockIdx.x, vstep = gridDim.x;
    if (gridDim.x == 256 && NB * 32 * 2 * 64 == 32 * NTH) { const int m = blockIdx.x & 15; if (m != 0 && m != 15) return; vb = (blockIdx.x >> 4) * 2 + (m == 15 ? 1 : 0); vstep = 32; }
    for (int i = vb * NTH + tidx(); i < NB * 32 * 2 * 64; i += vstep * NTH) { const int pi = i & 63, d = (i >> 6) & 1, g = (i >> 7) & 31, b = i >> 12;
        const float* pr = (const float*)(p.ws + WS_S5P) + ((size_t)((j * 2 + d) * 32 + g) * 64 + pi) * S5P_STRIDE; const float aLr = pr[2], aLi = pr[3];
        const size_t base = (size_t)((b * 32 + g) * 2 + d) * NCH; float hr = 0.f, hi = 0.f;
        f32x2 en[S5B_BS];
#pragma unroll
        for (int x = 0; x < S5B_BS; ++x) { const int k = x < NCH ? x : NCH - 1; const int c = chunk_order(d, k); en[x] = *(const f32x2*)(E + (base + c) * 128 + pi * 2); }
#pragma unroll 1
        for (int kb = 0; kb < NBT; ++kb) { f32x2 e[S5B_BS];
#pragma unroll
            for (int x = 0; x < S5B_BS; ++x) e[x] = en[x];
            if (kb + 1 < NBT) {
#pragma unroll
                for (int x = 0; x < S5B_BS; ++x) { const int k = (kb + 1) * S5B_BS + x < NCH ? (kb + 1) * S5B_BS + x : NCH - 1; const int c = chunk_order(d, k); en[x] = *(const f32x2*)(E + (base + c) * 128 + pi * 2); } }
#pragma unroll
            for (int x = 0; x < S5B_BS; ++x) { const int k = kb * S5B_BS + x; if (k < NCH) { const int c = chunk_order(d, k);
                *(f32x2*)(Hin + (base + c) * 128 + pi * 2) = (f32x2){hr, hi};
                const float nr = aLr * hr - aLi * hi + e[x][0], ni = aLr * hi + aLi * hr + e[x][1]; hr = nr; hi = ni; } } }
    }
}
DEVFN void phase_s5c(const Params& p, unsigned char* lds, int j) {
    const int wave = tidx() >> 6, lane = tidx() & 63; float* buf = (float*)(lds + wave * S5_WAVE_LDS);
    const int NIT = NB * 32 * NCH, GW = gridDim.x * 8, full = (NIT / GW) * GW, rem = NIT - full;
    for (int it = blockIdx.x * 8 + wave; it < full; it += GW) { const int c = it % NCH, g = (it / NCH) % 32, b = it / (NCH * 32); s5_chunk(p, buf, j, b, g, c, lane, true); }
    float* xch = (float*)(lds + 8 * S5_WAVE_LDS) + (wave & 3) * 1024;
    for (int base = blockIdx.x * 4; base < rem; base += gridDim.x * 4) { const int ri = base + (wave & 3), d = wave >> 2;
        if (ri < rem) { const int it = full + ri; const int c = it % NCH, g = (it / NCH) % 32, b = it / (NCH * 32); s5_chunk(p, buf, j, b, g, c, lane, true, d, d + 1, xch); }
        else __syncthreads();
        __syncthreads(); }
}

template <int NDV> struct AttnState { float m, l; f32x16 o[NDV]; };
template <int NDV> DEVFN void attn_init(AttnState<NDV>& st) { st.m = -INFINITY; st.l = 0.f;
#pragma unroll
    for (int i = 0; i < NDV; ++i)
#pragma unroll
        for (int r = 0; r < 16; ++r) st.o[i][r] = 0.f; }
DEVFN float attn_softmax(float& m, float& l, f32x16 s, bf16x8 (&pb)[2]) {
    float mx = fmaxf(fmaxf(fmaxf(s[0], s[1]), fmaxf(s[2], s[3])), fmaxf(fmaxf(s[4], s[5]), fmaxf(s[6], s[7])));
    mx = fmaxf(mx, fmaxf(fmaxf(fmaxf(s[8], s[9]), fmaxf(s[10], s[11])), fmaxf(fmaxf(s[12], s[13]), fmaxf(s[14], s[15]))));
    mx = fmaxf(mx, __shfl_xor(mx, 32));
    const float mn = fmaxf(m, mx), ms = mn == -INFINITY ? 0.f : mn, corr = fexp2(m - ms);
    m = mn; float ps = 0.f;
#pragma unroll
    for (int r = 0; r < 16; ++r) { s[r] = fexp2(s[r] - ms); ps += s[r]; }
    ps += __shfl_xor(ps, 32);
    l = l * corr + ps;
#pragma unroll
    for (int ks = 0; ks < 2; ++ks) { u32x4 w;
#pragma unroll
        for (int jj = 0; jj < 4; ++jj) w[jj] = pack2(s[8 * ks + 2 * jj], s[8 * ks + 2 * jj + 1]);
        pb[ks] = __builtin_bit_cast(bf16x8, w); }
    return corr;
}
DEVFN bf16x8 cat4(const bf16x4 a, const bf16x4 b) { bf16x8 o;
#pragma unroll
    for (int jj = 0; jj < 4; ++jj) { o[jj] = a[jj]; o[4 + jj] = b[jj]; }
    return o; }
template <int NDV, class VLoad>
DEVFN void attn_update(AttnState<NDV>& st, f32x16 s, VLoad vload) {
    bf16x8 pb[2]; const float corr = attn_softmax(st.m, st.l, s, pb);
    if (!wave_all(corr == 1.0f)) {
#pragma unroll
        for (int i = 0; i < NDV; ++i)
#pragma unroll
            for (int r = 0; r < 16; ++r) st.o[i][r] *= corr; }
#pragma unroll
    for (int ks = 0; ks < 2; ++ks)
#pragma unroll
        for (int mt = 0; mt < NDV; ++mt) st.o[mt] = mfma32(vload(mt, ks), pb[ks], st.o[mt]);
}

DEVFN float attn_softmax2(float& m, float& l, f32x16 s0, f32x16 s1, bf16x8 (&pb0)[2], bf16x8 (&pb1)[2]) {
    float mx = fmaxf(s0[0], s1[0]);
#pragma unroll
    for (int r = 1; r < 16; ++r) mx = fmaxf(mx, fmaxf(s0[r], s1[r]));
    mx = fmaxf(mx, __shfl_xor(mx, 32));
    const float mn = fmaxf(m, mx), ms = mn == -INFINITY ? 0.f : mn, corr = fexp2(m - ms);
    m = mn; float ps = 0.f;
#pragma unroll
    for (int r = 0; r < 16; ++r) { s0[r] = fexp2(s0[r] - ms); s1[r] = fexp2(s1[r] - ms); ps += s0[r] + s1[r]; }
    ps += __shfl_xor(ps, 32);
    l = l * corr + ps;
#pragma unroll
    for (int ks = 0; ks < 2; ++ks) { u32x4 w0, w1;
#pragma unroll
        for (int jj = 0; jj < 4; ++jj) { w0[jj] = pack2(s0[8 * ks + 2 * jj], s0[8 * ks + 2 * jj + 1]); w1[jj] = pack2(s1[8 * ks + 2 * jj], s1[8 * ks + 2 * jj + 1]); }
        pb0[ks] = __builtin_bit_cast(bf16x8, w0); pb1[ks] = __builtin_bit_cast(bf16x8, w1); }
    return corr;
}
template <int NDV, class VLoad>
DEVFN void attn_update2(AttnState<NDV>& st, f32x16 s0, f32x16 s1, VLoad vload) {
    bf16x8 pb0[2], pb1[2]; const float corr = attn_softmax2(st.m, st.l, s0, s1, pb0, pb1);
    if (!wave_all(corr == 1.0f)) {
#pragma unroll
        for (int i = 0; i < NDV; ++i)
#pragma unroll
            for (int r = 0; r < 16; ++r) st.o[i][r] *= corr; }
#pragma unroll
    for (int ks = 0; ks < 2; ++ks)
#pragma unroll
        for (int mt = 0; mt < NDV; ++mt) { st.o[mt] = mfma32(vload(0, mt, ks), pb0[ks], st.o[mt]); st.o[mt] = mfma32(vload(1, mt, ks), pb1[ks], st.o[mt]); }
}

constexpr int NAT_STAGE = 16384, NAT_RING = 4, NAT_RPB = NAT_RING * NAT_STAGE;
DEVFN void phase_natten(const Params& p, unsigned char* lds, int j) {
    const int tid = tidx(), wave = tid >> 6, lane = tid & 63, ql = lane & 31, hh = lane >> 5;
#ifdef CPU_EMU
    const int wvu = wave;
#else
    const int wvu = __builtin_amdgcn_readfirstlane(wave);
#endif
    const bf16* Z = (const bf16*)(p.ws + WS_Z); const bf16* Q = Z + ZE_Q; const bf16* K = Z + ZE_K; const bf16* VT = Z + ZE_VT; bf16* Y = (bf16*)(p.ws + WS_YMIX);
    float* rpbs = (float*)(lds + NAT_RPB);
    constexpr int NRG = GROWS / 4, NLAT = NB * 8 * NRG, NCQ = (LC + 255) / 256, NCTX = NB * 8 * NCQ, NCT = LC / 64;
    const bool remap = gridDim.x == 256 && NLAT == 512 && NCTX == 32 && NRG == 16;
    for (int uu = blockIdx.x; uu < NLAT + (remap ? (int)gridDim.x : NCTX); uu += gridDim.x) { int u = uu;
        if (remap && uu >= NLAT) { const int m = blockIdx.x & 15; if (m != 0 && m != 15) break; u = NLAT + (blockIdx.x >> 4) * 2 + (m == 15 ? 1 : 0); }
        const bool lat = u < NLAT;
        int b, hd, r = 0, rs = 0, klo = 0, nloc = 0, qp; bool qvalid = true;
        if (lat) { const int rg = u % NRG; hd = (u / NRG) & 7; b = u / (NRG * 8); r = rg * 4 + (wave >> 1); rs = r - 4 < 0 ? 0 : (r - 4 > GROWS - 8 ? GROWS - 8 : r - 4);
            const int ra = rg * 4, rb = rg * 4 + 3; klo = ra - 4 < 0 ? 0 : (ra - 4 > GROWS - 8 ? GROWS - 8 : ra - 4); const int khi = (rb - 4 < 0 ? 0 : (rb - 4 > GROWS - 8 ? GROWS - 8 : rb - 4)) + 7; nloc = khi - klo + 1;
            qp = LC + r * 64 + (wave & 1) * 32 + ql; }
        else { const int v = u - NLAT; const int qt = v % NCQ; hd = (v / NCQ) & 7; b = v / (NCQ * 8); qp = qt * 256 + wave * 32 + ql; qvalid = qp < LC; if (!qvalid) qp = 0; }
        const size_t qrow = (size_t)b * PT + qp; const int ntile = nloc + NCT;
        __syncthreads();
        if (lat) for (int i = tid; i < 15 * 31; i += NTH) rpbs[i] = LOG2E * p.in[I_RPB][(size_t)(j * 8 + hd) * 15 * 31 + i];
        bf16x8 qf[4];
#pragma unroll
        for (int ks = 0; ks < 4; ++ks) qf[ks] = *(const bf16x8*)(Q + qrow * 512 + hd * 64 + ks * 16 + hh * 8);
        const int drow = tid >> 3, dch = (tid & 7) ^ (drow & 7);
        const bf16* ksrc = K + ((size_t)b * PT + drow) * 512 + hd * 64 + dch * 8; const bf16* vsrc = VT + ((size_t)(b * 8 + hd) * 64 + drow) * PT + dch * 8;
        auto tile_tok = [&](int t) { return t < nloc ? LC + (klo + t) * 64 : (t - nloc) * 64; };
#define NAT_DMA(t) do { const int tok_ = tile_tok(t); unsigned char* st_ = lds + ((t) & (NAT_RING - 1)) * NAT_STAGE + (wvu * 64) * 16; dma16(ksrc + (size_t)tok_ * 512, st_); dma16(vsrc + tok_, st_ + 8192); } while (0)
        AttnState<2> st; attn_init(st);
        const int cq = (wave & 1) * 32 + ql, cstart = cq - 8 < 0 ? 0 : (cq - 8 > 48 ? 48 : cq - 8);
        for (int t = 0; t < 3 && t < ntile; ++t) NAT_DMA(t);
        if (ntile >= 3) dma_wait_barrier<4>(); else if (ntile == 2) dma_wait_barrier<2>(); else dma_wait_barrier<0>();
        for (int t = 0; t < ntile; ++t) {
            if (t + 3 < ntile) NAT_DMA(t + 3);
            const bool loc = t < nloc; const int krow = klo + t; const bool active = !loc || (krow >= rs && krow <= rs + 7);
            if (active) { const unsigned char* sb = lds + (t & (NAT_RING - 1)) * NAT_STAGE;
#pragma unroll
                for (int s2 = 0; s2 < 2; ++s2) { f32x16 s;
#pragma unroll
                    for (int i = 0; i < 16; ++i) s[i] = 0.f;
#pragma unroll
                    for (int ks = 0; ks < 4; ++ks) s = mfma32(*(const bf16x8*)(sb + lds_sw(s2 * 32 + ql, ks * 2 + hh)), qf[ks], s);
                    if (loc) {
#pragma unroll
                        for (int i = 0; i < 16; ++i) { const int ck = s2 * 32 + (i & 3) + 8 * (i >> 2) + 4 * hh; const bool ok = ck >= cstart && ck < cstart + 16; const int dc = ok ? ck - cq + 15 : 0;
                            s[i] = ok ? s[i] + rpbs[(krow - r + 7) * 31 + dc] : -INFINITY; } }
                    attn_update<2>(st, s, [&](int mt, int ks) { return *(const bf16x8*)(sb + 8192 + lds_sw(mt * 32 + ql, s2 * 4 + ks * 2 + hh)); }); } }
            const int inflight = (t + 3 < ntile ? t + 3 : ntile - 1) - (t + 1);
            if (inflight >= 2) dma_wait_barrier<4>(); else if (inflight == 1) dma_wait_barrier<2>(); else dma_wait_barrier<0>();
        }
#undef NAT_DMA
        const float il = 1.0f / st.l;
        if (qvalid) {
#pragma unroll
            for (int mt = 0; mt < 2; ++mt)
#pragma unroll
                for (int q4 = 0; q4 < 4; ++q4) { const int dv = mt * 32 + 8 * q4 + 4 * hh; f32x4 o;
#pragma unroll
                    for (int k = 0; k < 4; ++k) o[k] = st.o[mt][q4 * 4 + k] * il;
                    store4_t(Y + qrow * D + 512 + hd * 64 + dv, o); } }
    }
}

DEVFN int chunk_order(int d, int k) { return d == 0 ? k : (k < NCC ? NCC - 1 - k : NCH - 1 - (k - NCC)); }
constexpr int GLR = 144;
constexpr int GL_CUM = 0, GL_ZZ = 32768, GL_PART = 32768 + 8192, GL_KT = 45056, GL_VT = GL_KT + 64 * GLR, GL_K = GL_VT + 128 * GLR, GL_Q = GL_K + 64 * GLR, GL_S = GL_Q + 64 * GLR, GL_SSQ = GL_S + 256 * GLR;
static_assert(GL_SSQ + 512 <= LDS_BYTES, "GLA LDS");
DEVFN bf16x8 scale8(const u32x4 raw, const float (&f)[8]) { u32x4 w;
#pragma unroll
    for (int i = 0; i < 4; ++i) w[i] = pack2(bitsf(raw[i] << 16) * f[2 * i], bitsf(raw[i] & 0xffff0000u) * f[2 * i + 1]);
    return __builtin_bit_cast(bf16x8, w); }
DEVFN void gl_stage(unsigned char* dst, const bf16* src, size_t ld, int rows, int tid) {
    for (int i = tid; i < rows * 8; i += NTH) { const int r = i >> 3, ch = i & 7; *(u32x4*)(dst + r * GLR + ch * 16) = *(const u32x4*)(src + (size_t)r * ld + ch * 8); }
}

DEVFN void phase_gla_a(const Params& p, unsigned char* lds, int j) {
    const int tid = tidx(), lane = tid & 63, wave = tid >> 6, fr = lane & 15, fg = lane >> 4; float* cum = (float*)(lds + GL_CUM); float* zz = (float*)(lds + GL_ZZ); float* part = (float*)(lds + GL_PART);
    const bf16* Z = (const bf16*)(p.ws + WS_Z); float* GU = (float*)(p.ws + WS_SB + SBO_GU); float* GDEC = (float*)(p.ws + WS_SB + SBO_GDEC); float* GCUM = (float*)(p.ws + WS_SB + SBO_GCUM);
    u32x2 pz; u32x4 pk, pv0, pv1; float pw[16], pgb;
#define GLA_A_FETCH(itx) { const int c_ = (itx) % NCH, hd_ = ((itx) / NCH) & 3, b_ = (itx) / (NCH * 4); \
        pz = *(const u32x2*)(Z + ZO_GZ + ((size_t)b_ * PT + c_ * 64) * 32 + tid * 4); \
        pk = *(const u32x4*)(Z + ZO_GKT + (size_t)(b_ * 4 + hd_) * 64 * PT + c_ * 64 + (size_t)(tid >> 3) * PT + (tid & 7) * 8); \
        const bf16* vs_ = Z + ZO_GVT + (size_t)(b_ * 4 + hd_) * 128 * PT + c_ * 64; \
        pv0 = *(const u32x4*)(vs_ + (size_t)(tid >> 3) * PT + (tid & 7) * 8); pv1 = *(const u32x4*)(vs_ + (size_t)(64 + (tid >> 3)) * PT + (tid & 7) * 8); \
        { const int d_ = tid >> 8, dk_ = (tid >> 2) & 63; const float* gw_ = p.in[I_GGW] + ((size_t)(j * 2 + d_) * 16) * 256 + hd_ * 64 + dk_; pgb = p.in[I_GGB][(size_t)(j * 2 + d_) * 256 + hd_ * 64 + dk_]; \
          _Pragma("unroll") for (int r = 0; r < 16; ++r) pw[r] = gw_[(size_t)r * 256]; } }
    if (blockIdx.x < NB * 4 * NCH) GLA_A_FETCH(blockIdx.x)
    for (int it = blockIdx.x; it < NB * 4 * NCH; it += gridDim.x) { const int c = it % NCH, hd = (it / NCH) & 3, b = it / (NCH * 4);
        __syncthreads();
        { f32x4 zf = (f32x4){bitsf(pz.x << 16), bitsf(pz.x & 0xffff0000u), bitsf(pz.y << 16), bitsf(pz.y & 0xffff0000u)}; *(f32x4*)(zz + tid * 4) = zf;
          *(u32x4*)(lds + GL_KT + (tid >> 3) * GLR + (tid & 7) * 16) = pk;
          *(u32x4*)(lds + GL_VT + (tid >> 3) * GLR + (tid & 7) * 16) = pv0; *(u32x4*)(lds + GL_VT + (64 + (tid >> 3)) * GLR + (tid & 7) * 16) = pv1; }
        float w[16]; const float gb = pgb;
#pragma unroll
        for (int r = 0; r < 16; ++r) w[r] = pw[r];
        if (it + (int)gridDim.x < NB * 4 * NCH) GLA_A_FETCH(it + gridDim.x)
        __syncthreads();
        { const int d = tid >> 8, dk = (tid >> 2) & 63, tg = tid & 3; float gl[16];
#pragma unroll
            for (int t = 0; t < 16; ++t) { float x = gb;
#pragma unroll
                for (int r = 0; r < 16; ++r) x += zz[(tg * 16 + t) * 32 + d * 16 + r] * w[r];
                gl[t] = logsigf_(x) * (1.0f / 16.0f); }
            if (d == 0) {
#pragma unroll
                for (int t = 1; t < 16; ++t) gl[t] += gl[t - 1];
                part[(d * 64 + dk) * 4 + tg] = gl[15];
            } else {
#pragma unroll
                for (int t = 14; t >= 0; --t) gl[t] += gl[t + 1];
                part[(d * 64 + dk) * 4 + tg] = gl[0]; }
            __syncthreads();
            float pre = 0.f;
#pragma unroll
            for (int q = 0; q < 4; ++q) { const bool inc = d == 0 ? q < tg : q > tg; pre += inc ? part[(d * 64 + dk) * 4 + q] : 0.f; }
            float* gc = GCUM + ((size_t)((b * 4 + hd) * NCH + c) * 2 + d) * 4096;
#pragma unroll
            for (int t = 0; t < 16; ++t) { const float v = gl[t] + pre; cum[(d * 64 + tg * 16 + t) * 64 + dk] = v; gc[(tg * 16 + t) * 64 + dk] = v; } }
        __syncthreads();
        bf16x8 va[2];
#pragma unroll
        for (int ks = 0; ks < 2; ++ks) va[ks] = *(const bf16x8*)(lds + GL_VT + (wave * 16 + fr) * GLR + (ks * 32 + fg * 8) * 2);
#pragma unroll
        for (int d = 0; d < 2; ++d) { const int tend = d ? 0 : 63;
#pragma unroll
            for (int n = 0; n < 4; ++n) { const int dk = n * 16 + fr; const float cend = cum[(d * 64 + tend) * 64 + dk]; f32x4 acc = (f32x4){0.f, 0.f, 0.f, 0.f};
#pragma unroll
                for (int ks = 0; ks < 2; ++ks) { const u32x4 raw = *(const u32x4*)(lds + GL_KT + dk * GLR + (ks * 32 + fg * 8) * 2); float f[8];
#pragma unroll
                    for (int e = 0; e < 8; ++e) f[e] = fexp(cend - cum[(d * 64 + ks * 32 + fg * 8 + e) * 64 + dk]);
                    acc = mfma16(va[ks], scale8(raw, f), acc); }
                float* dst = GU + ((size_t)(((b * 4 + hd) * 2 + d) * NCH + c) * 128 + wave * 16 + fg * 4) * 64 + dk;
#pragma unroll
                for (int r = 0; r < 4; ++r) dst[r * 64] = acc[r]; } }
        if (tid < 128) { const int d = tid >> 6, dk = tid & 63; GDEC[(size_t)(((b * 4 + hd) * 2 + d) * NCH + c) * 64 + dk] = fexp(cum[(d * 64 + (d ? 0 : 63)) * 64 + dk]); }
    }
#undef GLA_A_FETCH
}
constexpr int GLB_BS = 17;
DEVFN void phase_gla_b(const Params& p) {
    const float* GU = (const float*)(p.ws + WS_SB + SBO_GU); const float* GDEC = (const float*)(p.ws + WS_SB + SBO_GDEC); bf16* GSB = (bf16*)(p.ws + WS_H + (size_t)MR * D * 2);
    constexpr int NBT = (NCH + GLB_BS - 1) / GLB_BS, TOT = NB * 4 * 2 * 8192;
    const int GT = gridDim.x * NTH;
    for (int i = blockIdx.x * NTH + tidx(); i < TOT; i += 2 * GT) { int e[2], seq[2], dk[2], d[2]; bool ok[2]; float s[2] = {0.f, 0.f};
#pragma unroll
        for (int q = 0; q < 2; ++q) { const int iq = i + q * GT; ok[q] = iq < TOT; const int ic = ok[q] ? iq : i; e[q] = ic & 8191; seq[q] = ic >> 13; dk[q] = e[q] & 63; d[q] = seq[q] & 1; }
        float un[2][GLB_BS], dn[2][GLB_BS];
#pragma unroll
        for (int q = 0; q < 2; ++q)
#pragma unroll
            for (int x = 0; x < GLB_BS; ++x) { const int k = x < NCH ? x : NCH - 1; const int c = chunk_order(d[q], k); un[q][x] = GU[((size_t)seq[q] * NCH + c) * 8192 + e[q]]; dn[q][x] = GDEC[((size_t)seq[q] * NCH + c) * 64 + dk[q]]; }
#pragma unroll 1
        for (int kb = 0; kb < NBT; ++kb) { float u[2][GLB_BS], dc[2][GLB_BS];
#pragma unroll
            for (int q = 0; q < 2; ++q)
#pragma unroll
                for (int x = 0; x < GLB_BS; ++x) { u[q][x] = un[q][x]; dc[q][x] = dn[q][x]; }
            if (kb + 1 < NBT) {
#pragma unroll
                for (int q = 0; q < 2; ++q)
#pragma unroll
                    for (int x = 0; x < GLB_BS; ++x) { const int k = (kb + 1) * GLB_BS + x < NCH ? (kb + 1) * GLB_BS + x : NCH - 1; const int c = chunk_order(d[q], k); un[q][x] = GU[((size_t)seq[q] * NCH + c) * 8192 + e[q]]; dn[q][x] = GDEC[((size_t)seq[q] * NCH + c) * 64 + dk[q]]; } }
#pragma unroll
            for (int x = 0; x < GLB_BS; ++x) { const int k = kb * GLB_BS + x; if (k < NCH) {
#pragma unroll
                for (int q = 0; q < 2; ++q) { const int c = chunk_order(d[q], k); if (ok[q]) GSB[((size_t)seq[q] * NCH + c) * 8192 + e[q]] = f2bf(s[q]); s[q] = dc[q][x] * s[q] + u[q][x]; } } } }
    }
}
DEVFN void phase_gla_c(const Params& p, unsigned char* lds, int j) {
    const int tid = tidx(), lane = tid & 63, wave = tid >> 6, fr = lane & 15, fg = lane >> 4, itl = wave & 3, half = wave >> 2;
    float* cum = (float*)(lds + GL_CUM); float* ssq = (float*)(lds + GL_SSQ);
    const bf16* Z = (const bf16*)(p.ws + WS_Z); const bf16* GSB = (const bf16*)(p.ws + WS_H + (size_t)MR * D * 2); const float* GCUM = (const float*)(p.ws + WS_SB + SBO_GCUM); bf16* Y = (bf16*)(p.ws + WS_YMIX);
    f32x4 pc[4]; u32x4 pkq[2], pvt[2];
#define GLA_C_FETCH(itx) { const int c_ = (itx) % NCH, hd_ = ((itx) / NCH) & 3, b_ = (itx) / (NCH * 4); const size_t row0_ = (size_t)b_ * PT + c_ * 64; \
        const float* gc_ = GCUM + (size_t)((b_ * 4 + hd_) * NCH + c_) * 8192; \
        _Pragma("unroll") for (int x = 0; x < 4; ++x) pc[x] = *(const f32x4*)(gc_ + (x * NTH + tid) * 4); \
        pkq[0] = *(const u32x4*)(Z + ZO_GK + (row0_ + (tid >> 3)) * 256 + hd_ * 64 + (tid & 7) * 8); pkq[1] = *(const u32x4*)(Z + ZO_GQ + (row0_ + (tid >> 3)) * 256 + hd_ * 64 + (tid & 7) * 8); \
        const bf16* vs_ = Z + ZO_GVT + (size_t)(b_ * 4 + hd_) * 128 * PT + c_ * 64; \
        pvt[0] = *(const u32x4*)(vs_ + (size_t)(tid >> 3) * PT + (tid & 7) * 8); pvt[1] = *(const u32x4*)(vs_ + (size_t)(64 + (tid >> 3)) * PT + (tid & 7) * 8); }
    if (blockIdx.x < NB * 4 * NCH) GLA_C_FETCH(blockIdx.x)
    for (int it = blockIdx.x; it < NB * 4 * NCH; it += gridDim.x) { const int c = it % NCH, hd = (it / NCH) & 3, b = it / (NCH * 4);
        const size_t row0 = (size_t)b * PT + c * 64;
        __syncthreads();
#pragma unroll
        for (int x = 0; x < 4; ++x) *(f32x4*)(cum + (x * NTH + tid) * 4) = pc[x];
        *(u32x4*)(lds + GL_K + (tid >> 3) * GLR + (tid & 7) * 16) = pkq[0]; *(u32x4*)(lds + GL_Q + (tid >> 3) * GLR + (tid & 7) * 16) = pkq[1];
        *(u32x4*)(lds + GL_VT + (tid >> 3) * GLR + (tid & 7) * 16) = pvt[0]; *(u32x4*)(lds + GL_VT + (64 + (tid >> 3)) * GLR + (tid & 7) * 16) = pvt[1];
        for (int i = tid; i < 2 * 128 * 8; i += NTH) { const int d = i >> 10, r = (i >> 3) & 127, ch = i & 7;
            *(u32x4*)(lds + GL_S + (d * 128 + r) * GLR + ch * 16) = *(const u32x4*)(GSB + ((size_t)(((b * 4 + hd) * 2 + d) * NCH + c) * 128 + r) * 64 + ch * 8); }
        if (it + (int)gridDim.x < NB * 4 * NCH) GLA_C_FETCH(it + gridDim.x)
        __syncthreads();
        const int ti = itl * 16 + fr;
        f32x4 o[4];
#pragma unroll
        for (int mt = 0; mt < 4; ++mt) o[mt] = (f32x4){0.f, 0.f, 0.f, 0.f};
#pragma unroll 1
        for (int d = 0; d < 2; ++d) {
            bf16x8 qd[2];
#pragma unroll
            for (int ks = 0; ks < 2; ++ks) { const u32x4 raw = *(const u32x4*)(lds + GL_Q + ti * GLR + (ks * 32 + fg * 8) * 2); float f[8];
#pragma unroll
                for (int e = 0; e < 8; ++e) f[e] = fexp(cum[(d * 64 + ti) * 64 + ks * 32 + fg * 8 + e]);
                qd[ks] = scale8(raw, f); }
            f32x4 att[4];
#pragma unroll
            for (int jt = 0; jt < 4; ++jt) { const int tj = jt * 16 + fr; f32x4 a = (f32x4){0.f, 0.f, 0.f, 0.f};
#pragma unroll
                for (int ks = 0; ks < 2; ++ks) { const u32x4 raw = *(const u32x4*)(lds + GL_K + tj * GLR + (ks * 32 + fg * 8) * 2); float f[8];
#pragma unroll
                    for (int e = 0; e < 8; ++e) f[e] = fexp(-cum[(d * 64 + tj) * 64 + ks * 32 + fg * 8 + e]);
                    a = mfma16(scale8(raw, f), qd[ks], a); }
#pragma unroll
                for (int r = 0; r < 4; ++r) { const int jrow = jt * 16 + fg * 4 + r; const bool keep = d ? (jrow >= ti) : (jrow <= ti); a[r] = keep ? a[r] : 0.f; }
                att[jt] = a; }
#pragma unroll
            for (int s2 = 0; s2 < 2; ++s2) { bf16x8 pb;
#pragma unroll
                for (int e = 0; e < 0; ++e) {}
                { u32x4 w; w[0] = pack2(att[2 * s2][0], att[2 * s2][1]); w[1] = pack2(att[2 * s2][2], att[2 * s2][3]); w[2] = pack2(att[2 * s2 + 1][0], att[2 * s2 + 1][1]); w[3] = pack2(att[2 * s2 + 1][2], att[2 * s2 + 1][3]); pb = __builtin_bit_cast(bf16x8, w); }
#pragma unroll
                for (int mt = 0; mt < 4; ++mt) { const unsigned char* vp = lds + GL_VT + (half * 64 + mt * 16 + fr) * GLR + (s2 * 32 + fg * 4) * 2;
                    o[mt] = mfma16(cat4(*(const bf16x4*)vp, *(const bf16x4*)(vp + 32)), pb, o[mt]); } }
#pragma unroll
            for (int ks = 0; ks < 2; ++ks)
#pragma unroll
                for (int mt = 0; mt < 4; ++mt) o[mt] = mfma16(*(const bf16x8*)(lds + GL_S + (d * 128 + half * 64 + mt * 16 + fr) * GLR + (ks * 32 + fg * 8) * 2), qd[ks], o[mt]);
        }
        float ss = 0.f;
#pragma unroll
        for (int mt = 0; mt < 4; ++mt)
#pragma unroll
            for (int r = 0; r < 4; ++r) ss += o[mt][r] * o[mt][r];
        ss += __shfl_xor(ss, 16); ss += __shfl_xor(ss, 32);
        if (fg == 0) ssq[half * 64 + ti] = ss;
        __syncthreads();
        const float rstd = 1.0f / sqrtf((ssq[ti] + ssq[64 + ti]) * (1.0f / 128.0f) + LN_EPS);
#pragma unroll
        for (int mt = 0; mt < 4; ++mt) { const int dv = hd * 128 + half * 64 + mt * 16 + fg * 4; const f32x4 ng = *(const f32x4*)(p.in[I_GNG] + (size_t)j * 512 + dv);
            const u32x2 rr = *(const u32x2*)(Z + ZO_GR + (row0 + ti) * 512 + dv); f32x4 y;
            y[0] = o[mt][0] * rstd * ng[0] * siluf_(bitsf(rr.x << 16)); y[1] = o[mt][1] * rstd * ng[1] * siluf_(bitsf(rr.x & 0xffff0000u));
            y[2] = o[mt][2] * rstd * ng[2] * siluf_(bitsf(rr.y << 16)); y[3] = o[mt][3] * rstd * ng[3] * siluf_(bitsf(rr.y & 0xffff0000u));
            store4_t(Y + (row0 + ti) * D + dv, y); }
    }
#undef GLA_C_FETCH
}

constexpr int DK_ROW = 272, DV_ROW = 144, DF_VOFF = 64 * DK_ROW, DF_BUF = DF_VOFF + 128 * DV_ROW, DF_Q = 2 * DF_BUF;
DEVFN int dk_off(int key, int ch) { return key * DK_ROW + ch * 16; }
DEVFN int dv_off(int dv, int ch) { return dv * DV_ROW + ch * 16; }
DEVFN void phase_diff(const Params& p, unsigned char* lds, int l, int part) {
    const int j = l >> 1, tid = tidx(), lane = tid & 63, wave = tid >> 6, ql = lane & 31, hh = lane >> 5, qg = wave >> 1, m = wave & 1;
    const bf16* Z = (const bf16*)(p.ws + WS_Z); bf16* Y = (bf16*)(p.ws + WS_YMIX);
    constexpr int NQT = TS / 128, NQC = (LC + 127) / 128, NU = NB * 4 * (NQT + NQC);
    constexpr int NUL = NB * 4 * NQT;
    const int G_ = gridDim.x, u0 = part == 0 ? (int)blockIdx.x : NUL + ((int)blockIdx.x + G_ - (64 % G_)) % G_, uend = part == 0 ? NUL : NU;
    if (u0 >= uend) return;
    const float laminit = 0.8f - 0.6f * expf(-0.3f * (float)l);
    const float d1 = wave_sum(p.in[I_LQ1][j * 64 + lane] * p.in[I_LK1][j * 64 + lane]), d2 = wave_sum(p.in[I_LQ2][j * 64 + lane] * p.in[I_LK2][j * 64 + lane]);
    const float lam = expf(d1) - expf(d2) + laminit;
    for (int u = u0; u < uend; u += gridDim.x) { const bool isctx = u >= NUL; const int v = isctx ? u - NUL : u, per = isctx ? NQC : NQT;
        const int qt = isctx ? NQT + v % per : v % per, hd = (v / per) & 3, b = v / (per * 4);
        const int q0 = isctx ? (qt - NQT) * 128 : LC + qt * 128, nkt = (isctx ? LC : PT) / 64; const int qp = q0 + qg * 32 + ql; const size_t qrow = (size_t)b * PT + qp;
        const bool qvalid = !isctx || qp < LC;
        bf16x8 qf[4];
#pragma unroll
        for (int ks = 0; ks < 4; ++ks) qf[ks] = *(const bf16x8*)(Z + ZO_DQ + qrow * 512 + hd * 128 + m * 64 + ks * 16 + hh * 8);
        AttnState<4> st; attn_init(st);
        const bf16* ksrc[2]; const bf16* vsrc[2]; int klo[2], vlo[2];
#pragma unroll
        for (int i = 0; i < 2; ++i) { const int idx = i * NTH + tid; const int key = idx >> 4, kch = idx & 15, dv = idx >> 3, vch = idx & 7;
            ksrc[i] = Z + ZO_DK + ((size_t)b * PT + key) * 512 + hd * 128 + kch * 8; klo[i] = dk_off(key, kch);
            vsrc[i] = Z + ZO_DVT + ((size_t)(b * 4 + hd) * 128 + dv) * PT + vch * 8; vlo[i] = DF_VOFF + dv_off(dv, vch); }
        u32x4 rk0[2], rv0[2], rk1[2], rv1[2];
#define DF_LOAD(RK, RV, t) do { _Pragma("unroll") for (int i = 0; i < 2; ++i) { RK[i] = *(const u32x4*)(ksrc[i] + (size_t)(t) * 64 * 512); RV[i] = *(const u32x4*)(vsrc[i] + (t) * 64); } } while (0)
#define DF_STORE(RK, RV, buf) do { _Pragma("unroll") for (int i = 0; i < 2; ++i) { *(u32x4*)(lds + (buf) + klo[i]) = RK[i]; *(u32x4*)(lds + (buf) + vlo[i]) = RV[i]; } } while (0)
#define DF_COMPUTE(cur) do { f32x16 sA, sB; _Pragma("unroll") for (int i = 0; i < 16; ++i) { sA[i] = 0.f; sB[i] = 0.f; } \
            _Pragma("unroll") for (int ks = 0; ks < 4; ++ks) { sA = mfma32(*(const bf16x8*)(lds + (cur) + dk_off(ql, m * 8 + ks * 2 + hh)), qf[ks], sA); sB = mfma32(*(const bf16x8*)(lds + (cur) + dk_off(32 + ql, m * 8 + ks * 2 + hh)), qf[ks], sB); } \
            const unsigned char* vb = lds + (cur) + DF_VOFF + 16 * hh; \
            attn_update2<4>(st, sA, sB, [&](int st2, int mt, int ks) { return *(const bf16x8*)(vb + dv_off(mt * 32 + ql, st2 * 4 + ks * 2)); }); } while (0)
        __syncthreads();
        DF_LOAD(rk0, rv0, 0); DF_LOAD(rk1, rv1, 1);
        DF_STORE(rk0, rv0, 0);
        __syncthreads();
        for (int t = 0; t < nkt; t += 2) {
            if (t + 2 < nkt) DF_LOAD(rk0, rv0, t + 2);
            DF_COMPUTE(0);
            DF_STORE(rk1, rv1, DF_BUF);
            __syncthreads();
            if (t + 3 < nkt) DF_LOAD(rk1, rv1, t + 3);
            DF_COMPUTE(DF_BUF);
            if (t + 2 < nkt) DF_STORE(rk0, rv0, 0);
            __syncthreads();
        }
#undef DF_LOAD
#undef DF_STORE
#undef DF_COMPUTE
        float* xch = (float*)lds + (size_t)qg * 4096 + lane;
        if (m == 1) { const float f = lam / st.l;
#pragma unroll
            for (int mt = 0; mt < 4; ++mt)
#pragma unroll
                for (int r = 0; r < 16; ++r) xch[(mt * 16 + r) * 64] = st.o[mt][r] * f; }
        __syncthreads();
        if (m == 0) { const float i0 = 1.0f / st.l; float ss = 0.f;
#pragma unroll
            for (int mt = 0; mt < 4; ++mt)
#pragma unroll
                for (int r = 0; r < 16; ++r) { const float o = st.o[mt][r] * i0 - xch[(mt * 16 + r) * 64]; st.o[mt][r] = o; ss += o * o; }
            ss += __shfl_xor(ss, 32);
            const float rstd = (1.0f - laminit) / sqrtf(ss * (1.0f / 128.0f) + LN_EPS);
            if (qvalid) {
#pragma unroll
                for (int mt = 0; mt < 4; ++mt)
#pragma unroll
                    for (int q4 = 0; q4 < 4; ++q4) { const int dv = mt * 32 + 8 * q4 + 4 * hh; const f32x4 ng = *(const f32x4*)(p.in[I_DNG] + (size_t)j * 128 + dv); f32x4 o;
#pragma unroll
                        for (int k = 0; k < 4; ++k) o[k] = st.o[mt][q4 * 4 + k] * rstd * ng[k];
                        store4_t(Y + qrow * D + 512 + hd * 128 + dv, o); } }
        }
    }
}

enum { PH_CONVERT = 0, PH_INIT, PH_INPROJ_E, PH_S5A, PH_S5B_NAT, PH_S5C, PH_GLU, PH_INPROJ_O, PH_GLA_A, PH_GLAB_DIFF, PH_GLA_C, PH_GLA_B, PH_DIFF, PH_OUTPROJ, PH_LN1, PH_MOE_UP, PH_MOE_DOWN, PH_LN2, PH_COUNT };

#ifdef CPU_EMU
#define PHASEFN static
#else
#define PHASEFN __device__ __forceinline__
#endif
template <int PH> PHASEFN void run_phase(const Params& p, unsigned char* lds, int l) {
    if constexpr (PH == PH_CONVERT) phase_convert(p, lds);
    else if constexpr (PH == PH_INIT) phase_init_h(p);
    else if constexpr (PH == PH_INPROJ_E) phase_inproj_even(p, lds, l);
    else if constexpr (PH == PH_S5A) phase_s5a(p, lds, l >> 1);
    else if constexpr (PH == PH_S5B_NAT) { phase_s5b(p, l >> 1); phase_natten(p, lds, l >> 1); }
    else if constexpr (PH == PH_S5C) phase_s5c(p, lds, l >> 1);
    else if constexpr (PH == PH_GLU) phase_glu(p, lds, l >> 1);
    else if constexpr (PH == PH_INPROJ_O) phase_inproj_odd(p, lds, l);
    else if constexpr (PH == PH_GLA_A) { phase_gla_a(p, lds, l >> 1); phase_diff(p, lds, l, 1); }
    else if constexpr (PH == PH_GLAB_DIFF) { phase_gla_b(p); phase_diff(p, lds, l, 0); }
    else if constexpr (PH == PH_GLA_C) phase_gla_c(p, lds, l >> 1);
    else if constexpr (PH == PH_GLA_B) phase_gla_b(p);
    else if constexpr (PH == PH_DIFF) phase_diff(p, lds, l, 0);
    else if constexpr (PH == PH_OUTPROJ) phase_outproj(p, lds, l);
    else if constexpr (PH == PH_LN1) phase_ln1_route(p, lds, l);
    else if constexpr (PH == PH_MOE_UP) phase_moe_up(p, lds, l);
    else if constexpr (PH == PH_MOE_DOWN) phase_moe_down(p, lds, l);
    else if constexpr (PH == PH_LN2) phase_ln2(p, lds, l);
}

template <int PH> __global__ void __launch_bounds__(NTH, 2) k_phase(Params p, int l) { DECL_LDS; run_phase<PH>(p, lds, l); }

#ifdef CPU_EMU
static int g_grid = 8; static int g_stop_layer = 1000, g_stop_phase = 1000;
template <int PH> static bool launch_phase(const Params& p, int l, hipStream_t) {
    if (l > g_stop_layer || (l == g_stop_layer && PH > g_stop_phase)) return false;
    fprintf(stderr, "[emu] layer %d phase %d\n", l, PH);
    emu::launch([=] { k_phase<PH>(p, l); }, dim3(g_grid), dim3(NTH), LDS_BYTES); return true;
}
static void hipMemsetAsync(void* d, int v, size_t n, hipStream_t) { memset(d, v, n); }
#else
static int g_grid = 0;
template <int PH> static bool launch_phase(const Params& p, int l, hipStream_t s) {
    static bool attr = false;
    if (!attr) { (void)hipFuncSetAttribute((const void*)k_phase<PH>, hipFuncAttributeMaxDynamicSharedMemorySize, LDS_BYTES); attr = true; }
    hipLaunchKernelGGL(k_phase<PH>, dim3(g_grid), dim3(NTH), LDS_BYTES, s, p, l); return true;
}
#endif


__global__ void __launch_bounds__(NTH, 2) k_mega(Params p_arg) {
    DECL_LDS;
#ifdef CPU_EMU
    const Params& p = p_arg;
#else
    const Params& p = *(const Params*)(uintptr_t)__builtin_amdgcn_kernarg_segment_ptr();
#endif
#ifndef CPU_EMU
    if (threadIdx.x == 0) *(uint4*)(lds + LDS_BYTES) = make_uint4(0u, 0u, 0u, 0u);
    __syncthreads();
    XcdBarrier gbar = xcd_barrier_post((unsigned*)(p.ws + WS_CTL + CTL_BAR), (volatile LAS unsigned*)(lds + LDS_BYTES));
#endif
    run_phase<PH_CONVERT>(p, lds, -1); GRID_SYNC();
    if (PROBE_MASK & 2048) { run_phase<PH_CONVERT>(p, lds, -1); GRID_SYNC(); }
    run_phase<PH_INIT>(p, lds, -1); GRID_SYNC();
#define RP(ph, l, bit) do { run_phase<ph>(p, lds, l); GRID_SYNC(); if (PROBE_MASK & (bit)) { run_phase<ph>(p, lds, l); GRID_SYNC(); } } while (0)
#define MK_EVEN(l) do { RP(PH_INPROJ_E, l, 1); RP(PH_S5A, l, 2); RP(PH_S5B_NAT, l, 4); RP(PH_S5C, l, 8); RP(PH_GLU, l, 16); } while (0)
#define MK_ODD(l) do { RP(PH_INPROJ_O, l, 1); RP(PH_GLA_A, l, 32); run_phase<PH_GLA_B>(p, lds, l); RP(PH_DIFF, l, 64); RP(PH_GLA_C, l, 128); } while (0)
#define MK_TAIL(l) do { RP(PH_OUTPROJ, l, 256); run_phase<PH_LN1>(p, lds, l); GRID_SYNC(); RP(PH_MOE_UP, l, 512); RP(PH_MOE_DOWN, l, 1024); run_phase<PH_LN2>(p, lds, l); if ((l) + 1 < NL) GRID_SYNC(); } while (0)
    MK_EVEN(0); MK_TAIL(0);
    if (NL > 1) { MK_ODD(1); MK_TAIL(1); }
    if (NL > 2) { MK_EVEN(2); MK_TAIL(2); }
    if (NL > 3) { MK_ODD(3); MK_TAIL(3); }
}
#ifdef CPU_EMU
static void launch_mega(const Params& p, hipStream_t) { emu::launch([=] { k_mega(p); }, dim3(g_grid), dim3(NTH), LDS_TOTAL); }
#else
static void launch_mega(const Params& p, hipStream_t s) {
    static bool attr = false;
    if (!attr) { (void)hipFuncSetAttribute((const void*)k_mega, hipFuncAttributeMaxDynamicSharedMemorySize, LDS_TOTAL); attr = true; }
    hipLaunchKernelGGL(k_mega, dim3(g_grid), dim3(NTH), LDS_TOTAL, s, p);
}
#endif

extern "C" void kernel_launch(void* const* d_in, const int* in_sizes, int n_in, void* d_out, int out_size, void* d_ws, size_t ws_size, hipStream_t stream) {
#ifndef CPU_EMU
    if (g_grid == 0) { int dev = 0, cus = 0; (void)hipGetDevice(&dev); (void)hipDeviceGetAttribute(&cus, hipDeviceAttributeMultiprocessorCount, dev); g_grid = cus > 0 ? cus : 256; }
#endif
    if (n_in != N_IN || ws_size < WS_END) { fprintf(stderr, "kernel_launch: unexpected inputs (n_in %d) or workspace (%zu < %zu)\n", n_in, ws_size, (size_t)WS_END); return; }
    Params p{};
    for (int i = 0; i < N_IN; ++i) p.in[i] = (const float*)d_in[i];
    p.out = (float*)d_out; p.ws = (unsigned char*)d_ws;
    (void)hipMemsetAsync((char*)d_ws + WS_CTL, 0, CTL_BYTES, stream);
#if defined(MK_MULTI)
    launch_phase<PH_CONVERT>(p, -1, stream);
    launch_phase<PH_INIT>(p, -1, stream);
    for (int l = 0; l < NL; ++l) {
        if ((l & 1) == 0) { launch_phase<PH_INPROJ_E>(p, l, stream); launch_phase<PH_S5A>(p, l, stream); launch_phase<PH_S5B_NAT>(p, l, stream); launch_phase<PH_S5C>(p, l, stream); launch_phase<PH_GLU>(p, l, stream); }
        else { launch_phase<PH_INPROJ_O>(p, l, stream); launch_phase<PH_GLA_A>(p, l, stream); launch_phase<PH_GLAB_DIFF>(p, l, stream); launch_phase<PH_GLA_C>(p, l, stream); }
        launch_phase<PH_OUTPROJ>(p, l, stream); launch_phase<PH_LN1>(p, l, stream); launch_phase<PH_MOE_UP>(p, l, stream); launch_phase<PH_MOE_DOWN>(p, l, stream); launch_phase<PH_LN2>(p, l, stream);
    }
#else
    launch_mega(p, stream);
#endif
}

#ifdef CPU_EMU_MAIN
#include <string>
#include <fstream>
#include <sys/mman.h>
static void* guard_alloc(size_t n) { const size_t pg = 4096, tot = ((n + pg - 1) / pg + 2) * pg; char* b = (char*)mmap(nullptr, tot, PROT_READ | PROT_WRITE, MAP_PRIVATE | MAP_ANONYMOUS, -1, 0); mprotect(b, pg, PROT_NONE); mprotect(b + tot - pg, pg, PROT_NONE); return b + tot - pg - ((n + 255) & ~(size_t)255); }
static std::vector<float> load_npy(const std::string& fn, bool& ok) {
    std::ifstream f(fn, std::ios::binary); std::vector<float> v; ok = false; if (!f) return v;
    char hdr[10]; f.read(hdr, 10); int hl = (unsigned char)hdr[8] | ((unsigned char)hdr[9] << 8); std::string h(hl, ' '); f.read(&h[0], hl);
    f.seekg(0, std::ios::end); size_t n = ((size_t)f.tellg() - 10 - hl) / 4; f.seekg(10 + hl); v.resize(n); f.read((char*)v.data(), n * 4); ok = true; return v;
}
template <class G> static void check(const char* name, const std::vector<float>& ref, size_t rows, size_t cols, size_t ref_ld, size_t ref_c0, G get) {
    double num = 0, den = 0, mx = 0; size_t wr = 0, wc = 0;
    for (size_t r = 0; r < rows; ++r) for (size_t c = 0; c < cols; ++c) { const double a = get(r, c), b = ref[r * ref_ld + ref_c0 + c], e = a - b; num += e * e; den += b * b; if (fabs(e) > mx) { mx = fabs(e); wr = r; wc = c; } }
    printf("CHECK %-14s rvr=%.3e  maxabs=%.4f at (%zu,%zu) refrms=%.4f\n", name, num / (den + 1e-30), mx, wr, wc, sqrt(den / (rows * cols)));
}
int main(int argc, char** argv) {
    std::string dir = argv[1]; if (argc > 2) g_stop_layer = atoi(argv[2]); if (argc > 3) g_stop_phase = atoi(argv[3]); if (const char* e = getenv("EMU_GRID")) g_grid = atoi(e);
    std::vector<int> sizes; { std::ifstream f(dir + "/sizes.txt"); int s; while (f >> s) sizes.push_back(s); }
    if ((int)sizes.size() != N_IN) { printf("bad sizes\n"); return 1; }
    std::vector<void*> din(N_IN); { std::ifstream f(dir + "/inputs.bin", std::ios::binary); for (int i = 0; i < N_IN; ++i) { din[i] = guard_alloc((size_t)sizes[i] * 4); f.read((char*)din[i], (size_t)sizes[i] * 4); } }
    printf("WS_END = %.1f MB\n", WS_END / 1048576.0);
    unsigned char* ws = (unsigned char*)guard_alloc(WS_END); memset(ws, 0x7F, WS_END);
    std::vector<float> out((size_t)NB * TS * D, NAN);
    kernel_launch(din.data(), sizes.data(), N_IN, out.data(), (int)out.size(), ws, WS_END, nullptr);
    const int L = g_stop_layer < NL ? g_stop_layer : NL - 1; const int PHS = g_stop_layer < NL ? g_stop_phase : 1000; bool ok; char nm[64];
    const bf16* Z = (const bf16*)(ws + WS_Z); const bf16* Y = (const bf16*)(ws + WS_YMIX); const bf16* H = (const bf16*)(ws + WS_H);
    auto ref = [&](const char* what) { snprintf(nm, 64, "/L%d_%s.npy", L, what); return load_npy(dir + nm, ok); };
    if (PHS >= PH_INPROJ_E || PHS >= PH_INPROJ_O) {
        auto a = ref("a"); if (ok && PHS < PH_LN1) check("abf", a, MR, D, D, 0, [&](size_t r, size_t c) { return bf2f(((const bf16*)(ws + WS_ABF))[r * D + c]); });
        auto z = ref("z");
        if (ok && (L & 1) == 0 && PHS < PH_OUTPROJ) {
            check("z.u", z, MR, 512, 2048, 0, [&](size_t r, size_t c) { return bf2f(Z[ZE_U + r * 512 + c]); });
            check("z.q", z, MR, 512, 2048, 512, [&](size_t r, size_t c) { return bf2f(Z[ZE_Q + r * 512 + c]) / QSCALE; });
            check("z.k", z, MR, 512, 2048, 1024, [&](size_t r, size_t c) { return bf2f(Z[ZE_K + r * 512 + c]); });
            check("z.v", z, MR, 512, 2048, 1536, [&](size_t r, size_t c) { size_t b = r / PT, pp = r % PT; return bf2f(Z[ZE_VT + ((b * 8 + c / 64) * 64 + c % 64) * PT + vperm((int)pp)]); });
        }
        if (ok && (L & 1) == 1 && PHS < PH_OUTPROJ) {
            check("z.gq", z, MR, 256, ODD_N, 0, [&](size_t r, size_t c) { return bf2f(Z[ZO_GQ + r * 256 + c]) * 8.f; });
            check("z.gk", z, MR, 256, ODD_N, 256, [&](size_t r, size_t c) { return bf2f(Z[ZO_GK + r * 256 + c]); });
            check("z.gkt", z, MR, 256, ODD_N, 256, [&](size_t r, size_t c) { size_t b = r / PT, pp = r % PT; return bf2f(Z[ZO_GKT + ((b * 4 + c / 64) * 64 + c % 64) * PT + pp]); });
            check("z.gvt", z, MR, 512, ODD_N, 512, [&](size_t r, size_t c) { size_t b = r / PT, pp = r % PT; return bf2f(Z[ZO_GVT + ((b * 4 + c / 128) * 128 + c % 128) * PT + pp]); });
            check("z.gr", z, MR, 512, ODD_N, 1024, [&](size_t r, size_t c) { return bf2f(Z[ZO_GR + r * 512 + c]); });
            check("z.gz", z, MR, 32, ODD_N, 1536, [&](size_t r, size_t c) { return bf2f(Z[ZO_GZ + r * 32 + c]); });
            check("z.dvt", z, MR, 512, ODD_N, 2592, [&](size_t r, size_t c) { size_t b = r / PT, pp = r % PT; return bf2f(Z[ZO_DVT + ((b * 4 + c / 128) * 128 + c % 128) * PT + vperm((int)pp)]); });
            check("z.dq(ctx rows)", z, LC, 512, ODD_N, 1568, [&](size_t r, size_t c) { return bf2f(Z[ZO_DQ + r * 512 + c]) / QSCALE; });
            check("z.dk(ctx rows)", z, LC, 512, ODD_N, 2080, [&](size_t r, size_t c) { return bf2f(Z[ZO_DK + r * 512 + c]); });
        }
    }
    if ((L & 1) == 0 && PHS >= PH_S5C && PHS < PH_MOE_DOWN) { auto s = ref("s5pre"); for (auto& x : s) x = geluf_(x); if (ok) check("gelu(s5pre)", s, MR, 512, 512, 0, [&](size_t r, size_t c) { return bf2f(((const bf16*)(ws + WS_SB + SBO_GS))[r * 512 + c]); }); }
    if (PHS >= PH_GLU && PHS >= PH_GLA_C) { auto m = ref("mix"); if (ok) { check("mix[0:512]", m, MR, 512, D, 0, [&](size_t r, size_t c) { return bf2f(Y[r * D + c]); }); check("mix[512:]", m, MR, 512, D, 512, [&](size_t r, size_t c) { return bf2f(Y[r * D + 512 + c]); }); } }
    else if (PHS >= PH_S5B_NAT) { auto m = ref("mix"); if (ok) { check("mix[0:512]", m, MR, 512, D, 0, [&](size_t r, size_t c) { return bf2f(Y[r * D + c]); }); check("mix[512:]", m, MR, 512, D, 512, [&](size_t r, size_t c) { return bf2f(Y[r * D + 512 + c]); }); } }
    if (PHS >= PH_OUTPROJ && PHS < PH_LN2) { auto y = ref("y"); if (ok && PHS < PH_MOE_UP) check("y", y, MR, D, D, 0, [&](size_t r, size_t c) { return bf2f(((const bf16*)(ws + WS_Z))[r * D + c]); }); }
    if (PHS >= PH_LN1 && PHS < PH_LN2) { auto h = ref("h1"); if (ok) check("h1", h, MR, D, D, 0, [&](size_t r, size_t c) { return bf2f(H[r * D + c]); });
        std::vector<int> eid; { snprintf(nm, 64, "/L%d_eid.npy", L); auto e = load_npy(dir + nm, ok); if (ok) { const int* ep = (const int*)e.data(); const int* rt = (const int*)(ws + WS_ROUTE); int bad = 0; for (int r = 0; r < MR; ++r) if (rt[r * 4] != ep[r * 2] || rt[r * 4 + 1] != ep[r * 2 + 1]) ++bad; printf("CHECK routing mismatches: %d / %d\n", bad, MR); } } }
    if (PHS >= PH_MOE_DOWN && PHS < PH_LN2) { auto f = ref("f"); if (ok) { const unsigned* cnt = (const unsigned*)(ws + WS_CTL + CTL_CNT) + L * NEXP; const int* rt = (const int*)(ws + WS_ROUTE); const bf16* F2 = (const bf16*)(ws + WS_SB);
        check("moe f", f, MR, D, D, 0, [&](size_t r, size_t c) { size_t r0 = (size_t)moe_off(cnt, rt[r * 4]) + rt[r * 4 + 2], r1 = (size_t)moe_off(cnt, rt[r * 4 + 1]) + rt[r * 4 + 3]; return bf2f(F2[r0 * D + c]) + bf2f(F2[r1 * D + c]); }); } }
    if (PHS >= PH_LN2 && L + 1 < NL) { auto h = ref("h2"); if (ok) check("h2", h, MR, D, D, 0, [&](size_t r, size_t c) { return bf2f(H[r * D + c]); }); }
    if (g_stop_layer >= NL) { auto o = load_npy(dir + "/ref_out.npy", ok); if (ok) { std::vector<float> of(o.size() / 2); const double* od = (const double*)o.data(); for (size_t i = 0; i < of.size(); ++i) of[i] = (float)od[i];
        check("FINAL out", of, (size_t)NB * TS, D, D, 0, [&](size_t r, size_t c) { return out[r * D + c]; }); } }
    return 0;
}
#endif
```
